# Optimizing an MI355X kernel written in HIP

```python
import math
import jax
import jax.numpy as jnp
from jax import lax
import numpy as np

D_MODEL = 1024
BATCH = 8
SEQ = 4096
DEPTH = 4

CTX_LEN = 256
GRID_W = 64
MIX_WIDTH = D_MODEL
ATT_QK = 64
ATT_V = 2 * ATT_QK
ATT_WIDTH = MIX_WIDTH // 2
ATT_HEADS = ATT_WIDTH // ATT_V
SSM_INNER = MIX_WIDTH // 4
SSM_HEAD_DIM = 64
SSM_HEADS = SSM_INNER // SSM_HEAD_DIM
SSM_GROUPS = 2
SSM_STATE = 128
SSM_XBC = SSM_INNER + 2 * SSM_GROUPS * SSM_STATE
CONV_W = 5
RET_WIDTH = MIX_WIDTH // 4
RET_DIM = 64
RET_HEADS = RET_WIDTH // RET_DIM
IN_SIZES = (ATT_HEADS * 2 * ATT_QK, ATT_HEADS * 2 * ATT_QK, ATT_WIDTH, SSM_INNER, SSM_XBC, SSM_HEADS, RET_WIDTH, RET_WIDTH, RET_WIDTH, RET_WIDTH)
IN_COLS = sum(IN_SIZES)
D_FF = 2816
CHUNK = 128
ATT_BLOCK = 128
ROPE_BASE = 10000.0
LN_EPS = 1e-5
RMS_EPS = 1e-6
DEEPNORM_ALPHA = (2 * DEPTH) ** 0.25
DEEPNORM_BETA = (8 * DEPTH) ** -0.25

kernel_name = 'hybrid_diffattn_ssd_retention_dit'


def layer_norm(h, g, b):
    hf = h.astype(jnp.float32)
    mu = jnp.mean(hf, axis=-1, keepdims=True)
    var = jnp.mean(jnp.square(hf - mu), axis=-1, keepdims=True)
    return ((hf - mu) * lax.rsqrt(var + LN_EPS)).astype(h.dtype) * g + b


def group_norm(h):
    hf = h.astype(jnp.float32)
    mu = jnp.mean(hf, axis=-1, keepdims=True)
    var = jnp.mean(jnp.square(hf - mu), axis=-1, keepdims=True)
    return ((hf - mu) * lax.rsqrt(var + LN_EPS)).astype(h.dtype)


def rms_norm(h, g):
    hf = h.astype(jnp.float32)
    return (hf * lax.rsqrt(jnp.mean(jnp.square(hf), axis=-1, keepdims=True) + RMS_EPS)).astype(h.dtype) * g


def rotate(h, ang):
    cos = jnp.cos(ang).astype(h.dtype)
    sin = jnp.sin(ang).astype(h.dtype)
    h1, h2 = jnp.split(h, 2, axis=-1)
    return jnp.concatenate([h1 * cos - h2 * sin, h2 * cos + h1 * sin], axis=-1)


def axial_rotary(h, ang_row, ang_col):
    hr, hc = jnp.split(h, 2, axis=-1)
    return jnp.concatenate([rotate(hr, ang_row), rotate(hc, ang_col)], axis=-1)


def swiglu(h, wg, wu, wd):
    return (jax.nn.silu(h @ wg) * (h @ wu)) @ wd


def sublayer_in(h, m, i):
    return h * (1.0 + m[..., i, 1, :]) + m[..., i, 0, :]


def residual(h, sub, m, i, g, b):
    return layer_norm(DEEPNORM_ALPHA * h + (1.0 + m[..., i, 2, :]) * sub, g, b)


def split_cols(p):
    idx = []
    acc = 0
    for s in IN_SIZES[:-1]:
        acc += s
        idx.append(acc)
    return jnp.split(p, idx, axis=-1)


def dwconv(u, w, bias):
    k = w.shape[0]
    out = lax.conv_general_dilated(u, w[:, None, :], window_strides=(1,), padding=[(k // 2, k // 2)],
                                   dimension_numbers=('NWC', 'WIO', 'NWC'), feature_group_count=u.shape[-1])
    return out + bias


def diff_attend(q, k, v, lam):
    s = jnp.einsum('bqhmd,bkhmd->bhmqk', q, k).astype(jnp.float32) * (ATT_QK ** -0.5)
    p = jax.nn.softmax(s, axis=-1)
    a = (p[:, :, 0] - lam * p[:, :, 1]).astype(v.dtype)
    return jnp.einsum('bhqk,bkhe->bqhe', a, v)


def chunked_scan(q, k, v, log_a, h0):
    b, L, h, n = q.shape
    p = v.shape[-1]
    nc = L // CHUNK
    qc = q.reshape(b, nc, CHUNK, h, n)
    kc = k.reshape(b, nc, CHUNK, h, n)
    vc = v.reshape(b, nc, CHUNK, h, p)
    a_cum = jnp.cumsum(log_a.astype(jnp.float32).reshape(b, nc, CHUNK, h), axis=2)
    seg = a_cum[:, :, :, None, :] - a_cum[:, :, None, :, :]
    lower = jnp.tril(jnp.ones((CHUNK, CHUNK), dtype=bool))[:, :, None]
    decay = jnp.exp(jnp.where(lower, seg, -jnp.inf)).astype(v.dtype)
    scores = jnp.einsum('bclhn,bcshn->bclsh', qc, kc) * decay
    y_diag = jnp.einsum('bclsh,bcshp->bclhp', scores, vc)
    to_end = jnp.exp(a_cum[:, :, -1:, :] - a_cum).astype(v.dtype)
    chunk_states = jnp.einsum('bcshn,bcshp->bchpn', kc * to_end[..., None], vc)
    chunk_decay = jnp.exp(a_cum[:, :, -1, :]).astype(v.dtype)

    def step(s, inp):
        st, dec = inp
        return s * dec[:, :, None, None] + st, s

    h_final, h_enter = lax.scan(step, h0, (jnp.moveaxis(chunk_states, 1, 0), jnp.moveaxis(chunk_decay, 1, 0)))
    h_enter = jnp.moveaxis(h_enter, 0, 1)
    from_start = jnp.exp(a_cum).astype(v.dtype)
    y_off = jnp.einsum('bclhn,bchpn->bclhp', qc * from_start[..., None], h_enter)
    return (y_diag + y_off).reshape(b, L, h, p), h_final


def final_state(k, v, log_a):
    a_cum = jnp.cumsum(log_a.astype(jnp.float32), axis=1)
    w = jnp.exp(a_cum[:, -1:, :] - a_cum).astype(v.dtype)
    return jnp.einsum('blhn,blhp->bhpn', k * w[..., None], v)


def directional_scan(q_l, k_l, v_l, la_l, q_c, k_c, v_c, la_c, reverse, need_ctx):
    if reverse:
        q_l, k_l, v_l, la_l, q_c, k_c, v_c, la_c = [jnp.flip(t, axis=1) for t in (q_l, k_l, v_l, la_l, q_c, k_c, v_c, la_c)]
    if need_ctx:
        b, _, h, n = k_c.shape
        h0 = jnp.zeros((b, h, v_c.shape[-1], n), v_c.dtype)
        y_c, h_ctx = chunked_scan(q_c, k_c, v_c, la_c, h0)
    else:
        y_c, h_ctx = None, final_state(k_c, v_c, la_c)
    y_l, _ = chunked_scan(q_l, k_l, v_l, la_l, h_ctx)
    if reverse:
        y_l = jnp.flip(y_l, axis=1)
        if need_ctx:
            y_c = jnp.flip(y_c, axis=1)
    return y_l, y_c


def ssm_streams(xbc, conv_w, conv_b):
    b, L, _ = xbc.shape
    u = jax.nn.silu(dwconv(xbc, conv_w, conv_b))
    xs, bm, cm = jnp.split(u, [SSM_INNER, SSM_INNER + SSM_GROUPS * SSM_STATE], axis=-1)
    rep = SSM_HEADS // SSM_GROUPS
    xs = xs.reshape(b, L, SSM_HEADS, SSM_HEAD_DIM)
    bm = jnp.repeat(bm.reshape(b, L, SSM_GROUPS, SSM_STATE), rep, axis=2)
    cm = jnp.repeat(cm.reshape(b, L, SSM_GROUPS, SSM_STATE), rep, axis=2)
    return xs, bm, cm


def ssm_step_inputs(xs, dt_raw, a_log, dt_bias):
    dt = jax.nn.softplus(dt_raw.astype(jnp.float32) + dt_bias.astype(jnp.float32))
    la = -dt * jnp.exp(a_log.astype(jnp.float32))
    return xs * dt[..., None].astype(xs.dtype), la


def hybrid_mixer(u_l, u_c, w_in, conv_w, conv_b, att_lambda, att_subln_g, lam_init, ssm_a_log, ssm_dt_bias, ssm_d,
                 ssm_norm_g, ret_log_gamma, w_out, ang_row, ang_col, ret_ang, need_ctx):
    b, S, _ = u_l.shape
    lc = u_c.shape[1]
    aq_l, ak_l, av_l, z_l, xbc_l, dt_l, rq_l, rk_l, rv_l, rg_l = split_cols(u_l @ w_in)
    aq_c, ak_c, av_c, z_c, xbc_c, dt_c, rq_c, rk_c, rv_c, rg_c = split_cols(u_c @ w_in)

    q_l = axial_rotary(aq_l.reshape(b, S, ATT_HEADS, 2, ATT_QK), ang_row, ang_col)
    k_l = axial_rotary(ak_l.reshape(b, S, ATT_HEADS, 2, ATT_QK), ang_row, ang_col)
    v_l = av_l.reshape(b, S, ATT_HEADS, ATT_V)
    k_c = ak_c.reshape(b, lc, ATT_HEADS, 2, ATT_QK)
    v_c = av_c.reshape(b, lc, ATT_HEADS, ATT_V)
    lv = att_lambda.astype(jnp.float32)
    lam = jnp.exp(jnp.sum(lv[0] * lv[1])) - jnp.exp(jnp.sum(lv[2] * lv[3])) + lam_init
    k_all = jnp.concatenate([k_l, k_c], axis=1)
    v_all = jnp.concatenate([v_l, v_c], axis=1)
    q_blocks = jnp.moveaxis(q_l.reshape(b, S // ATT_BLOCK, ATT_BLOCK, ATT_HEADS, 2, ATT_QK), 1, 0)
    o_l = lax.map(lambda qb: diff_attend(qb, k_all, v_all, lam), q_blocks)
    o_l = jnp.moveaxis(o_l, 0, 1).reshape(b, S, ATT_HEADS, ATT_V)

    xs_l, bm_l, cm_l = ssm_streams(xbc_l, conv_w, conv_b)
    xs_c, bm_c, cm_c = ssm_streams(xbc_c, conv_w, conv_b)
    ys_l, ys_c = [], []
    for d in range(2):
        vd_l, la_l = ssm_step_inputs(xs_l, dt_l, ssm_a_log[d], ssm_dt_bias[d])
        vd_c, la_c = ssm_step_inputs(xs_c, dt_c, ssm_a_log[d], ssm_dt_bias[d])
        yl, yc = directional_scan(cm_l, bm_l, vd_l, la_l, cm_c, bm_c, vd_c, la_c, d == 1, need_ctx)
        skip = ssm_d[d][:, None]
        ys_l.append(yl + skip * xs_l)
        if need_ctx:
            ys_c.append(yc + skip * xs_c)

    rq_l = rotate(rq_l.reshape(b, S, RET_HEADS, RET_DIM), ret_ang)
    rk_l = rotate(rk_l.reshape(b, S, RET_HEADS, RET_DIM), ret_ang) * (RET_DIM ** -0.5)
    rv_l = rv_l.reshape(b, S, RET_HEADS, RET_DIM)
    rq_c = rq_c.reshape(b, lc, RET_HEADS, RET_DIM)
    rk_c = rk_c.reshape(b, lc, RET_HEADS, RET_DIM) * (RET_DIM ** -0.5)
    rv_c = rv_c.reshape(b, lc, RET_HEADS, RET_DIM)
    yr_l, yr_c = [], []
    for d in range(2):
        la_l = jnp.broadcast_to(ret_log_gamma[d], (b, S, RET_HEADS))
        la_c = jnp.broadcast_to(ret_log_gamma[d], (b, lc, RET_HEADS))
        yl, yc = directional_scan(rq_l, rk_l, rv_l, la_l, rq_c, rk_c, rv_c, la_c, d == 1, need_ctx)
        yr_l.append(yl)
        yr_c.append(yc)

    def merge(o_att, y_ssm, z, y_ret, g, L):
        att = (rms_norm(o_att, att_subln_g) * (1.0 - lam_init)).reshape(b, L, ATT_WIDTH)
        ssm = rms_norm(y_ssm.reshape(b, L, SSM_INNER) * jax.nn.silu(z), ssm_norm_g)
        ret = group_norm(y_ret).reshape(b, L, RET_WIDTH) * jax.nn.silu(g)
        return jnp.concatenate([att, ssm, ret], axis=-1) @ w_out

    out_l = merge(o_l, ys_l[0] + ys_l[1], z_l, yr_l[0] + yr_l[1], rg_l, S)
    out_c = None
    if need_ctx:
        q_c = aq_c.reshape(b, lc, ATT_HEADS, 2, ATT_QK)
        o_c = diff_attend(q_c, k_c, v_c, lam)
        out_c = merge(o_c, ys_c[0] + ys_c[1], z_c, yr_c[0] + yr_c[1], rg_c, lc)
    return out_l, out_c


def setup_inputs(seed: int = 0) -> dict:
    key = jax.random.key(seed)
    ks = jax.random.split(key, 24)
    f32 = jnp.float32

    def nrm(k, shape, scale):
        return jax.random.normal(k, shape, f32) * scale

    x = nrm(ks[0], (BATCH, SEQ, D_MODEL), 1.0)
    c = nrm(ks[1], (BATCH, D_MODEL), 1.0)
    ctx = nrm(ks[2], (BATCH, CTX_LEN, D_MODEL), 1.0)
    c_ctx = nrm(ks[3], (D_MODEL,), 1.0)
    ada_w = nrm(ks[4], (DEPTH, D_MODEL, 9 * D_MODEL), 0.5 * D_MODEL ** -0.5)
    ada_b = nrm(ks[5], (DEPTH, 9 * D_MODEL), 0.02)
    norm_g = 1.0 + nrm(ks[6], (DEPTH, 3, D_MODEL), 0.05)
    norm_b = nrm(ks[7], (DEPTH, 3, D_MODEL), 0.02)
    ffn_w_gate = nrm(ks[8], (DEPTH, 2, D_MODEL, D_FF), D_MODEL ** -0.5)
    ffn_w_up = nrm(ks[9], (DEPTH, 2, D_MODEL, D_FF), D_MODEL ** -0.5)
    ffn_w_down = nrm(ks[10], (DEPTH, 2, D_FF, D_MODEL), DEEPNORM_BETA * D_FF ** -0.5)
    w_in = nrm(ks[11], (DEPTH, D_MODEL, IN_COLS), D_MODEL ** -0.5)
    conv_w = nrm(ks[12], (DEPTH, CONV_W, SSM_XBC), CONV_W ** -0.5)
    conv_b = nrm(ks[13], (DEPTH, SSM_XBC), 0.02)
    att_lambda = nrm(ks[14], (DEPTH, 4, ATT_QK), 0.1)
    att_subln_g = 1.0 + nrm(ks[15], (DEPTH, ATT_V), 0.05)
    ssm_a_log = jnp.log(jax.random.uniform(ks[16], (DEPTH, 2, SSM_HEADS), f32, 1.0, 16.0))
    dt0 = jnp.exp(jax.random.uniform(ks[17], (DEPTH, 2, SSM_HEADS), f32, math.log(1e-3), math.log(1e-1)))
    ssm_dt_bias = dt0 + jnp.log(-jnp.expm1(-dt0))
    ssm_d = 1.0 + nrm(ks[18], (DEPTH, 2, SSM_HEADS), 0.1)
    ssm_norm_g = 1.0 + nrm(ks[19], (DEPTH, SSM_INNER), 0.05)
    jitter = jax.random.uniform(ks[20], (DEPTH, 2, RET_HEADS), f32)
    ret_log_gamma = jnp.log1p(-jnp.exp2(-(5.0 + jnp.arange(RET_HEADS, dtype=f32) + 0.5 * jitter)))
    w_out = nrm(ks[21], (DEPTH, MIX_WIDTH, D_MODEL), DEEPNORM_BETA * MIX_WIDTH ** -0.5)
    return {'x': x, 'c': c, 'ctx': ctx, 'c_ctx': c_ctx, 'ada_w': ada_w, 'ada_b': ada_b, 'norm_g': norm_g,
            'norm_b': norm_b, 'ffn_w_gate': ffn_w_gate, 'ffn_w_up': ffn_w_up, 'ffn_w_down': ffn_w_down,
            'w_in': w_in, 'conv_w': conv_w, 'conv_b': conv_b, 'att_lambda': att_lambda,
            'att_subln_g': att_subln_g, 'ssm_a_log': ssm_a_log, 'ssm_dt_bias': ssm_dt_bias, 'ssm_d': ssm_d,
            'ssm_norm_g': ssm_norm_g, 'ret_log_gamma': ret_log_gamma, 'w_out': w_out}


def reference(x, c, ctx, c_ctx, ada_w, ada_b, norm_g, norm_b, ffn_w_gate, ffn_w_up, ffn_w_down, w_in, conv_w,
              conv_b, att_lambda, att_subln_g, ssm_a_log, ssm_dt_bias, ssm_d, ssm_norm_g, ret_log_gamma, w_out):
    b, S, D = x.shape
    rows = S // GRID_W
    f32 = jnp.float32
    row_pos = jnp.repeat(jnp.arange(rows, dtype=f32), GRID_W)
    col_pos = jnp.tile(jnp.arange(GRID_W, dtype=f32), rows)
    axis_dim = ATT_QK // 2
    axis_freq = 1.0 / (ROPE_BASE ** (jnp.arange(0, axis_dim, 2, dtype=f32) / axis_dim))
    ang_row = (row_pos[:, None] * axis_freq)[:, None, None, :]
    ang_col = (col_pos[:, None] * axis_freq)[:, None, None, :]
    ret_freq = 1.0 / (ROPE_BASE ** jnp.linspace(0.0, 1.0, RET_DIM // 2, dtype=f32))
    ret_ang = (jnp.arange(S, dtype=f32)[:, None] * ret_freq)[:, None, :]

    sc = jax.nn.silu(c)
    scc = jax.nn.silu(c_ctx)
    xc = ctx
    for l in range(DEPTH):
        need_ctx = l < DEPTH - 1
        lam_init = 0.8 - 0.6 * math.exp(-0.3 * l)
        m_l = (sc @ ada_w[l] + ada_b[l]).reshape(b, 1, 3, 3, D)
        m_c = (scc @ ada_w[l] + ada_b[l]).reshape(3, 3, D)
        x_new = residual(x, 0.5 * swiglu(sublayer_in(x, m_l, 0), ffn_w_gate[l, 0], ffn_w_up[l, 0], ffn_w_down[l, 0]),
                         m_l, 0, norm_g[l, 0], norm_b[l, 0])
        xc = residual(xc, 0.5 * swiglu(sublayer_in(xc, m_c, 0), ffn_w_gate[l, 0], ffn_w_up[l, 0], ffn_w_down[l, 0]),
                      m_c, 0, norm_g[l, 0], norm_b[l, 0])
        x = x_new
        y_l, y_c = hybrid_mixer(sublayer_in(x, m_l, 1), sublayer_in(xc, m_c, 1), w_in[l], conv_w[l], conv_b[l],
                                att_lambda[l], att_subln_g[l], lam_init, ssm_a_log[l], ssm_dt_bias[l], ssm_d[l],
                                ssm_norm_g[l], ret_log_gamma[l], w_out[l], ang_row, ang_col, ret_ang, need_ctx)
        x = residual(x, y_l, m_l, 1, norm_g[l, 1], norm_b[l, 1])
        x = residual(x, 0.5 * swiglu(sublayer_in(x, m_l, 2), ffn_w_gate[l, 1], ffn_w_up[l, 1], ffn_w_down[l, 1]),
                     m_l, 2, norm_g[l, 2], norm_b[l, 2])
        if need_ctx:
            xc = residual(xc, y_c, m_c, 1, norm_g[l, 1], norm_b[l, 1])
            xc = residual(xc, 0.5 * swiglu(sublayer_in(xc, m_c, 2), ffn_w_gate[l, 1], ffn_w_up[l, 1], ffn_w_down[l, 1]),
                          m_c, 2, norm_g[l, 2], norm_b[l, 2])
    return x
```

```cpp
#include <hip/hip_runtime.h>
#include <hip/hip_cooperative_groups.h>
#include <cstdio>
#include <cstdint>
#include <cmath>
namespace cg = cooperative_groups;

namespace pg8 {
#define PG8_LAS __attribute__((address_space(3)))
typedef unsigned short bf16_t;
typedef short bf16x8 __attribute__((ext_vector_type(8)));
typedef float f32x4 __attribute__((ext_vector_type(4)));
typedef unsigned u32x4 __attribute__((ext_vector_type(4)));
constexpr int BM = 256, BK = 64, HALF = 128, HTB = HALF * BK * 2  , STAGE_BYTES = 8 * HTB, NXCD = 8, WGM = 8;

__host__ __device__ __forceinline__ int lds_byte(int r, int c) { const int st = (r >> 4) * 2 + (c >> 5), rr = r & 15, cc = c & 31, ob = rr * 64 + cc * 2; return st * 1024 + (ob ^ (((ob >> 9) & 1) << 5)); }
__host__ __device__ __forceinline__ void stage_rc(int b, int& R, int& C) { const int st = b / 1024, sb = b % 1024, swz = sb ^ (((sb >> 9) & 1) << 5); R = (st >> 1) * 16 + swz / 64; C = (st & 1) * 32 + (swz % 64) / 2; }
__host__ __device__ __forceinline__ int perm32(int rho) { const int n = rho >> 4, i = rho & 15; return 8 * (i >> 2) + 4 * n + (i & 3); }

struct Unit { int pm, pn; };
struct Gemm { const bf16_t* A; const bf16_t* Bt; int M, N, K, ld; };

struct StaticOrder {
    int nM, nN, nwg, G, c;
    __host__ __device__ void init(int M, int N, int G_, int c_) { nM = M / BM; nN = N / BM; nwg = nM * nN; G = G_; c = c_; }
    __host__ __device__ bool next(int i, Unit& u) const {
        const long L = (long)i * G + c; if (L >= nwg) return false;
        int wgid = (int)L; { const int q = nwg / NXCD, r = nwg % NXCD, xcd = wgid % NXCD, off = wgid / NXCD; wgid = (xcd < r ? xcd * (q + 1) : r * (q + 1) + (xcd - r) * q) + off; }
        const int nig = WGM * nN, gid = wgid / nig, fm = gid * WGM, gsz = (nM - fm) < WGM ? (nM - fm) : WGM;
        u.pm = fm + ((wgid % nig) % gsz); u.pn = (wgid % nig) / gsz; return true;
    }
    __device__ __forceinline__ void a_ready(const Unit&) const {}
    __device__ __forceinline__ void done(const Unit&) const {}
};

__device__ __forceinline__ unsigned cvt_pk_bf16(float lo, float hi) { unsigned r; asm volatile("v_cvt_pk_bf16_f32 %0, %1, %2" : "=v"(r) : "v"(lo), "v"(hi)); return r; }
template <class Epi, class Sched, bool ALIGN_EPI = false, bool SP2 = false>
__device__ __forceinline__ void gemm_phase(PG8_LAS unsigned char* lds, const Gemm g, const Sched& S, const Epi& E, const int tid) {
    const int wid = __builtin_amdgcn_readfirstlane(tid >> 6), lane = tid & 63, wr = wid >> 2, wc = wid & 3, fr = lane & 15, fq = lane >> 4;
    const int K = g.K, nt = K / BK;
    unsigned voffA[2], voffB[2];
#pragma unroll
    for (int i = 0; i < 2; ++i) { int R, C; stage_rc(tid * 16 + i * 8192, R, C); const int Rb = Epi::PERM ? ((R & ~31) + perm32(R & 31)) : R;
        voffA[i] = (unsigned)(R * g.ld + C) * 2u; voffB[i] = (unsigned)(Rb * g.ld + C) * 2u; }
    const size_t kstep = (size_t)(BK * 2);
    const size_t hstep = (size_t)HALF * g.ld * 2;
    const size_t tstep = 2 * hstep;
    const unsigned ldsw = (unsigned)wid * 1024u;
    const int aoff = lds_byte(wr * 64 + fr, fq * 8), boff = lds_byte(wc * 32 + fr, fq * 8);
#define PG8_SA(b, h) (((b) * 2 + (h)) * HTB)
#define PG8_SB(b, h) ((4 + (b) * 2 + (h)) * HTB)
#define PG8_STAGE(bufoff, gbase, voff) do { _Pragma("unroll") for (int _i = 0; _i < 2; ++_i) \
        __builtin_amdgcn_global_load_lds((const unsigned*)((const char*)(gbase) + (voff)[_i]), (PG8_LAS unsigned*)(lds + (bufoff) + ldsw + _i * 8192), 16, 0, 0); } while (0)
#define PG8_LDA(dst, b, h) do { _Pragma("unroll") for (int m = 0; m < 4; ++m) _Pragma("unroll") for (int k = 0; k < 2; ++k) dst[m][k] = *(const PG8_LAS bf16x8*)(lds + PG8_SA(b, h) + aoff + m * 2048 + k * 1024); } while (0)
#define PG8_LDB(dst, b, h) do { _Pragma("unroll") for (int n = 0; n < 2; ++n) _Pragma("unroll") for (int k = 0; k < 2; ++k) dst[n][k] = *(const PG8_LAS bf16x8*)(lds + PG8_SB(b, h) + boff + n * 2048 + k * 1024); } while (0)
#define PG8_MMA(ai, bj, At, Bt) do { __builtin_amdgcn_s_setprio(1); _Pragma("unroll") for (int m = 0; m < 4; ++m) _Pragma("unroll") for (int n = 0; n < 2; ++n) _Pragma("unroll") for (int k = 0; k < 2; ++k) \
        acc[ai][bj][m][n] = __builtin_amdgcn_mfma_f32_16x16x32_bf16(Bt[n][k], At[m][k], acc[ai][bj][m][n], 0, 0, 0); __builtin_amdgcn_s_setprio(0); } while (0)
#define PG8_WAIT_V(n) asm volatile("s_waitcnt vmcnt(" #n ")" ::: "memory")
#define PG8_WAIT_L(n) asm volatile("s_waitcnt lgkmcnt(" #n ")" ::: "memory")
#define PG8_BAR __builtin_amdgcn_s_barrier()
#define PG8_SCHED __builtin_amdgcn_sched_barrier(0)
    Unit cur, nxt; int ui = 0;
    if (!S.next(0, cur)) return;
    f32x4 acc[2][2][4][2];
#pragma unroll
    for (int a = 0; a < 2; ++a)
#pragma unroll
        for (int b = 0; b < 2; ++b)
#pragma unroll
            for (int m = 0; m < 4; ++m)
#pragma unroll
                for (int n = 0; n < 2; ++n) acc[a][b][m][n] = (f32x4){0.f, 0.f, 0.f, 0.f};
    bf16x8 At[4][2], B0[2][2], B1[2][2];
    const char* cA = (const char*)g.A + (size_t)cur.pm * tstep; const char* cB = (const char*)g.Bt + (size_t)cur.pn * tstep;
    S.a_ready(cur);
    if constexpr (SP2) {
        PG8_STAGE(PG8_SB(0, 0), cB, voffB); PG8_STAGE(PG8_SB(0, 1), cB + hstep, voffB); PG8_STAGE(PG8_SA(0, 0), cA, voffA); PG8_STAGE(PG8_SA(0, 1), cA + hstep, voffA);
        if (wr == 1) PG8_BAR;
        PG8_WAIT_V(2); PG8_BAR;
        PG8_STAGE(PG8_SB(1, 0), cB + kstep, voffB); PG8_STAGE(PG8_SA(1, 0), cA + kstep, voffA); PG8_STAGE(PG8_SB(1, 1), cB + hstep + kstep, voffB);
        PG8_WAIT_V(6); PG8_BAR;
    } else {
        PG8_STAGE(PG8_SB(0, 0), cB, voffB); PG8_STAGE(PG8_SA(0, 0), cA, voffA); PG8_STAGE(PG8_SB(0, 1), cB + hstep, voffB); PG8_STAGE(PG8_SA(0, 1), cA + hstep, voffA);
        if (wr == 1) PG8_BAR;
        PG8_WAIT_V(4); PG8_BAR;
        PG8_STAGE(PG8_SB(1, 0), cB + kstep, voffB); PG8_STAGE(PG8_SA(1, 0), cA + kstep, voffA); PG8_STAGE(PG8_SB(1, 1), cB + hstep + kstep, voffB);
        PG8_WAIT_V(6); PG8_BAR;
    }
    for (;;) {
        const bool has_next = S.next(ui + 1, nxt);
        const char* nA = has_next ? (const char*)g.A + (size_t)nxt.pm * tstep : cA; const char* nB = has_next ? (const char*)g.Bt + (size_t)nxt.pn * tstep : cB;
        for (int t = 0; t < nt; t += 2) {
            const bool last = (t == nt - 2);
            const char* a1 = cA + (size_t)(t + 1) * kstep;
            const char* a2 = last ? nA : cA + (size_t)(t + 2) * kstep; const char* b2 = last ? nB : cB + (size_t)(t + 2) * kstep;
            const char* a3 = a2 + kstep; const char* b3 = b2 + kstep;
            if (last && has_next) S.a_ready(nxt);
            if constexpr (SP2) {
            PG8_LDB(B0, 0, 0); PG8_LDB(B1, 0, 1); PG8_SCHED; PG8_LDA(At, 0, 0); PG8_STAGE(PG8_SA(1, 1), a1 + hstep, voffA);
            PG8_WAIT_V(8); PG8_WAIT_L(0); PG8_BAR; PG8_MMA(0, 0, At, B0); PG8_MMA(0, 1, At, B1); PG8_BAR; PG8_SCHED;
            PG8_LDA(At, 0, 1); PG8_STAGE(PG8_SB(0, 0), b2, voffB); PG8_STAGE(PG8_SB(0, 1), b2 + hstep, voffB); PG8_STAGE(PG8_SA(0, 0), a2, voffA);
            PG8_WAIT_V(8); PG8_WAIT_L(0); PG8_BAR; PG8_MMA(1, 0, At, B0); PG8_MMA(1, 1, At, B1); PG8_BAR; PG8_SCHED;
            PG8_LDB(B0, 1, 0); PG8_LDB(B1, 1, 1); PG8_SCHED; PG8_LDA(At, 1, 0); PG8_STAGE(PG8_SA(0, 1), a2 + hstep, voffA);
            PG8_WAIT_V(8); PG8_WAIT_L(0); PG8_BAR; PG8_MMA(0, 0, At, B0); PG8_MMA(0, 1, At, B1); PG8_BAR; PG8_SCHED;
            PG8_LDA(At, 1, 1); PG8_STAGE(PG8_SB(1, 0), b3, voffB); PG8_STAGE(PG8_SB(1, 1), b3 + hstep, voffB); PG8_STAGE(PG8_SA(1, 0), a3, voffA);
            PG8_WAIT_V(8); PG8_WAIT_L(0); PG8_BAR; PG8_MMA(1, 0, At, B0); PG8_MMA(1, 1, At, B1); PG8_BAR; PG8_SCHED;
            } else {
            PG8_LDB(B0, 0, 0); PG8_SCHED; PG8_LDA(At, 0, 0); PG8_STAGE(PG8_SA(1, 1), a1 + hstep, voffA);
            PG8_WAIT_L(8); PG8_BAR; PG8_WAIT_L(0); PG8_MMA(0, 0, At, B0); PG8_BAR; PG8_SCHED;
            PG8_LDB(B1, 0, 1); PG8_STAGE(PG8_SB(0, 0), b2, voffB);
            PG8_BAR; PG8_WAIT_L(0); PG8_MMA(0, 1, At, B1); PG8_BAR;
            PG8_LDA(At, 0, 1); PG8_STAGE(PG8_SA(0, 0), a2, voffA);
            PG8_BAR; PG8_WAIT_L(0); PG8_MMA(1, 0, At, B0); PG8_BAR; PG8_SCHED;
            PG8_STAGE(PG8_SB(0, 1), b2 + hstep, voffB);
            PG8_WAIT_V(6); PG8_BAR; PG8_MMA(1, 1, At, B1); PG8_BAR;
            PG8_LDB(B0, 1, 0); PG8_SCHED; PG8_LDA(At, 1, 0); PG8_STAGE(PG8_SA(0, 1), a2 + hstep, voffA);
            PG8_WAIT_L(8); PG8_BAR; PG8_WAIT_L(0); PG8_MMA(0, 0, At, B0); PG8_BAR; PG8_SCHED;
            PG8_LDB(B1, 1, 1); PG8_STAGE(PG8_SB(1, 0), b3, voffB);
            PG8_BAR; PG8_WAIT_L(0); PG8_MMA(0, 1, At, B1); PG8_BAR;
            PG8_LDA(At, 1, 1); PG8_STAGE(PG8_SA(1, 0), a3, voffA);
            PG8_BAR; PG8_WAIT_L(0); PG8_MMA(1, 0, At, B0); PG8_BAR; PG8_SCHED;
            PG8_STAGE(PG8_SB(1, 1), b3 + hstep, voffB);
            PG8_WAIT_V(6); PG8_BAR; PG8_MMA(1, 1, At, B1); PG8_BAR;
            }
        }
        if constexpr (ALIGN_EPI) { if (wr == 0) PG8_BAR; }
        if constexpr (!Epi::AFTER_DRAIN) { E(acc, cur, wr, wc, fr, fq); S.done(cur); }
        if (!has_next) break;
#pragma unroll
        for (int a = 0; a < 2; ++a)
#pragma unroll
            for (int b = 0; b < 2; ++b)
#pragma unroll
                for (int m = 0; m < 4; ++m)
#pragma unroll
                    for (int n = 0; n < 2; ++n) acc[a][b][m][n] = (f32x4){0.f, 0.f, 0.f, 0.f};
        cur = nxt; cA = nA; cB = nB; ++ui;
        if constexpr (ALIGN_EPI) { if (wr == 1) PG8_BAR; }
    }
    PG8_WAIT_V(0);
    if constexpr (!ALIGN_EPI) { if (wr == 0) PG8_BAR; }
    PG8_BAR;
    if constexpr (Epi::AFTER_DRAIN) { E.fused(acc, cur, wr, wc, fr, fq, lds, wid, lane); S.done(cur); }
#undef PG8_SA
#undef PG8_SB
#undef PG8_STAGE
#undef PG8_LDA
#undef PG8_LDB
#undef PG8_MMA
#undef PG8_WAIT_V
#undef PG8_WAIT_L
#undef PG8_BAR
#undef PG8_SCHED
}
}

#define DI __device__ __forceinline__
#define LAS __attribute__((address_space(3)))
typedef unsigned short bf16;
typedef short bf16x8 __attribute__((ext_vector_type(8)));
typedef float f32x4 __attribute__((ext_vector_type(4)));
typedef float f32x2 __attribute__((ext_vector_type(2)));
typedef float f32x16 __attribute__((ext_vector_type(16)));
typedef unsigned u32x4 __attribute__((ext_vector_type(4)));
typedef unsigned u32x2 __attribute__((ext_vector_type(2)));
typedef __bf16 bf16x2_t __attribute__((ext_vector_type(2)));

DI unsigned pk2(float lo, float hi) { f32x2 v = {lo, hi}; bf16x2_t b = __builtin_convertvector(v, bf16x2_t); return __builtin_bit_cast(unsigned, b); }
DI bf16 f2bf(float f) { return (bf16)(pk2(f, 0.f) & 0xffffu); }
DI float bf2f(bf16 v) { return __builtin_bit_cast(float, (unsigned)v << 16); }
DI float bflo(unsigned u) { return __builtin_bit_cast(float, u << 16); }
DI float bfhi(unsigned u) { return __builtin_bit_cast(float, u & 0xffff0000u); }
typedef _Float16 f16x2_t __attribute__((ext_vector_type(2)));
typedef __fp16 fp16x2_t __attribute__((ext_vector_type(2)));
DI unsigned pkh2(float lo, float hi) { return __builtin_bit_cast(unsigned, __builtin_amdgcn_cvt_pkrtz(lo, hi)); }
DI float hlo(unsigned u) { return (float)__builtin_bit_cast(f16x2_t, u).x; }
DI float hhi(unsigned u) { return (float)__builtin_bit_cast(f16x2_t, u).y; }
DI float silu_f(float x) { return x * __builtin_amdgcn_rcpf(1.f + __expf(-x)); }
DI float ex2(float x) { return __builtin_amdgcn_exp2f(x); }
#define MFMA32(a, b, c) __builtin_amdgcn_mfma_f32_32x32x16_bf16((a), (b), (c), 0, 0, 0)

constexpr int DM = 1024, NB = 8, SEQ = 4096, CTXL = 256, DEPTH = 4;
constexpr int M_LAT = NB * SEQ, M_CTX = NB * CTXL, M_ALL = M_LAT + M_CTX;
constexpr int DFF = 2816, NGU = 2 * DFF, NIN = 3584, INC = 3588, NKEY = SEQ + CTXL, NVC = 34;
constexpr int XBC0 = 1792;
constexpr float ALPHA = 1.6817928305074290f;
constexpr float QSCALE = 0.125f * 1.4426950408889634f;
constexpr size_t MiB = 1u << 20;
constexpr size_t WS_MOD = 0, WS_TATT = 2 * MiB, WS_LAM = 2 * MiB + 65536, WS_BAR = 2 * MiB + 131072, WS_STAT = 2 * MiB + 262144, WS_ONES = 2 * MiB + 655360, WS_ZEROS = 2 * MiB + 655360 + 4096, WS_HALVES = 2 * MiB + 655360 + 8192, WS_TRET = 3 * MiB, WS_DT = 4 * MiB, WS_DEC = 5 * MiB, WS_XC = 6 * MiB,
                 WS_WGU = 14 * MiB, WS_WDN = 36 * MiB, WS_WIN = 47 * MiB, WS_WOUT = 54 * MiB, WS_A = 56 * MiB, WS_HP = 124 * MiB,
                 WS_VT = 362 * MiB, WS_STS = 396 * MiB, WS_STR = 430 * MiB, WS_U = 447 * MiB, WS_T = 498 * MiB, WS_X16 = 530 * MiB, WS_END = 598 * MiB;
constexpr int LDS_BYTES = 147456;
constexpr int NTHREADS = 512;

struct Args { const float* in[22]; float* out; unsigned char* ws; float afreq[16]; float rfreq[32]; int ph_lo, ph_hi; };
enum { I_X = 0, I_C, I_CTX, I_CCTX, I_ADAW, I_ADAB, I_NG, I_NB, I_WG, I_WU, I_WD, I_WIN, I_CONVW, I_CONVB, I_LAMBDA, I_SUBG, I_ALOG, I_DTB, I_SSMD, I_SSMG, I_RLG, I_WOUT };

DI float* xrow_ptr(float* xlat, float* xctx, int row) { return row < M_LAT ? xlat + (size_t)row * DM : xctx + (size_t)(row - M_LAT) * DM; }
DI int swap23(int o) { return (o & 3) | (((o >> 3) & 1) << 2) | (((o >> 2) & 1) << 3); }

struct EpiSwiglu {
    static constexpr bool PERM = true, AFTER_DRAIN = false;
    bf16* H;
    DI void operator()(const pg8::f32x4 (&acc)[2][2][4][2], const pg8::Unit& u, int wr, int wc, int fr, int fq) const {
        const int row0 = u.pm * 256 + wr * 64 + fr, col = u.pn * 128 + wc * 32 + 8 * fq;
#pragma unroll
        for (int ai = 0; ai < 2; ++ai)
#pragma unroll
            for (int m = 0; m < 4; ++m) {
                bf16* p = H + (size_t)(row0 + ai * 128 + m * 16) * DFF + col;
                float h[8];
#pragma unroll
                for (int n = 0; n < 2; ++n)
#pragma unroll
                    for (int j = 0; j < 4; ++j) h[n * 4 + j] = silu_f(acc[ai][0][m][n][j]) * acc[ai][1][m][n][j];
                u32x4 w; w.x = pk2(h[0], h[1]); w.y = pk2(h[2], h[3]); w.z = pk2(h[4], h[5]); w.w = pk2(h[6], h[7]);
                *(u32x4*)p = w;
                __builtin_amdgcn_sched_barrier(0);
            }
    }
};

struct EpiResid {
    static constexpr bool PERM = true, AFTER_DRAIN = false;
    bf16* X; const float* modg; const float* scale_p; const f32x2* stat; const float* gprev; const float* bprev;
    DI void operator()(const pg8::f32x4 (&acc)[2][2][4][2], const pg8::Unit& u, int wr, int wc, int fr, int fq) const {
        const int mi = (u.pm < 128) ? (u.pm >> 4) : 8;
        const float* gp = modg + (size_t)mi * 9216;
        const int row0 = u.pm * 256 + wr * 64 + fr, col0 = u.pn * 256 + wc * 32 + 8 * fq;
        const float scale = *scale_p;
#pragma unroll
        for (int bj = 0; bj < 2; ++bj) {
            f32x4 gs[2], gq[2], bq[2];
#pragma unroll
            for (int n = 0; n < 2; ++n) { const f32x4 g = *(const f32x4*)(gp + col0 + bj * 128 + 4 * n); gs[n] = (g + 1.0f) * scale;
                gq[n] = *(const f32x4*)(gprev + col0 + bj * 128 + 4 * n) * ALPHA; bq[n] = *(const f32x4*)(bprev + col0 + bj * 128 + 4 * n) * ALPHA; }
#pragma unroll
            for (int ai = 0; ai < 2; ++ai) {
                u32x4 xv[4]; f32x2 st[4];
#pragma unroll
                for (int m = 0; m < 4; ++m) { const int row = row0 + ai * 128 + m * 16; xv[m] = *(const u32x4*)(X + (size_t)row * DM + col0 + bj * 128); st[m] = stat[row]; }
                __builtin_amdgcn_sched_barrier(0);
#pragma unroll
                for (int m = 0; m < 4; ++m) {
                    const f32x4 x0 = {hlo(xv[m].x), hhi(xv[m].x), hlo(xv[m].y), hhi(xv[m].y)}, x1 = {hlo(xv[m].z), hhi(xv[m].z), hlo(xv[m].w), hhi(xv[m].w)};
                    const f32x4 y0 = (x0 - st[m].x) * st[m].y * gq[0] + bq[0] + gs[0] * acc[ai][bj][m][0];
                    const f32x4 y1 = (x1 - st[m].x) * st[m].y * gq[1] + bq[1] + gs[1] * acc[ai][bj][m][1];
                    u32x4 w; w.x = pkh2(y0.x, y0.y); w.y = pkh2(y0.z, y0.w); w.z = pkh2(y1.x, y1.y); w.w = pkh2(y1.z, y1.w);
                    *(u32x4*)(X + (size_t)(row0 + ai * 128 + m * 16) * DM + col0 + bj * 128) = w;
                }
                __builtin_amdgcn_sched_barrier(0);
            }
        }
    }
};
struct EpiPartial {
    static constexpr bool PERM = true, AFTER_DRAIN = false;
    float* T; const float* modg; const float* scale_p;
    DI void operator()(const pg8::f32x4 (&acc)[2][2][4][2], const pg8::Unit& u, int wr, int wc, int fr, int fq) const {
        const float* gp = modg + (size_t)8 * 9216; const float scale = *scale_p;
        const int row0 = u.pm * 256 + wr * 64 + fr - M_LAT, col0 = u.pn * 256 + wc * 32 + 8 * fq;
        f32x4 gs[2][2];
#pragma unroll
        for (int bj = 0; bj < 2; ++bj)
#pragma unroll
            for (int n = 0; n < 2; ++n) { f32x4 g = *(const f32x4*)(gp + col0 + bj * 128 + 4 * n); gs[bj][n] = (g + 1.0f) * scale; }
#pragma unroll
        for (int ai = 0; ai < 2; ++ai)
#pragma unroll
            for (int m = 0; m < 4; ++m) {
                float* tp = T + (size_t)(row0 + ai * 128 + m * 16) * DM + col0;
#pragma unroll
                for (int bj = 0; bj < 2; ++bj)
#pragma unroll
                    for (int n = 0; n < 2; ++n) *(f32x4*)(tp + bj * 128 + 4 * n) = gs[bj][n] * acc[ai][bj][m][n];
                __builtin_amdgcn_sched_barrier(0);
            }
    }
};
struct OneUnit {
    int have; pg8::Unit u;
    DI bool next(int i, pg8::Unit& o) const { if (i == 0 && have) { o = u; return true; } return false; }
    DI void a_ready(const pg8::Unit&) const {}
    DI void done(const pg8::Unit&) const {}
};

struct EpiIn {
    static constexpr bool PERM = true, AFTER_DRAIN = false;
    bf16* P; bf16* Vt; const f32x2* tatt; const f32x2* tret;
    DI void operator()(const pg8::f32x4 (&acc)[2][2][4][2], const pg8::Unit& u, int wr, int wc, int fr, int fq) const {
        const int pn = u.pn;
        const int row0 = u.pm * 256 + wr * 64 + fr;
        if (pn == 4 || pn == 5) {
#pragma unroll
            for (int ai = 0; ai < 2; ++ai)
#pragma unroll
                for (int m = 0; m < 4; ++m) {
                    const int row = row0 + ai * 128 + m * 16;
                    int b, key;
                    if (row < M_LAT) { b = row >> 12; key = row & 4095; } else { const int r2 = row - M_LAT; b = r2 >> 8; key = 4096 + (r2 & 255); }
                    const int kp = (key & ~15) | swap23(key & 15);
#pragma unroll
                    for (int bj = 0; bj < 2; ++bj) {
                        const int h = 2 * (pn - 4) + bj;
                        bf16* vp = Vt + ((size_t)(b * 4 + h) * 128 + wc * 32 + 8 * fq) * NKEY + kp;
#pragma unroll
                        for (int n = 0; n < 2; ++n)
#pragma unroll
                            for (int j = 0; j < 4; ++j) vp[(size_t)(n * 4 + j) * NKEY] = f2bf(acc[ai][bj][m][n][j]);
                    }
                    __builtin_amdgcn_sched_barrier(0);
                }
            return;
        }
        const bool att = pn < 4, ret = (pn == 10 || pn == 11);
        const float sc = (pn < 2) ? QSCALE : (pn == 11 ? 0.125f : 1.0f);
#pragma unroll
        for (int ai = 0; ai < 2; ++ai)
#pragma unroll
            for (int m = 0; m < 4; ++m) {
                const int row = row0 + ai * 128 + m * 16;
                f32x2 cs[4];
                bool rot = false;
                if ((att || ret) && row < M_LAT) {
                    rot = true;
                    const int s = row & 4095;
                    const f32x2* tp;
                    if (att) { const int pos = (wc & 1) ? (s & 63) : (s >> 6); tp = tatt + pos * 16 + 4 * fq; }
                    else { tp = tret + (size_t)s * 32 + 16 * (wc & 1) + 4 * fq; }
                    const f32x4 t0 = *(const f32x4*)tp, t1 = *(const f32x4*)(tp + 2);
                    cs[0] = (f32x2){t0.x, t0.y}; cs[1] = (f32x2){t0.z, t0.w}; cs[2] = (f32x2){t1.x, t1.y}; cs[3] = (f32x2){t1.z, t1.w};
                }
#pragma unroll
                for (int bj = 0; bj < 2; ++bj) {
                    float v[8];
#pragma unroll
                    for (int n = 0; n < 2; ++n)
#pragma unroll
                        for (int j = 0; j < 4; ++j) v[n * 4 + j] = acc[ai][bj][m][n][j];
                    if (rot) {
#pragma unroll
                        for (int q = 0; q < 4; ++q) { const float h1 = v[2 * q], h2 = v[2 * q + 1]; v[2 * q] = h1 * cs[q].x - h2 * cs[q].y; v[2 * q + 1] = h2 * cs[q].x + h1 * cs[q].y; }
                    }
                    u32x4 w; w.x = pk2(v[0] * sc, v[1] * sc); w.y = pk2(v[2] * sc, v[3] * sc); w.z = pk2(v[4] * sc, v[5] * sc); w.w = pk2(v[6] * sc, v[7] * sc);
                    *(u32x4*)(P + (size_t)row * NIN + pn * 256 + bj * 128 + wc * 32 + 8 * fq) = w;
                }
                __builtin_amdgcn_sched_barrier(0);
            }
    }
};

DI void sincos_d(float angf, float& c, float& s) {
    const double a = (double)angf;
    const double k = rint(a * 0.15915494309189535);
    double r = fma(-k, 6.283185307179586, a); r = fma(-k, 2.4492935982947064e-16, r);
    const double r2 = r * r;
    double ts = r, ss = r, tc = 1.0, sc = 1.0;
#pragma unroll 1
    for (int n = 1; n <= 15; ++n) {
        tc = -tc * r2 / (double)((2 * n - 1) * (2 * n)); sc += tc;
        ts = -ts * r2 / (double)((2 * n) * (2 * n + 1)); ss += ts;
    }
    c = (float)sc; s = (float)ss;
}

DI int in_srccol(int j) {
    if (j < 1024) { const int blk = j >> 6, dp = j & 63, half = dp >> 5, i = (dp & 31) >> 1, sec = dp & 1; return blk * 64 + half * 32 + i + 16 * sec; }
    if (j < 2560) return j;
    if (j < 3072) { const int jj = j - 2560, blk = jj >> 6, dp = jj & 63, i = dp >> 1, sec = dp & 1; return 2564 + blk * 64 + i + 32 * sec; }
    return j + 4;
}

DI void transpose_item(const float* W, int ldw, int K, int srccol_lane, bf16* WT, int n0, int k0, LAS float* scr, int lane) {
#pragma unroll 8
    for (int i = 0; i < 32; ++i) { const int kk = 2 * i + (lane >> 5); scr[kk * 33 + (lane & 31)] = W[(size_t)(k0 + kk) * ldw + srccol_lane]; }
    asm volatile("s_waitcnt lgkmcnt(0)" ::: "memory");
    const int c = lane & 7;
#pragma unroll
    for (int j = 0; j < 4; ++j) {
        const int n = (lane >> 3) + 8 * j; const LAS float* s = scr + (8 * c) * 33 + n;
        u32x4 o; o.x = pk2(s[0 * 33], s[1 * 33]); o.y = pk2(s[2 * 33], s[3 * 33]); o.z = pk2(s[4 * 33], s[5 * 33]); o.w = pk2(s[6 * 33], s[7 * 33]);
        *(u32x4*)(WT + (size_t)(n0 + n) * K + k0 + 8 * c) = o;
    }
    asm volatile("s_waitcnt lgkmcnt(0)" ::: "memory");
}

DI void convw_phase(const Args& A, int l, LAS unsigned char* lds, int tid, int bid, int b0, int nbw, int sel) {
    const int lane = tid & 63, wave = tid >> 6;
    LAS float* scr = (LAS float*)(lds + 65536 + wave * 8448);
    if (bid < b0 || bid >= b0 + nbw) return;
    const int gw = (bid - b0) * 8 + wave, NGW = nbw * 8;
    constexpr int I_GU = 2 * 16 * (NGU / 32), I_DN = 2 * (DFF / 64) * (DM / 32), I_IN = 16 * (NIN / 32), I_OUT = 16 * 32;
    bf16* wgu = (bf16*)(A.ws + WS_WGU); bf16* wdn = (bf16*)(A.ws + WS_WDN); bf16* win = (bf16*)(A.ws + WS_WIN); bf16* wout = (bf16*)(A.ws + WS_WOUT);
    for (int it = gw; it < I_GU + I_DN + I_IN + I_OUT; it += NGW) {
        int r = it;
        { const int part = (it < I_GU) ? ((it < I_GU / 2) ? 1 : 4) : (it < I_GU + I_DN ? ((it - I_GU < I_DN / 2) ? 1 : 4) : 2); if (!(sel & part)) continue; }
        if (r < I_GU) {
            const int f = r / (16 * (NGU / 32)); r -= f * 16 * (NGU / 32);
            const int kb = r / (NGU / 32), nb = r % (NGU / 32), n0 = nb * 32, pn = n0 >> 8, cc = n0 & 255;
            const float* src = (cc < 128 ? A.in[I_WG] : A.in[I_WU]) + (size_t)(l * 2 + f) * DM * DFF;
            transpose_item(src, DFF, DM, 128 * pn + (cc & 127) + (lane & 31), wgu + (size_t)f * NGU * DM, n0, kb * 64, scr, lane);
            continue;
        }
        r -= I_GU;
        if (r < I_DN) {
            const int f = r / ((DFF / 64) * 32); r -= f * (DFF / 64) * 32;
            const int kb = r / 32, nb = r % 32;
            transpose_item(A.in[I_WD] + (size_t)(l * 2 + f) * DFF * DM, DM, DFF, nb * 32 + (lane & 31), wdn + (size_t)f * DM * DFF, nb * 32, kb * 64, scr, lane);
            continue;
        }
        r -= I_DN;
        if (r < I_IN) {
            const int kb = r / (NIN / 32), nb = r % (NIN / 32);
            transpose_item(A.in[I_WIN] + (size_t)l * DM * INC, INC, DM, in_srccol(nb * 32 + (lane & 31)), win, nb * 32, kb * 64, scr, lane);
            continue;
        }
        r -= I_IN;
        { const int kb = r / 32, nb = r % 32;
          transpose_item(A.in[I_WOUT] + (size_t)l * DM * DM, DM, DM, nb * 32 + (lane & 31), wout, nb * 32, kb * 64, scr, lane); }
    }
}

DI void p0a_phase(const Args& A, LAS unsigned char* lds, int tid, int bid, int G) {
    const int lane = tid & 63, wave = tid >> 6;
    { const int gt = bid * NTHREADS + tid;
      f32x2* tatt = (f32x2*)(A.ws + WS_TATT); f32x2* tret = (f32x2*)(A.ws + WS_TRET);
      if (gt < 1024) { ((float*)(A.ws + WS_ONES))[gt] = 1.0f; ((float*)(A.ws + WS_ZEROS))[gt] = 0.0f; ((float*)(A.ws + WS_HALVES))[gt] = 0.5f; }
      if (gt < 1024) { const int pos = gt >> 4, i = gt & 15; float c, s; sincos_d((float)pos * A.afreq[i], c, s); tatt[gt] = (f32x2){c, s}; }
      for (int e = gt; e < SEQ * 32; e += G * NTHREADS) { const int sidx = e >> 5, i = e & 31; float c, s; sincos_d((float)sidx * A.rfreq[i], c, s); tret[e] = (f32x2){c, s}; }
      if (gt < DEPTH) {
          const float* lv = A.in[I_LAMBDA] + gt * 256; float d0 = 0.f, d1 = 0.f;
          for (int i = 0; i < 64; ++i) { d0 += lv[i] * lv[64 + i]; d1 += lv[128 + i] * lv[192 + i]; }
          const float lam_init = 0.8f - 0.6f * expf(-0.3f * (float)gt);
          ((float*)(A.ws + WS_LAM))[gt] = expf(d0) - expf(d1) + lam_init;
      }
    }
    LAS float* scs = (LAS float*)lds;
    LAS float* red = (LAS float*)(lds + 36864);
    for (int e = tid; e < 9 * 1024; e += NTHREADS) { const int mi = e >> 10, k = e & 1023; const float v = (mi < 8) ? A.in[I_C][mi * 1024 + k] : A.in[I_CCTX][k]; scs[e] = silu_f(v); }
    __syncthreads();
    float* MOD = (float*)(A.ws + WS_MOD);
    for (int it = bid; it < DEPTH * 144; it += G) {
        const int l = it / 144, cg0 = (it % 144) * 64;
        const float* w = A.in[I_ADAW] + (size_t)l * DM * 9216 + cg0 + lane;
        float acc[9];
#pragma unroll
        for (int mi = 0; mi < 9; ++mi) acc[mi] = 0.f;
#pragma unroll 4
        for (int k = wave * 128; k < wave * 128 + 128; ++k) {
            const float wv = w[(size_t)k * 9216];
#pragma unroll
            for (int mi = 0; mi < 9; ++mi) acc[mi] += scs[mi * 1024 + k] * wv;
        }
#pragma unroll
        for (int mi = 0; mi < 9; ++mi) red[(wave * 9 + mi) * 64 + lane] = acc[mi];
        __syncthreads();
        for (int e = tid; e < 576; e += NTHREADS) {
            const int mi = e >> 6, cl = e & 63; float s = A.in[I_ADAB][l * 9216 + cg0 + cl];
#pragma unroll
            for (int w8 = 0; w8 < 8; ++w8) s += red[(w8 * 9 + mi) * 64 + cl];
            MOD[((size_t)l * 9 + mi) * 9216 + cg0 + cl] = s;
        }
        __syncthreads();
    }
    convw_phase(A, 0, lds, tid, bid, 0, G, 7);
}

DI float wave_sum(float v) {
#pragma unroll
    for (int o = 1; o < 64; o <<= 1) v += __shfl_xor(v, o);
    return v;
}
DI void lnmod_phase(const Args& A, LAS unsigned char* lds, int tid, int bid, int G, bool init, int l_norm, int i_norm, int l_mod, int i_mod, bool want_dt, int nrows, bool ctx_partial, const float* gprev, const float* bprev) {
    const int lane = tid & 63, wave = tid >> 6;
    LAS f32x4* wdt = (LAS f32x4*)lds;
    if (want_dt) {
        for (int k = tid; k < 1024; k += NTHREADS) wdt[k] = *(const f32x4*)(A.in[I_WIN] + ((size_t)l_mod * DM + k) * INC + 2560);
        __syncthreads();
    }
    const float* MOD = (const float*)(A.ws + WS_MOD);
    bf16* Abuf = (bf16*)(A.ws + WS_A);
    float* DT = (float*)(A.ws + WS_DT);
    f32x4 g[4], bb[4];
    if (l_norm >= 0) {
#pragma unroll
        for (int j = 0; j < 4; ++j) { g[j] = *(const f32x4*)(A.in[I_NG] + (l_norm * 3 + i_norm) * DM + 256 * j + 4 * lane); bb[j] = *(const f32x4*)(A.in[I_NB] + (l_norm * 3 + i_norm) * DM + 256 * j + 4 * lane); }
    }
    bf16* X16 = (bf16*)(A.ws + WS_X16);
    u32x2 un[4]; f32x4 fn[4];
    { const int row = bid * 8 + wave;
      if (row < nrows) {
          if (init) { const float* xin = row < M_LAT ? A.in[I_X] + (size_t)row * DM : A.in[I_CTX] + (size_t)(row - M_LAT) * DM;
#pragma unroll
              for (int j = 0; j < 4; ++j) fn[j] = *(const f32x4*)(xin + 256 * j + 4 * lane); }
          else {
#pragma unroll
              for (int j = 0; j < 4; ++j) un[j] = *(const u32x2*)(X16 + (size_t)row * DM + 256 * j + 4 * lane); } } }
    for (int row = bid * 8 + wave; row < nrows; row += G * 8) {
        bf16* xout = X16 + (size_t)row * DM;
        f32x4 v[4];
#pragma unroll
        for (int j = 0; j < 4; ++j) v[j] = init ? fn[j] : (f32x4){hlo(un[j].x), hhi(un[j].x), hlo(un[j].y), hhi(un[j].y)};
        { const int rown = row + G * 8;
          if (rown < nrows) {
              if (init) { const float* xin = rown < M_LAT ? A.in[I_X] + (size_t)rown * DM : A.in[I_CTX] + (size_t)(rown - M_LAT) * DM;
#pragma unroll
                  for (int j = 0; j < 4; ++j) fn[j] = *(const f32x4*)(xin + 256 * j + 4 * lane); }
              else {
#pragma unroll
                  for (int j = 0; j < 4; ++j) un[j] = *(const u32x2*)(X16 + (size_t)rown * DM + 256 * j + 4 * lane); } } }
        f32x2* STAT = (f32x2*)(A.ws + WS_STAT);
        if (ctx_partial && row >= M_LAT) {
            { const f32x2 st = STAT[row];
#pragma unroll
              for (int j = 0; j < 4; ++j) v[j] = (v[j] - st.x) * st.y * *(const f32x4*)(gprev + 256 * j + 4 * lane) + *(const f32x4*)(bprev + 256 * j + 4 * lane); }
            const float* t0 = (const float*)(A.ws + WS_T) + (size_t)(row - M_LAT) * DM; const float* t1 = t0 + (size_t)M_CTX * DM; const float* t2 = t1 + (size_t)M_CTX * DM; const float* t3 = t2 + (size_t)M_CTX * DM;
#pragma unroll
            for (int j = 0; j < 4; ++j) { v[j] = v[j] * ALPHA + (*(const f32x4*)(t0 + 256 * j + 4 * lane) + *(const f32x4*)(t1 + 256 * j + 4 * lane)) + (*(const f32x4*)(t2 + 256 * j + 4 * lane) + *(const f32x4*)(t3 + 256 * j + 4 * lane)); u32x2 w_; w_.x = pkh2(v[j].x, v[j].y); w_.y = pkh2(v[j].z, v[j].w); *(u32x2*)(xout + 256 * j + 4 * lane) = w_; }
        }
        if (l_norm >= 0) {
            float s = 0.f;
#pragma unroll
            for (int j = 0; j < 4; ++j) s += (v[j].x + v[j].y) + (v[j].z + v[j].w);
            const float mean = wave_sum(s) * (1.f / DM);
            float s2 = 0.f;
#pragma unroll
            for (int j = 0; j < 4; ++j) { v[j] = v[j] - mean; s2 += (v[j].x * v[j].x + v[j].y * v[j].y) + (v[j].z * v[j].z + v[j].w * v[j].w); }
            const float rstd = 1.0f / sqrtf(wave_sum(s2) * (1.f / DM) + 1e-5f);
            if (l_mod >= 0 && lane == 0) STAT[row] = (f32x2){mean, rstd};
#pragma unroll
            for (int j = 0; j < 4; ++j) v[j] = v[j] * rstd * g[j] + bb[j];
        }
        if (init && lane == 0) STAT[row] = (f32x2){0.f, 1.f};
        if (init) {
#pragma unroll
            for (int j = 0; j < 4; ++j) { u32x2 w_; w_.x = pkh2(v[j].x, v[j].y); w_.y = pkh2(v[j].z, v[j].w); *(u32x2*)(xout + 256 * j + 4 * lane) = w_; }
        }
        if (l_norm >= 0 && l_mod < 0) {
#pragma unroll
            for (int j = 0; j < 4; ++j) *(f32x4*)(A.out + (size_t)row * DM + 256 * j + 4 * lane) = v[j];
        }
        if (l_mod >= 0) {
            const int mi = row < M_LAT ? (row >> 12) : 8;
            const float* mp = MOD + ((size_t)l_mod * 9 + mi) * 9216 + i_mod * 3072;
            float d0 = 0.f, d1 = 0.f, d2 = 0.f, d3 = 0.f;
#pragma unroll
            for (int j = 0; j < 4; ++j) {
                const f32x4 sh = *(const f32x4*)(mp + 256 * j + 4 * lane), scl = *(const f32x4*)(mp + 1024 + 256 * j + 4 * lane);
                const f32x4 a = v[j] * (scl + 1.0f) + sh;
                u32x2 w; w.x = pk2(a.x, a.y); w.y = pk2(a.z, a.w);
                *(u32x2*)(Abuf + (size_t)row * DM + 256 * j + 4 * lane) = w;
                if (want_dt) {
                    const int k0 = 256 * j + 4 * lane;
                    const f32x4 w0 = wdt[k0], w1 = wdt[k0 + 1], w2 = wdt[k0 + 2], w3 = wdt[k0 + 3];
                    d0 += a.x * w0.x + a.y * w1.x + a.z * w2.x + a.w * w3.x;
                    d1 += a.x * w0.y + a.y * w1.y + a.z * w2.y + a.w * w3.y;
                    d2 += a.x * w0.z + a.y * w1.z + a.z * w2.z + a.w * w3.z;
                    d3 += a.x * w0.w + a.y * w1.w + a.z * w2.w + a.w * w3.w;
                }
            }
            if (want_dt) {
                d0 = wave_sum(d0); d1 = wave_sum(d1); d2 = wave_sum(d2); d3 = wave_sum(d3);
                if (lane == 0) *(f32x4*)(DT + (size_t)row * 4) = (f32x4){d0, d1, d2, d3};
            }
        }
    }
}

DI float max3f(float a, float b, float c) { float r; asm("v_max3_f32 %0, %1, %2, %3" : "=v"(r) : "v"(a), "v"(b), "v"(c)); return r; }
DI float max3f_mfma(float a, float b, float c) { float r; asm("s_nop 15\n\ts_nop 7\n\tv_max3_f32 %0, %1, %2, %3" : "=v"(r) : "v"(a), "v"(b), "v"(c)); return r; }
DI void attn_unit(LAS unsigned char* lds, int tid, const bf16* __restrict__ P, const bf16* __restrict__ Vt, bf16* MG, int b, int h, int qrow0, int jt0, int jt1,
                  float lam, float oscale, const float* subg) {
    asm volatile("" : "+v"(tid));
    constexpr int KP = 136, VP = 72, KBYTES = 64 * KP * 2, VBYTES = 128 * VP * 2;
    const int lane = tid & 63, wave = tid >> 6, r32 = lane & 31, hi = lane >> 5;
    const int qb = wave >> 1, m = wave & 1;
    const int qrow = qrow0 + qb * 32 + r32;
    bf16x8 qf[4];
#pragma unroll
    for (int ks = 0; ks < 4; ++ks) qf[ks] = *(const bf16x8*)(P + (size_t)qrow * NIN + h * 128 + m * 64 + ks * 16 + hi * 8);
    f32x16 O[4];
#pragma unroll
    for (int es = 0; es < 4; ++es)
#pragma unroll
        for (int i = 0; i < 16; ++i) O[es][i] = 0.f;
    float mrun = 0.f, lrun = 0.f;
    u32x4 kreg[2], vreg[2];
    const bf16* vbase = Vt + (size_t)(b * 4 + h) * 128 * NKEY;
#define ATT_LOADG(j) do { _Pragma("unroll") for (int i_ = 0; i_ < 2; ++i_) { const int c_ = tid + 512 * i_; const int key_ = c_ >> 4, part_ = c_ & 15; \
        const int row_ = ((j) < 64) ? b * SEQ + (j) * 64 + key_ : M_LAT + b * CTXL + ((j) - 64) * 64 + key_; \
        kreg[i_] = *(const u32x4*)(P + (size_t)row_ * NIN + 512 + h * 128 + part_ * 8); \
        const int e_ = c_ >> 3, vp_ = c_ & 7; vreg[i_] = *(const u32x4*)(vbase + (size_t)e_ * NKEY + (j) * 64 + vp_ * 8); } } while (0)
#define ATT_STORE(buf) do { _Pragma("unroll") for (int i_ = 0; i_ < 2; ++i_) { const int c_ = tid + 512 * i_; const int key_ = c_ >> 4, part_ = c_ & 15, e_ = c_ >> 3, vp_ = c_ & 7; \
        *(LAS u32x4*)(lds + (buf) * KBYTES + (key_ * KP + part_ * 8) * 2) = kreg[i_]; \
        *(LAS u32x4*)(lds + 2 * KBYTES + (buf) * VBYTES + (e_ * VP + vp_ * 8) * 2) = vreg[i_]; } } while (0)
    const bool halfB = wave >= 4;
    bf16x8 pf[4];
#define ATT_QKS(bufk, first_) do { \
        const LAS bf16* Kb = (const LAS bf16*)(lds + (bufk) * KBYTES) + m * 64 + hi * 8; \
        f32x16 s0, s1; \
        { const float ninit = -mrun; _Pragma("unroll") for (int i = 0; i < 16; ++i) { s0[i] = ninit; s1[i] = ninit; } } \
        _Pragma("unroll") for (int ks = 0; ks < 4; ++ks) { \
            const bf16x8 a0 = *(const LAS bf16x8*)(Kb + r32 * KP + ks * 16); \
            const bf16x8 a1 = *(const LAS bf16x8*)(Kb + (32 + r32) * KP + ks * 16); \
            s0 = MFMA32(a0, qf[ks], s0); s1 = MFMA32(a1, qf[ks], s1); } \
        float mx = max3f_mfma(s0[0], s1[0], s0[1]); \
        mx = max3f(mx, s1[1], s0[2]); mx = max3f(mx, s1[2], s0[3]); mx = max3f(mx, s1[3], s0[4]); mx = max3f(mx, s1[4], s0[5]); \
        mx = max3f(mx, s1[5], s0[6]); mx = max3f(mx, s1[6], s0[7]); mx = max3f(mx, s1[7], s0[8]); mx = max3f(mx, s1[8], s0[9]); \
        mx = max3f(mx, s1[9], s0[10]); mx = max3f(mx, s1[10], s0[11]); mx = max3f(mx, s1[11], s0[12]); mx = max3f(mx, s1[12], s0[13]); \
        mx = max3f(mx, s1[13], s0[14]); mx = max3f(mx, s1[14], s0[15]); mx = max3f(mx, s1[15], mx); \
        mx = max3f(mx, __shfl_xor(mx, 32), mx); \
        if ((first_) || __builtin_amdgcn_ballot_w64(mx > 8.0f) != 0ull) { \
            const float d = (first_) ? mx : (mx > 8.0f ? mx : 0.f); \
            mrun += d; \
            if (!(first_)) { const float alpha = ex2(-d); lrun *= alpha; _Pragma("unroll") for (int es = 0; es < 4; ++es) O[es] = O[es] * alpha; } \
            _Pragma("unroll") for (int i = 0; i < 16; ++i) { s0[i] -= d; s1[i] -= d; } } \
        float sum = 0.f; \
        _Pragma("unroll") for (int i = 0; i < 16; ++i) { s0[i] = ex2(s0[i]); s1[i] = ex2(s1[i]); sum += s0[i] + s1[i]; } \
        lrun += sum; \
        _Pragma("unroll") for (int s2 = 0; s2 < 2; ++s2) { u32x4 w0, w1; \
            w0.x = pk2(s0[8 * s2 + 0], s0[8 * s2 + 1]); w0.y = pk2(s0[8 * s2 + 2], s0[8 * s2 + 3]); w0.z = pk2(s0[8 * s2 + 4], s0[8 * s2 + 5]); w0.w = pk2(s0[8 * s2 + 6], s0[8 * s2 + 7]); \
            w1.x = pk2(s1[8 * s2 + 0], s1[8 * s2 + 1]); w1.y = pk2(s1[8 * s2 + 2], s1[8 * s2 + 3]); w1.z = pk2(s1[8 * s2 + 4], s1[8 * s2 + 5]); w1.w = pk2(s1[8 * s2 + 6], s1[8 * s2 + 7]); \
            pf[s2] = __builtin_bit_cast(bf16x8, w0); pf[2 + s2] = __builtin_bit_cast(bf16x8, w1); } } while (0)
#define ATT_PV(bufv) do { \
        const LAS bf16* Vb = (const LAS bf16*)(lds + 2 * KBYTES + (bufv) * VBYTES) + hi * 8; \
        _Pragma("unroll") for (int es = 0; es < 4; ++es) _Pragma("unroll") for (int kk = 0; kk < 4; ++kk) { \
            const bf16x8 a = *(const LAS bf16x8*)(Vb + (es * 32 + r32) * VP + kk * 16); O[es] = MFMA32(a, pf[kk], O[es]); } } while (0)
    __syncthreads();
    ATT_LOADG(jt0);
    for (int j = jt0; j < jt1; ++j) {
        const int buf = (j - jt0) & 1;
        ATT_STORE(buf);
        __syncthreads();
        if (j + 1 < jt1) ATT_LOADG(j + 1);
        if (!halfB) { ATT_QKS(buf, j == jt0); } else if (j > jt0) { ATT_PV(buf ^ 1); }
        __syncthreads();
        if (!halfB) { ATT_PV(buf); } else { ATT_QKS(buf, j == jt0); }
    }
    if (halfB) { ATT_PV((jt1 - 1 - jt0) & 1); }
#undef ATT_QKS
#undef ATT_PV
#undef ATT_LOADG
#undef ATT_STORE
    __syncthreads();
    const float l = lrun + __shfl_xor(lrun, 32);
    const float inv = (m ? lam : 1.0f) / l;
    LAS float* X = (LAS float*)lds + qb * 4096 + lane;
    if (m) {
#pragma unroll
        for (int es = 0; es < 4; ++es)
#pragma unroll
            for (int i = 0; i < 16; ++i) X[(es * 16 + i) * 64] = O[es][i] * inv;
    }
    __syncthreads();
    if (!m) {
        float ss = 0.f;
#pragma unroll
        for (int es = 0; es < 4; ++es)
#pragma unroll
            for (int i = 0; i < 16; ++i) { const float o = O[es][i] * inv - X[(es * 16 + i) * 64]; O[es][i] = o; ss += o * o; }
        ss += __shfl_xor(ss, 32);
        const float rn = (1.0f / sqrtf(ss * (1.0f / 128.0f) + 1e-6f)) * oscale;
#pragma unroll
        for (int es = 0; es < 4; ++es)
#pragma unroll
            for (int g4 = 0; g4 < 4; ++g4) {
                const int e = es * 32 + 8 * g4 + 4 * hi;
                const f32x4 gv = *(const f32x4*)(subg + e);
                u32x2 w; w.x = pk2(O[es][4 * g4 + 0] * rn * gv.x, O[es][4 * g4 + 1] * rn * gv.y); w.y = pk2(O[es][4 * g4 + 2] * rn * gv.z, O[es][4 * g4 + 3] * rn * gv.w);
                *(u32x2*)(MG + (size_t)qrow * DM + h * 128 + e) = w;
            }
    }
}

constexpr int SC_ACF = 0, SC_ACB = 1, SC_DT0 = 2, SC_DT1 = 3;
constexpr int L_STAT = 8192, L_BUF = 16384;
constexpr int TP = 136;
constexpr int QP = 72;
constexpr int UW = 768;

DI int vc_row0(int b, int vc) { return vc < 2 ? M_LAT + b * CTXL + vc * 128 : b * SEQ + (vc - 2) * 128; }
DI float softplus_f(float x) { return fmaxf(x, 0.f) + log1pf(__expf(-fabsf(x))); }

struct ScanCtx { const bf16* P; const bf16* U; const float* DT; bf16* sts; bf16* str; float* dec; bf16* MG; const float* cw; const float* cb; const float* alog; const float* dtb; const float* ssmd; const float* ssmg; const float* rlg; };

DI void conv_phase(const bf16* __restrict__ P, bf16* __restrict__ U, const float* cw, const float* cb, int tid, int bid, int G) {
    const int lane = tid & 63, wave = tid >> 6;
    for (int it = bid * 8 + wave; it < (M_ALL / 16) * 6; it += G * 8) {
        const int run = it / 6, cgp = it % 6, row0 = run * 16, ch = cgp * 128 + 2 * lane;
        int s0, L; if (row0 < M_LAT) { s0 = row0 & (SEQ - 1); L = SEQ; } else { s0 = (row0 - M_LAT) & (CTXL - 1); L = CTXL; }
        float wa[5], wb[5];
#pragma unroll
        for (int k = 0; k < 5; ++k) { const f32x2 w = *(const f32x2*)(cw + k * UW + ch); wa[k] = w.x; wb[k] = w.y; }
        const f32x2 bias = *(const f32x2*)(cb + ch);
        float xa[20], xb[20];
#pragma unroll
        for (int i = 0; i < 20; ++i) { const int s = s0 - 2 + i; unsigned v = 0u; if (s >= 0 && s < L) v = *(const unsigned*)(P + (size_t)(row0 - 2 + i) * NIN + XBC0 + ch); xa[i] = bflo(v); xb[i] = bfhi(v); }
#pragma unroll
        for (int t = 0; t < 16; ++t) {
            const float a = bias.x + wa[0] * xa[t] + wa[1] * xa[t + 1] + wa[2] * xa[t + 2] + wa[3] * xa[t + 3] + wa[4] * xa[t + 4];
            const float c = bias.y + wb[0] * xb[t] + wb[1] * xb[t + 1] + wb[2] * xb[t + 2] + wb[3] * xb[t + 3] + wb[4] * xb[t + 4];
            *(unsigned*)(U + (size_t)(row0 + t) * UW + ch) = pk2(silu_f(a), silu_f(c));
        }
    }
}

DI void ssd_scalars(LAS float* sc, int tid, const float* DT, int row0, const float* alog, const float* dtb, float* dec_f, float* dec_b) {
    const int lane = tid & 63, wave = tid >> 6;
    if (wave < 4) {
        const int h = wave;
        const float r0 = DT[(size_t)(row0 + 2 * lane) * 4 + h], r1 = DT[(size_t)(row0 + 2 * lane + 1) * 4 + h];
        const float ea0 = __expf(alog[h]), ea1 = __expf(alog[4 + h]);
        const float d00 = softplus_f(r0 + dtb[h]), d01 = softplus_f(r1 + dtb[h]);
        const float d10 = softplus_f(r0 + dtb[4 + h]), d11 = softplus_f(r1 + dtb[4 + h]);
        const float la00 = -d00 * ea0, la01 = -d01 * ea0, la10 = -d10 * ea1, la11 = -d11 * ea1;
        float pf = la00 + la01, pb = la10 + la11;
#pragma unroll
        for (int o = 1; o < 64; o <<= 1) { const float tf = __shfl_up(pf, o), tb = __shfl_up(pb, o); if (lane >= o) { pf += tf; pb += tb; } }
        const float totb = __shfl(pb, 63), totf = __shfl(pf, 63);
        sc[(SC_ACF * 4 + h) * 128 + 2 * lane + 1] = pf; sc[(SC_ACF * 4 + h) * 128 + 2 * lane] = pf - la01;
        sc[(SC_ACB * 4 + h) * 128 + 2 * lane + 1] = totb - pb + la11; sc[(SC_ACB * 4 + h) * 128 + 2 * lane] = totb - (pb - la11) + la10;
        sc[(SC_DT0 * 4 + h) * 128 + 2 * lane] = d00; sc[(SC_DT0 * 4 + h) * 128 + 2 * lane + 1] = d01;
        sc[(SC_DT1 * 4 + h) * 128 + 2 * lane] = d10; sc[(SC_DT1 * 4 + h) * 128 + 2 * lane + 1] = d11;
        if (dec_f && lane == 0) { dec_f[h] = __expf(totf); dec_b[h] = __expf(totb); }
    }
}

DI f32x16 zero16() { f32x16 z;
#pragma unroll
    for (int i = 0; i < 16; ++i) z[i] = 0.f;
    return z; }
template <int KSTEPS> DI f32x16 mma_lds(f32x16 acc, const LAS bf16* Ap, int pa, const LAS bf16* Bp, int pb, int lane) {
    const int r32 = lane & 31, hi = lane >> 5;
    Ap += r32 * pa + 8 * hi; Bp += r32 * pb + 8 * hi;
#pragma unroll
    for (int ks = 0; ks < KSTEPS; ++ks) { const bf16x8 a = *(const LAS bf16x8*)(Ap + 16 * ks), bq = *(const LAS bf16x8*)(Bp + 16 * ks); acc = MFMA32(a, bq, acc); }
    return acc;
}

template <int C, bool SCALED> DI void stage_T(LAS bf16* d0, LAS bf16* d1, const bf16* __restrict__ src, int spitch, const LAS float* w0, const LAS float* w1, int tid) {
    constexpr int OC = C / 8;
#pragma unroll
    for (int it0 = 0; it0 < 64 * OC; it0 += NTHREADS) {
        const int it = it0 + tid, oct = it % OC, tp = it / OC;
        const u32x4 r0 = *(const u32x4*)(src + (size_t)(2 * tp) * spitch + oct * 8), r1 = *(const u32x4*)(src + (size_t)(2 * tp + 1) * spitch + oct * 8);
        const unsigned a[4] = {r0.x, r0.y, r0.z, r0.w}, bq[4] = {r1.x, r1.y, r1.z, r1.w};
        if (!SCALED) {
#pragma unroll
            for (int k = 0; k < 4; ++k) {
                *(LAS unsigned*)(d0 + (oct * 8 + 2 * k) * TP + 2 * tp) = (a[k] & 0xffffu) | (bq[k] << 16);
                *(LAS unsigned*)(d0 + (oct * 8 + 2 * k + 1) * TP + 2 * tp) = (a[k] >> 16) | (bq[k] & 0xffff0000u);
            }
        } else {
            const float u0 = w0[2 * tp], u1 = w0[2 * tp + 1], v0 = w1[2 * tp], v1 = w1[2 * tp + 1];
#pragma unroll
            for (int k = 0; k < 4; ++k) {
                const float e0 = bflo(a[k]), e1 = bfhi(a[k]), f0 = bflo(bq[k]), f1 = bfhi(bq[k]);
                *(LAS unsigned*)(d0 + (oct * 8 + 2 * k) * TP + 2 * tp) = pk2(e0 * u0, f0 * u1);
                *(LAS unsigned*)(d0 + (oct * 8 + 2 * k + 1) * TP + 2 * tp) = pk2(e1 * u0, f1 * u1);
                *(LAS unsigned*)(d1 + (oct * 8 + 2 * k) * TP + 2 * tp) = pk2(e0 * v0, f0 * v1);
                *(LAS unsigned*)(d1 + (oct * 8 + 2 * k + 1) * TP + 2 * tp) = pk2(e1 * v0, f1 * v1);
            }
        }
    }
}
template <int R, int C> DI void stage_N(LAS bf16* d, int dp, const bf16* __restrict__ src, int spitch, int tid) {
    constexpr int OC = C / 8;
#pragma unroll
    for (int it0 = 0; it0 < R * OC; it0 += NTHREADS) { const int it = it0 + tid, oct = it % OC, r = it / OC; *(LAS u32x4*)(d + r * dp + oct * 8) = *(const u32x4*)(src + (size_t)r * spitch + oct * 8); }
}

DI void s1_ssd_unit(LAS unsigned char* lds, int tid, const ScanCtx& C, int b, int vc) {
    asm volatile("" : "+v"(tid));
    const int lane = tid & 63, wave = tid >> 6, r32 = lane & 31, hi = lane >> 5;
    LAS float* sc = (LAS float*)lds; LAS float* wts = (LAS float*)(lds + L_STAT);
    LAS bf16* BkT = (LAS bf16*)(lds + L_BUF); LAS bf16* XF = (LAS bf16*)(lds + L_BUF + 34816); LAS bf16* XB = (LAS bf16*)(lds + L_BUF + 34816 + 17408);
    const int row0 = vc_row0(b, vc);
    float* decp = C.dec + (size_t)((b * NVC + vc) * 2) * 8;
    __syncthreads();
    ssd_scalars(sc, tid, C.DT, row0, C.alog, C.dtb, decp, decp + 8);
    __syncthreads();
    { const int h = tid >> 7, s = tid & 127;
      wts[h * 128 + s] = __expf(sc[(SC_ACF * 4 + h) * 128 + 127] - sc[(SC_ACF * 4 + h) * 128 + s]) * sc[(SC_DT0 * 4 + h) * 128 + s];
      wts[(4 + h) * 128 + s] = __expf(sc[(SC_ACB * 4 + h) * 128 + 0] - sc[(SC_ACB * 4 + h) * 128 + s]) * sc[(SC_DT1 * 4 + h) * 128 + s]; }
    const bf16* Urow = C.U + (size_t)row0 * UW;
    for (int g = 0; g < 2; ++g) {
        __syncthreads();
        stage_T<128, false>(BkT, BkT, Urow + 256 + g * 128, UW, nullptr, nullptr, tid);
        for (int hh = 0; hh < 2; ++hh) {
            const int h = 2 * g + hh;
            if (hh) __syncthreads();
            stage_T<64, true>(XF, XB, Urow + h * 64, UW, wts + h * 128, wts + (4 + h) * 128, tid);
            __syncthreads();
            const int pt = wave >> 2, nt = wave & 3;
            f32x16 af = zero16(), ab = zero16();
            { const LAS bf16* Bp = BkT + (nt * 32 + r32) * TP + 8 * hi; const LAS bf16* Af = XF + (pt * 32 + r32) * TP + 8 * hi; const LAS bf16* Ab = XB + (pt * 32 + r32) * TP + 8 * hi;
#pragma unroll
              for (int ks = 0; ks < 8; ++ks) { const bf16x8 bq = *(const LAS bf16x8*)(Bp + 16 * ks); af = MFMA32(*(const LAS bf16x8*)(Af + 16 * ks), bq, af); ab = MFMA32(*(const LAS bf16x8*)(Ab + 16 * ks), bq, ab); } }
            bf16* of = C.sts + ((size_t)(((b * NVC + vc) * 2 + 0) * 4 + h)) * 8192; bf16* ob = C.sts + ((size_t)(((b * NVC + vc) * 2 + 1) * 4 + h)) * 8192;
#pragma unroll
            for (int i = 0; i < 16; ++i) { const int p = pt * 32 + 8 * (i >> 2) + 4 * hi + (i & 3), n = nt * 32 + r32; of[p * 128 + n] = f2bf(af[i]); ob[p * 128 + n] = f2bf(ab[i]); }
        }
    }
}
DI void s1_ret_unit(LAS unsigned char* lds, int tid, const ScanCtx& C, int b, int vc, int h0, int nh) {
    asm volatile("" : "+v"(tid));
    const int lane = tid & 63, wave = tid >> 6, r32 = lane & 31, hi = lane >> 5;
    LAS float* wts = (LAS float*)(lds + L_STAT);
    LAS bf16* KT = (LAS bf16*)(lds + L_BUF); LAS bf16* VF = (LAS bf16*)(lds + L_BUF + 17408); LAS bf16* VB = (LAS bf16*)(lds + L_BUF + 2 * 17408);
    const int row0 = vc_row0(b, vc);
    float* decp = C.dec + (size_t)((b * NVC + vc) * 2) * 8;
    __syncthreads();
    { const int h = tid >> 7, s = tid & 127; const float lg0 = C.rlg[h], lg1 = C.rlg[4 + h];
      wts[h * 128 + s] = __expf((float)(127 - s) * lg0); wts[(4 + h) * 128 + s] = __expf((float)s * lg1);
      if (s == 0) { decp[4 + h] = __expf(128.f * lg0); decp[8 + 4 + h] = __expf(128.f * lg1); } }
    const bf16* Prow = C.P + (size_t)row0 * NIN;
#pragma unroll 1
    for (int h = h0; h < h0 + nh; ++h) {
        __syncthreads();
        stage_T<64, false>(KT, KT, Prow + 2816 + h * 64, NIN, nullptr, nullptr, tid);
        stage_T<64, true>(VF, VB, Prow + 3072 + h * 64, NIN, wts + h * 128, wts + (4 + h) * 128, tid);
        __syncthreads();
        const int dir = wave >> 2, pt = (wave >> 1) & 1, nt = wave & 1;
        const f32x16 a = mma_lds<8>(zero16(), (dir ? VB : VF) + pt * 32 * TP, TP, KT + nt * 32 * TP, TP, lane);
        bf16* o = C.str + ((size_t)(((b * NVC + vc) * 2 + dir) * 4 + h)) * 4096;
#pragma unroll
        for (int i = 0; i < 16; ++i) { const int p = pt * 32 + 8 * (i >> 2) + 4 * hi + (i & 3), n = nt * 32 + r32; o[p * 64 + n] = f2bf(a[i]); }
    }
}

DI int s2_order(int dir, int step) { return dir == 0 ? step : (step == 0 ? 1 : (step == 1 ? 0 : 35 - step)); }
DI void s2_item(const ScanCtx& C, int gt) {
    bf16* base; int hh, dir, b; size_t vcstride;
    if (gt < 65536) { const int v = gt & 1023, h = (gt >> 10) & 3; dir = (gt >> 12) & 1; b = gt >> 13; hh = h; base = C.sts + (size_t)((b * NVC * 2 + dir) * 4 + h) * 8192 + v * 8; vcstride = (size_t)2 * 4 * 8192; }
    else if (gt < 65536 + 32768) { const int g2 = gt - 65536; const int v = g2 & 511, h = (g2 >> 9) & 3; dir = (g2 >> 11) & 1; b = g2 >> 12; hh = 4 + h; base = C.str + (size_t)((b * NVC * 2 + dir) * 4 + h) * 4096 + v * 8; vcstride = (size_t)2 * 4 * 4096; }
    else return;
    float s[8]; float zf = 0.f; asm volatile("" : "+v"(zf));
#pragma unroll
    for (int i = 0; i < 8; ++i) s[i] = zf;
#define S2_LD(k, st_) { const int vc_ = s2_order(dir, (st_)); v##k = *(const u32x4*)(base + (size_t)vc_ * vcstride); d##k = C.dec[(size_t)((b * NVC + vc_) * 2 + dir) * 8 + hh]; }
#define S2_ST(k, st_) { const int vc_ = s2_order(dir, (st_)); u32x4 w_; w_.x = pk2(s[0], s[1]); w_.y = pk2(s[2], s[3]); w_.z = pk2(s[4], s[5]); w_.w = pk2(s[6], s[7]); \
        *(u32x4*)(base + (size_t)vc_ * vcstride) = w_; \
        s[0] = s[0] * d##k + bflo(v##k.x); s[1] = s[1] * d##k + bfhi(v##k.x); s[2] = s[2] * d##k + bflo(v##k.y); s[3] = s[3] * d##k + bfhi(v##k.y); \
        s[4] = s[4] * d##k + bflo(v##k.z); s[5] = s[5] * d##k + bfhi(v##k.z); s[6] = s[6] * d##k + bflo(v##k.w); s[7] = s[7] * d##k + bfhi(v##k.w); }
    u32x4 v0, v1, v2, v3; float d0, d1, d2, d3;
    S2_LD(0, 0) S2_LD(1, 1) S2_LD(2, 2) S2_LD(3, 3)
#pragma unroll 1
    for (int step = 0; step < 32; step += 4) {
        S2_ST(0, step) if (step + 4 < NVC) S2_LD(0, step + 4)
        S2_ST(1, step + 1) if (step + 5 < NVC) S2_LD(1, step + 5)
        S2_ST(2, step + 2) if (step + 6 < NVC) S2_LD(2, step + 6)
        S2_ST(3, step + 3) if (step + 7 < NVC) S2_LD(3, step + 7)
    }
    S2_ST(0, 32) S2_ST(1, 33)
#undef S2_LD
#undef S2_ST
}

DI void s2_phase(const ScanCtx& C, int tid, int bid, int G) {
#pragma unroll 1
    for (int gt = bid * NTHREADS + tid; gt < 65536 + 32768; gt += G * NTHREADS) s2_item(C, gt);
}

DI void s3_ssd_unit(LAS unsigned char* lds, int tid, const ScanCtx& C, int b, int vc) {
    asm volatile("" : "+v"(tid));
    const int lane = tid & 63, wave = tid >> 6, r32 = lane & 31, hi = lane >> 5;
    LAS float* sc = (LAS float*)lds; LAS float* stat = (LAS float*)(lds + L_STAT);
    LAS bf16* Cq = (LAS bf16*)(lds + L_BUF); LAS bf16* BkM = (LAS bf16*)(lds + L_BUF + 34816); LAS bf16* XsT = (LAS bf16*)(lds + L_BUF + 2 * 34816);
    LAS bf16* Hf = (LAS bf16*)(lds + L_BUF + 2 * 34816 + 17408); LAS bf16* Hb = (LAS bf16*)(lds + L_BUF + 2 * 34816 + 2 * 17408);
    const int row0 = vc_row0(b, vc);
    const int pt = wave & 1, tt = wave >> 1;
    const bf16* Urow = C.U + (size_t)row0 * UW;
    __syncthreads();
    ssd_scalars(sc, tid, C.DT, row0, C.alog, C.dtb, nullptr, nullptr);
    float ssq = 0.f;
    const int tq_ = tt * 32 + r32; const int rowq = row0 + tq_;
#pragma unroll 1
    for (int g = 0; g < 2; ++g) {
        __syncthreads();
        stage_N<128, 128>(Cq, TP, Urow + 512 + g * 128, UW, tid);
        stage_N<128, 128>(BkM, TP, Urow + 256 + g * 128, UW, tid);
        __syncthreads();
        f32x16 gacc0, gacc1;
        { const int id = 2 * wave, st = id & 3, tq = id >> 2; gacc0 = mma_lds<8>(zero16(), BkM + st * 32 * TP, TP, Cq + tq * 32 * TP, TP, lane); }
        { const int id = 2 * wave + 1, st = id & 3, tq = id >> 2; gacc1 = mma_lds<8>(zero16(), BkM + st * 32 * TP, TP, Cq + tq * 32 * TP, TP, lane); }
#pragma unroll 1
        for (int hh = 0; hh < 2; ++hh) {
            const int h = 2 * g + hh;
            __syncthreads();
            const int oct_ = tid & 7, tp_ = tid >> 3;
            const u32x4 xr0 = *(const u32x4*)(Urow + h * 64 + (size_t)(2 * tp_) * UW + oct_ * 8), xr1 = *(const u32x4*)(Urow + h * 64 + (size_t)(2 * tp_ + 1) * UW + oct_ * 8);
            const bf16* sfp = C.sts + ((size_t)(((b * NVC + vc) * 2 + 0) * 4 + h)) * 8192; const bf16* sbp = C.sts + ((size_t)(((b * NVC + vc) * 2 + 1) * 4 + h)) * 8192;
            u32x4 hfv[2], hbv[2];
#pragma unroll
            for (int i = 0; i < 2; ++i) { const int itn = tid + NTHREADS * i, octn = itn & 15, rn = itn >> 4; hfv[i] = *(const u32x4*)(sfp + rn * 128 + octn * 8); hbv[i] = *(const u32x4*)(sbp + rn * 128 + octn * 8); }
            u32x2 zz[4];
#pragma unroll
            for (int g4 = 0; g4 < 4; ++g4) zz[g4] = *(const u32x2*)(C.P + (size_t)rowq * NIN + 1536 + h * 64 + pt * 32 + 8 * g4 + 4 * hi);
            { const LAS float* acf = sc + (SC_ACF * 4 + h) * 128; const LAS float* acb = sc + (SC_ACB * 4 + h) * 128; const LAS float* d0 = sc + (SC_DT0 * 4 + h) * 128; const LAS float* d1 = sc + (SC_DT1 * 4 + h) * 128;
#pragma unroll
              for (int q = 0; q < 2; ++q) { const int id = 2 * wave + q, st = id & 3, tq = id >> 2; const int t = tq * 32 + r32; const float aft = acf[t], abt = acb[t];
#pragma unroll
                  for (int g4 = 0; g4 < 4; ++g4) { float mv[4];
#pragma unroll
                      for (int j = 0; j < 4; ++j) { const int s = st * 32 + 8 * g4 + 4 * hi + j;
                          float f; if (s < t) f = __expf(aft - acf[s]) * d0[s]; else if (s > t) f = __expf(abt - acb[s]) * d1[s]; else f = d0[s] + d1[s];
                          mv[j] = (q ? gacc1[4 * g4 + j] : gacc0[4 * g4 + j]) * f; }
                      u32x2 w; w.x = pk2(mv[0], mv[1]); w.y = pk2(mv[2], mv[3]);
                      *(LAS u32x2*)(BkM + t * TP + st * 32 + 8 * g4 + 4 * hi) = w; } } }
            { const unsigned a_[4] = {xr0.x, xr0.y, xr0.z, xr0.w}, b_[4] = {xr1.x, xr1.y, xr1.z, xr1.w};
#pragma unroll
              for (int k = 0; k < 4; ++k) {
                  *(LAS unsigned*)(XsT + (oct_ * 8 + 2 * k) * TP + 2 * tp_) = (a_[k] & 0xffffu) | (b_[k] << 16);
                  *(LAS unsigned*)(XsT + (oct_ * 8 + 2 * k + 1) * TP + 2 * tp_) = (a_[k] >> 16) | (b_[k] & 0xffff0000u); }
#pragma unroll
              for (int i = 0; i < 2; ++i) { const int itn = tid + NTHREADS * i, octn = itn & 15, rn = itn >> 4; *(LAS u32x4*)(Hf + rn * TP + octn * 8) = hfv[i]; *(LAS u32x4*)(Hb + rn * TP + octn * 8) = hbv[i]; } }
            __syncthreads();
            f32x16 y = mma_lds<8>(zero16(), XsT + pt * 32 * TP, TP, BkM + tt * 32 * TP, TP, lane);
            { const float dsum = C.ssmd[h] + C.ssmd[4 + h];
#pragma unroll
              for (int i = 0; i < 16; ++i) { const int p = pt * 32 + 8 * (i >> 2) + 4 * hi + (i & 3); y[i] += dsum * bf2f(XsT[p * TP + tq_]); } }
            __builtin_amdgcn_sched_barrier(0);
            { const f32x16 af = mma_lds<8>(zero16(), Hf + pt * 32 * TP, TP, Cq + tt * 32 * TP, TP, lane);
              const float ef = __expf(sc[(SC_ACF * 4 + h) * 128 + tq_]);
#pragma unroll
              for (int i = 0; i < 16; ++i) y[i] += ef * af[i]; }
            __builtin_amdgcn_sched_barrier(0);
            { const f32x16 ab = mma_lds<8>(zero16(), Hb + pt * 32 * TP, TP, Cq + tt * 32 * TP, TP, lane);
              const float eb = __expf(sc[(SC_ACB * 4 + h) * 128 + tq_]);
#pragma unroll
              for (int i = 0; i < 16; ++i) y[i] += eb * ab[i]; }
#pragma unroll
            for (int g4 = 0; g4 < 4; ++g4) {
                const int p = pt * 32 + 8 * g4 + 4 * hi;
                const float v0 = y[4 * g4] * silu_f(bflo(zz[g4].x)), v1 = y[4 * g4 + 1] * silu_f(bfhi(zz[g4].x)), v2 = y[4 * g4 + 2] * silu_f(bflo(zz[g4].y)), v3 = y[4 * g4 + 3] * silu_f(bfhi(zz[g4].y));
                ssq += v0 * v0 + v1 * v1 + v2 * v2 + v3 * v3;
                u32x2 w; w.x = pk2(v0, v1); w.y = pk2(v2, v3);
                *(u32x2*)(C.MG + (size_t)rowq * DM + 512 + h * 64 + p) = w;
            }
        }
    }
    ssq += __shfl_xor(ssq, 32);
    __syncthreads();
    if (hi == 0) stat[tq_ * 2 + pt] = ssq;
    __syncthreads();
    const float rn = 1.0f / sqrtf((stat[tq_ * 2] + stat[tq_ * 2 + 1]) * (1.0f / 256.0f) + 1e-6f);
#pragma unroll
    for (int h = 0; h < 4; ++h)
#pragma unroll
        for (int g4 = 0; g4 < 4; ++g4) {
            const int p = pt * 32 + 8 * g4 + 4 * hi;
            const f32x4 gv = *(const f32x4*)(C.ssmg + h * 64 + p);
            u32x2* mp = (u32x2*)(C.MG + (size_t)rowq * DM + 512 + h * 64 + p);
            const u32x2 v = *mp;
            u32x2 w; w.x = pk2(bflo(v.x) * rn * gv.x, bfhi(v.x) * rn * gv.y); w.y = pk2(bflo(v.y) * rn * gv.z, bfhi(v.y) * rn * gv.w);
            *mp = w;
        }
}
DI void s3_ret_unit(LAS unsigned char* lds, int tid, const ScanCtx& C, int b, int vc, int h0, int nh) {
    asm volatile("" : "+v"(tid));
    const int lane = tid & 63, wave = tid >> 6, r32 = lane & 31, hi = lane >> 5;
    LAS float* stat = (LAS float*)(lds + L_STAT);
    LAS bf16* Q = (LAS bf16*)(lds + L_BUF); LAS bf16* K = (LAS bf16*)(lds + L_BUF + 18432); LAS bf16* VT = (LAS bf16*)(lds + L_BUF + 2 * 18432);
    LAS bf16* Hf = (LAS bf16*)(lds + L_BUF + 2 * 18432 + 17408); LAS bf16* Hb = (LAS bf16*)(lds + L_BUF + 2 * 18432 + 17408 + 9216); LAS bf16* MB = (LAS bf16*)(lds + L_BUF + 2 * 18432 + 17408 + 2 * 9216);
    const int row0 = vc_row0(b, vc);
    const int pt = wave & 1, tt = wave >> 1;
    const bf16* Prow = C.P + (size_t)row0 * NIN;
    const int t = tt * 32 + r32; const int row = row0 + t;
#pragma unroll 1
    for (int h = h0; h < h0 + nh; ++h) {
        const float lg0 = C.rlg[h], lg1 = C.rlg[4 + h];
        __syncthreads();
        stage_N<128, 64>(Q, QP, Prow + 2560 + h * 64, NIN, tid);
        stage_N<128, 64>(K, QP, Prow + 2816 + h * 64, NIN, tid);
        stage_T<64, false>(VT, VT, Prow + 3072 + h * 64, NIN, nullptr, nullptr, tid);
        stage_N<64, 64>(Hf, QP, C.str + ((size_t)(((b * NVC + vc) * 2 + 0) * 4 + h)) * 4096, 64, tid);
        stage_N<64, 64>(Hb, QP, C.str + ((size_t)(((b * NVC + vc) * 2 + 1) * 4 + h)) * 4096, 64, tid);
        __syncthreads();
#pragma unroll
        for (int q = 0; q < 2; ++q) { const int id = 2 * wave + q, st = id & 3, tq = id >> 2;
            const f32x16 gacc = mma_lds<4>(zero16(), K + st * 32 * QP, QP, Q + tq * 32 * QP, QP, lane);
            const int t2 = tq * 32 + r32;
#pragma unroll
            for (int g4 = 0; g4 < 4; ++g4) { float mv[4];
#pragma unroll
                for (int j = 0; j < 4; ++j) { const int s = st * 32 + 8 * g4 + 4 * hi + j;
                    const float f = (s < t2) ? __expf((float)(t2 - s) * lg0) : ((s > t2) ? __expf((float)(s - t2) * lg1) : 2.0f);
                    mv[j] = gacc[4 * g4 + j] * f; }
                u32x2 w; w.x = pk2(mv[0], mv[1]); w.y = pk2(mv[2], mv[3]);
                *(LAS u32x2*)(MB + t2 * TP + st * 32 + 8 * g4 + 4 * hi) = w; } }
        __syncthreads();
        u32x2 ggv[4];
#pragma unroll
        for (int g4 = 0; g4 < 4; ++g4) ggv[g4] = *(const u32x2*)(C.P + (size_t)row * NIN + 3328 + h * 64 + pt * 32 + 8 * g4 + 4 * hi);
        f32x16 y = mma_lds<8>(zero16(), VT + pt * 32 * TP, TP, MB + tt * 32 * TP, TP, lane);
        { const f32x16 af = mma_lds<4>(zero16(), Hf + pt * 32 * QP, QP, Q + tt * 32 * QP, QP, lane);
          const float ef = __expf((float)(t + 1) * lg0);
#pragma unroll
          for (int i = 0; i < 16; ++i) y[i] += ef * af[i]; }
        { const f32x16 ab = mma_lds<4>(zero16(), Hb + pt * 32 * QP, QP, Q + tt * 32 * QP, QP, lane);
          const float eb = __expf((float)(128 - t) * lg1);
#pragma unroll
          for (int i = 0; i < 16; ++i) y[i] += eb * ab[i]; }
        float s1 = 0.f, s2 = 0.f;
#pragma unroll
        for (int i = 0; i < 16; ++i) { s1 += y[i]; s2 += y[i] * y[i]; }
        s1 += __shfl_xor(s1, 32); s2 += __shfl_xor(s2, 32);
        if (hi == 0) { stat[(t * 2 + pt) * 2] = s1; stat[(t * 2 + pt) * 2 + 1] = s2; }
        __syncthreads();
        const float t1 = stat[(t * 2) * 2] + stat[(t * 2 + 1) * 2], t2s = stat[(t * 2) * 2 + 1] + stat[(t * 2 + 1) * 2 + 1];
        const float mean = t1 * (1.0f / 64.0f), var = fmaxf(t2s * (1.0f / 64.0f) - mean * mean, 0.f), rs = 1.0f / sqrtf(var + 1e-5f);
#pragma unroll
        for (int g4 = 0; g4 < 4; ++g4) {
            const int p = pt * 32 + 8 * g4 + 4 * hi;
            const float g0 = silu_f(bflo(ggv[g4].x)), g1 = silu_f(bfhi(ggv[g4].x)), g2 = silu_f(bflo(ggv[g4].y)), g3 = silu_f(bfhi(ggv[g4].y));
            u32x2 w; w.x = pk2((y[4 * g4] - mean) * rs * g0, (y[4 * g4 + 1] - mean) * rs * g1); w.y = pk2((y[4 * g4 + 2] - mean) * rs * g2, (y[4 * g4 + 3] - mean) * rs * g3);
            *(u32x2*)(C.MG + (size_t)row * DM + 768 + h * 64 + p) = w;
        }
    }
}

constexpr int NPP = 13, NPH = 2 + NPP * DEPTH;
#ifndef PMASK
#define PMASK 0xffff
#endif
#define PEN(k) ((PMASK >> (k)) & 1)
#ifndef PROBE_LASTONLY
#define PROBE_LASTONLY 0
#endif
#ifndef PROBE_N
#define PROBE_N 1
#endif
#ifndef REP_SPLIT
#define REP_SPLIT 1
#endif
#ifndef REP_P0
#define REP_P0 1
#endif
#ifndef REP_LN
#define REP_LN 1
#endif
#ifndef REP_SYNC
#define REP_SYNC 1
#endif
#ifndef REP_ATTN
#define REP_ATTN 1
#endif
#ifndef REP_UP
#define REP_UP 1
#endif
#ifndef REP_IN
#define REP_IN 1
#endif
#ifndef REP_SCAN
#define REP_SCAN 1
#endif

#define GAS __attribute__((address_space(1)))
#define XB_TMO      128
#define XB_XCNT(j)  (256  + 64 * (j))
#define XB_XSUB(j)  (1280 + 64 * (j))
#define XB_XGEN(j)  (2304 + 64 * (j))
#define XB_TOP      3328
#define XB_TOPGEN   3392
#define XCD_BAR_WORDS 3456
#define XB_SPIN_CAP (1u << 18)

__device__ __forceinline__ unsigned xb_ld(unsigned* p)              { return __hip_atomic_load(p, __ATOMIC_RELAXED, __HIP_MEMORY_SCOPE_AGENT); }
__device__ __forceinline__ unsigned xb_add(unsigned* p, unsigned v) { return __hip_atomic_fetch_add(p, v, __ATOMIC_RELAXED, __HIP_MEMORY_SCOPE_AGENT); }
__device__ __forceinline__ unsigned xb_xcc_id() { return (unsigned)__builtin_amdgcn_s_getreg((3 << 11) | 20) & 0xFu; }
#define XB_SPIN(cond, bar) do { unsigned _sp = 0; while (cond) { __builtin_amdgcn_s_sleep(1); \
    if ((++_sp & 255u) == 0u) { if (xb_ld(&(bar)[XB_TMO])) break; if (_sp > XB_SPIN_CAP) { atomicAdd(&(bar)[XB_TMO], 1u); break; } } } } while (0)

struct XcdBarrier {
    unsigned* bar; unsigned x;
    volatile LAS unsigned* st;
};

__device__ __forceinline__ XcdBarrier xcd_barrier_post(unsigned* bar, volatile LAS unsigned* st) {
    XcdBarrier b; b.bar = bar; b.x = xb_xcc_id(); b.st = st;
    if (threadIdx.x == 0) (void)xb_add(&bar[XB_XCNT(b.x)], 1u);
    return b;
}
__device__ __forceinline__ void xcd_barrier_complete(unsigned* bar, unsigned x, unsigned& nloc, unsigned& nx) {
    const unsigned G = gridDim.x * gridDim.y * gridDim.z;
    unsigned sum, cnt, mine, sp = 0u;
    for (;;) {
        sum = 0u; cnt = 0u; mine = 0u;
#pragma unroll
        for (unsigned j = 0; j < 16; ++j) { const unsigned c = xb_ld(&bar[XB_XCNT(j)]); sum += c; cnt += (c > 0u) ? 1u : 0u; mine = (j == x) ? c : mine; }
        if (sum == G) break;
        __builtin_amdgcn_s_sleep(1);
        if ((++sp & 255u) == 0u) { if (xb_ld(&bar[XB_TMO])) break; if (sp > XB_SPIN_CAP) { atomicAdd(&bar[XB_TMO], 1u); break; } }
    }
    nloc = mine > 0u ? mine : 1u; nx = cnt > 0u ? cnt : 1u;
}

__device__ __forceinline__ void xcd_barrier(const XcdBarrier& b) {
    asm volatile("s_waitcnt vmcnt(0)" ::: "memory");
    __syncthreads();
    if (threadIdx.x == 0) {
        unsigned* bar = b.bar;
        __builtin_amdgcn_s_waitcnt(0);
        unsigned nloc = b.st[0], nx = b.st[1];
        if (nloc == 0u) { xcd_barrier_complete(bar, b.x, nloc, nx); b.st[0] = nloc; b.st[1] = nx; }
        const unsigned old = xb_add(&bar[XB_XSUB(b.x)], 1u);
        const unsigned gen = old / nloc;
        if (old + 1u == (gen + 1u) * nloc) {
            __builtin_amdgcn_fence(__ATOMIC_RELEASE, "agent");
            asm volatile("s_waitcnt vmcnt(0)" ::: "memory");
            const unsigned og = xb_add(&bar[XB_TOP], 1u);
            const unsigned tg = og / nx;
            if (og + 1u == (tg + 1u) * nx) xb_add(&bar[XB_TOPGEN], 1u);
            else XB_SPIN(xb_ld(&bar[XB_TOPGEN]) == tg, bar);
            __builtin_amdgcn_fence(__ATOMIC_ACQUIRE, "agent");
            xb_add(&bar[XB_XGEN(b.x)], 1u);
            asm volatile("s_waitcnt vmcnt(0)" ::: "memory");
        } else {
            XB_SPIN(xb_ld(&bar[XB_XGEN(b.x)]) == gen, bar);
            __builtin_amdgcn_fence(__ATOMIC_ACQUIRE, "agent");
            asm volatile("s_waitcnt vmcnt(0)" ::: "memory");
        }
    }
    __syncthreads();
}
template <class Epi> DI void run_gemm(LAS unsigned char* lds, int tid, const bf16* Ap, const bf16* Bt, int M, int N, int K, int G, int bid, const Epi& E, int ld = 0) {
    pg8::Gemm g{Ap, Bt, M, N, K, ld ? ld : K}; pg8::StaticOrder S; S.init(M, N, G, bid);
    pg8::gemm_phase<Epi, pg8::StaticOrder, true, true>(lds, g, S, E, tid);
}

__global__ void __launch_bounds__(NTHREADS, 2) mega(Args A) {
    extern __shared__ __attribute__((aligned(16))) unsigned char lds_raw[];
    LAS unsigned char* lds = (LAS unsigned char*)lds_raw;
    cg::grid_group grid = cg::this_grid();
    const int tid0 = threadIdx.x, bid0 = blockIdx.x, G0 = gridDim.x;
    { volatile LAS unsigned* bst0 = (volatile LAS unsigned*)(lds + LDS_BYTES - 64); if (tid0 < 16) bst0[tid0] = 0u;
      if (bid0 == 0) { unsigned* bw = (unsigned*)(A.ws + WS_BAR); for (int i = tid0; i < XCD_BAR_WORDS; i += NTHREADS) bw[i] = 0u; } }
    __syncthreads();
    int rep_done = 0; (void)rep_done;
    for (int ph = A.ph_lo; ph < A.ph_hi; ++ph) {
        if (ph > A.ph_lo) {
            if (ph == A.ph_lo + 1) { grid.sync(); (void)xcd_barrier_post((unsigned*)(A.ws + WS_BAR), (volatile LAS unsigned*)(lds + LDS_BYTES - 64)); }
            else { for (int rs_ = 0; rs_ < REP_SYNC; ++rs_) { XcdBarrier xb_; xb_.bar = (unsigned*)(A.ws + WS_BAR); xb_.x = xb_xcc_id(); xb_.st = (volatile LAS unsigned*)(lds + LDS_BYTES - 64); xcd_barrier(xb_); } }
        }
        int tid = tid0, bid = bid0, G = G0; size_t zoff = 0;
        asm volatile("" : "+v"(tid)); asm volatile("" : "+s"(bid)); asm volatile("" : "+s"(G)); asm volatile("" : "+s"(zoff));
        unsigned char* ws = A.ws + zoff;
        float* xc = (float*)(ws + WS_XC);
        bf16* Abuf = (bf16*)(ws + WS_A); bf16* HP = (bf16*)(ws + WS_HP); bf16* Vt = (bf16*)(ws + WS_VT);
        const float* MOD = (const float*)(ws + WS_MOD);
        if (ph == 0) { if (PEN(0)) for (int rp_ = 0; rp_ < REP_P0; ++rp_) { p0a_phase(A, lds, tid, bid, G); __syncthreads(); } continue; }
        if (ph == 1) { if (PEN(1)) for (int rp_ = 0; rp_ < REP_LN; ++rp_) lnmod_phase(A, lds, tid, bid, G, true, -1, 0, 0, 0, false, M_ALL, false, nullptr, nullptr); continue; }
        const int q = ph - 2, l = q / NPP; int s = q % NPP; const bool is_conv = (s == 4); if (s >= 4) s -= 1; if (is_conv) s = 100;
        const bool last = (l == DEPTH - 1);
        const int Mpost = last ? M_LAT : M_ALL;
        if ((s == 0 || s == 9) && PEN(2)) {
            const int f = (s == 9); EpiSwiglu E{HP};
            for (int rp_ = 0; rp_ < REP_UP; ++rp_) run_gemm(lds, tid, Abuf, (const bf16*)(ws + WS_WGU) + (size_t)f * NGU * DM, f ? Mpost : M_ALL, NGU, DM, G, bid, E);
            if (f && !last && G == 256) convw_phase(A, l + 1, lds, tid, bid, 176, 80, 2);
        } else if ((s == 1 || s == 10 || s == 7) && PEN(3)) {
            const int i = (s == 1) ? 0 : (s == 7 ? 1 : 2);
            const int prev_idx = (i == 0) ? (l == 0 ? -1 : (l - 1) * 3 + 2) : l * 3 + (i - 1);
            const float* modg_p = MOD + (size_t)l * 9 * 9216 + i * 3072 + 2048;
            const float* scale_v = (s == 7) ? (const float*)(ws + WS_ONES) : (const float*)(ws + WS_HALVES);
            const float* gprev_p = prev_idx < 0 ? (const float*)(ws + WS_ONES) : A.in[I_NG] + prev_idx * DM; const float* bprev_p = prev_idx < 0 ? (const float*)(ws + WS_ZEROS) : A.in[I_NB] + prev_idx * DM;
            EpiResid E{(bf16*)(ws + WS_X16), modg_p, scale_v, (const f32x2*)(ws + WS_STAT), gprev_p, bprev_p};
            const bool has_ctx = (s == 1) || !last;
            const bf16* Ap = (s == 7) ? Abuf : HP; const bf16* Bp = (s == 7) ? (const bf16*)(ws + WS_WOUT) : (const bf16*)(ws + WS_WDN) + (size_t)(s == 10) * DM * DFF;
            const int Kd = (s == 7) ? DM : DFF;
            const int ldd = (s == 7) ? DM : DFF;
            run_gemm(lds, tid, Ap, Bp, M_LAT, DM, Kd, G, bid, E, ldd);
            if (has_ctx) {
                const int sb = (G == 256 && ((bid >> 3) & 7) < 4 && bid < 256) ? ((bid & 7) | (((bid >> 3) & 3) << 3) | ((bid >> 6) << 5)) : (G == 256 ? 999 : (bid + G - 64) % G);
                const int qd = (sb >> 5) & 3;
                const int kt0 = (s == 7) ? 4 * qd : (qd < 2 ? 12 * qd : 24 + 10 * (qd - 2));
                const int ktn = (s == 7) ? 4 : (qd < 2 ? 12 : 10);
                OneUnit S1u; S1u.have = sb < 128; S1u.u.pm = 128 + (sb & 7); S1u.u.pn = (sb >> 3) & 3;
                EpiPartial Ep{(float*)(ws + WS_T) + (size_t)qd * M_CTX * DM, modg_p, scale_v};
                pg8::Gemm g2{Ap + (size_t)kt0 * 64, Bp + (size_t)kt0 * 64, M_ALL, DM, ktn * 64, ldd};
                pg8::gemm_phase<EpiPartial, OneUnit, true, true>(lds, g2, S1u, Ep, tid);
            }
        } else if (s == 2 && PEN(1)) {
            lnmod_phase(A, lds, tid, bid, G, false, l, 0, l, 1, true, M_ALL, true, l == 0 ? (const float*)(ws + WS_ONES) : A.in[I_NG] + ((l - 1) * 3 + 2) * DM, l == 0 ? (const float*)(ws + WS_ZEROS) : A.in[I_NB] + ((l - 1) * 3 + 2) * DM);
        } else if (s == 3 && PEN(4)) {
            EpiIn E{HP, Vt, (const f32x2*)(ws + WS_TATT), (const f32x2*)(ws + WS_TRET)};
            for (int rp_ = 0; rp_ < REP_IN; ++rp_) run_gemm(lds, tid, Abuf, (const bf16*)(ws + WS_WIN), M_ALL, NIN, DM, G, bid, E);
            if (!last && G == 256) convw_phase(A, l + 1, lds, tid, bid, 112, 144, 1);
        } else if (is_conv || s == 4 || s == 5 || s == 6) {
            ScanCtx C{HP, (const bf16*)(ws + WS_U), (const float*)(ws + WS_DT), (bf16*)(ws + WS_STS), (bf16*)(ws + WS_STR), (float*)(ws + WS_DEC), Abuf,
                      A.in[I_CONVW] + (size_t)l * 5 * 768, A.in[I_CONVB] + l * 768, A.in[I_ALOG] + l * 8, A.in[I_DTB] + l * 8, A.in[I_SSMD] + l * 8, A.in[I_SSMG] + l * 256, A.in[I_RLG] + l * 8};
            const float lam = ((const float*)(ws + WS_LAM))[l];
            const float lam_init = 0.8f - 0.6f * expf(-0.3f * (float)l);
            const float* subg = A.in[I_SUBG] + l * 128;
            const int r = is_conv ? 0 : s - 3;
            if (PEN(7)) for (int rp_ = 0; rp_ < REP_ATTN; ++rp_) for (int u = bid; u < 256; u += G) { const int bh = r * 8 + (u & 7), qb = u >> 3;
                attn_unit(lds, tid, HP, Vt, Abuf, bh >> 2, bh & 3, (bh >> 2) * SEQ + qb * 128, 0, 68, lam, 1.0f - lam_init, subg); }
            if (is_conv) {
                if (PEN(10)) conv_phase(HP, (bf16*)(ws + WS_U), C.cw, C.cb, tid, bid, G);
            } else if (s == 4) {
                { const int nS1 = NB * NVC, extra1 = (nS1 > G && nS1 < 2 * G) ? nS1 - G : 0;
                  if (PEN(5)) { for (int u = bid; u < nS1; u += G) s1_ssd_unit(lds, tid, C, u / NVC, u % NVC);
                      if (bid >= extra1) for (int r = bid - extra1; r < 4 * nS1; r += G - extra1) { const int v = r >> 2; s1_ret_unit(lds, tid, C, v / NVC, v % NVC, r & 3, 1); } } }
            } else if (s == 5) {
                if (PEN(6)) s2_phase(C, tid, bid, G);
            } else {
                const int vc0 = last ? 2 : 0, nvc = NVC - vc0;
                const int nS = NB * nvc, extra = (nS > G && nS < 2 * G) ? nS - G : 0;
                if (PEN(8)) for (int u = bid; u < nS; u += G) s3_ssd_unit(lds, tid, C, u / nvc, vc0 + u % nvc);
                if (PEN(9) && bid >= extra) for (int r = bid - extra; r < 4 * nS; r += G - extra) { const int v = r >> 2; s3_ret_unit(lds, tid, C, v / nvc, vc0 + v % nvc, r & 3, 1); }
                if (!last && PEN(7)) for (int u = (bid + G - 64) % G; u < 64; u += G) { const int bh = u >> 1; attn_unit(lds, tid, HP, Vt, Abuf, bh >> 2, bh & 3, M_LAT + (bh >> 2) * CTXL + (u & 1) * 128, 64, 68, lam, 1.0f - lam_init, subg); }
            }
        } else if (s == 8 && PEN(1)) {
            lnmod_phase(A, lds, tid, bid, G, false, l, 1, l, 2, false, Mpost, !last, A.in[I_NG] + (l * 3) * DM, A.in[I_NB] + (l * 3) * DM);
        } else if (s == 11 && PEN(1)) {
            lnmod_phase(A, lds, tid, bid, G, false, l, 2, last ? -1 : l + 1, 0, false, Mpost, !last, A.in[I_NG] + (l * 3 + 1) * DM, A.in[I_NB] + (l * 3 + 1) * DM);
            if (!last) convw_phase(A, l + 1, lds, tid, bid, 0, G, (G == 256) ? 4 : 7);
        }
#ifdef PROBE_S
        if ((s == (PROBE_S) || s == (PROBE_S2)) && (PROBE_LASTONLY == 0 || last) && rep_done < PROBE_N) { ++rep_done; --ph; } else rep_done = 0;
#endif
    }
}

extern "C" void kernel_launch(void* const* d_in, const int* in_sizes, int n_in, void* d_out, int out_size, void* d_ws, size_t ws_size, hipStream_t stream) {
    static int grid = 0;
    if (grid == 0) {
        if (n_in != 22 || in_sizes[0] != M_LAT * DM || out_size != M_LAT * DM || ws_size < WS_END) { fprintf(stderr, "kernel_launch: unexpected shapes (n_in %d, out %d, ws %zu)\n", n_in, out_size, ws_size); grid = -1; return; }
        int dev = 0, cus = 0, per_cu = 0;
        hipGetDevice(&dev); hipDeviceGetAttribute(&cus, hipDeviceAttributeMultiprocessorCount, dev);
        if (hipFuncSetAttribute((const void*)mega, hipFuncAttributeMaxDynamicSharedMemorySize, LDS_BYTES) != hipSuccess) { fprintf(stderr, "kernel_launch: hipFuncSetAttribute failed\n"); grid = -1; return; }
        if (hipOccupancyMaxActiveBlocksPerMultiprocessor(&per_cu, (const void*)mega, NTHREADS, LDS_BYTES) != hipSuccess || per_cu < 1) { fprintf(stderr, "kernel_launch: occupancy query says %d\n", per_cu); per_cu = 1; }
        (void)hipGetLastError();
        grid = cus * 1;
    }
    if (grid < 0) return;
    Args a{};
    for (int i = 0; i < 22; ++i) a.in[i] = (const float*)d_in[i];
    a.out = (float*)d_out; a.ws = (unsigned char*)d_ws;
    for (int i = 0; i < 16; ++i) a.afreq[i] = 1.0f / powf(10000.0f, (float)(2 * i) / 32.0f);
    for (int i = 0; i < 32; ++i) a.rfreq[i] = 1.0f / powf(10000.0f, (float)i / 31.0f);
#ifdef MK_MULTI
    for (int ph = 0; ph < NPH; ++ph) { a.ph_lo = ph; a.ph_hi = ph + 1; hipLaunchKernelGGL(mega, dim3(grid), dim3(NTHREADS), LDS_BYTES, stream, a); }
#else
    a.ph_lo = 0; a.ph_hi = NPH;
    void* args[] = {&a};
    hipError_t e = hipLaunchCooperativeKernel((const void*)mega, dim3(grid), dim3(NTHREADS), args, LDS_BYTES, stream);
    if (e != hipSuccess) fprintf(stderr, "cooperative launch failed: %s (grid %d)\n", hipGetErrorString(e), grid);
#endif
}
```

```cpp
#include <hip/hip_runtime.h>
#include <hip/hip_cooperative_groups.h>
#include <cstdio>
#include <cstdint>
#include <cmath>
namespace cg = cooperative_groups;

namespace pg8 {
#define PG8_LAS __attribute__((address_space(3)))
typedef unsigned short bf16_t;
typedef short bf16x8 __attribute__((ext_vector_type(8)));
typedef float f32x4 __attribute__((ext_vector_type(4)));
typedef unsigned u32x4 __attribute__((ext_vector_type(4)));
constexpr int BM = 256, BK = 64, HALF = 128, HTB = HALF * BK * 2  , STAGE_BYTES = 8 * HTB, NXCD = 8, WGM = 8;

__host__ __device__ __forceinline__ int lds_byte(int r, int c) { const int st = (r >> 4) * 2 + (c >> 5), rr = r & 15, cc = c & 31, ob = rr * 64 + cc * 2; return st * 1024 + (ob ^ (((ob >> 9) & 1) << 5)); }
__host__ __device__ __forceinline__ void stage_rc(int b, int& R, int& C) { const int st = b / 1024, sb = b % 1024, swz = sb ^ (((sb >> 9) & 1) << 5); R = (st >> 1) * 16 + swz / 64; C = (st & 1) * 32 + (swz % 64) / 2; }
__host__ __device__ __forceinline__ int perm32(int rho) { const int n = rho >> 4, i = rho & 15; return 8 * (i >> 2) + 4 * n + (i & 3); }

struct Unit { int pm, pn; };
struct Gemm { const bf16_t* A; const bf16_t* Bt; int M, N, K, ld; };

struct StaticOrder {
    int nM, nN, nwg, G, c;
    __host__ __device__ void init(int M, int N, int G_, int c_) { nM = M / BM; nN = N / BM; nwg = nM * nN; G = G_; c = c_; }
    __host__ __device__ bool next(int i, Unit& u) const {
        const long L = (long)i * G + c; if (L >= nwg) return false;
        int wgid = (int)L; { const int q = nwg / NXCD, r = nwg % NXCD, xcd = wgid % NXCD, off = wgid / NXCD; wgid = (xcd < r ? xcd * (q + 1) : r * (q + 1) + (xcd - r) * q) + off; }
        const int nig = WGM * nN, gid = wgid / nig, fm = gid * WGM, gsz = (nM - fm) < WGM ? (nM - fm) : WGM;
        u.pm = fm + ((wgid % nig) % gsz); u.pn = (wgid % nig) / gsz; return true;
    }
    __device__ __forceinline__ void a_ready(const Unit&) const {}
    __device__ __forceinline__ void done(const Unit&) const {}
};

__device__ __forceinline__ unsigned cvt_pk_bf16(float lo, float hi) { unsigned r; asm volatile("v_cvt_pk_bf16_f32 %0, %1, %2" : "=v"(r) : "v"(lo), "v"(hi)); return r; }
template <class Epi, class Sched, bool ALIGN_EPI = false, bool SP2 = false>
__device__ __forceinline__ void gemm_phase(PG8_LAS unsigned char* lds, const Gemm g, const Sched& S, const Epi& E, const int tid) {
    const int wid = __builtin_amdgcn_readfirstlane(tid >> 6), lane = tid & 63, wr = wid >> 2, wc = wid & 3, fr = lane & 15, fq = lane >> 4;
    const int K = g.K, nt = K / BK;
    unsigned voffA[2], voffB[2];
#pragma unroll
    for (int i = 0; i < 2; ++i) { int R, C; stage_rc(tid * 16 + i * 8192, R, C); const int Rb = Epi::PERM ? ((R & ~31) + perm32(R & 31)) : R;
        voffA[i] = (unsigned)(R * g.ld + C) * 2u; voffB[i] = (unsigned)(Rb * g.ld + C) * 2u; }
    const size_t kstep = (size_t)(BK * 2);
    const size_t hstep = (size_t)HALF * g.ld * 2;
    const size_t tstep = 2 * hstep;
    const unsigned ldsw = (unsigned)wid * 1024u;
    const int aoff = lds_byte(wr * 64 + fr, fq * 8), boff = lds_byte(wc * 32 + fr, fq * 8);
#define PG8_SA(b, h) (((b) * 2 + (h)) * HTB)
#define PG8_SB(b, h) ((4 + (b) * 2 + (h)) * HTB)
#define PG8_STAGE(bufoff, gbase, voff) do { _Pragma("unroll") for (int _i = 0; _i < 2; ++_i) \
        __builtin_amdgcn_global_load_lds((const unsigned*)((const char*)(gbase) + (voff)[_i]), (PG8_LAS unsigned*)(lds + (bufoff) + ldsw + _i * 8192), 16, 0, 0); } while (0)
#define PG8_LDA(dst, b, h) do { _Pragma("unroll") for (int m = 0; m < 4; ++m) _Pragma("unroll") for (int k = 0; k < 2; ++k) dst[m][k] = *(const PG8_LAS bf16x8*)(lds + PG8_SA(b, h) + aoff + m * 2048 + k * 1024); } while (0)
#define PG8_LDB(dst, b, h) do { _Pragma("unroll") for (int n = 0; n < 2; ++n) _Pragma("unroll") for (int k = 0; k < 2; ++k) dst[n][k] = *(const PG8_LAS bf16x8*)(lds + PG8_SB(b, h) + boff + n * 2048 + k * 1024); } while (0)
#define PG8_MMA(ai, bj, At, Bt) do { __builtin_amdgcn_s_setprio(1); _Pragma("unroll") for (int m = 0; m < 4; ++m) _Pragma("unroll") for (int n = 0; n < 2; ++n) _Pragma("unroll") for (int k = 0; k < 2; ++k) \
        acc[ai][bj][m][n] = __builtin_amdgcn_mfma_f32_16x16x32_bf16(Bt[n][k], At[m][k], acc[ai][bj][m][n], 0, 0, 0); __builtin_amdgcn_s_setprio(0); } while (0)
#define PG8_WAIT_V(n) asm volatile("s_waitcnt vmcnt(" #n ")" ::: "memory")
#define PG8_WAIT_L(n) asm volatile("s_waitcnt lgkmcnt(" #n ")" ::: "memory")
#define PG8_BAR __builtin_amdgcn_s_barrier()
#define PG8_SCHED __builtin_amdgcn_sched_barrier(0)
    Unit cur, nxt; int ui = 0;
    if (!S.next(0, cur)) return;
    f32x4 acc[2][2][4][2];
#pragma unroll
    for (int a = 0; a < 2; ++a)
#pragma unroll
        for (int b = 0; b < 2; ++b)
#pragma unroll
            for (int m = 0; m < 4; ++m)
#pragma unroll
                for (int n = 0; n < 2; ++n) acc[a][b][m][n] = (f32x4){0.f, 0.f, 0.f, 0.f};
    bf16x8 At[4][2], B0[2][2], B1[2][2];
    const char* cA = (const char*)g.A + (size_t)cur.pm * tstep; const char* cB = (const char*)g.Bt + (size_t)cur.pn * tstep;
    S.a_ready(cur);
    if constexpr (SP2) {
        PG8_STAGE(PG8_SB(0, 0), cB, voffB); PG8_STAGE(PG8_SB(0, 1), cB + hstep, voffB); PG8_STAGE(PG8_SA(0, 0), cA, voffA); PG8_STAGE(PG8_SA(0, 1), cA + hstep, voffA);
        if (wr == 1) PG8_BAR;
        PG8_WAIT_V(2); PG8_BAR;
        PG8_STAGE(PG8_SB(1, 0), cB + kstep, voffB); PG8_STAGE(PG8_SA(1, 0), cA + kstep, voffA); PG8_STAGE(PG8_SB(1, 1), cB + hstep + kstep, voffB);
        PG8_WAIT_V(6); PG8_BAR;
    } else {
        PG8_STAGE(PG8_SB(0, 0), cB, voffB); PG8_STAGE(PG8_SA(0, 0), cA, voffA); PG8_STAGE(PG8_SB(0, 1), cB + hstep, voffB); PG8_STAGE(PG8_SA(0, 1), cA + hstep, voffA);
        if (wr == 1) PG8_BAR;
        PG8_WAIT_V(4); PG8_BAR;
        PG8_STAGE(PG8_SB(1, 0), cB + kstep, voffB); PG8_STAGE(PG8_SA(1, 0), cA + kstep, voffA); PG8_STAGE(PG8_SB(1, 1), cB + hstep + kstep, voffB);
        PG8_WAIT_V(6); PG8_BAR;
    }
    for (;;) {
        const bool has_next = S.next(ui + 1, nxt);
        const char* nA = has_next ? (const char*)g.A + (size_t)nxt.pm * tstep : cA; const char* nB = has_next ? (const char*)g.Bt + (size_t)nxt.pn * tstep : cB;
        for (int t = 0; t < nt; t += 2) {
            const bool last = (t == nt - 2);
            const char* a1 = cA + (size_t)(t + 1) * kstep;
            const char* a2 = last ? nA : cA + (size_t)(t + 2) * kstep; const char* b2 = last ? nB : cB + (size_t)(t + 2) * kstep;
            const char* a3 = a2 + kstep; const char* b3 = b2 + kstep;
            if (last && has_next) S.a_ready(nxt);
            if constexpr (SP2) {
            PG8_LDB(B0, 0, 0); PG8_LDB(B1, 0, 1); PG8_SCHED; PG8_LDA(At, 0, 0); PG8_STAGE(PG8_SA(1, 1), a1 + hstep, voffA);
            PG8_WAIT_V(8); PG8_WAIT_L(0); PG8_BAR; PG8_MMA(0, 0, At, B0); PG8_MMA(0, 1, At, B1); PG8_BAR; PG8_SCHED;
            PG8_LDA(At, 0, 1); PG8_STAGE(PG8_SB(0, 0), b2, voffB); PG8_STAGE(PG8_SB(0, 1), b2 + hstep, voffB); PG8_STAGE(PG8_SA(0, 0), a2, voffA);
            PG8_WAIT_V(8); PG8_WAIT_L(0); PG8_BAR; PG8_MMA(1, 0, At, B0); PG8_MMA(1, 1, At, B1); PG8_BAR; PG8_SCHED;
            PG8_LDB(B0, 1, 0); PG8_LDB(B1, 1, 1); PG8_SCHED; PG8_LDA(At, 1, 0); PG8_STAGE(PG8_SA(0, 1), a2 + hstep, voffA);
            PG8_WAIT_V(8); PG8_WAIT_L(0); PG8_BAR; PG8_MMA(0, 0, At, B0); PG8_MMA(0, 1, At, B1); PG8_BAR; PG8_SCHED;
            PG8_LDA(At, 1, 1); PG8_STAGE(PG8_SB(1, 0), b3, voffB); PG8_STAGE(PG8_SB(1, 1), b3 + hstep, voffB); PG8_STAGE(PG8_SA(1, 0), a3, voffA);
            PG8_WAIT_V(8); PG8_WAIT_L(0); PG8_BAR; PG8_MMA(1, 0, At, B0); PG8_MMA(1, 1, At, B1); PG8_BAR; PG8_SCHED;
            } else {
            PG8_LDB(B0, 0, 0); PG8_SCHED; PG8_LDA(At, 0, 0); PG8_STAGE(PG8_SA(1, 1), a1 + hstep, voffA);
            PG8_WAIT_L(8); PG8_BAR; PG8_WAIT_L(0); PG8_MMA(0, 0, At, B0); PG8_BAR; PG8_SCHED;
            PG8_LDB(B1, 0, 1); PG8_STAGE(PG8_SB(0, 0), b2, voffB);
            PG8_BAR; PG8_WAIT_L(0); PG8_MMA(0, 1, At, B1); PG8_BAR;
            PG8_LDA(At, 0, 1); PG8_STAGE(PG8_SA(0, 0), a2, voffA);
            PG8_BAR; PG8_WAIT_L(0); PG8_MMA(1, 0, At, B0); PG8_BAR; PG8_SCHED;
            PG8_STAGE(PG8_SB(0, 1), b2 + hstep, voffB);
            PG8_WAIT_V(6); PG8_BAR; PG8_MMA(1, 1, At, B1); PG8_BAR;
            PG8_LDB(B0, 1, 0); PG8_SCHED; PG8_LDA(At, 1, 0); PG8_STAGE(PG8_SA(0, 1), a2 + hstep, voffA);
            PG8_WAIT_L(8); PG8_BAR; PG8_WAIT_L(0); PG8_MMA(0, 0, At, B0); PG8_BAR; PG8_SCHED;
            PG8_LDB(B1, 1, 1); PG8_STAGE(PG8_SB(1, 0), b3, voffB);
            PG8_BAR; PG8_WAIT_L(0); PG8_MMA(0, 1, At, B1); PG8_BAR;
            PG8_LDA(At, 1, 1); PG8_STAGE(PG8_SA(1, 0), a3, voffA);
            PG8_BAR; PG8_WAIT_L(0); PG8_MMA(1, 0, At, B0); PG8_BAR; PG8_SCHED;
            PG8_STAGE(PG8_SB(1, 1), b3 + hstep, voffB);
            PG8_WAIT_V(6); PG8_BAR; PG8_MMA(1, 1, At, B1); PG8_BAR;
            }
        }
        if constexpr (ALIGN_EPI) { if (wr == 0) PG8_BAR; }
        if constexpr (!Epi::AFTER_DRAIN) { E(acc, cur, wr, wc, fr, fq); S.done(cur); }
        if (!has_next) break;
#pragma unroll
        for (int a = 0; a < 2; ++a)
#pragma unroll
            for (int b = 0; b < 2; ++b)
#pragma unroll
                for (int m = 0; m < 4; ++m)
#pragma unroll
                    for (int n = 0; n < 2; ++n) acc[a][b][m][n] = (f32x4){0.f, 0.f, 0.f, 0.f};
        cur = nxt; cA = nA; cB = nB; ++ui;
        if constexpr (ALIGN_EPI) { if (wr == 1) PG8_BAR; }
    }
    PG8_WAIT_V(0);
    if constexpr (!ALIGN_EPI) { if (wr == 0) PG8_BAR; }
    PG8_BAR;
    if constexpr (Epi::AFTER_DRAIN) { E.fused(acc, cur, wr, wc, fr, fq, lds, wid, lane); S.done(cur); }
#undef PG8_SA
#undef PG8_SB
#undef PG8_STAGE
#undef PG8_LDA
#undef PG8_LDB
#undef PG8_MMA
#undef PG8_WAIT_V
#undef PG8_WAIT_L
#undef PG8_BAR
#undef PG8_SCHED
}
}

#define DI __device__ __forceinline__
#define LAS __attribute__((address_space(3)))
typedef unsigned short bf16;
typedef short bf16x8 __attribute__((ext_vector_type(8)));
typedef float f32x4 __attribute__((ext_vector_type(4)));
typedef float f32x2 __attribute__((ext_vector_type(2)));
typedef float f32x16 __attribute__((ext_vector_type(16)));
typedef unsigned u32x4 __attribute__((ext_vector_type(4)));
typedef unsigned u32x2 __attribute__((ext_vector_type(2)));
typedef __bf16 bf16x2_t __attribute__((ext_vector_type(2)));

DI unsigned pk2(float lo, float hi) { f32x2 v = {lo, hi}; bf16x2_t b = __builtin_convertvector(v, bf16x2_t); return __builtin_bit_cast(unsigned, b); }
DI bf16 f2bf(float f) { return (bf16)(pk2(f, 0.f) & 0xffffu); }
DI float bf2f(bf16 v) { return __builtin_bit_cast(float, (unsigned)v << 16); }
DI float bflo(unsigned u) { return __builtin_bit_cast(float, u << 16); }
DI float bfhi(unsigned u) { return __builtin_bit_cast(float, u & 0xffff0000u); }
typedef _Float16 f16x2_t __attribute__((ext_vector_type(2)));
typedef __fp16 fp16x2_t __attribute__((ext_vector_type(2)));
DI unsigned pkh2(float lo, float hi) { return __builtin_bit_cast(unsigned, __builtin_amdgcn_cvt_pkrtz(lo, hi)); }
DI float hlo(unsigned u) { return (float)__builtin_bit_cast(f16x2_t, u).x; }
DI float hhi(unsigned u) { return (float)__builtin_bit_cast(f16x2_t, u).y; }
DI float silu_f(float x) { return x * __builtin_amdgcn_rcpf(1.f + __expf(-x)); }
DI float ex2(float x) { return __builtin_amdgcn_exp2f(x); }
#define MFMA32(a, b, c) __builtin_amdgcn_mfma_f32_32x32x16_bf16((a), (b), (c), 0, 0, 0)

constexpr int DM = 1024, NB = 8, SEQ = 4096, CTXL = 256, DEPTH = 4;
constexpr int M_LAT = NB * SEQ, M_CTX = NB * CTXL, M_ALL = M_LAT + M_CTX;
constexpr int DFF = 2816, NGU = 2 * DFF, NIN = 3584, INC = 3588, NKEY = SEQ + CTXL, NVC = 34;
constexpr int XBC0 = 1792;
constexpr float ALPHA = 1.6817928305074290f;
constexpr float QSCALE = 0.125f * 1.4426950408889634f;
constexpr size_t MiB = 1u << 20;
constexpr size_t WS_MOD = 0, WS_TATT = 2 * MiB, WS_LAM = 2 * MiB + 65536, WS_BAR = 2 * MiB + 131072, WS_STAT = 2 * MiB + 262144, WS_ONES = 2 * MiB + 655360, WS_ZEROS = 2 * MiB + 655360 + 4096, WS_HALVES = 2 * MiB + 655360 + 8192, WS_TRET = 3 * MiB, WS_DT = 4 * MiB, WS_DEC = 5 * MiB, WS_XC = 6 * MiB,
                 WS_WGU = 14 * MiB, WS_WDN = 36 * MiB, WS_WIN = 47 * MiB, WS_WOUT = 54 * MiB, WS_A = 56 * MiB, WS_HP = 124 * MiB,
                 WS_VT = 362 * MiB, WS_STS = 396 * MiB, WS_STR = 430 * MiB, WS_U = 447 * MiB, WS_T = 498 * MiB, WS_X16 = 530 * MiB, WS_END = 598 * MiB;
constexpr int LDS_BYTES = 147456;
constexpr int NTHREADS = 512;

struct Args { const float* in[22]; float* out; unsigned char* ws; float afreq[16]; float rfreq[32]; int ph_lo, ph_hi; };
enum { I_X = 0, I_C, I_CTX, I_CCTX, I_ADAW, I_ADAB, I_NG, I_NB, I_WG, I_WU, I_WD, I_WIN, I_CONVW, I_CONVB, I_LAMBDA, I_SUBG, I_ALOG, I_DTB, I_SSMD, I_SSMG, I_RLG, I_WOUT };

DI float* xrow_ptr(float* xlat, float* xctx, int row) { return row < M_LAT ? xlat + (size_t)row * DM : xctx + (size_t)(row - M_LAT) * DM; }
DI int swap23(int o) { return (o & 3) | (((o >> 3) & 1) << 2) | (((o >> 2) & 1) << 3); }

struct EpiSwiglu {
    static constexpr bool PERM = true, AFTER_DRAIN = false;
    bf16* H;
    DI void operator()(const pg8::f32x4 (&acc)[2][2][4][2], const pg8::Unit& u, int wr, int wc, int fr, int fq) const {
        const int row0 = u.pm * 256 + wr * 64 + fr, col = u.pn * 128 + wc * 32 + 8 * fq;
#pragma unroll
        for (int ai = 0; ai < 2; ++ai)
#pragma unroll
            for (int m = 0; m < 4; ++m) {
                bf16* p = H + (size_t)(row0 + ai * 128 + m * 16) * DFF + col;
                float h[8];
#pragma unroll
                for (int n = 0; n < 2; ++n)
#pragma unroll
                    for (int j = 0; j < 4; ++j) h[n * 4 + j] = silu_f(acc[ai][0][m][n][j]) * acc[ai][1][m][n][j];
                u32x4 w; w.x = pk2(h[0], h[1]); w.y = pk2(h[2], h[3]); w.z = pk2(h[4], h[5]); w.w = pk2(h[6], h[7]);
                *(u32x4*)p = w;
                __builtin_amdgcn_sched_barrier(0);
            }
    }
};

struct EpiResid {
    static constexpr bool PERM = true, AFTER_DRAIN = false;
    bf16* X; const float* modg; const float* scale_p; const f32x2* stat; const float* gprev; const float* bprev;
    DI void operator()(const pg8::f32x4 (&acc)[2][2][4][2], const pg8::Unit& u, int wr, int wc, int fr, int fq) const {
        const int mi = (u.pm < 128) ? (u.pm >> 4) : 8;
        const float* gp = modg + (size_t)mi * 9216;
        const int row0 = u.pm * 256 + wr * 64 + fr, col0 = u.pn * 256 + wc * 32 + 8 * fq;
        const float scale = *scale_p;
#pragma unroll
        for (int bj = 0; bj < 2; ++bj) {
            f32x4 gs[2], gq[2], bq[2];
#pragma unroll
            for (int n = 0; n < 2; ++n) { const f32x4 g = *(const f32x4*)(gp + col0 + bj * 128 + 4 * n); gs[n] = (g + 1.0f) * scale;
                gq[n] = *(const f32x4*)(gprev + col0 + bj * 128 + 4 * n) * ALPHA; bq[n] = *(const f32x4*)(bprev + col0 + bj * 128 + 4 * n) * ALPHA; }
#pragma unroll
            for (int ai = 0; ai < 2; ++ai) {
                u32x4 xv[4]; f32x2 st[4];
#pragma unroll
                for (int m = 0; m < 4; ++m) { const int row = row0 + ai * 128 + m * 16; xv[m] = *(const u32x4*)(X + (size_t)row * DM + col0 + bj * 128); st[m] = stat[row]; }
                __builtin_amdgcn_sched_barrier(0);
#pragma unroll
                for (int m = 0; m < 4; ++m) {
                    const f32x4 x0 = {hlo(xv[m].x), hhi(xv[m].x), hlo(xv[m].y), hhi(xv[m].y)}, x1 = {hlo(xv[m].z), hhi(xv[m].z), hlo(xv[m].w), hhi(xv[m].w)};
                    const f32x4 y0 = (x0 - st[m].x) * st[m].y * gq[0] + bq[0] + gs[0] * acc[ai][bj][m][0];
                    const f32x4 y1 = (x1 - st[m].x) * st[m].y * gq[1] + bq[1] + gs[1] * acc[ai][bj][m][1];
                    u32x4 w; w.x = pkh2(y0.x, y0.y); w.y = pkh2(y0.z, y0.w); w.z = pkh2(y1.x, y1.y); w.w = pkh2(y1.z, y1.w);
                    *(u32x4*)(X + (size_t)(row0 + ai * 128 + m * 16) * DM + col0 + bj * 128) = w;
                }
                __builtin_amdgcn_sched_barrier(0);
            }
        }
    }
};
struct EpiPartial {
    static constexpr bool PERM = true, AFTER_DRAIN = false;
    float* T; const float* modg; const float* scale_p;
    DI void operator()(const pg8::f32x4 (&acc)[2][2][4][2], const pg8::Unit& u, int wr, int wc, int fr, int fq) const {
        const float* gp = modg + (size_t)8 * 9216; const float scale = *scale_p;
        const int row0 = u.pm * 256 + wr * 64 + fr - M_LAT, col0 = u.pn * 256 + wc * 32 + 8 * fq;
        f32x4 gs[2][2];
#pragma unroll
        for (int bj = 0; bj < 2; ++bj)
#pragma unroll
            for (int n = 0; n < 2; ++n) { f32x4 g = *(const f32x4*)(gp + col0 + bj * 128 + 4 * n); gs[bj][n] = (g + 1.0f) * scale; }
#pragma unroll
        for (int ai = 0; ai < 2; ++ai)
#pragma unroll
            for (int m = 0; m < 4; ++m) {
                float* tp = T + (size_t)(row0 + ai * 128 + m * 16) * DM + col0;
#pragma unroll
                for (int bj = 0; bj < 2; ++bj)
#pragma unroll
                    for (int n = 0; n < 2; ++n) *(f32x4*)(tp + bj * 128 + 4 * n) = gs[bj][n] * acc[ai][bj][m][n];
                __builtin_amdgcn_sched_barrier(0);
            }
    }
};
struct OneUnit {
    int have; pg8::Unit u;
    DI bool next(int i, pg8::Unit& o) const { if (i == 0 && have) { o = u; return true; } return false; }
    DI void a_ready(const pg8::Unit&) const {}
    DI void done(const pg8::Unit&) const {}
};

struct EpiIn {
    static constexpr bool PERM = true, AFTER_DRAIN = false;
    bf16* P; bf16* Vt; const f32x2* tatt; const f32x2* tret;
    DI void operator()(const pg8::f32x4 (&acc)[2][2][4][2], const pg8::Unit& u, int wr, int wc, int fr, int fq) const {
        const int pn = u.pn;
        const int row0 = u.pm * 256 + wr * 64 + fr;
        if (pn == 4 || pn == 5) {
#pragma unroll
            for (int ai = 0; ai < 2; ++ai)
#pragma unroll
                for (int m = 0; m < 4; ++m) {
                    const int row = row0 + ai * 128 + m * 16;
                    int b, key;
                    if (row < M_LAT) { b = row >> 12; key = row & 4095; } else { const int r2 = row - M_LAT; b = r2 >> 8; key = 4096 + (r2 & 255); }
                    const int kp = (key & ~15) | swap23(key & 15);
#pragma unroll
                    for (int bj = 0; bj < 2; ++bj) {
                        const int h = 2 * (pn - 4) + bj;
                        bf16* vp = Vt + ((size_t)(b * 4 + h) * 128 + wc * 32 + 8 * fq) * NKEY + kp;
#pragma unroll
                        for (int n = 0; n < 2; ++n)
#pragma unroll
                            for (int j = 0; j < 4; ++j) vp[(size_t)(n * 4 + j) * NKEY] = f2bf(acc[ai][bj][m][n][j]);
                    }
                    __builtin_amdgcn_sched_barrier(0);
                }
            return;
        }
        const bool att = pn < 4, ret = (pn == 10 || pn == 11);
        const float sc = (pn < 2) ? QSCALE : (pn == 11 ? 0.125f : 1.0f);
#pragma unroll
        for (int ai = 0; ai < 2; ++ai)
#pragma unroll
            for (int m = 0; m < 4; ++m) {
                const int row = row0 + ai * 128 + m * 16;
                f32x2 cs[4];
                bool rot = false;
                if ((att || ret) && row < M_LAT) {
                    rot = true;
                    const int s = row & 4095;
                    const f32x2* tp;
                    if (att) { const int pos = (wc & 1) ? (s & 63) : (s >> 6); tp = tatt + pos * 16 + 4 * fq; }
                    else { tp = tret + (size_t)s * 32 + 16 * (wc & 1) + 4 * fq; }
                    const f32x4 t0 = *(const f32x4*)tp, t1 = *(const f32x4*)(tp + 2);
                    cs[0] = (f32x2){t0.x, t0.y}; cs[1] = (f32x2){t0.z, t0.w}; cs[2] = (f32x2){t1.x, t1.y}; cs[3] = (f32x2){t1.z, t1.w};
                }
#pragma unroll
                for (int bj = 0; bj < 2; ++bj) {
                    float v[8];
#pragma unroll
                    for (int n = 0; n < 2; ++n)
#pragma unroll
                        for (int j = 0; j < 4; ++j) v[n * 4 + j] = acc[ai][bj][m][n][j];
                    if (rot) {
#pragma unroll
                        for (int q = 0; q < 4; ++q) { const float h1 = v[2 * q], h2 = v[2 * q + 1]; v[2 * q] = h1 * cs[q].x - h2 * cs[q].y; v[2 * q + 1] = h2 * cs[q].x + h1 * cs[q].y; }
                    }
                    u32x4 w; w.x = pk2(v[0] * sc, v[1] * sc); w.y = pk2(v[2] * sc, v[3] * sc); w.z = pk2(v[4] * sc, v[5] * sc); w.w = pk2(v[6] * sc, v[7] * sc);
                    *(u32x4*)(P + (size_t)row * NIN + pn * 256 + bj * 128 + wc * 32 + 8 * fq) = w;
                }
                __builtin_amdgcn_sched_barrier(0);
            }
    }
};

DI void sincos_d(float angf, float& c, float& s) {
    const double a = (double)angf;
    const double k = rint(a * 0.15915494309189535);
    double r = fma(-k, 6.283185307179586, a); r = fma(-k, 2.4492935982947064e-16, r);
    const double r2 = r * r;
    double ts = r, ss = r, tc = 1.0, sc = 1.0;
#pragma unroll 1
    for (int n = 1; n <= 15; ++n) {
        tc = -tc * r2 / (double)((2 * n - 1) * (2 * n)); sc += tc;
        ts = -ts * r2 / (double)((2 * n) * (2 * n + 1)); ss += ts;
    }
    c = (float)sc; s = (float)ss;
}

DI int in_srccol(int j) {
    if (j < 1024) { const int blk = j >> 6, dp = j & 63, half = dp >> 5, i = (dp & 31) >> 1, sec = dp & 1; return blk * 64 + half * 32 + i + 16 * sec; }
    if (j < 2560) return j;
    if (j < 3072) { const int jj = j - 2560, blk = jj >> 6, dp = jj & 63, i = dp >> 1, sec = dp & 1; return 2564 + blk * 64 + i + 32 * sec; }
    return j + 4;
}

DI void transpose_item(const float* W, int ldw, int K, int srccol_lane, bf16* WT, int n0, int k0, LAS float* scr, int lane) {
#pragma unroll 8
    for (int i = 0; i < 32; ++i) { const int kk = 2 * i + (lane >> 5); scr[kk * 33 + (lane & 31)] = W[(size_t)(k0 + kk) * ldw + srccol_lane]; }
    asm volatile("s_waitcnt lgkmcnt(0)" ::: "memory");
    const int c = lane & 7;
#pragma unroll
    for (int j = 0; j < 4; ++j) {
        const int n = (lane >> 3) + 8 * j; const LAS float* s = scr + (8 * c) * 33 + n;
        u32x4 o; o.x = pk2(s[0 * 33], s[1 * 33]); o.y = pk2(s[2 * 33], s[3 * 33]); o.z = pk2(s[4 * 33], s[5 * 33]); o.w = pk2(s[6 * 33], s[7 * 33]);
        *(u32x4*)(WT + (size_t)(n0 + n) * K + k0 + 8 * c) = o;
    }
    asm volatile("s_waitcnt lgkmcnt(0)" ::: "memory");
}

DI void convw_phase(const Args& A, int l, LAS unsigned char* lds, int tid, int bid, int G) {
    const int lane = tid & 63, wave = tid >> 6;
    LAS float* scr = (LAS float*)(lds + 65536 + wave * 8448);
    const int gw = bid * 8 + wave, NGW = G * 8;
    constexpr int I_GU = 2 * 16 * (NGU / 32), I_DN = 2 * (DFF / 64) * (DM / 32), I_IN = 16 * (NIN / 32), I_OUT = 16 * 32;
    bf16* wgu = (bf16*)(A.ws + WS_WGU); bf16* wdn = (bf16*)(A.ws + WS_WDN); bf16* win = (bf16*)(A.ws + WS_WIN); bf16* wout = (bf16*)(A.ws + WS_WOUT);
    for (int it = gw; it < I_GU + I_DN + I_IN + I_OUT; it += NGW) {
        int r = it;
        if (r < I_GU) {
            const int f = r / (16 * (NGU / 32)); r -= f * 16 * (NGU / 32);
            const int kb = r / (NGU / 32), nb = r % (NGU / 32), n0 = nb * 32, pn = n0 >> 8, cc = n0 & 255;
            const float* src = (cc < 128 ? A.in[I_WG] : A.in[I_WU]) + (size_t)(l * 2 + f) * DM * DFF;
            transpose_item(src, DFF, DM, 128 * pn + (cc & 127) + (lane & 31), wgu + (size_t)f * NGU * DM, n0, kb * 64, scr, lane);
            continue;
        }
        r -= I_GU;
        if (r < I_DN) {
            const int f = r / ((DFF / 64) * 32); r -= f * (DFF / 64) * 32;
            const int kb = r / 32, nb = r % 32;
            transpose_item(A.in[I_WD] + (size_t)(l * 2 + f) * DFF * DM, DM, DFF, nb * 32 + (lane & 31), wdn + (size_t)f * DM * DFF, nb * 32, kb * 64, scr, lane);
            continue;
        }
        r -= I_DN;
        if (r < I_IN) {
            const int kb = r / (NIN / 32), nb = r % (NIN / 32);
            transpose_item(A.in[I_WIN] + (size_t)l * DM * INC, INC, DM, in_srccol(nb * 32 + (lane & 31)), win, nb * 32, kb * 64, scr, lane);
            continue;
        }
        r -= I_IN;
        { const int kb = r / 32, nb = r % 32;
          transpose_item(A.in[I_WOUT] + (size_t)l * DM * DM, DM, DM, nb * 32 + (lane & 31), wout, nb * 32, kb * 64, scr, lane); }
    }
}

DI void p0a_phase(const Args& A, LAS unsigned char* lds, int tid, int bid, int G) {
    const int lane = tid & 63, wave = tid >> 6;
    { const int gt = bid * NTHREADS + tid;
      f32x2* tatt = (f32x2*)(A.ws + WS_TATT); f32x2* tret = (f32x2*)(A.ws + WS_TRET);
      if (gt < 1024) { ((float*)(A.ws + WS_ONES))[gt] = 1.0f; ((float*)(A.ws + WS_ZEROS))[gt] = 0.0f; ((float*)(A.ws + WS_HALVES))[gt] = 0.5f; }
      if (gt < 1024) { const int pos = gt >> 4, i = gt & 15; float c, s; sincos_d((float)pos * A.afreq[i], c, s); tatt[gt] = (f32x2){c, s}; }
      for (int e = gt; e < SEQ * 32; e += G * NTHREADS) { const int sidx = e >> 5, i = e & 31; float c, s; sincos_d((float)sidx * A.rfreq[i], c, s); tret[e] = (f32x2){c, s}; }
      if (gt < DEPTH) {
          const float* lv = A.in[I_LAMBDA] + gt * 256; float d0 = 0.f, d1 = 0.f;
          for (int i = 0; i < 64; ++i) { d0 += lv[i] * lv[64 + i]; d1 += lv[128 + i] * lv[192 + i]; }
          const float lam_init = 0.8f - 0.6f * expf(-0.3f * (float)gt);
          ((float*)(A.ws + WS_LAM))[gt] = expf(d0) - expf(d1) + lam_init;
      }
    }
    LAS float* scs = (LAS float*)lds;
    LAS float* red = (LAS float*)(lds + 36864);
    for (int e = tid; e < 9 * 1024; e += NTHREADS) { const int mi = e >> 10, k = e & 1023; const float v = (mi < 8) ? A.in[I_C][mi * 1024 + k] : A.in[I_CCTX][k]; scs[e] = silu_f(v); }
    __syncthreads();
    float* MOD = (float*)(A.ws + WS_MOD);
    for (int it = bid; it < DEPTH * 144; it += G) {
        const int l = it / 144, cg0 = (it % 144) * 64;
        const float* w = A.in[I_ADAW] + (size_t)l * DM * 9216 + cg0 + lane;
        float acc[9];
#pragma unroll
        for (int mi = 0; mi < 9; ++mi) acc[mi] = 0.f;
#pragma unroll 4
        for (int k = wave * 128; k < wave * 128 + 128; ++k) {
            const float wv = w[(size_t)k * 9216];
#pragma unroll
            for (int mi = 0; mi < 9; ++mi) acc[mi] += scs[mi * 1024 + k] * wv;
        }
#pragma unroll
        for (int mi = 0; mi < 9; ++mi) red[(wave * 9 + mi) * 64 + lane] = acc[mi];
        __syncthreads();
        for (int e = tid; e < 576; e += NTHREADS) {
            const int mi = e >> 6, cl = e & 63; float s = A.in[I_ADAB][l * 9216 + cg0 + cl];
#pragma unroll
            for (int w8 = 0; w8 < 8; ++w8) s += red[(w8 * 9 + mi) * 64 + cl];
            MOD[((size_t)l * 9 + mi) * 9216 + cg0 + cl] = s;
        }
        __syncthreads();
    }
    convw_phase(A, 0, lds, tid, bid, G);
}

DI float wave_sum(float v) {
#pragma unroll
    for (int o = 1; o < 64; o <<= 1) v += __shfl_xor(v, o);
    return v;
}
DI void lnmod_phase(const Args& A, LAS unsigned char* lds, int tid, int bid, int G, bool init, int l_norm, int i_norm, int l_mod, int i_mod, bool want_dt, int nrows, bool ctx_partial, const float* gprev, const float* bprev) {
    const int lane = tid & 63, wave = tid >> 6;
    LAS f32x4* wdt = (LAS f32x4*)lds;
    if (want_dt) {
        for (int k = tid; k < 1024; k += NTHREADS) wdt[k] = *(const f32x4*)(A.in[I_WIN] + ((size_t)l_mod * DM + k) * INC + 2560);
        __syncthreads();
    }
    const float* MOD = (const float*)(A.ws + WS_MOD);
    bf16* Abuf = (bf16*)(A.ws + WS_A);
    float* DT = (float*)(A.ws + WS_DT);
    f32x4 g[4], bb[4];
    if (l_norm >= 0) {
#pragma unroll
        for (int j = 0; j < 4; ++j) { g[j] = *(const f32x4*)(A.in[I_NG] + (l_norm * 3 + i_norm) * DM + 256 * j + 4 * lane); bb[j] = *(const f32x4*)(A.in[I_NB] + (l_norm * 3 + i_norm) * DM + 256 * j + 4 * lane); }
    }
    bf16* X16 = (bf16*)(A.ws + WS_X16);
    u32x2 un[4]; f32x4 fn[4];
    { const int row = bid * 8 + wave;
      if (row < nrows) {
          if (init) { const float* xin = row < M_LAT ? A.in[I_X] + (size_t)row * DM : A.in[I_CTX] + (size_t)(row - M_LAT) * DM;
#pragma unroll
              for (int j = 0; j < 4; ++j) fn[j] = *(const f32x4*)(xin + 256 * j + 4 * lane); }
          else {
#pragma unroll
              for (int j = 0; j < 4; ++j) un[j] = *(const u32x2*)(X16 + (size_t)row * DM + 256 * j + 4 * lane); } } }
    for (int row = bid * 8 + wave; row < nrows; row += G * 8) {
        bf16* xout = X16 + (size_t)row * DM;
        f32x4 v[4];
#pragma unroll
        for (int j = 0; j < 4; ++j) v[j] = init ? fn[j] : (f32x4){hlo(un[j].x), hhi(un[j].x), hlo(un[j].y), hhi(un[j].y)};
        { const int rown = row + G * 8;
          if (rown < nrows) {
              if (init) { const float* xin = rown < M_LAT ? A.in[I_X] + (size_t)rown * DM : A.in[I_CTX] + (size_t)(rown - M_LAT) * DM;
#pragma unroll
                  for (int j = 0; j < 4; ++j) fn[j] = *(const f32x4*)(xin + 256 * j + 4 * lane); }
              else {
#pragma unroll
                  for (int j = 0; j < 4; ++j) un[j] = *(const u32x2*)(X16 + (size_t)rown * DM + 256 * j + 4 * lane); } } }
        f32x2* STAT = (f32x2*)(A.ws + WS_STAT);
        if (ctx_partial && row >= M_LAT) {
            { const f32x2 st = STAT[row];
#pragma unroll
              for (int j = 0; j < 4; ++j) v[j] = (v[j] - st.x) * st.y * *(const f32x4*)(gprev + 256 * j + 4 * lane) + *(const f32x4*)(bprev + 256 * j + 4 * lane); }
            const float* t0 = (const float*)(A.ws + WS_T) + (size_t)(row - M_LAT) * DM; const float* t1 = t0 + (size_t)M_CTX * DM; const float* t2 = t1 + (size_t)M_CTX * DM; const float* t3 = t2 + (size_t)M_CTX * DM;
#pragma unroll
            for (int j = 0; j < 4; ++j) { v[j] = v[j] * ALPHA + (*(const f32x4*)(t0 + 256 * j + 4 * lane) + *(const f32x4*)(t1 + 256 * j + 4 * lane)) + (*(const f32x4*)(t2 + 256 * j + 4 * lane) + *(const f32x4*)(t3 + 256 * j + 4 * lane)); u32x2 w_; w_.x = pkh2(v[j].x, v[j].y); w_.y = pkh2(v[j].z, v[j].w); *(u32x2*)(xout + 256 * j + 4 * lane) = w_; }
        }
        if (l_norm >= 0) {
            float s = 0.f;
#pragma unroll
            for (int j = 0; j < 4; ++j) s += (v[j].x + v[j].y) + (v[j].z + v[j].w);
            const float mean = wave_sum(s) * (1.f / DM);
            float s2 = 0.f;
#pragma unroll
            for (int j = 0; j < 4; ++j) { v[j] = v[j] - mean; s2 += (v[j].x * v[j].x + v[j].y * v[j].y) + (v[j].z * v[j].z + v[j].w * v[j].w); }
            const float rstd = 1.0f / sqrtf(wave_sum(s2) * (1.f / DM) + 1e-5f);
            if (l_mod >= 0 && lane == 0) STAT[row] = (f32x2){mean, rstd};
#pragma unroll
            for (int j = 0; j < 4; ++j) v[j] = v[j] * rstd * g[j] + bb[j];
        }
        if (init && lane == 0) STAT[row] = (f32x2){0.f, 1.f};
        if (init) {
#pragma unroll
            for (int j = 0; j < 4; ++j) { u32x2 w_; w_.x = pkh2(v[j].x, v[j].y); w_.y = pkh2(v[j].z, v[j].w); *(u32x2*)(xout + 256 * j + 4 * lane) = w_; }
        }
        if (l_norm >= 0 && l_mod < 0) {
#pragma unroll
            for (int j = 0; j < 4; ++j) *(f32x4*)(A.out + (size_t)row * DM + 256 * j + 4 * lane) = v[j];
        }
        if (l_mod >= 0) {
            const int mi = row < M_LAT ? (row >> 12) : 8;
            const float* mp = MOD + ((size_t)l_mod * 9 + mi) * 9216 + i_mod * 3072;
            float d0 = 0.f, d1 = 0.f, d2 = 0.f, d3 = 0.f;
#pragma unroll
            for (int j = 0; j < 4; ++j) {
                const f32x4 sh = *(const f32x4*)(mp + 256 * j + 4 * lane), scl = *(const f32x4*)(mp + 1024 + 256 * j + 4 * lane);
                const f32x4 a = v[j] * (scl + 1.0f) + sh;
                u32x2 w; w.x = pk2(a.x, a.y); w.y = pk2(a.z, a.w);
                *(u32x2*)(Abuf + (size_t)row * DM + 256 * j + 4 * lane) = w;
                if (want_dt) {
                    const int k0 = 256 * j + 4 * lane;
                    const f32x4 w0 = wdt[k0], w1 = wdt[k0 + 1], w2 = wdt[k0 + 2], w3 = wdt[k0 + 3];
                    d0 += a.x * w0.x + a.y * w1.x + a.z * w2.x + a.w * w3.x;
                    d1 += a.x * w0.y + a.y * w1.y + a.z * w2.y + a.w * w3.y;
                    d2 += a.x * w0.z + a.y * w1.z + a.z * w2.z + a.w * w3.z;
                    d3 += a.x * w0.w + a.y * w1.w + a.z * w2.w + a.w * w3.w;
                }
            }
            if (want_dt) {
                d0 = wave_sum(d0); d1 = wave_sum(d1); d2 = wave_sum(d2); d3 = wave_sum(d3);
                if (lane == 0) *(f32x4*)(DT + (size_t)row * 4) = (f32x4){d0, d1, d2, d3};
            }
        }
    }
}

DI float max3f(float a, float b, float c) { float r; asm("v_max3_f32 %0, %1, %2, %3" : "=v"(r) : "v"(a), "v"(b), "v"(c)); return r; }
DI float max3f_mfma(float a, float b, float c) { float r; asm("s_nop 15\n\ts_nop 7\n\tv_max3_f32 %0, %1, %2, %3" : "=v"(r) : "v"(a), "v"(b), "v"(c)); return r; }
DI void attn_unit(LAS unsigned char* lds, int tid, const bf16* __restrict__ P, const bf16* __restrict__ Vt, bf16* MG, int b, int h, int qrow0, int jt0, int jt1,
                  float lam, float oscale, const float* subg) {
    asm volatile("" : "+v"(tid));
    constexpr int KP = 136, VP = 72, KBYTES = 64 * KP * 2, VBYTES = 128 * VP * 2;
    const int lane = tid & 63, wave = tid >> 6, r32 = lane & 31, hi = lane >> 5;
    const int qb = wave >> 1, m = wave & 1;
    const int qrow = qrow0 + qb * 32 + r32;
    bf16x8 qf[4];
#pragma unroll
    for (int ks = 0; ks < 4; ++ks) qf[ks] = *(const bf16x8*)(P + (size_t)qrow * NIN + h * 128 + m * 64 + ks * 16 + hi * 8);
    f32x16 O[4];
#pragma unroll
    for (int es = 0; es < 4; ++es)
#pragma unroll
        for (int i = 0; i < 16; ++i) O[es][i] = 0.f;
    float mrun = 0.f, lrun = 0.f;
    u32x4 kreg[2], vreg[2];
    const bf16* vbase = Vt + (size_t)(b * 4 + h) * 128 * NKEY;
#define ATT_LOADG(j) do { _Pragma("unroll") for (int i_ = 0; i_ < 2; ++i_) { const int c_ = tid + 512 * i_; const int key_ = c_ >> 4, part_ = c_ & 15; \
        const int row_ = ((j) < 64) ? b * SEQ + (j) * 64 + key_ : M_LAT + b * CTXL + ((j) - 64) * 64 + key_; \
        kreg[i_] = *(const u32x4*)(P + (size_t)row_ * NIN + 512 + h * 128 + part_ * 8); \
        const int e_ = c_ >> 3, vp_ = c_ & 7; vreg[i_] = *(const u32x4*)(vbase + (size_t)e_ * NKEY + (j) * 64 + vp_ * 8); } } while (0)
#define ATT_STORE(buf) do { _Pragma("unroll") for (int i_ = 0; i_ < 2; ++i_) { const int c_ = tid + 512 * i_; const int key_ = c_ >> 4, part_ = c_ & 15, e_ = c_ >> 3, vp_ = c_ & 7; \
        *(LAS u32x4*)(lds + (buf) * KBYTES + (key_ * KP + part_ * 8) * 2) = kreg[i_]; \
        *(LAS u32x4*)(lds + 2 * KBYTES + (buf) * VBYTES + (e_ * VP + vp_ * 8) * 2) = vreg[i_]; } } while (0)
    const bool halfB = wave >= 4;
    bf16x8 pf[4];
#define ATT_QKS(bufk, first_) do { \
        const LAS bf16* Kb = (const LAS bf16*)(lds + (bufk) * KBYTES) + m * 64 + hi * 8; \
        f32x16 s0, s1; \
        { const float ninit = -mrun; _Pragma("unroll") for (int i = 0; i < 16; ++i) { s0[i] = ninit; s1[i] = ninit; } } \
        _Pragma("unroll") for (int ks = 0; ks < 4; ++ks) { \
            const bf16x8 a0 = *(const LAS bf16x8*)(Kb + r32 * KP + ks * 16); \
            const bf16x8 a1 = *(const LAS bf16x8*)(Kb + (32 + r32) * KP + ks * 16); \
            s0 = MFMA32(a0, qf[ks], s0); s1 = MFMA32(a1, qf[ks], s1); } \
        float mx = max3f_mfma(s0[0], s1[0], s0[1]); \
        mx = max3f(mx, s1[1], s0[2]); mx = max3f(mx, s1[2], s0[3]); mx = max3f(mx, s1[3], s0[4]); mx = max3f(mx, s1[4], s0[5]); \
        mx = max3f(mx, s1[5], s0[6]); mx = max3f(mx, s1[6], s0[7]); mx = max3f(mx, s1[7], s0[8]); mx = max3f(mx, s1[8], s0[9]); \
        mx = max3f(mx, s1[9], s0[10]); mx = max3f(mx, s1[10], s0[11]); mx = max3f(mx, s1[11], s0[12]); mx = max3f(mx, s1[12], s0[13]); \
        mx = max3f(mx, s1[13], s0[14]); mx = max3f(mx, s1[14], s0[15]); mx = max3f(mx, s1[15], mx); \
        mx = max3f(mx, __shfl_xor(mx, 32), mx); \
        if ((first_) || __builtin_amdgcn_ballot_w64(mx > 8.0f) != 0ull) { \
            const float d = (first_) ? mx : (mx > 8.0f ? mx : 0.f); \
            mrun += d; \
            if (!(first_)) { const float alpha = ex2(-d); lrun *= alpha; _Pragma("unroll") for (int es = 0; es < 4; ++es) O[es] = O[es] * alpha; } \
            _Pragma("unroll") for (int i = 0; i < 16; ++i) { s0[i] -= d; s1[i] -= d; } } \
        float sum = 0.f; \
        _Pragma("unroll") for (int i = 0; i < 16; ++i) { s0[i] = ex2(s0[i]); s1[i] = ex2(s1[i]); sum += s0[i] + s1[i]; } \
        lrun += sum; \
        _Pragma("unroll") for (int s2 = 0; s2 < 2; ++s2) { u32x4 w0, w1; \
            w0.x = pk2(s0[8 * s2 + 0], s0[8 * s2 + 1]); w0.y = pk2(s0[8 * s2 + 2], s0[8 * s2 + 3]); w0.z = pk2(s0[8 * s2 + 4], s0[8 * s2 + 5]); w0.w = pk2(s0[8 * s2 + 6], s0[8 * s2 + 7]); \
            w1.x = pk2(s1[8 * s2 + 0], s1[8 * s2 + 1]); w1.y = pk2(s1[8 * s2 + 2], s1[8 * s2 + 3]); w1.z = pk2(s1[8 * s2 + 4], s1[8 * s2 + 5]); w1.w = pk2(s1[8 * s2 + 6], s1[8 * s2 + 7]); \
            pf[s2] = __builtin_bit_cast(bf16x8, w0); pf[2 + s2] = __builtin_bit_cast(bf16x8, w1); } } while (0)
#define ATT_PV(bufv) do { \
        const LAS bf16* Vb = (const LAS bf16*)(lds + 2 * KBYTES + (bufv) * VBYTES) + hi * 8; \
        _Pragma("unroll") for (int es = 0; es < 4; ++es) _Pragma("unroll") for (int kk = 0; kk < 4; ++kk) { \
            const bf16x8 a = *(const LAS bf16x8*)(Vb + (es * 32 + r32) * VP + kk * 16); O[es] = MFMA32(a, pf[kk], O[es]); } } while (0)
    __syncthreads();
    ATT_LOADG(jt0);
    for (int j = jt0; j < jt1; ++j) {
        const int buf = (j - jt0) & 1;
        ATT_STORE(buf);
        __syncthreads();
        if (j + 1 < jt1) ATT_LOADG(j + 1);
        if (!halfB) { ATT_QKS(buf, j == jt0); } else if (j > jt0) { ATT_PV(buf ^ 1); }
        __syncthreads();
        if (!halfB) { ATT_PV(buf); } else { ATT_QKS(buf, j == jt0); }
    }
    if (halfB) { ATT_PV((jt1 - 1 - jt0) & 1); }
#undef ATT_QKS
#undef ATT_PV
#undef ATT_LOADG
#undef ATT_STORE
    __syncthreads();
    const float l = lrun + __shfl_xor(lrun, 32);
    const float inv = (m ? lam : 1.0f) / l;
    LAS float* X = (LAS float*)lds + qb * 4096 + lane;
    if (m) {
#pragma unroll
        for (int es = 0; es < 4; ++es)
#pragma unroll
            for (int i = 0; i < 16; ++i) X[(es * 16 + i) * 64] = O[es][i] * inv;
    }
    __syncthreads();
    if (!m) {
        float ss = 0.f;
#pragma unroll
        for (int es = 0; es < 4; ++es)
#pragma unroll
            for (int i = 0; i < 16; ++i) { const float o = O[es][i] * inv - X[(es * 16 + i) * 64]; O[es][i] = o; ss += o * o; }
        ss += __shfl_xor(ss, 32);
        const float rn = (1.0f / sqrtf(ss * (1.0f / 128.0f) + 1e-6f)) * oscale;
#pragma unroll
        for (int es = 0; es < 4; ++es)
#pragma unroll
            for (int g4 = 0; g4 < 4; ++g4) {
                const int e = es * 32 + 8 * g4 + 4 * hi;
                const f32x4 gv = *(const f32x4*)(subg + e);
                u32x2 w; w.x = pk2(O[es][4 * g4 + 0] * rn * gv.x, O[es][4 * g4 + 1] * rn * gv.y); w.y = pk2(O[es][4 * g4 + 2] * rn * gv.z, O[es][4 * g4 + 3] * rn * gv.w);
                *(u32x2*)(MG + (size_t)qrow * DM + h * 128 + e) = w;
            }
    }
}

constexpr int SC_ACF = 0, SC_ACB = 1, SC_DT0 = 2, SC_DT1 = 3;
constexpr int L_STAT = 8192, L_BUF = 16384;
constexpr int TP = 136;
constexpr int QP = 72;
constexpr int UW = 768;

DI int vc_row0(int b, int vc) { return vc < 2 ? M_LAT + b * CTXL + vc * 128 : b * SEQ + (vc - 2) * 128; }
DI float softplus_f(float x) { return fmaxf(x, 0.f) + log1pf(__expf(-fabsf(x))); }

struct ScanCtx { const bf16* P; const bf16* U; const float* DT; bf16* sts; bf16* str; float* dec; bf16* MG; const float* cw; const float* cb; const float* alog; const float* dtb; const float* ssmd; const float* ssmg; const float* rlg; };

DI void conv_phase(const bf16* __restrict__ P, bf16* __restrict__ U, const float* cw, const float* cb, int tid, int bid, int G) {
    const int lane = tid & 63, wave = tid >> 6;
    for (int it = bid * 8 + wave; it < (M_ALL / 16) * 3; it += G * 8) {
        const int run = it / 3, cgp = it % 3, row0 = run * 16, ch = cgp * 256 + 4 * lane;
        int s0, L; if (row0 < M_LAT) { s0 = row0 & (SEQ - 1); L = SEQ; } else { s0 = (row0 - M_LAT) & (CTXL - 1); L = CTXL; }
        f32x4 w[5];
#pragma unroll
        for (int k = 0; k < 5; ++k) w[k] = *(const f32x4*)(cw + k * UW + ch);
        const f32x4 bias = *(const f32x4*)(cb + ch);
        f32x4 x[20];
#pragma unroll
        for (int i = 0; i < 20; ++i) { const int s = s0 - 2 + i; u32x2 v = {0u, 0u}; if (s >= 0 && s < L) v = *(const u32x2*)(P + (size_t)(row0 - 2 + i) * NIN + XBC0 + ch);
            x[i] = (f32x4){bflo(v.x), bfhi(v.x), bflo(v.y), bfhi(v.y)}; }
#pragma unroll
        for (int t = 0; t < 16; ++t) {
            const f32x4 a = bias + w[0] * x[t] + w[1] * x[t + 1] + w[2] * x[t + 2] + w[3] * x[t + 3] + w[4] * x[t + 4];
            u32x2 o; o.x = pk2(silu_f(a.x), silu_f(a.y)); o.y = pk2(silu_f(a.z), silu_f(a.w));
            *(u32x2*)(U + (size_t)(row0 + t) * UW + ch) = o;
        }
    }
}

DI void ssd_scalars(LAS float* sc, int tid, const float* DT, int row0, const float* alog, const float* dtb, float* dec_f, float* dec_b) {
    const int lane = tid & 63, wave = tid >> 6;
    if (wave < 4) {
        const int h = wave;
        const float r0 = DT[(size_t)(row0 + 2 * lane) * 4 + h], r1 = DT[(size_t)(row0 + 2 * lane + 1) * 4 + h];
        const float ea0 = __expf(alog[h]), ea1 = __expf(alog[4 + h]);
        const float d00 = softplus_f(r0 + dtb[h]), d01 = softplus_f(r1 + dtb[h]);
        const float d10 = softplus_f(r0 + dtb[4 + h]), d11 = softplus_f(r1 + dtb[4 + h]);
        const float la00 = -d00 * ea0, la01 = -d01 * ea0, la10 = -d10 * ea1, la11 = -d11 * ea1;
        float pf = la00 + la01, pb = la10 + la11;
#pragma unroll
        for (int o = 1; o < 64; o <<= 1) { const float tf = __shfl_up(pf, o), tb = __shfl_up(pb, o); if (lane >= o) { pf += tf; pb += tb; } }
        const float totb = __shfl(pb, 63), totf = __shfl(pf, 63);
        sc[(SC_ACF * 4 + h) * 128 + 2 * lane + 1] = pf; sc[(SC_ACF * 4 + h) * 128 + 2 * lane] = pf - la01;
        sc[(SC_ACB * 4 + h) * 128 + 2 * lane + 1] = totb - pb + la11; sc[(SC_ACB * 4 + h) * 128 + 2 * lane] = totb - (pb - la11) + la10;
        sc[(SC_DT0 * 4 + h) * 128 + 2 * lane] = d00; sc[(SC_DT0 * 4 + h) * 128 + 2 * lane + 1] = d01;
        sc[(SC_DT1 * 4 + h) * 128 + 2 * lane] = d10; sc[(SC_DT1 * 4 + h) * 128 + 2 * lane + 1] = d11;
        if (dec_f && lane == 0) { dec_f[h] = __expf(totf); dec_b[h] = __expf(totb); }
    }
}

DI f32x16 zero16() { f32x16 z;
#pragma unroll
    for (int i = 0; i < 16; ++i) z[i] = 0.f;
    return z; }
template <int KSTEPS> DI f32x16 mma_lds(f32x16 acc, const LAS bf16* Ap, int pa, const LAS bf16* Bp, int pb, int lane) {
    const int r32 = lane & 31, hi = lane >> 5;
    Ap += r32 * pa + 8 * hi; Bp += r32 * pb + 8 * hi;
#pragma unroll
    for (int ks = 0; ks < KSTEPS; ++ks) { const bf16x8 a = *(const LAS bf16x8*)(Ap + 16 * ks), bq = *(const LAS bf16x8*)(Bp + 16 * ks); acc = MFMA32(a, bq, acc); }
    return acc;
}

template <int C, bool SCALED> DI void stage_T(LAS bf16* d0, LAS bf16* d1, const bf16* __restrict__ src, int spitch, const LAS float* w0, const LAS float* w1, int tid) {
    constexpr int OC = C / 8;
#pragma unroll
    for (int it0 = 0; it0 < 64 * OC; it0 += NTHREADS) {
        const int it = it0 + tid, oct = it % OC, tp = it / OC;
        const u32x4 r0 = *(const u32x4*)(src + (size_t)(2 * tp) * spitch + oct * 8), r1 = *(const u32x4*)(src + (size_t)(2 * tp + 1) * spitch + oct * 8);
        const unsigned a[4] = {r0.x, r0.y, r0.z, r0.w}, bq[4] = {r1.x, r1.y, r1.z, r1.w};
        if (!SCALED) {
#pragma unroll
            for (int k = 0; k < 4; ++k) {
                *(LAS unsigned*)(d0 + (oct * 8 + 2 * k) * TP + 2 * tp) = (a[k] & 0xffffu) | (bq[k] << 16);
                *(LAS unsigned*)(d0 + (oct * 8 + 2 * k + 1) * TP + 2 * tp) = (a[k] >> 16) | (bq[k] & 0xffff0000u);
            }
        } else {
            const float u0 = w0[2 * tp], u1 = w0[2 * tp + 1], v0 = w1[2 * tp], v1 = w1[2 * tp + 1];
#pragma unroll
            for (int k = 0; k < 4; ++k) {
                const float e0 = bflo(a[k]), e1 = bfhi(a[k]), f0 = bflo(bq[k]), f1 = bfhi(bq[k]);
                *(LAS unsigned*)(d0 + (oct * 8 + 2 * k) * TP + 2 * tp) = pk2(e0 * u0, f0 * u1);
                *(LAS unsigned*)(d0 + (oct * 8 + 2 * k + 1) * TP + 2 * tp) = pk2(e1 * u0, f1 * u1);
                *(LAS unsigned*)(d1 + (oct * 8 + 2 * k) * TP + 2 * tp) = pk2(e0 * v0, f0 * v1);
                *(LAS unsigned*)(d1 + (oct * 8 + 2 * k + 1) * TP + 2 * tp) = pk2(e1 * v0, f1 * v1);
            }
        }
    }
}
template <int R, int C> DI void stage_N(LAS bf16* d, int dp, const bf16* __restrict__ src, int spitch, int tid) {
    constexpr int OC = C / 8;
#pragma unroll
    for (int it0 = 0; it0 < R * OC; it0 += NTHREADS) { const int it = it0 + tid, oct = it % OC, r = it / OC; *(LAS u32x4*)(d + r * dp + oct * 8) = *(const u32x4*)(src + (size_t)r * spitch + oct * 8); }
}

DI void s1_ssd_unit(LAS unsigned char* lds, int tid, const ScanCtx& C, int b, int vc) {
    asm volatile("" : "+v"(tid));
    const int lane = tid & 63, wave = tid >> 6, r32 = lane & 31, hi = lane >> 5;
    LAS float* sc = (LAS float*)lds; LAS float* wts = (LAS float*)(lds + L_STAT);
    LAS bf16* BkT = (LAS bf16*)(lds + L_BUF); LAS bf16* XF = (LAS bf16*)(lds + L_BUF + 34816); LAS bf16* XB = (LAS bf16*)(lds + L_BUF + 34816 + 17408);
    const int row0 = vc_row0(b, vc);
    float* decp = C.dec + (size_t)((b * NVC + vc) * 2) * 8;
    __syncthreads();
    ssd_scalars(sc, tid, C.DT, row0, C.alog, C.dtb, decp, decp + 8);
    __syncthreads();
    { const int h = tid >> 7, s = tid & 127;
      wts[h * 128 + s] = __expf(sc[(SC_ACF * 4 + h) * 128 + 127] - sc[(SC_ACF * 4 + h) * 128 + s]) * sc[(SC_DT0 * 4 + h) * 128 + s];
      wts[(4 + h) * 128 + s] = __expf(sc[(SC_ACB * 4 + h) * 128 + 0] - sc[(SC_ACB * 4 + h) * 128 + s]) * sc[(SC_DT1 * 4 + h) * 128 + s]; }
    const bf16* Urow = C.U + (size_t)row0 * UW;
    for (int g = 0; g < 2; ++g) {
        __syncthreads();
        stage_T<128, false>(BkT, BkT, Urow + 256 + g * 128, UW, nullptr, nullptr, tid);
        for (int hh = 0; hh < 2; ++hh) {
            const int h = 2 * g + hh;
            if (hh) __syncthreads();
            stage_T<64, true>(XF, XB, Urow + h * 64, UW, wts + h * 128, wts + (4 + h) * 128, tid);
            __syncthreads();
            const int pt = wave >> 2, nt = wave & 3;
            f32x16 af = zero16(), ab = zero16();
            { const LAS bf16* Bp = BkT + (nt * 32 + r32) * TP + 8 * hi; const LAS bf16* Af = XF + (pt * 32 + r32) * TP + 8 * hi; const LAS bf16* Ab = XB + (pt * 32 + r32) * TP + 8 * hi;
#pragma unroll
              for (int ks = 0; ks < 8; ++ks) { const bf16x8 bq = *(const LAS bf16x8*)(Bp + 16 * ks); af = MFMA32(*(const LAS bf16x8*)(Af + 16 * ks), bq, af); ab = MFMA32(*(const LAS bf16x8*)(Ab + 16 * ks), bq, ab); } }
            bf16* of = C.sts + ((size_t)(((b * NVC + vc) * 2 + 0) * 4 + h)) * 8192; bf16* ob = C.sts + ((size_t)(((b * NVC + vc) * 2 + 1) * 4 + h)) * 8192;
#pragma unroll
            for (int i = 0; i < 16; ++i) { const int p = pt * 32 + 8 * (i >> 2) + 4 * hi + (i & 3), n = nt * 32 + r32; of[p * 128 + n] = f2bf(af[i]); ob[p * 128 + n] = f2bf(ab[i]); }
        }
    }
}
DI void s1_ret_unit(LAS unsigned char* lds, int tid, const ScanCtx& C, int b, int vc, int h0, int nh) {
    asm volatile("" : "+v"(tid));
    const int lane = tid & 63, wave = tid >> 6, r32 = lane & 31, hi = lane >> 5;
    LAS float* wts = (LAS float*)(lds + L_STAT);
    LAS bf16* KT = (LAS bf16*)(lds + L_BUF); LAS bf16* VF = (LAS bf16*)(lds + L_BUF + 17408); LAS bf16* VB = (LAS bf16*)(lds + L_BUF + 2 * 17408);
    const int row0 = vc_row0(b, vc);
    float* decp = C.dec + (size_t)((b * NVC + vc) * 2) * 8;
    __syncthreads();
    { const int h = tid >> 7, s = tid & 127; const float lg0 = C.rlg[h], lg1 = C.rlg[4 + h];
      wts[h * 128 + s] = __expf((float)(127 - s) * lg0); wts[(4 + h) * 128 + s] = __expf((float)s * lg1);
      if (s == 0) { decp[4 + h] = __expf(128.f * lg0); decp[8 + 4 + h] = __expf(128.f * lg1); } }
    const bf16* Prow = C.P + (size_t)row0 * NIN;
#pragma unroll 1
    for (int h = h0; h < h0 + nh; ++h) {
        __syncthreads();
        stage_T<64, false>(KT, KT, Prow + 2816 + h * 64, NIN, nullptr, nullptr, tid);
        stage_T<64, true>(VF, VB, Prow + 3072 + h * 64, NIN, wts + h * 128, wts + (4 + h) * 128, tid);
        __syncthreads();
        const int dir = wave >> 2, pt = (wave >> 1) & 1, nt = wave & 1;
        const f32x16 a = mma_lds<8>(zero16(), (dir ? VB : VF) + pt * 32 * TP, TP, KT + nt * 32 * TP, TP, lane);
        bf16* o = C.str + ((size_t)(((b * NVC + vc) * 2 + dir) * 4 + h)) * 4096;
#pragma unroll
        for (int i = 0; i < 16; ++i) { const int p = pt * 32 + 8 * (i >> 2) + 4 * hi + (i & 3), n = nt * 32 + r32; o[p * 64 + n] = f2bf(a[i]); }
    }
}

DI int s2_order(int dir, int step) { return dir == 0 ? step : (step == 0 ? 1 : (step == 1 ? 0 : 35 - step)); }
DI void s2_item(const ScanCtx& C, int gt) {
    bf16* base; int hh, dir, b; size_t vcstride;
    if (gt < 65536) { const int v = gt & 1023, h = (gt >> 10) & 3; dir = (gt >> 12) & 1; b = gt >> 13; hh = h; base = C.sts + (size_t)((b * NVC * 2 + dir) * 4 + h) * 8192 + v * 8; vcstride = (size_t)2 * 4 * 8192; }
    else if (gt < 65536 + 32768) { const int g2 = gt - 65536; const int v = g2 & 511, h = (g2 >> 9) & 3; dir = (g2 >> 11) & 1; b = g2 >> 12; hh = 4 + h; base = C.str + (size_t)((b * NVC * 2 + dir) * 4 + h) * 4096 + v * 8; vcstride = (size_t)2 * 4 * 4096; }
    else return;
    float s[8]; float zf = 0.f; asm volatile("" : "+v"(zf));
#pragma unroll
    for (int i = 0; i < 8; ++i) s[i] = zf;
#define S2_LD(k, st_) { const int vc_ = s2_order(dir, (st_)); v##k = *(const u32x4*)(base + (size_t)vc_ * vcstride); d##k = C.dec[(size_t)((b * NVC + vc_) * 2 + dir) * 8 + hh]; }
#define S2_ST(k, st_) { const int vc_ = s2_order(dir, (st_)); u32x4 w_; w_.x = pk2(s[0], s[1]); w_.y = pk2(s[2], s[3]); w_.z = pk2(s[4], s[5]); w_.w = pk2(s[6], s[7]); \
        *(u32x4*)(base + (size_t)vc_ * vcstride) = w_; \
        s[0] = s[0] * d##k + bflo(v##k.x); s[1] = s[1] * d##k + bfhi(v##k.x); s[2] = s[2] * d##k + bflo(v##k.y); s[3] = s[3] * d##k + bfhi(v##k.y); \
        s[4] = s[4] * d##k + bflo(v##k.z); s[5] = s[5] * d##k + bfhi(v##k.z); s[6] = s[6] * d##k + bflo(v##k.w); s[7] = s[7] * d##k + bfhi(v##k.w); }
    u32x4 v0, v1, v2, v3; float d0, d1, d2, d3;
    S2_LD(0, 0) S2_LD(1, 1) S2_LD(2, 2) S2_LD(3, 3)
#pragma unroll 1
    for (int step = 0; step < 32; step += 4) {
        S2_ST(0, step) if (step + 4 < NVC) S2_LD(0, step + 4)
        S2_ST(1, step + 1) if (step + 5 < NVC) S2_LD(1, step + 5)
        S2_ST(2, step + 2) if (step + 6 < NVC) S2_LD(2, step + 6)
        S2_ST(3, step + 3) if (step + 7 < NVC) S2_LD(3, step + 7)
    }
    S2_ST(0, 32) S2_ST(1, 33)
#undef S2_LD
#undef S2_ST
}

DI void s2_phase(const ScanCtx& C, int tid, int bid, int G) {
#pragma unroll 1
    for (int gt = bid * NTHREADS + tid; gt < 65536 + 32768; gt += G * NTHREADS) s2_item(C, gt);
}

DI void s3_ssd_unit(LAS unsigned char* lds, int tid, const ScanCtx& C, int b, int vc) {
    asm volatile("" : "+v"(tid));
    const int lane = tid & 63, wave = tid >> 6, r32 = lane & 31, hi = lane >> 5;
    LAS float* sc = (LAS float*)lds; LAS float* stat = (LAS float*)(lds + L_STAT);
    LAS bf16* Cq = (LAS bf16*)(lds + L_BUF); LAS bf16* BkM = (LAS bf16*)(lds + L_BUF + 34816); LAS bf16* XsT = (LAS bf16*)(lds + L_BUF + 2 * 34816);
    LAS bf16* Hf = (LAS bf16*)(lds + L_BUF + 2 * 34816 + 17408); LAS bf16* Hb = (LAS bf16*)(lds + L_BUF + 2 * 34816 + 2 * 17408);
    const int row0 = vc_row0(b, vc);
    const int pt = wave & 1, tt = wave >> 1;
    const bf16* Urow = C.U + (size_t)row0 * UW;
    __syncthreads();
    ssd_scalars(sc, tid, C.DT, row0, C.alog, C.dtb, nullptr, nullptr);
    float ssq = 0.f;
    const int tq_ = tt * 32 + r32; const int rowq = row0 + tq_;
#pragma unroll 1
    for (int g = 0; g < 2; ++g) {
        __syncthreads();
        stage_N<128, 128>(Cq, TP, Urow + 512 + g * 128, UW, tid);
        stage_N<128, 128>(BkM, TP, Urow + 256 + g * 128, UW, tid);
        __syncthreads();
        f32x16 gacc0, gacc1;
        { const int id = 2 * wave, st = id & 3, tq = id >> 2; gacc0 = mma_lds<8>(zero16(), BkM + st * 32 * TP, TP, Cq + tq * 32 * TP, TP, lane); }
        { const int id = 2 * wave + 1, st = id & 3, tq = id >> 2; gacc1 = mma_lds<8>(zero16(), BkM + st * 32 * TP, TP, Cq + tq * 32 * TP, TP, lane); }
#pragma unroll 1
        for (int hh = 0; hh < 2; ++hh) {
            const int h = 2 * g + hh;
            __syncthreads();
            const int oct_ = tid & 7, tp_ = tid >> 3;
            const u32x4 xr0 = *(const u32x4*)(Urow + h * 64 + (size_t)(2 * tp_) * UW + oct_ * 8), xr1 = *(const u32x4*)(Urow + h * 64 + (size_t)(2 * tp_ + 1) * UW + oct_ * 8);
            const bf16* sfp = C.sts + ((size_t)(((b * NVC + vc) * 2 + 0) * 4 + h)) * 8192; const bf16* sbp = C.sts + ((size_t)(((b * NVC + vc) * 2 + 1) * 4 + h)) * 8192;
            u32x4 hfv[2], hbv[2];
#pragma unroll
            for (int i = 0; i < 2; ++i) { const int itn = tid + NTHREADS * i, octn = itn & 15, rn = itn >> 4; hfv[i] = *(const u32x4*)(sfp + rn * 128 + octn * 8); hbv[i] = *(const u32x4*)(sbp + rn * 128 + octn * 8); }
            u32x2 zz[4];
#pragma unroll
            for (int g4 = 0; g4 < 4; ++g4) zz[g4] = *(const u32x2*)(C.P + (size_t)rowq * NIN + 1536 + h * 64 + pt * 32 + 8 * g4 + 4 * hi);
            { const LAS float* acf = sc + (SC_ACF * 4 + h) * 128; const LAS float* acb = sc + (SC_ACB * 4 + h) * 128; const LAS float* d0 = sc + (SC_DT0 * 4 + h) * 128; const LAS float* d1 = sc + (SC_DT1 * 4 + h) * 128;
#pragma unroll
              for (int q = 0; q < 2; ++q) { const int id = 2 * wave + q, st = id & 3, tq = id >> 2; const int t = tq * 32 + r32; const float aft = acf[t], abt = acb[t];
#pragma unroll
                  for (int g4 = 0; g4 < 4; ++g4) { float mv[4];
#pragma unroll
                      for (int j = 0; j < 4; ++j) { const int s = st * 32 + 8 * g4 + 4 * hi + j;
                          float f; if (s < t) f = __expf(aft - acf[s]) * d0[s]; else if (s > t) f = __expf(abt - acb[s]) * d1[s]; else f = d0[s] + d1[s];
                          mv[j] = (q ? gacc1[4 * g4 + j] : gacc0[4 * g4 + j]) * f; }
                      u32x2 w; w.x = pk2(mv[0], mv[1]); w.y = pk2(mv[2], mv[3]);
                      *(LAS u32x2*)(BkM + t * TP + st * 32 + 8 * g4 + 4 * hi) = w; } } }
            { const unsigned a_[4] = {xr0.x, xr0.y, xr0.z, xr0.w}, b_[4] = {xr1.x, xr1.y, xr1.z, xr1.w};
#pragma unroll
              for (int k = 0; k < 4; ++k) {
                  *(LAS unsigned*)(XsT + (oct_ * 8 + 2 * k) * TP + 2 * tp_) = (a_[k] & 0xffffu) | (b_[k] << 16);
                  *(LAS unsigned*)(XsT + (oct_ * 8 + 2 * k + 1) * TP + 2 * tp_) = (a_[k] >> 16) | (b_[k] & 0xffff0000u); }
#pragma unroll
              for (int i = 0; i < 2; ++i) { const int itn = tid + NTHREADS * i, octn = itn & 15, rn = itn >> 4; *(LAS u32x4*)(Hf + rn * TP + octn * 8) = hfv[i]; *(LAS u32x4*)(Hb + rn * TP + octn * 8) = hbv[i]; } }
            __syncthreads();
            f32x16 y = mma_lds<8>(zero16(), XsT + pt * 32 * TP, TP, BkM + tt * 32 * TP, TP, lane);
            { const float dsum = C.ssmd[h] + C.ssmd[4 + h];
#pragma unroll
              for (int i = 0; i < 16; ++i) { const int p = pt * 32 + 8 * (i >> 2) + 4 * hi + (i & 3); y[i] += dsum * bf2f(XsT[p * TP + tq_]); } }
            __builtin_amdgcn_sched_barrier(0);
            { const f32x16 af = mma_lds<8>(zero16(), Hf + pt * 32 * TP, TP, Cq + tt * 32 * TP, TP, lane);
              const float ef = __expf(sc[(SC_ACF * 4 + h) * 128 + tq_]);
#pragma unroll
              for (int i = 0; i < 16; ++i) y[i] += ef * af[i]; }
            __builtin_amdgcn_sched_barrier(0);
            { const f32x16 ab = mma_lds<8>(zero16(), Hb + pt * 32 * TP, TP, Cq + tt * 32 * TP, TP, lane);
              const float eb = __expf(sc[(SC_ACB * 4 + h) * 128 + tq_]);
#pragma unroll
              for (int i = 0; i < 16; ++i) y[i] += eb * ab[i]; }
#pragma unroll
            for (int g4 = 0; g4 < 4; ++g4) {
                const int p = pt * 32 + 8 * g4 + 4 * hi;
                const float v0 = y[4 * g4] * silu_f(bflo(zz[g4].x)), v1 = y[4 * g4 + 1] * silu_f(bfhi(zz[g4].x)), v2 = y[4 * g4 + 2] * silu_f(bflo(zz[g4].y)), v3 = y[4 * g4 + 3] * silu_f(bfhi(zz[g4].y));
                ssq += v0 * v0 + v1 * v1 + v2 * v2 + v3 * v3;
                u32x2 w; w.x = pk2(v0, v1); w.y = pk2(v2, v3);
                *(u32x2*)(C.MG + (size_t)rowq * DM + 512 + h * 64 + p) = w;
            }
        }
    }
    ssq += __shfl_xor(ssq, 32);
    __syncthreads();
    if (hi == 0) stat[tq_ * 2 + pt] = ssq;
    __syncthreads();
    const float rn = 1.0f / sqrtf((stat[tq_ * 2] + stat[tq_ * 2 + 1]) * (1.0f / 256.0f) + 1e-6f);
#pragma unroll
    for (int h = 0; h < 4; ++h)
#pragma unroll
        for (int g4 = 0; g4 < 4; ++g4) {
            const int p = pt * 32 + 8 * g4 + 4 * hi;
            const f32x4 gv = *(const f32x4*)(C.ssmg + h * 64 + p);
            u32x2* mp = (u32x2*)(C.MG + (size_t)rowq * DM + 512 + h * 64 + p);
            const u32x2 v = *mp;
            u32x2 w; w.x = pk2(bflo(v.x) * rn * gv.x, bfhi(v.x) * rn * gv.y); w.y = pk2(bflo(v.y) * rn * gv.z, bfhi(v.y) * rn * gv.w);
            *mp = w;
        }
}
DI void s3_ret_unit(LAS unsigned char* lds, int tid, const ScanCtx& C, int b, int vc, int h0, int nh) {
    asm volatile("" : "+v"(tid));
    const int lane = tid & 63, wave = tid >> 6, r32 = lane & 31, hi = lane >> 5;
    LAS float* stat = (LAS float*)(lds + L_STAT);
    LAS bf16* Q = (LAS bf16*)(lds + L_BUF); LAS bf16* K = (LAS bf16*)(lds + L_BUF + 18432); LAS bf16* VT = (LAS bf16*)(lds + L_BUF + 2 * 18432);
    LAS bf16* Hf = (LAS bf16*)(lds + L_BUF + 2 * 18432 + 17408); LAS bf16* Hb = (LAS bf16*)(lds + L_BUF + 2 * 18432 + 17408 + 9216); LAS bf16* MB = (LAS bf16*)(lds + L_BUF + 2 * 18432 + 17408 + 2 * 9216);
    const int row0 = vc_row0(b, vc);
    const int pt = wave & 1, tt = wave >> 1;
    const bf16* Prow = C.P + (size_t)row0 * NIN;
    const int t = tt * 32 + r32; const int row = row0 + t;
#pragma unroll 1
    for (int h = h0; h < h0 + nh; ++h) {
        const float lg0 = C.rlg[h], lg1 = C.rlg[4 + h];
        __syncthreads();
        stage_N<128, 64>(Q, QP, Prow + 2560 + h * 64, NIN, tid);
        stage_N<128, 64>(K, QP, Prow + 2816 + h * 64, NIN, tid);
        stage_T<64, false>(VT, VT, Prow + 3072 + h * 64, NIN, nullptr, nullptr, tid);
        stage_N<64, 64>(Hf, QP, C.str + ((size_t)(((b * NVC + vc) * 2 + 0) * 4 + h)) * 4096, 64, tid);
        stage_N<64, 64>(Hb, QP, C.str + ((size_t)(((b * NVC + vc) * 2 + 1) * 4 + h)) * 4096, 64, tid);
        __syncthreads();
#pragma unroll
        for (int q = 0; q < 2; ++q) { const int id = 2 * wave + q, st = id & 3, tq = id >> 2;
            const f32x16 gacc = mma_lds<4>(zero16(), K + st * 32 * QP, QP, Q + tq * 32 * QP, QP, lane);
            const int t2 = tq * 32 + r32;
#pragma unroll
            for (int g4 = 0; g4 < 4; ++g4) { float mv[4];
#pragma unroll
                for (int j = 0; j < 4; ++j) { const int s = st * 32 + 8 * g4 + 4 * hi + j;
                    const float f = (s < t2) ? __expf((float)(t2 - s) * lg0) : ((s > t2) ? __expf((float)(s - t2) * lg1) : 2.0f);
                    mv[j] = gacc[4 * g4 + j] * f; }
                u32x2 w; w.x = pk2(mv[0], mv[1]); w.y = pk2(mv[2], mv[3]);
                *(LAS u32x2*)(MB + t2 * TP + st * 32 + 8 * g4 + 4 * hi) = w; } }
        __syncthreads();
        u32x2 ggv[4];
#pragma unroll
        for (int g4 = 0; g4 < 4; ++g4) ggv[g4] = *(const u32x2*)(C.P + (size_t)row * NIN + 3328 + h * 64 + pt * 32 + 8 * g4 + 4 * hi);
        f32x16 y = mma_lds<8>(zero16(), VT + pt * 32 * TP, TP, MB + tt * 32 * TP, TP, lane);
        { const f32x16 af = mma_lds<4>(zero16(), Hf + pt * 32 * QP, QP, Q + tt * 32 * QP, QP, lane);
          const float ef = __expf((float)(t + 1) * lg0);
#pragma unroll
          for (int i = 0; i < 16; ++i) y[i] += ef * af[i]; }
        { const f32x16 ab = mma_lds<4>(zero16(), Hb + pt * 32 * QP, QP, Q + tt * 32 * QP, QP, lane);
          const float eb = __expf((float)(128 - t) * lg1);
#pragma unroll
          for (int i = 0; i < 16; ++i) y[i] += eb * ab[i]; }
        float s1 = 0.f, s2 = 0.f;
#pragma unroll
        for (int i = 0; i < 16; ++i) { s1 += y[i]; s2 += y[i] * y[i]; }
        s1 += __shfl_xor(s1, 32); s2 += __shfl_xor(s2, 32);
        if (hi == 0) { stat[(t * 2 + pt) * 2] = s1; stat[(t * 2 + pt) * 2 + 1] = s2; }
        __syncthreads();
        const float t1 = stat[(t * 2) * 2] + stat[(t * 2 + 1) * 2], t2s = stat[(t * 2) * 2 + 1] + stat[(t * 2 + 1) * 2 + 1];
        const float mean = t1 * (1.0f / 64.0f), var = fmaxf(t2s * (1.0f / 64.0f) - mean * mean, 0.f), rs = 1.0f / sqrtf(var + 1e-5f);
#pragma unroll
        for (int g4 = 0; g4 < 4; ++g4) {
            const int p = pt * 32 + 8 * g4 + 4 * hi;
            const float g0 = silu_f(bflo(ggv[g4].x)), g1 = silu_f(bfhi(ggv[g4].x)), g2 = silu_f(bflo(ggv[g4].y)), g3 = silu_f(bfhi(ggv[g4].y));
            u32x2 w; w.x = pk2((y[4 * g4] - mean) * rs * g0, (y[4 * g4 + 1] - mean) * rs * g1); w.y = pk2((y[4 * g4 + 2] - mean) * rs * g2, (y[4 * g4 + 3] - mean) * rs * g3);
            *(u32x2*)(C.MG + (size_t)row * DM + 768 + h * 64 + p) = w;
        }
    }
}

constexpr int NPP = 13, NPH = 2 + NPP * DEPTH;
#ifndef PMASK
#define PMASK 0xffff
#endif
#define PEN(k) ((PMASK >> (k)) & 1)
#ifndef PROBE_LASTONLY
#define PROBE_LASTONLY 0
#endif
#ifndef PROBE_N
#define PROBE_N 1
#endif
#ifndef REP_SPLIT
#define REP_SPLIT 1
#endif
#ifndef REP_P0
#define REP_P0 1
#endif
#ifndef REP_LN
#define REP_LN 1
#endif
#ifndef REP_SYNC
#define REP_SYNC 1
#endif
#ifndef REP_ATTN
#define REP_ATTN 1
#endif
#ifndef REP_UP
#define REP_UP 1
#endif
#ifndef REP_IN
#define REP_IN 1
#endif
#ifndef REP_SCAN
#define REP_SCAN 1
#endif

#define GAS __attribute__((address_space(1)))
#define XB_TMO      128
#define XB_XCNT(j)  (256  + 64 * (j))
#define XB_XSUB(j)  (1280 + 64 * (j))
#define XB_XGEN(j)  (2304 + 64 * (j))
#define XB_TOP      3328
#define XB_TOPGEN   3392
#define XCD_BAR_WORDS 3456
#define XB_SPIN_CAP (1u << 18)

__device__ __forceinline__ unsigned xb_ld(unsigned* p)              { return __hip_atomic_load(p, __ATOMIC_RELAXED, __HIP_MEMORY_SCOPE_AGENT); }
__device__ __forceinline__ unsigned xb_add(unsigned* p, unsigned v) { return __hip_atomic_fetch_add(p, v, __ATOMIC_RELAXED, __HIP_MEMORY_SCOPE_AGENT); }
__device__ __forceinline__ unsigned xb_xcc_id() { return (unsigned)__builtin_amdgcn_s_getreg((3 << 11) | 20) & 0xFu; }
#define XB_SPIN(cond, bar) do { unsigned _sp = 0; while (cond) { __builtin_amdgcn_s_sleep(1); \
    if ((++_sp & 255u) == 0u) { if (xb_ld(&(bar)[XB_TMO])) break; if (_sp > XB_SPIN_CAP) { atomicAdd(&(bar)[XB_TMO], 1u); break; } } } } while (0)

struct XcdBarrier {
    unsigned* bar; unsigned x;
    volatile LAS unsigned* st;
};

__device__ __forceinline__ XcdBarrier xcd_barrier_post(unsigned* bar, volatile LAS unsigned* st) {
    XcdBarrier b; b.bar = bar; b.x = xb_xcc_id(); b.st = st;
    if (threadIdx.x == 0) (void)xb_add(&bar[XB_XCNT(b.x)], 1u);
    return b;
}
__device__ __forceinline__ void xcd_barrier_complete(unsigned* bar, unsigned x, unsigned& nloc, unsigned& nx) {
    const unsigned G = gridDim.x * gridDim.y * gridDim.z;
    unsigned sum, cnt, mine, sp = 0u;
    for (;;) {
        sum = 0u; cnt = 0u; mine = 0u;
#pragma unroll
        for (unsigned j = 0; j < 16; ++j) { const unsigned c = xb_ld(&bar[XB_XCNT(j)]); sum += c; cnt += (c > 0u) ? 1u : 0u; mine = (j == x) ? c : mine; }
        if (sum == G) break;
        __builtin_amdgcn_s_sleep(1);
        if ((++sp & 255u) == 0u) { if (xb_ld(&bar[XB_TMO])) break; if (sp > XB_SPIN_CAP) { atomicAdd(&bar[XB_TMO], 1u); break; } }
    }
    nloc = mine > 0u ? mine : 1u; nx = cnt > 0u ? cnt : 1u;
}

__device__ __forceinline__ void xcd_barrier(const XcdBarrier& b) {
    asm volatile("s_waitcnt vmcnt(0)" ::: "memory");
    __syncthreads();
    if (threadIdx.x == 0) {
        unsigned* bar = b.bar;
        __builtin_amdgcn_s_waitcnt(0);
        unsigned nloc = b.st[0], nx = b.st[1];
        if (nloc == 0u) { xcd_barrier_complete(bar, b.x, nloc, nx); b.st[0] = nloc; b.st[1] = nx; }
        const unsigned old = xb_add(&bar[XB_XSUB(b.x)], 1u);
        const unsigned gen = old / nloc;
        if (old + 1u == (gen + 1u) * nloc) {
            __builtin_amdgcn_fence(__ATOMIC_RELEASE, "agent");
            asm volatile("s_waitcnt vmcnt(0)" ::: "memory");
            const unsigned og = xb_add(&bar[XB_TOP], 1u);
            const unsigned tg = og / nx;
            if (og + 1u == (tg + 1u) * nx) xb_add(&bar[XB_TOPGEN], 1u);
            else XB_SPIN(xb_ld(&bar[XB_TOPGEN]) == tg, bar);
            __builtin_amdgcn_fence(__ATOMIC_ACQUIRE, "agent");
            xb_add(&bar[XB_XGEN(b.x)], 1u);
            asm volatile("s_waitcnt vmcnt(0)" ::: "memory");
        } else {
            XB_SPIN(xb_ld(&bar[XB_XGEN(b.x)]) == gen, bar);
            __builtin_amdgcn_fence(__ATOMIC_ACQUIRE, "agent");
            asm volatile("s_waitcnt vmcnt(0)" ::: "memory");
        }
    }
    __syncthreads();
}
template <class Epi> DI void run_gemm(LAS unsigned char* lds, int tid, const bf16* Ap, const bf16* Bt, int M, int N, int K, int G, int bid, const Epi& E, int ld = 0) {
    pg8::Gemm g{Ap, Bt, M, N, K, ld ? ld : K}; pg8::StaticOrder S; S.init(M, N, G, bid);
    pg8::gemm_phase<Epi, pg8::StaticOrder, true, true>(lds, g, S, E, tid);
}

__global__ void __launch_bounds__(NTHREADS, 2) mega(Args A) {
    extern __shared__ __attribute__((aligned(16))) unsigned char lds_raw[];
    LAS unsigned char* lds = (LAS unsigned char*)lds_raw;
    cg::grid_group grid = cg::this_grid();
    const int tid0 = threadIdx.x, bid0 = blockIdx.x, G0 = gridDim.x;
    { volatile LAS unsigned* bst0 = (volatile LAS unsigned*)(lds + LDS_BYTES - 64); if (tid0 < 16) bst0[tid0] = 0u;
      if (bid0 == 0) { unsigned* bw = (unsigned*)(A.ws + WS_BAR); for (int i = tid0; i < XCD_BAR_WORDS; i += NTHREADS) bw[i] = 0u; } }
    __syncthreads();
    int rep_done = 0; (void)rep_done;
    for (int ph = A.ph_lo; ph < A.ph_hi; ++ph) {
        if (ph > A.ph_lo) {
            if (ph == A.ph_lo + 1) { grid.sync(); (void)xcd_barrier_post((unsigned*)(A.ws + WS_BAR), (volatile LAS unsigned*)(lds + LDS_BYTES - 64)); }
            else { for (int rs_ = 0; rs_ < REP_SYNC; ++rs_) { XcdBarrier xb_; xb_.bar = (unsigned*)(A.ws + WS_BAR); xb_.x = xb_xcc_id(); xb_.st = (volatile LAS unsigned*)(lds + LDS_BYTES - 64); xcd_barrier(xb_); } }
        }
        int tid = tid0, bid = bid0, G = G0; size_t zoff = 0;
        asm volatile("" : "+v"(tid)); asm volatile("" : "+s"(bid)); asm volatile("" : "+s"(G)); asm volatile("" : "+s"(zoff));
        unsigned char* ws = A.ws + zoff;
        float* xc = (float*)(ws + WS_XC);
        bf16* Abuf = (bf16*)(ws + WS_A); bf16* HP = (bf16*)(ws + WS_HP); bf16* Vt = (bf16*)(ws + WS_VT);
        const float* MOD = (const float*)(ws + WS_MOD);
        if (ph == 0) { if (PEN(0)) for (int rp_ = 0; rp_ < REP_P0; ++rp_) { p0a_phase(A, lds, tid, bid, G); __syncthreads(); } continue; }
        if (ph == 1) { if (PEN(1)) for (int rp_ = 0; rp_ < REP_LN; ++rp_) lnmod_phase(A, lds, tid, bid, G, true, -1, 0, 0, 0, false, M_ALL, false, nullptr, nullptr); continue; }
        const int q = ph - 2, l = q / NPP; int s = q % NPP; const bool is_conv = (s == 4); if (s >= 4) s -= 1; if (is_conv) s = 100;
        const bool last = (l == DEPTH - 1);
        const int Mpost = last ? M_LAT : M_ALL;
        if ((s == 0 || s == 9) && PEN(2)) {
            const int f = (s == 9); EpiSwiglu E{HP};
            for (int rp_ = 0; rp_ < REP_UP; ++rp_) run_gemm(lds, tid, Abuf, (const bf16*)(ws + WS_WGU) + (size_t)f * NGU * DM, f ? Mpost : M_ALL, NGU, DM, G, bid, E);
        } else if ((s == 1 || s == 10 || s == 7) && PEN(3)) {
            const int i = (s == 1) ? 0 : (s == 7 ? 1 : 2);
            const int prev_idx = (i == 0) ? (l == 0 ? -1 : (l - 1) * 3 + 2) : l * 3 + (i - 1);
            const float* modg_p = MOD + (size_t)l * 9 * 9216 + i * 3072 + 2048;
            const float* scale_v = (s == 7) ? (const float*)(ws + WS_ONES) : (const float*)(ws + WS_HALVES);
            const float* gprev_p = prev_idx < 0 ? (const float*)(ws + WS_ONES) : A.in[I_NG] + prev_idx * DM; const float* bprev_p = prev_idx < 0 ? (const float*)(ws + WS_ZEROS) : A.in[I_NB] + prev_idx * DM;
            EpiResid E{(bf16*)(ws + WS_X16), modg_p, scale_v, (const f32x2*)(ws + WS_STAT), gprev_p, bprev_p};
            const bool has_ctx = (s == 1) || !last;
            const bf16* Ap = (s == 7) ? Abuf : HP; const bf16* Bp = (s == 7) ? (const bf16*)(ws + WS_WOUT) : (const bf16*)(ws + WS_WDN) + (size_t)(s == 10) * DM * DFF;
            const int Kd = (s == 7) ? DM : DFF;
            const int ldd = (s == 7) ? DM : DFF;
            run_gemm(lds, tid, Ap, Bp, M_LAT, DM, Kd, G, bid, E, ldd);
            if (has_ctx) {
                const int sb = (G == 256 && ((bid >> 3) & 7) < 4 && bid < 256) ? ((bid & 7) | (((bid >> 3) & 3) << 3) | ((bid >> 6) << 5)) : (G == 256 ? 999 : (bid + G - 64) % G);
                const int qd = (sb >> 5) & 3;
                const int kt0 = (s == 7) ? 4 * qd : (qd < 2 ? 12 * qd : 24 + 10 * (qd - 2));
                const int ktn = (s == 7) ? 4 : (qd < 2 ? 12 : 10);
                OneUnit S1u; S1u.have = sb < 128; S1u.u.pm = 128 + (sb & 7); S1u.u.pn = (sb >> 3) & 3;
                EpiPartial Ep{(float*)(ws + WS_T) + (size_t)qd * M_CTX * DM, modg_p, scale_v};
                pg8::Gemm g2{Ap + (size_t)kt0 * 64, Bp + (size_t)kt0 * 64, M_ALL, DM, ktn * 64, ldd};
                pg8::gemm_phase<EpiPartial, OneUnit, true, true>(lds, g2, S1u, Ep, tid);
            }
        } else if (s == 2 && PEN(1)) {
            lnmod_phase(A, lds, tid, bid, G, false, l, 0, l, 1, true, M_ALL, true, l == 0 ? (const float*)(ws + WS_ONES) : A.in[I_NG] + ((l - 1) * 3 + 2) * DM, l == 0 ? (const float*)(ws + WS_ZEROS) : A.in[I_NB] + ((l - 1) * 3 + 2) * DM);
        } else if (s == 3 && PEN(4)) {
            EpiIn E{HP, Vt, (const f32x2*)(ws + WS_TATT), (const f32x2*)(ws + WS_TRET)};
            for (int rp_ = 0; rp_ < REP_IN; ++rp_) run_gemm(lds, tid, Abuf, (const bf16*)(ws + WS_WIN), M_ALL, NIN, DM, G, bid, E);
        } else if (is_conv || s == 4 || s == 5 || s == 6) {
            ScanCtx C{HP, (const bf16*)(ws + WS_U), (const float*)(ws + WS_DT), (bf16*)(ws + WS_STS), (bf16*)(ws + WS_STR), (float*)(ws + WS_DEC), Abuf,
                      A.in[I_CONVW] + (size_t)l * 5 * 768, A.in[I_CONVB] + l * 768, A.in[I_ALOG] + l * 8, A.in[I_DTB] + l * 8, A.in[I_SSMD] + l * 8, A.in[I_SSMG] + l * 256, A.in[I_RLG] + l * 8};
            const float lam = ((const float*)(ws + WS_LAM))[l];
            const float lam_init = 0.8f - 0.6f * expf(-0.3f * (float)l);
            const float* subg = A.in[I_SUBG] + l * 128;
            const int r = is_conv ? 0 : s - 3;
            if (PEN(7)) for (int rp_ = 0; rp_ < REP_ATTN; ++rp_) for (int u = bid; u < 256; u += G) { const int bh = r * 8 + (u & 7), qb = u >> 3;
                attn_unit(lds, tid, HP, Vt, Abuf, bh >> 2, bh & 3, (bh >> 2) * SEQ + qb * 128, 0, 68, lam, 1.0f - lam_init, subg); }
            if (is_conv) {
                if (PEN(10)) conv_phase(HP, (bf16*)(ws + WS_U), C.cw, C.cb, tid, bid, G);
            } else if (s == 4) {
                { const int nS1 = NB * NVC, extra1 = (nS1 > G && nS1 < 2 * G) ? nS1 - G : 0;
                  if (PEN(5)) { for (int u = bid; u < nS1; u += G) s1_ssd_unit(lds, tid, C, u / NVC, u % NVC);
                      if (bid >= extra1) for (int r = bid - extra1; r < 4 * nS1; r += G - extra1) { const int v = r >> 2; s1_ret_unit(lds, tid, C, v / NVC, v % NVC, r & 3, 1); } } }
            } else if (s == 5) {
                if (PEN(6)) s2_phase(C, tid, bid, G);
            } else {
                const int vc0 = last ? 2 : 0, nvc = NVC - vc0;
                const int nS = NB * nvc, extra = (nS > G && nS < 2 * G) ? nS - G : 0;
                if (PEN(8)) for (int u = bid; u < nS; u += G) s3_ssd_unit(lds, tid, C, u / nvc, vc0 + u % nvc);
                if (PEN(9) && bid >= extra) for (int r = bid - extra; r < 4 * nS; r += G - extra) { const int v = r >> 2; s3_ret_unit(lds, tid, C, v / nvc, vc0 + v % nvc, r & 3, 1); }
                if (!last && PEN(7)) for (int u = (bid + G - 64) % G; u < 64; u += G) { const int bh = u >> 1; attn_unit(lds, tid, HP, Vt, Abuf, bh >> 2, bh & 3, M_LAT + (bh >> 2) * CTXL + (u & 1) * 128, 64, 68, lam, 1.0f - lam_init, subg); }
            }
        } else if (s == 8 && PEN(1)) {
            lnmod_phase(A, lds, tid, bid, G, false, l, 1, l, 2, false, Mpost, !last, A.in[I_NG] + (l * 3) * DM, A.in[I_NB] + (l * 3) * DM);
        } else if (s == 11 && PEN(1)) {
            lnmod_phase(A, lds, tid, bid, G, false, l, 2, last ? -1 : l + 1, 0, false, Mpost, !last, A.in[I_NG] + (l * 3 + 1) * DM, A.in[I_NB] + (l * 3 + 1) * DM);
            if (!last) convw_phase(A, l + 1, lds, tid, bid, G);
        }
#ifdef PROBE_S
        if ((s == (PROBE_S) || s == (PROBE_S2)) && (PROBE_LASTONLY == 0 || last) && rep_done < PROBE_N) { ++rep_done; --ph; } else rep_done = 0;
#endif
    }
}

extern "C" void kernel_launch(void* const* d_in, const int* in_sizes, int n_in, void* d_out, int out_size, void* d_ws, size_t ws_size, hipStream_t stream) {
    static int grid = 0;
    if (grid == 0) {
        if (n_in != 22 || in_sizes[0] != M_LAT * DM || out_size != M_LAT * DM || ws_size < WS_END) { fprintf(stderr, "kernel_launch: unexpected shapes (n_in %d, out %d, ws %zu)\n", n_in, out_size, ws_size); grid = -1; return; }
        int dev = 0, cus = 0, per_cu = 0;
        hipGetDevice(&dev); hipDeviceGetAttribute(&cus, hipDeviceAttributeMultiprocessorCount, dev);
        if (hipFuncSetAttribute((const void*)mega, hipFuncAttributeMaxDynamicSharedMemorySize, LDS_BYTES) != hipSuccess) { fprintf(stderr, "kernel_launch: hipFuncSetAttribute failed\n"); grid = -1; return; }
        if (hipOccupancyMaxActiveBlocksPerMultiprocessor(&per_cu, (const void*)mega, NTHREADS, LDS_BYTES) != hipSuccess || per_cu < 1) { fprintf(stderr, "kernel_launch: occupancy query says %d\n", per_cu); per_cu = 1; }
        (void)hipGetLastError();
        grid = cus * 1;
    }
    if (grid < 0) return;
    Args a{};
    for (int i = 0; i < 22; ++i) a.in[i] = (const float*)d_in[i];
    a.out = (float*)d_out; a.ws = (unsigned char*)d_ws;
    for (int i = 0; i < 16; ++i) a.afreq[i] = 1.0f / powf(10000.0f, (float)(2 * i) / 32.0f);
    for (int i = 0; i < 32; ++i) a.rfreq[i] = 1.0f / powf(10000.0f, (float)i / 31.0f);
#ifdef MK_MULTI
    for (int ph = 0; ph < NPH; ++ph) { a.ph_lo = ph; a.ph_hi = ph + 1; hipLaunchKernelGGL(mega, dim3(grid), dim3(NTHREADS), LDS_BYTES, stream, a); }
#else
    a.ph_lo = 0; a.ph_hi = NPH;
    void* args[] = {&a};
    hipError_t e = hipLaunchCooperativeKernel((const void*)mega, dim3(grid), dim3(NTHREADS), args, LDS_BYTES, stream);
    if (e != hipSuccess) fprintf(stderr, "cooperative launch failed: %s (grid %d)\n", hipGetErrorString(e), grid);
#endif
}
```

```cpp
#include <hip/hip_runtime.h>
#include <hip/hip_cooperative_groups.h>
#include <cstdio>
#include <cstdint>
#include <cmath>
namespace cg = cooperative_groups;

namespace pg8 {
#define PG8_LAS __attribute__((address_space(3)))
typedef unsigned short bf16_t;
typedef short bf16x8 __attribute__((ext_vector_type(8)));
typedef float f32x4 __attribute__((ext_vector_type(4)));
typedef unsigned u32x4 __attribute__((ext_vector_type(4)));
constexpr int BM = 256, BK = 64, HALF = 128, HTB = HALF * BK * 2  , STAGE_BYTES = 8 * HTB, NXCD = 8, WGM = 8;

__host__ __device__ __forceinline__ int lds_byte(int r, int c) { const int st = (r >> 4) * 2 + (c >> 5), rr = r & 15, cc = c & 31, ob = rr * 64 + cc * 2; return st * 1024 + (ob ^ (((ob >> 9) & 1) << 5)); }
__host__ __device__ __forceinline__ void stage_rc(int b, int& R, int& C) { const int st = b / 1024, sb = b % 1024, swz = sb ^ (((sb >> 9) & 1) << 5); R = (st >> 1) * 16 + swz / 64; C = (st & 1) * 32 + (swz % 64) / 2; }
__host__ __device__ __forceinline__ int perm32(int rho) { const int n = rho >> 4, i = rho & 15; return 8 * (i >> 2) + 4 * n + (i & 3); }

struct Unit { int pm, pn; };
struct Gemm { const bf16_t* A; const bf16_t* Bt; int M, N, K, ld; };

struct StaticOrder {
    int nM, nN, nwg, G, c;
    __host__ __device__ void init(int M, int N, int G_, int c_) { nM = M / BM; nN = N / BM; nwg = nM * nN; G = G_; c = c_; }
    __host__ __device__ bool next(int i, Unit& u) const {
        const long L = (long)i * G + c; if (L >= nwg) return false;
        int wgid = (int)L; { const int q = nwg / NXCD, r = nwg % NXCD, xcd = wgid % NXCD, off = wgid / NXCD; wgid = (xcd < r ? xcd * (q + 1) : r * (q + 1) + (xcd - r) * q) + off; }
        const int nig = WGM * nN, gid = wgid / nig, fm = gid * WGM, gsz = (nM - fm) < WGM ? (nM - fm) : WGM;
        u.pm = fm + ((wgid % nig) % gsz); u.pn = (wgid % nig) / gsz; return true;
    }
    __device__ __forceinline__ void a_ready(const Unit&) const {}
    __device__ __forceinline__ void done(const Unit&) const {}
};

__device__ __forceinline__ unsigned cvt_pk_bf16(float lo, float hi) { unsigned r; asm volatile("v_cvt_pk_bf16_f32 %0, %1, %2" : "=v"(r) : "v"(lo), "v"(hi)); return r; }
template <class Epi, class Sched, bool ALIGN_EPI = false, bool SP2 = false>
__device__ __forceinline__ void gemm_phase(PG8_LAS unsigned char* lds, const Gemm g, const Sched& S, const Epi& E, const int tid) {
    const int wid = __builtin_amdgcn_readfirstlane(tid >> 6), lane = tid & 63, wr = wid >> 2, wc = wid & 3, fr = lane & 15, fq = lane >> 4;
    const int K = g.K, nt = K / BK;
    unsigned voffA[2], voffB[2];
#pragma unroll
    for (int i = 0; i < 2; ++i) { int R, C; stage_rc(tid * 16 + i * 8192, R, C); const int Rb = Epi::PERM ? ((R & ~31) + perm32(R & 31)) : R;
        voffA[i] = (unsigned)(R * g.ld + C) * 2u; voffB[i] = (unsigned)(Rb * g.ld + C) * 2u; }
    const size_t kstep = (size_t)(BK * 2);
    const size_t hstep = (size_t)HALF * g.ld * 2;
    const size_t tstep = 2 * hstep;
    const unsigned ldsw = (unsigned)wid * 1024u;
    const int aoff = lds_byte(wr * 64 + fr, fq * 8), boff = lds_byte(wc * 32 + fr, fq * 8);
#define PG8_SA(b, h) (((b) * 2 + (h)) * HTB)
#define PG8_SB(b, h) ((4 + (b) * 2 + (h)) * HTB)
#define PG8_STAGE(bufoff, gbase, voff) do { _Pragma("unroll") for (int _i = 0; _i < 2; ++_i) \
        __builtin_amdgcn_global_load_lds((const unsigned*)((const char*)(gbase) + (voff)[_i]), (PG8_LAS unsigned*)(lds + (bufoff) + ldsw + _i * 8192), 16, 0, 0); } while (0)
#define PG8_LDA(dst, b, h) do { _Pragma("unroll") for (int m = 0; m < 4; ++m) _Pragma("unroll") for (int k = 0; k < 2; ++k) dst[m][k] = *(const PG8_LAS bf16x8*)(lds + PG8_SA(b, h) + aoff + m * 2048 + k * 1024); } while (0)
#define PG8_LDB(dst, b, h) do { _Pragma("unroll") for (int n = 0; n < 2; ++n) _Pragma("unroll") for (int k = 0; k < 2; ++k) dst[n][k] = *(const PG8_LAS bf16x8*)(lds + PG8_SB(b, h) + boff + n * 2048 + k * 1024); } while (0)
#define PG8_MMA(ai, bj, At, Bt) do { __builtin_amdgcn_s_setprio(1); _Pragma("unroll") for (int m = 0; m < 4; ++m) _Pragma("unroll") for (int n = 0; n < 2; ++n) _Pragma("unroll") for (int k = 0; k < 2; ++k) \
        acc[ai][bj][m][n] = __builtin_amdgcn_mfma_f32_16x16x32_bf16(Bt[n][k], At[m][k], acc[ai][bj][m][n], 0, 0, 0); __builtin_amdgcn_s_setprio(0); } while (0)
#define PG8_WAIT_V(n) asm volatile("s_waitcnt vmcnt(" #n ")" ::: "memory")
#define PG8_WAIT_L(n) asm volatile("s_waitcnt lgkmcnt(" #n ")" ::: "memory")
#define PG8_BAR __builtin_amdgcn_s_barrier()
#define PG8_SCHED __builtin_amdgcn_sched_barrier(0)
    Unit cur, nxt; int ui = 0;
    if (!S.next(0, cur)) return;
    f32x4 acc[2][2][4][2];
#pragma unroll
    for (int a = 0; a < 2; ++a)
#pragma unroll
        for (int b = 0; b < 2; ++b)
#pragma unroll
            for (int m = 0; m < 4; ++m)
#pragma unroll
                for (int n = 0; n < 2; ++n) acc[a][b][m][n] = (f32x4){0.f, 0.f, 0.f, 0.f};
    bf16x8 At[4][2], B0[2][2], B1[2][2];
    const char* cA = (const char*)g.A + (size_t)cur.pm * tstep; const char* cB = (const char*)g.Bt + (size_t)cur.pn * tstep;
    S.a_ready(cur);
    if constexpr (SP2) {
        PG8_STAGE(PG8_SB(0, 0), cB, voffB); PG8_STAGE(PG8_SB(0, 1), cB + hstep, voffB); PG8_STAGE(PG8_SA(0, 0), cA, voffA); PG8_STAGE(PG8_SA(0, 1), cA + hstep, voffA);
        if (wr == 1) PG8_BAR;
        PG8_WAIT_V(2); PG8_BAR;
        PG8_STAGE(PG8_SB(1, 0), cB + kstep, voffB); PG8_STAGE(PG8_SA(1, 0), cA + kstep, voffA); PG8_STAGE(PG8_SB(1, 1), cB + hstep + kstep, voffB);
        PG8_WAIT_V(6); PG8_BAR;
    } else {
        PG8_STAGE(PG8_SB(0, 0), cB, voffB); PG8_STAGE(PG8_SA(0, 0), cA, voffA); PG8_STAGE(PG8_SB(0, 1), cB + hstep, voffB); PG8_STAGE(PG8_SA(0, 1), cA + hstep, voffA);
        if (wr == 1) PG8_BAR;
        PG8_WAIT_V(4); PG8_BAR;
        PG8_STAGE(PG8_SB(1, 0), cB + kstep, voffB); PG8_STAGE(PG8_SA(1, 0), cA + kstep, voffA); PG8_STAGE(PG8_SB(1, 1), cB + hstep + kstep, voffB);
        PG8_WAIT_V(6); PG8_BAR;
    }
    for (;;) {
        const bool has_next = S.next(ui + 1, nxt);
        const char* nA = has_next ? (const char*)g.A + (size_t)nxt.pm * tstep : cA; const char* nB = has_next ? (const char*)g.Bt + (size_t)nxt.pn * tstep : cB;
        for (int t = 0; t < nt; t += 2) {
            const bool last = (t == nt - 2);
            const char* a1 = cA + (size_t)(t + 1) * kstep;
            const char* a2 = last ? nA : cA + (size_t)(t + 2) * kstep; const char* b2 = last ? nB : cB + (size_t)(t + 2) * kstep;
            const char* a3 = a2 + kstep; const char* b3 = b2 + kstep;
            if (last && has_next) S.a_ready(nxt);
            if constexpr (SP2) {
            PG8_LDB(B0, 0, 0); PG8_LDB(B1, 0, 1); PG8_SCHED; PG8_LDA(At, 0, 0); PG8_STAGE(PG8_SA(1, 1), a1 + hstep, voffA);
            PG8_WAIT_V(8); PG8_WAIT_L(0); PG8_BAR; PG8_MMA(0, 0, At, B0); PG8_MMA(0, 1, At, B1); PG8_BAR; PG8_SCHED;
            PG8_LDA(At, 0, 1); PG8_STAGE(PG8_SB(0, 0), b2, voffB); PG8_STAGE(PG8_SB(0, 1), b2 + hstep, voffB); PG8_STAGE(PG8_SA(0, 0), a2, voffA);
            PG8_WAIT_V(8); PG8_WAIT_L(0); PG8_BAR; PG8_MMA(1, 0, At, B0); PG8_MMA(1, 1, At, B1); PG8_BAR; PG8_SCHED;
            PG8_LDB(B0, 1, 0); PG8_LDB(B1, 1, 1); PG8_SCHED; PG8_LDA(At, 1, 0); PG8_STAGE(PG8_SA(0, 1), a2 + hstep, voffA);
            PG8_WAIT_V(8); PG8_WAIT_L(0); PG8_BAR; PG8_MMA(0, 0, At, B0); PG8_MMA(0, 1, At, B1); PG8_BAR; PG8_SCHED;
            PG8_LDA(At, 1, 1); PG8_STAGE(PG8_SB(1, 0), b3, voffB); PG8_STAGE(PG8_SB(1, 1), b3 + hstep, voffB); PG8_STAGE(PG8_SA(1, 0), a3, voffA);
            PG8_WAIT_V(8); PG8_WAIT_L(0); PG8_BAR; PG8_MMA(1, 0, At, B0); PG8_MMA(1, 1, At, B1); PG8_BAR; PG8_SCHED;
            } else {
            PG8_LDB(B0, 0, 0); PG8_SCHED; PG8_LDA(At, 0, 0); PG8_STAGE(PG8_SA(1, 1), a1 + hstep, voffA);
            PG8_WAIT_L(8); PG8_BAR; PG8_WAIT_L(0); PG8_MMA(0, 0, At, B0); PG8_BAR; PG8_SCHED;
            PG8_LDB(B1, 0, 1); PG8_STAGE(PG8_SB(0, 0), b2, voffB);
            PG8_BAR; PG8_WAIT_L(0); PG8_MMA(0, 1, At, B1); PG8_BAR;
            PG8_LDA(At, 0, 1); PG8_STAGE(PG8_SA(0, 0), a2, voffA);
            PG8_BAR; PG8_WAIT_L(0); PG8_MMA(1, 0, At, B0); PG8_BAR; PG8_SCHED;
            PG8_STAGE(PG8_SB(0, 1), b2 + hstep, voffB);
            PG8_WAIT_V(6); PG8_BAR; PG8_MMA(1, 1, At, B1); PG8_BAR;
            PG8_LDB(B0, 1, 0); PG8_SCHED; PG8_LDA(At, 1, 0); PG8_STAGE(PG8_SA(0, 1), a2 + hstep, voffA);
            PG8_WAIT_L(8); PG8_BAR; PG8_WAIT_L(0); PG8_MMA(0, 0, At, B0); PG8_BAR; PG8_SCHED;
            PG8_LDB(B1, 1, 1); PG8_STAGE(PG8_SB(1, 0), b3, voffB);
            PG8_BAR; PG8_WAIT_L(0); PG8_MMA(0, 1, At, B1); PG8_BAR;
            PG8_LDA(At, 1, 1); PG8_STAGE(PG8_SA(1, 0), a3, voffA);
            PG8_BAR; PG8_WAIT_L(0); PG8_MMA(1, 0, At, B0); PG8_BAR; PG8_SCHED;
            PG8_STAGE(PG8_SB(1, 1), b3 + hstep, voffB);
            PG8_WAIT_V(6); PG8_BAR; PG8_MMA(1, 1, At, B1); PG8_BAR;
            }
        }
        if constexpr (ALIGN_EPI) { if (wr == 0) PG8_BAR; }
        if constexpr (!Epi::AFTER_DRAIN) { E(acc, cur, wr, wc, fr, fq); S.done(cur); }
        if (!has_next) break;
#pragma unroll
        for (int a = 0; a < 2; ++a)
#pragma unroll
            for (int b = 0; b < 2; ++b)
#pragma unroll
                for (int m = 0; m < 4; ++m)
#pragma unroll
                    for (int n = 0; n < 2; ++n) acc[a][b][m][n] = (f32x4){0.f, 0.f, 0.f, 0.f};
        cur = nxt; cA = nA; cB = nB; ++ui;
        if constexpr (ALIGN_EPI) { if (wr == 1) PG8_BAR; }
    }
    PG8_WAIT_V(0);
    if constexpr (!ALIGN_EPI) { if (wr == 0) PG8_BAR; }
    PG8_BAR;
    if constexpr (Epi::AFTER_DRAIN) { E.fused(acc, cur, wr, wc, fr, fq, lds, wid, lane); S.done(cur); }
#undef PG8_SA
#undef PG8_SB
#undef PG8_STAGE
#undef PG8_LDA
#undef PG8_LDB
#undef PG8_MMA
#undef PG8_WAIT_V
#undef PG8_WAIT_L
#undef PG8_BAR
#undef PG8_SCHED
}
}

#define DI __device__ __forceinline__
#define LAS __attribute__((address_space(3)))
typedef unsigned short bf16;
typedef short bf16x8 __attribute__((ext_vector_type(8)));
typedef float f32x4 __attribute__((ext_vector_type(4)));
typedef float f32x2 __attribute__((ext_vector_type(2)));
typedef float f32x16 __attribute__((ext_vector_type(16)));
typedef unsigned u32x4 __attribute__((ext_vector_type(4)));
typedef unsigned u32x2 __attribute__((ext_vector_type(2)));
typedef __bf16 bf16x2_t __attribute__((ext_vector_type(2)));

DI unsigned pk2(float lo, float hi) { f32x2 v = {lo, hi}; bf16x2_t b = __builtin_convertvector(v, bf16x2_t); return __builtin_bit_cast(unsigned, b); }
DI bf16 f2bf(float f) { return (bf16)(pk2(f, 0.f) & 0xffffu); }
DI float bf2f(bf16 v) { return __builtin_bit_cast(float, (unsigned)v << 16); }
DI float bflo(unsigned u) { return __builtin_bit_cast(float, u << 16); }
DI float bfhi(unsigned u) { return __builtin_bit_cast(float, u & 0xffff0000u); }
typedef _Float16 f16x2_t __attribute__((ext_vector_type(2)));
typedef __fp16 fp16x2_t __attribute__((ext_vector_type(2)));
DI unsigned pkh2(float lo, float hi) { return __builtin_bit_cast(unsigned, __builtin_amdgcn_cvt_pkrtz(lo, hi)); }
DI float hlo(unsigned u) { return (float)__builtin_bit_cast(f16x2_t, u).x; }
DI float hhi(unsigned u) { return (float)__builtin_bit_cast(f16x2_t, u).y; }
DI float silu_f(float x) { return x * __builtin_amdgcn_rcpf(1.f + __expf(-x)); }
DI float ex2(float x) { return __builtin_amdgcn_exp2f(x); }
#define MFMA32(a, b, c) __builtin_amdgcn_mfma_f32_32x32x16_bf16((a), (b), (c), 0, 0, 0)

constexpr int DM = 1024, NB = 8, SEQ = 4096, CTXL = 256, DEPTH = 4;
constexpr int M_LAT = NB * SEQ, M_CTX = NB * CTXL, M_ALL = M_LAT + M_CTX;
constexpr int DFF = 2816, NGU = 2 * DFF, NIN = 3584, INC = 3588, NKEY = SEQ + CTXL, NVC = 34;
constexpr int XBC0 = 1792;
constexpr float ALPHA = 1.6817928305074290f;
constexpr float QSCALE = 0.125f * 1.4426950408889634f;
constexpr size_t MiB = 1u << 20;
constexpr size_t WS_MOD = 0, WS_TATT = 2 * MiB, WS_LAM = 2 * MiB + 65536, WS_BAR = 2 * MiB + 131072, WS_STAT = 2 * MiB + 262144, WS_ONES = 2 * MiB + 655360, WS_ZEROS = 2 * MiB + 655360 + 4096, WS_HALVES = 2 * MiB + 655360 + 8192, WS_TRET = 3 * MiB, WS_DT = 4 * MiB, WS_DEC = 5 * MiB, WS_XC = 6 * MiB,
                 WS_WGU = 14 * MiB, WS_WDN = 36 * MiB, WS_WIN = 47 * MiB, WS_WOUT = 54 * MiB, WS_A = 56 * MiB, WS_HP = 124 * MiB,
                 WS_VT = 362 * MiB, WS_STS = 396 * MiB, WS_STR = 430 * MiB, WS_U = 447 * MiB, WS_T = 498 * MiB, WS_X16 = 530 * MiB, WS_END = 598 * MiB;
constexpr int LDS_BYTES = 147456;
constexpr int NTHREADS = 512;

struct Args { const float* in[22]; float* out; unsigned char* ws; float afreq[16]; float rfreq[32]; int ph_lo, ph_hi; };
enum { I_X = 0, I_C, I_CTX, I_CCTX, I_ADAW, I_ADAB, I_NG, I_NB, I_WG, I_WU, I_WD, I_WIN, I_CONVW, I_CONVB, I_LAMBDA, I_SUBG, I_ALOG, I_DTB, I_SSMD, I_SSMG, I_RLG, I_WOUT };

DI float* xrow_ptr(float* xlat, float* xctx, int row) { return row < M_LAT ? xlat + (size_t)row * DM : xctx + (size_t)(row - M_LAT) * DM; }
DI int swap23(int o) { return (o & 3) | (((o >> 3) & 1) << 2) | (((o >> 2) & 1) << 3); }

struct EpiSwiglu {
    static constexpr bool PERM = true, AFTER_DRAIN = false;
    bf16* H;
    DI void operator()(const pg8::f32x4 (&acc)[2][2][4][2], const pg8::Unit& u, int wr, int wc, int fr, int fq) const {
        const int row0 = u.pm * 256 + wr * 64 + fr, col = u.pn * 128 + wc * 32 + 8 * fq;
#pragma unroll
        for (int ai = 0; ai < 2; ++ai)
#pragma unroll
            for (int m = 0; m < 4; ++m) {
                bf16* p = H + (size_t)(row0 + ai * 128 + m * 16) * DFF + col;
                float h[8];
#pragma unroll
                for (int n = 0; n < 2; ++n)
#pragma unroll
                    for (int j = 0; j < 4; ++j) h[n * 4 + j] = silu_f(acc[ai][0][m][n][j]) * acc[ai][1][m][n][j];
                u32x4 w; w.x = pk2(h[0], h[1]); w.y = pk2(h[2], h[3]); w.z = pk2(h[4], h[5]); w.w = pk2(h[6], h[7]);
                *(u32x4*)p = w;
                __builtin_amdgcn_sched_barrier(0);
            }
    }
};

struct EpiResid {
    static constexpr bool PERM = true, AFTER_DRAIN = false;
    bf16* X; const float* modg; const float* scale_p; const f32x2* stat; const float* gprev; const float* bprev;
    DI void operator()(const pg8::f32x4 (&acc)[2][2][4][2], const pg8::Unit& u, int wr, int wc, int fr, int fq) const {
        const int mi = (u.pm < 128) ? (u.pm >> 4) : 8;
        const float* gp = modg + (size_t)mi * 9216;
        const int row0 = u.pm * 256 + wr * 64 + fr, col0 = u.pn * 256 + wc * 32 + 8 * fq;
        const float scale = *scale_p;
#pragma unroll
        for (int bj = 0; bj < 2; ++bj) {
            f32x4 gs[2], gq[2], bq[2];
#pragma unroll
            for (int n = 0; n < 2; ++n) { const f32x4 g = *(const f32x4*)(gp + col0 + bj * 128 + 4 * n); gs[n] = (g + 1.0f) * scale;
                gq[n] = *(const f32x4*)(gprev + col0 + bj * 128 + 4 * n) * ALPHA; bq[n] = *(const f32x4*)(bprev + col0 + bj * 128 + 4 * n) * ALPHA; }
#pragma unroll
            for (int ai = 0; ai < 2; ++ai) {
                u32x4 xv[4]; f32x2 st[4];
#pragma unroll
                for (int m = 0; m < 4; ++m) { const int row = row0 + ai * 128 + m * 16; xv[m] = *(const u32x4*)(X + (size_t)row * DM + col0 + bj * 128); st[m] = stat[row]; }
                __builtin_amdgcn_sched_barrier(0);
#pragma unroll
                for (int m = 0; m < 4; ++m) {
                    const f32x4 x0 = {hlo(xv[m].x), hhi(xv[m].x), hlo(xv[m].y), hhi(xv[m].y)}, x1 = {hlo(xv[m].z), hhi(xv[m].z), hlo(xv[m].w), hhi(xv[m].w)};
                    const f32x4 y0 = (x0 - st[m].x) * st[m].y * gq[0] + bq[0] + gs[0] * acc[ai][bj][m][0];
                    const f32x4 y1 = (x1 - st[m].x) * st[m].y * gq[1] + bq[1] + gs[1] * acc[ai][bj][m][1];
                    u32x4 w; w.x = pkh2(y0.x, y0.y); w.y = pkh2(y0.z, y0.w); w.z = pkh2(y1.x, y1.y); w.w = pkh2(y1.z, y1.w);
                    *(u32x4*)(X + (size_t)(row0 + ai * 128 + m * 16) * DM + col0 + bj * 128) = w;
                }
                __builtin_amdgcn_sched_barrier(0);
            }
        }
    }
};
struct EpiPartial {
    static constexpr bool PERM = true, AFTER_DRAIN = false;
    float* T; const float* modg; const float* scale_p;
    DI void operator()(const pg8::f32x4 (&acc)[2][2][4][2], const pg8::Unit& u, int wr, int wc, int fr, int fq) const {
        const float* gp = modg + (size_t)8 * 9216; const float scale = *scale_p;
        const int row0 = u.pm * 256 + wr * 64 + fr - M_LAT, col0 = u.pn * 256 + wc * 32 + 8 * fq;
        f32x4 gs[2][2];
#pragma unroll
        for (int bj = 0; bj < 2; ++bj)
#pragma unroll
            for (int n = 0; n < 2; ++n) { f32x4 g = *(const f32x4*)(gp + col0 + bj * 128 + 4 * n); gs[bj][n] = (g + 1.0f) * scale; }
#pragma unroll
        for (int ai = 0; ai < 2; ++ai)
#pragma unroll
            for (int m = 0; m < 4; ++m) {
                float* tp = T + (size_t)(row0 + ai * 128 + m * 16) * DM + col0;
#pragma unroll
                for (int bj = 0; bj < 2; ++bj)
#pragma unroll
                    for (int n = 0; n < 2; ++n) *(f32x4*)(tp + bj * 128 + 4 * n) = gs[bj][n] * acc[ai][bj][m][n];
                __builtin_amdgcn_sched_barrier(0);
            }
    }
};
struct OneUnit {
    int have; pg8::Unit u;
    DI bool next(int i, pg8::Unit& o) const { if (i == 0 && have) { o = u; return true; } return false; }
    DI void a_ready(const pg8::Unit&) const {}
    DI void done(const pg8::Unit&) const {}
};

struct EpiIn {
    static constexpr bool PERM = true, AFTER_DRAIN = false;
    bf16* P; bf16* Vt; const f32x2* tatt; const f32x2* tret;
    DI void operator()(const pg8::f32x4 (&acc)[2][2][4][2], const pg8::Unit& u, int wr, int wc, int fr, int fq) const {
        const int pn = u.pn;
        const int row0 = u.pm * 256 + wr * 64 + fr;
        if (pn == 4 || pn == 5) {
#pragma unroll
            for (int ai = 0; ai < 2; ++ai)
#pragma unroll
                for (int m = 0; m < 4; ++m) {
                    const int row = row0 + ai * 128 + m * 16;
                    int b, key;
                    if (row < M_LAT) { b = row >> 12; key = row & 4095; } else { const int r2 = row - M_LAT; b = r2 >> 8; key = 4096 + (r2 & 255); }
                    const int kp = (key & ~15) | swap23(key & 15);
#pragma unroll
                    for (int bj = 0; bj < 2; ++bj) {
                        const int h = 2 * (pn - 4) + bj;
                        bf16* vp = Vt + ((size_t)(b * 4 + h) * 128 + wc * 32 + 8 * fq) * NKEY + kp;
#pragma unroll
                        for (int n = 0; n < 2; ++n)
#pragma unroll
                            for (int j = 0; j < 4; ++j) vp[(size_t)(n * 4 + j) * NKEY] = f2bf(acc[ai][bj][m][n][j]);
                    }
                    __builtin_amdgcn_sched_barrier(0);
                }
            return;
        }
        const bool att = pn < 4, ret = (pn == 10 || pn == 11);
        const float sc = (pn < 2) ? QSCALE : (pn == 11 ? 0.125f : 1.0f);
#pragma unroll
        for (int ai = 0; ai < 2; ++ai)
#pragma unroll
            for (int m = 0; m < 4; ++m) {
                const int row = row0 + ai * 128 + m * 16;
                f32x2 cs[4];
                bool rot = false;
                if ((att || ret) && row < M_LAT) {
                    rot = true;
                    const int s = row & 4095;
                    const f32x2* tp;
                    if (att) { const int pos = (wc & 1) ? (s & 63) : (s >> 6); tp = tatt + pos * 16 + 4 * fq; }
                    else { tp = tret + (size_t)s * 32 + 16 * (wc & 1) + 4 * fq; }
                    const f32x4 t0 = *(const f32x4*)tp, t1 = *(const f32x4*)(tp + 2);
                    cs[0] = (f32x2){t0.x, t0.y}; cs[1] = (f32x2){t0.z, t0.w}; cs[2] = (f32x2){t1.x, t1.y}; cs[3] = (f32x2){t1.z, t1.w};
                }
#pragma unroll
                for (int bj = 0; bj < 2; ++bj) {
                    float v[8];
#pragma unroll
                    for (int n = 0; n < 2; ++n)
#pragma unroll
                        for (int j = 0; j < 4; ++j) v[n * 4 + j] = acc[ai][bj][m][n][j];
                    if (rot) {
#pragma unroll
                        for (int q = 0; q < 4; ++q) { const float h1 = v[2 * q], h2 = v[2 * q + 1]; v[2 * q] = h1 * cs[q].x - h2 * cs[q].y; v[2 * q + 1] = h2 * cs[q].x + h1 * cs[q].y; }
                    }
                    u32x4 w; w.x = pk2(v[0] * sc, v[1] * sc); w.y = pk2(v[2] * sc, v[3] * sc); w.z = pk2(v[4] * sc, v[5] * sc); w.w = pk2(v[6] * sc, v[7] * sc);
                    *(u32x4*)(P + (size_t)row * NIN + pn * 256 + bj * 128 + wc * 32 + 8 * fq) = w;
                }
                __builtin_amdgcn_sched_barrier(0);
            }
    }
};

DI void sincos_d(float angf, float& c, float& s) {
    const double a = (double)angf;
    const double k = rint(a * 0.15915494309189535);
    double r = fma(-k, 6.283185307179586, a); r = fma(-k, 2.4492935982947064e-16, r);
    const double r2 = r * r;
    double ts = r, ss = r, tc = 1.0, sc = 1.0;
#pragma unroll 1
    for (int n = 1; n <= 15; ++n) {
        tc = -tc * r2 / (double)((2 * n - 1) * (2 * n)); sc += tc;
        ts = -ts * r2 / (double)((2 * n) * (2 * n + 1)); ss += ts;
    }
    c = (float)sc; s = (float)ss;
}

DI int in_srccol(int j) {
    if (j < 1024) { const int blk = j >> 6, dp = j & 63, half = dp >> 5, i = (dp & 31) >> 1, sec = dp & 1; return blk * 64 + half * 32 + i + 16 * sec; }
    if (j < 2560) return j;
    if (j < 3072) { const int jj = j - 2560, blk = jj >> 6, dp = jj & 63, i = dp >> 1, sec = dp & 1; return 2564 + blk * 64 + i + 32 * sec; }
    return j + 4;
}

DI void transpose_item(const float* W, int ldw, int K, int srccol_lane, bf16* WT, int n0, int k0, LAS float* scr, int lane) {
#pragma unroll 8
    for (int i = 0; i < 32; ++i) { const int kk = 2 * i + (lane >> 5); scr[kk * 33 + (lane & 31)] = W[(size_t)(k0 + kk) * ldw + srccol_lane]; }
    asm volatile("s_waitcnt lgkmcnt(0)" ::: "memory");
    const int c = lane & 7;
#pragma unroll
    for (int j = 0; j < 4; ++j) {
        const int n = (lane >> 3) + 8 * j; const LAS float* s = scr + (8 * c) * 33 + n;
        u32x4 o; o.x = pk2(s[0 * 33], s[1 * 33]); o.y = pk2(s[2 * 33], s[3 * 33]); o.z = pk2(s[4 * 33], s[5 * 33]); o.w = pk2(s[6 * 33], s[7 * 33]);
        *(u32x4*)(WT + (size_t)(n0 + n) * K + k0 + 8 * c) = o;
    }
    asm volatile("s_waitcnt lgkmcnt(0)" ::: "memory");
}

DI void convw_phase(const Args& A, int l, LAS unsigned char* lds, int tid, int bid, int G) {
    const int lane = tid & 63, wave = tid >> 6;
    LAS float* scr = (LAS float*)(lds + 65536 + wave * 8448);
    const int gw = bid * 8 + wave, NGW = G * 8;
    constexpr int I_GU = 2 * 16 * (NGU / 32), I_DN = 2 * (DFF / 64) * (DM / 32), I_IN = 16 * (NIN / 32), I_OUT = 16 * 32;
    bf16* wgu = (bf16*)(A.ws + WS_WGU); bf16* wdn = (bf16*)(A.ws + WS_WDN); bf16* win = (bf16*)(A.ws + WS_WIN); bf16* wout = (bf16*)(A.ws + WS_WOUT);
    for (int it = gw; it < I_GU + I_DN + I_IN + I_OUT; it += NGW) {
        int r = it;
        if (r < I_GU) {
            const int f = r / (16 * (NGU / 32)); r -= f * 16 * (NGU / 32);
            const int kb = r / (NGU / 32), nb = r % (NGU / 32), n0 = nb * 32, pn = n0 >> 8, cc = n0 & 255;
            const float* src = (cc < 128 ? A.in[I_WG] : A.in[I_WU]) + (size_t)(l * 2 + f) * DM * DFF;
            transpose_item(src, DFF, DM, 128 * pn + (cc & 127) + (lane & 31), wgu + (size_t)f * NGU * DM, n0, kb * 64, scr, lane);
            continue;
        }
        r -= I_GU;
        if (r < I_DN) {
            const int f = r / ((DFF / 64) * 32); r -= f * (DFF / 64) * 32;
            const int kb = r / 32, nb = r % 32;
            transpose_item(A.in[I_WD] + (size_t)(l * 2 + f) * DFF * DM, DM, DFF, nb * 32 + (lane & 31), wdn + (size_t)f * DM * DFF, nb * 32, kb * 64, scr, lane);
            continue;
        }
        r -= I_DN;
        if (r < I_IN) {
            const int kb = r / (NIN / 32), nb = r % (NIN / 32);
            transpose_item(A.in[I_WIN] + (size_t)l * DM * INC, INC, DM, in_srccol(nb * 32 + (lane & 31)), win, nb * 32, kb * 64, scr, lane);
            continue;
        }
        r -= I_IN;
        { const int kb = r / 32, nb = r % 32;
          transpose_item(A.in[I_WOUT] + (size_t)l * DM * DM, DM, DM, nb * 32 + (lane & 31), wout, nb * 32, kb * 64, scr, lane); }
    }
}

DI void p0a_phase(const Args& A, LAS unsigned char* lds, int tid, int bid, int G) {
    const int lane = tid & 63, wave = tid >> 6;
    { const int gt = bid * NTHREADS + tid;
      f32x2* tatt = (f32x2*)(A.ws + WS_TATT); f32x2* tret = (f32x2*)(A.ws + WS_TRET);
      if (gt < 1024) { ((float*)(A.ws + WS_ONES))[gt] = 1.0f; ((float*)(A.ws + WS_ZEROS))[gt] = 0.0f; ((float*)(A.ws + WS_HALVES))[gt] = 0.5f; }
      if (gt < 1024) { const int pos = gt >> 4, i = gt & 15; float c, s; sincos_d((float)pos * A.afreq[i], c, s); tatt[gt] = (f32x2){c, s}; }
      for (int e = gt; e < SEQ * 32; e += G * NTHREADS) { const int sidx = e >> 5, i = e & 31; float c, s; sincos_d((float)sidx * A.rfreq[i], c, s); tret[e] = (f32x2){c, s}; }
      if (gt < DEPTH) {
          const float* lv = A.in[I_LAMBDA] + gt * 256; float d0 = 0.f, d1 = 0.f;
          for (int i = 0; i < 64; ++i) { d0 += lv[i] * lv[64 + i]; d1 += lv[128 + i] * lv[192 + i]; }
          const float lam_init = 0.8f - 0.6f * expf(-0.3f * (float)gt);
          ((float*)(A.ws + WS_LAM))[gt] = expf(d0) - expf(d1) + lam_init;
      }
    }
    LAS float* scs = (LAS float*)lds;
    LAS float* red = (LAS float*)(lds + 36864);
    for (int e = tid; e < 9 * 1024; e += NTHREADS) { const int mi = e >> 10, k = e & 1023; const float v = (mi < 8) ? A.in[I_C][mi * 1024 + k] : A.in[I_CCTX][k]; scs[e] = silu_f(v); }
    __syncthreads();
    float* MOD = (float*)(A.ws + WS_MOD);
    for (int it = bid; it < DEPTH * 144; it += G) {
        const int l = it / 144, cg0 = (it % 144) * 64;
        const float* w = A.in[I_ADAW] + (size_t)l * DM * 9216 + cg0 + lane;
        float acc[9];
#pragma unroll
        for (int mi = 0; mi < 9; ++mi) acc[mi] = 0.f;
#pragma unroll 4
        for (int k = wave * 128; k < wave * 128 + 128; ++k) {
            const float wv = w[(size_t)k * 9216];
#pragma unroll
            for (int mi = 0; mi < 9; ++mi) acc[mi] += scs[mi * 1024 + k] * wv;
        }
#pragma unroll
        for (int mi = 0; mi < 9; ++mi) red[(wave * 9 + mi) * 64 + lane] = acc[mi];
        __syncthreads();
        for (int e = tid; e < 576; e += NTHREADS) {
            const int mi = e >> 6, cl = e & 63; float s = A.in[I_ADAB][l * 9216 + cg0 + cl];
#pragma unroll
            for (int w8 = 0; w8 < 8; ++w8) s += red[(w8 * 9 + mi) * 64 + cl];
            MOD[((size_t)l * 9 + mi) * 9216 + cg0 + cl] = s;
        }
        __syncthreads();
    }
    convw_phase(A, 0, lds, tid, bid, G);
}

DI float wave_sum(float v) {
#pragma unroll
    for (int o = 1; o < 64; o <<= 1) v += __shfl_xor(v, o);
    return v;
}
DI void lnmod_phase(const Args& A, LAS unsigned char* lds, int tid, int bid, int G, bool init, int l_norm, int i_norm, int l_mod, int i_mod, bool want_dt, int nrows, bool ctx_partial, const float* gprev, const float* bprev) {
    const int lane = tid & 63, wave = tid >> 6;
    LAS f32x4* wdt = (LAS f32x4*)lds;
    if (want_dt) {
        for (int k = tid; k < 1024; k += NTHREADS) wdt[k] = *(const f32x4*)(A.in[I_WIN] + ((size_t)l_mod * DM + k) * INC + 2560);
        __syncthreads();
    }
    const float* MOD = (const float*)(A.ws + WS_MOD);
    bf16* Abuf = (bf16*)(A.ws + WS_A);
    float* DT = (float*)(A.ws + WS_DT);
    f32x4 g[4], bb[4];
    if (l_norm >= 0) {
#pragma unroll
        for (int j = 0; j < 4; ++j) { g[j] = *(const f32x4*)(A.in[I_NG] + (l_norm * 3 + i_norm) * DM + 256 * j + 4 * lane); bb[j] = *(const f32x4*)(A.in[I_NB] + (l_norm * 3 + i_norm) * DM + 256 * j + 4 * lane); }
    }
    bf16* X16 = (bf16*)(A.ws + WS_X16);
    u32x2 un[4]; f32x4 fn[4];
    { const int row = bid * 8 + wave;
      if (row < nrows) {
          if (init) { const float* xin = row < M_LAT ? A.in[I_X] + (size_t)row * DM : A.in[I_CTX] + (size_t)(row - M_LAT) * DM;
#pragma unroll
              for (int j = 0; j < 4; ++j) fn[j] = *(const f32x4*)(xin + 256 * j + 4 * lane); }
          else {
#pragma unroll
              for (int j = 0; j < 4; ++j) un[j] = *(const u32x2*)(X16 + (size_t)row * DM + 256 * j + 4 * lane); } } }
    for (int row = bid * 8 + wave; row < nrows; row += G * 8) {
        bf16* xout = X16 + (size_t)row * DM;
        f32x4 v[4];
#pragma unroll
        for (int j = 0; j < 4; ++j) v[j] = init ? fn[j] : (f32x4){hlo(un[j].x), hhi(un[j].x), hlo(un[j].y), hhi(un[j].y)};
        { const int rown = row + G * 8;
          if (rown < nrows) {
              if (init) { const float* xin = rown < M_LAT ? A.in[I_X] + (size_t)rown * DM : A.in[I_CTX] + (size_t)(rown - M_LAT) * DM;
#pragma unroll
                  for (int j = 0; j < 4; ++j) fn[j] = *(const f32x4*)(xin + 256 * j + 4 * lane); }
              else {
#pragma unroll
                  for (int j = 0; j < 4; ++j) un[j] = *(const u32x2*)(X16 + (size_t)rown * DM + 256 * j + 4 * lane); } } }
        f32x2* STAT = (f32x2*)(A.ws + WS_STAT);
        if (ctx_partial && row >= M_LAT) {
            { const f32x2 st = STAT[row];
#pragma unroll
              for (int j = 0; j < 4; ++j) v[j] = (v[j] - st.x) * st.y * *(const f32x4*)(gprev + 256 * j + 4 * lane) + *(const f32x4*)(bprev + 256 * j + 4 * lane); }
            const float* t0 = (const float*)(A.ws + WS_T) + (size_t)(row - M_LAT) * DM; const float* t1 = t0 + (size_t)M_CTX * DM; const float* t2 = t1 + (size_t)M_CTX * DM; const float* t3 = t2 + (size_t)M_CTX * DM;
#pragma unroll
            for (int j = 0; j < 4; ++j) { v[j] = v[j] * ALPHA + (*(const f32x4*)(t0 + 256 * j + 4 * lane) + *(const f32x4*)(t1 + 256 * j + 4 * lane)) + (*(const f32x4*)(t2 + 256 * j + 4 * lane) + *(const f32x4*)(t3 + 256 * j + 4 * lane)); u32x2 w_; w_.x = pkh2(v[j].x, v[j].y); w_.y = pkh2(v[j].z, v[j].w); *(u32x2*)(xout + 256 * j + 4 * lane) = w_; }
        }
        if (l_norm >= 0) {
            float s = 0.f;
#pragma unroll
            for (int j = 0; j < 4; ++j) s += (v[j].x + v[j].y) + (v[j].z + v[j].w);
            const float mean = wave_sum(s) * (1.f / DM);
            float s2 = 0.f;
#pragma unroll
            for (int j = 0; j < 4; ++j) { v[j] = v[j] - mean; s2 += (v[j].x * v[j].x + v[j].y * v[j].y) + (v[j].z * v[j].z + v[j].w * v[j].w); }
            const float rstd = 1.0f / sqrtf(wave_sum(s2) * (1.f / DM) + 1e-5f);
            if (l_mod >= 0 && lane == 0) STAT[row] = (f32x2){mean, rstd};
#pragma unroll
            for (int j = 0; j < 4; ++j) v[j] = v[j] * rstd * g[j] + bb[j];
        }
        if (init && lane == 0) STAT[row] = (f32x2){0.f, 1.f};
        if (init) {
#pragma unroll
            for (int j = 0; j < 4; ++j) { u32x2 w_; w_.x = pkh2(v[j].x, v[j].y); w_.y = pkh2(v[j].z, v[j].w); *(u32x2*)(xout + 256 * j + 4 * lane) = w_; }
        }
        if (l_norm >= 0 && l_mod < 0) {
#pragma unroll
            for (int j = 0; j < 4; ++j) *(f32x4*)(A.out + (size_t)row * DM + 256 * j + 4 * lane) = v[j];
        }
        if (l_mod >= 0) {
            const int mi = row < M_LAT ? (row >> 12) : 8;
            const float* mp = MOD + ((size_t)l_mod * 9 + mi) * 9216 + i_mod * 3072;
            float d0 = 0.f, d1 = 0.f, d2 = 0.f, d3 = 0.f;
#pragma unroll
            for (int j = 0; j < 4; ++j) {
                const f32x4 sh = *(const f32x4*)(mp + 256 * j + 4 * lane), scl = *(const f32x4*)(mp + 1024 + 256 * j + 4 * lane);
                const f32x4 a = v[j] * (scl + 1.0f) + sh;
                u32x2 w; w.x = pk2(a.x, a.y); w.y = pk2(a.z, a.w);
                *(u32x2*)(Abuf + (size_t)row * DM + 256 * j + 4 * lane) = w;
                if (want_dt) {
                    const int k0 = 256 * j + 4 * lane;
                    const f32x4 w0 = wdt[k0], w1 = wdt[k0 + 1], w2 = wdt[k0 + 2], w3 = wdt[k0 + 3];
                    d0 += a.x * w0.x + a.y * w1.x + a.z * w2.x + a.w * w3.x;
                    d1 += a.x * w0.y + a.y * w1.y + a.z * w2.y + a.w * w3.y;
                    d2 += a.x * w0.z + a.y * w1.z + a.z * w2.z + a.w * w3.z;
                    d3 += a.x * w0.w + a.y * w1.w + a.z * w2.w + a.w * w3.w;
                }
            }
            if (want_dt) {
                d0 = wave_sum(d0); d1 = wave_sum(d1); d2 = wave_sum(d2); d3 = wave_sum(d3);
                if (lane == 0) *(f32x4*)(DT + (size_t)row * 4) = (f32x4){d0, d1, d2, d3};
            }
        }
    }
}

DI float max3f(float a, float b, float c) { float r; asm("v_max3_f32 %0, %1, %2, %3" : "=v"(r) : "v"(a), "v"(b), "v"(c)); return r; }
DI float max3f_mfma(float a, float b, float c) { float r; asm("s_nop 15\n\ts_nop 7\n\tv_max3_f32 %0, %1, %2, %3" : "=v"(r) : "v"(a), "v"(b), "v"(c)); return r; }
DI void attn_unit(LAS unsigned char* lds, int tid, const bf16* __restrict__ P, const bf16* __restrict__ Vt, bf16* MG, int b, int h, int qrow0, int jt0, int jt1,
                  float lam, float oscale, const float* subg) {
    asm volatile("" : "+v"(tid));
    constexpr int KP = 136, VP = 72, KBYTES = 64 * KP * 2, VBYTES = 128 * VP * 2;
    const int lane = tid & 63, wave = tid >> 6, r32 = lane & 31, hi = lane >> 5;
    const int qb = wave >> 1, m = wave & 1;
    const int qrow = qrow0 + qb * 32 + r32;
    bf16x8 qf[4];
#pragma unroll
    for (int ks = 0; ks < 4; ++ks) qf[ks] = *(const bf16x8*)(P + (size_t)qrow * NIN + h * 128 + m * 64 + ks * 16 + hi * 8);
    f32x16 O[4];
#pragma unroll
    for (int es = 0; es < 4; ++es)
#pragma unroll
        for (int i = 0; i < 16; ++i) O[es][i] = 0.f;
    float mrun = 0.f, lrun = 0.f;
    u32x4 kreg[2], vreg[2];
    const bf16* vbase = Vt + (size_t)(b * 4 + h) * 128 * NKEY;
#define ATT_LOADG(j) do { _Pragma("unroll") for (int i_ = 0; i_ < 2; ++i_) { const int c_ = tid + 512 * i_; const int key_ = c_ >> 4, part_ = c_ & 15; \
        const int row_ = ((j) < 64) ? b * SEQ + (j) * 64 + key_ : M_LAT + b * CTXL + ((j) - 64) * 64 + key_; \
        kreg[i_] = *(const u32x4*)(P + (size_t)row_ * NIN + 512 + h * 128 + part_ * 8); \
        const int e_ = c_ >> 3, vp_ = c_ & 7; vreg[i_] = *(const u32x4*)(vbase + (size_t)e_ * NKEY + (j) * 64 + vp_ * 8); } } while (0)
#define ATT_STORE(buf) do { _Pragma("unroll") for (int i_ = 0; i_ < 2; ++i_) { const int c_ = tid + 512 * i_; const int key_ = c_ >> 4, part_ = c_ & 15, e_ = c_ >> 3, vp_ = c_ & 7; \
        *(LAS u32x4*)(lds + (buf) * KBYTES + (key_ * KP + part_ * 8) * 2) = kreg[i_]; \
        *(LAS u32x4*)(lds + 2 * KBYTES + (buf) * VBYTES + (e_ * VP + vp_ * 8) * 2) = vreg[i_]; } } while (0)
    const bool halfB = wave >= 4;
    bf16x8 pf[4];
#define ATT_QKS(bufk, first_) do { \
        const LAS bf16* Kb = (const LAS bf16*)(lds + (bufk) * KBYTES) + m * 64 + hi * 8; \
        f32x16 s0, s1; \
        { const float ninit = -mrun; _Pragma("unroll") for (int i = 0; i < 16; ++i) { s0[i] = ninit; s1[i] = ninit; } } \
        _Pragma("unroll") for (int ks = 0; ks < 4; ++ks) { \
            const bf16x8 a0 = *(const LAS bf16x8*)(Kb + r32 * KP + ks * 16); \
            const bf16x8 a1 = *(const LAS bf16x8*)(Kb + (32 + r32) * KP + ks * 16); \
            s0 = MFMA32(a0, qf[ks], s0); s1 = MFMA32(a1, qf[ks], s1); } \
        float mx = max3f_mfma(s0[0], s1[0], s0[1]); \
        mx = max3f(mx, s1[1], s0[2]); mx = max3f(mx, s1[2], s0[3]); mx = max3f(mx, s1[3], s0[4]); mx = max3f(mx, s1[4], s0[5]); \
        mx = max3f(mx, s1[5], s0[6]); mx = max3f(mx, s1[6], s0[7]); mx = max3f(mx, s1[7], s0[8]); mx = max3f(mx, s1[8], s0[9]); \
        mx = max3f(mx, s1[9], s0[10]); mx = max3f(mx, s1[10], s0[11]); mx = max3f(mx, s1[11], s0[12]); mx = max3f(mx, s1[12], s0[13]); \
        mx = max3f(mx, s1[13], s0[14]); mx = max3f(mx, s1[14], s0[15]); mx = max3f(mx, s1[15], mx); \
        mx = max3f(mx, __shfl_xor(mx, 32), mx); \
        if ((first_) || __builtin_amdgcn_ballot_w64(mx > 8.0f) != 0ull) { \
            const float d = (first_) ? mx : (mx > 8.0f ? mx : 0.f); \
            mrun += d; \
            if (!(first_)) { const float alpha = ex2(-d); lrun *= alpha; _Pragma("unroll") for (int es = 0; es < 4; ++es) O[es] = O[es] * alpha; } \
            _Pragma("unroll") for (int i = 0; i < 16; ++i) { s0[i] -= d; s1[i] -= d; } } \
        float sum = 0.f; \
        _Pragma("unroll") for (int i = 0; i < 16; ++i) { s0[i] = ex2(s0[i]); s1[i] = ex2(s1[i]); sum += s0[i] + s1[i]; } \
        lrun += sum; \
        _Pragma("unroll") for (int s2 = 0; s2 < 2; ++s2) { u32x4 w0, w1; \
            w0.x = pk2(s0[8 * s2 + 0], s0[8 * s2 + 1]); w0.y = pk2(s0[8 * s2 + 2], s0[8 * s2 + 3]); w0.z = pk2(s0[8 * s2 + 4], s0[8 * s2 + 5]); w0.w = pk2(s0[8 * s2 + 6], s0[8 * s2 + 7]); \
            w1.x = pk2(s1[8 * s2 + 0], s1[8 * s2 + 1]); w1.y = pk2(s1[8 * s2 + 2], s1[8 * s2 + 3]); w1.z = pk2(s1[8 * s2 + 4], s1[8 * s2 + 5]); w1.w = pk2(s1[8 * s2 + 6], s1[8 * s2 + 7]); \
            pf[s2] = __builtin_bit_cast(bf16x8, w0); pf[2 + s2] = __builtin_bit_cast(bf16x8, w1); } } while (0)
#define ATT_PV(bufv) do { \
        const LAS bf16* Vb = (const LAS bf16*)(lds + 2 * KBYTES + (bufv) * VBYTES) + hi * 8; \
        _Pragma("unroll") for (int es = 0; es < 4; ++es) _Pragma("unroll") for (int kk = 0; kk < 4; ++kk) { \
            const bf16x8 a = *(const LAS bf16x8*)(Vb + (es * 32 + r32) * VP + kk * 16); O[es] = MFMA32(a, pf[kk], O[es]); } } while (0)
    __syncthreads();
    ATT_LOADG(jt0);
    for (int j = jt0; j < jt1; ++j) {
        const int buf = (j - jt0) & 1;
        ATT_STORE(buf);
        __syncthreads();
        if (j + 1 < jt1) ATT_LOADG(j + 1);
        if (!halfB) { ATT_QKS(buf, j == jt0); } else if (j > jt0) { ATT_PV(buf ^ 1); }
        __syncthreads();
        if (!halfB) { ATT_PV(buf); } else { ATT_QKS(buf, j == jt0); }
    }
    if (halfB) { ATT_PV((jt1 - 1 - jt0) & 1); }
#undef ATT_QKS
#undef ATT_PV
#undef ATT_LOADG
#undef ATT_STORE
    __syncthreads();
    const float l = lrun + __shfl_xor(lrun, 32);
    const float inv = (m ? lam : 1.0f) / l;
    LAS float* X = (LAS float*)lds + qb * 4096 + lane;
    if (m) {
#pragma unroll
        for (int es = 0; es < 4; ++es)
#pragma unroll
            for (int i = 0; i < 16; ++i) X[(es * 16 + i) * 64] = O[es][i] * inv;
    }
    __syncthreads();
    if (!m) {
        float ss = 0.f;
#pragma unroll
        for (int es = 0; es < 4; ++es)
#pragma unroll
            for (int i = 0; i < 16; ++i) { const float o = O[es][i] * inv - X[(es * 16 + i) * 64]; O[es][i] = o; ss += o * o; }
        ss += __shfl_xor(ss, 32);
        const float rn = (1.0f / sqrtf(ss * (1.0f / 128.0f) + 1e-6f)) * oscale;
#pragma unroll
        for (int es = 0; es < 4; ++es)
#pragma unroll
            for (int g4 = 0; g4 < 4; ++g4) {
                const int e = es * 32 + 8 * g4 + 4 * hi;
                const f32x4 gv = *(const f32x4*)(subg + e);
                u32x2 w; w.x = pk2(O[es][4 * g4 + 0] * rn * gv.x, O[es][4 * g4 + 1] * rn * gv.y); w.y = pk2(O[es][4 * g4 + 2] * rn * gv.z, O[es][4 * g4 + 3] * rn * gv.w);
                *(u32x2*)(MG + (size_t)qrow * DM + h * 128 + e) = w;
            }
    }
}

constexpr int SC_ACF = 0, SC_ACB = 1, SC_DT0 = 2, SC_DT1 = 3;
constexpr int L_STAT = 8192, L_BUF = 16384;
constexpr int TP = 136;
constexpr int QP = 72;
constexpr int UW = 768;

DI int vc_row0(int b, int vc) { return vc < 2 ? M_LAT + b * CTXL + vc * 128 : b * SEQ + (vc - 2) * 128; }
DI float softplus_f(float x) { return fmaxf(x, 0.f) + log1pf(__expf(-fabsf(x))); }

struct ScanCtx { const bf16* P; const bf16* U; const float* DT; bf16* sts; bf16* str; float* dec; bf16* MG; const float* cw; const float* cb; const float* alog; const float* dtb; const float* ssmd; const float* ssmg; const float* rlg; };

DI void conv_phase(const bf16* __restrict__ P, bf16* __restrict__ U, const float* cw, const float* cb, int tid, int bid, int G) {
    const int lane = tid & 63, wave = tid >> 6;
    for (int it = bid * 8 + wave; it < (M_ALL / 16) * 3; it += G * 8) {
        const int run = it / 3, cgp = it % 3, row0 = run * 16, ch = cgp * 256 + 4 * lane;
        int s0, L; if (row0 < M_LAT) { s0 = row0 & (SEQ - 1); L = SEQ; } else { s0 = (row0 - M_LAT) & (CTXL - 1); L = CTXL; }
        f32x4 w[5];
#pragma unroll
        for (int k = 0; k < 5; ++k) w[k] = *(const f32x4*)(cw + k * UW + ch);
        const f32x4 bias = *(const f32x4*)(cb + ch);
        f32x4 x[20];
#pragma unroll
        for (int i = 0; i < 20; ++i) { const int s = s0 - 2 + i; u32x2 v = {0u, 0u}; if (s >= 0 && s < L) v = *(const u32x2*)(P + (size_t)(row0 - 2 + i) * NIN + XBC0 + ch);
            x[i] = (f32x4){bflo(v.x), bfhi(v.x), bflo(v.y), bfhi(v.y)}; }
#pragma unroll
        for (int t = 0; t < 16; ++t) {
            const f32x4 a = bias + w[0] * x[t] + w[1] * x[t + 1] + w[2] * x[t + 2] + w[3] * x[t + 3] + w[4] * x[t + 4];
            u32x2 o; o.x = pk2(silu_f(a.x), silu_f(a.y)); o.y = pk2(silu_f(a.z), silu_f(a.w));
            *(u32x2*)(U + (size_t)(row0 + t) * UW + ch) = o;
        }
    }
}

DI void ssd_scalars(LAS float* sc, int tid, const float* DT, int row0, const float* alog, const float* dtb, float* dec_f, float* dec_b) {
    const int lane = tid & 63, wave = tid >> 6;
    if (wave < 4) {
        const int h = wave;
        const float r0 = DT[(size_t)(row0 + 2 * lane) * 4 + h], r1 = DT[(size_t)(row0 + 2 * lane + 1) * 4 + h];
        const float ea0 = __expf(alog[h]), ea1 = __expf(alog[4 + h]);
        const float d00 = softplus_f(r0 + dtb[h]), d01 = softplus_f(r1 + dtb[h]);
        const float d10 = softplus_f(r0 + dtb[4 + h]), d11 = softplus_f(r1 + dtb[4 + h]);
        const float la00 = -d00 * ea0, la01 = -d01 * ea0, la10 = -d10 * ea1, la11 = -d11 * ea1;
        float pf = la00 + la01, pb = la10 + la11;
#pragma unroll
        for (int o = 1; o < 64; o <<= 1) { const float tf = __shfl_up(pf, o), tb = __shfl_up(pb, o); if (lane >= o) { pf += tf; pb += tb; } }
        const float totb = __shfl(pb, 63), totf = __shfl(pf, 63);
        sc[(SC_ACF * 4 + h) * 128 + 2 * lane + 1] = pf; sc[(SC_ACF * 4 + h) * 128 + 2 * lane] = pf - la01;
        sc[(SC_ACB * 4 + h) * 128 + 2 * lane + 1] = totb - pb + la11; sc[(SC_ACB * 4 + h) * 128 + 2 * lane] = totb - (pb - la11) + la10;
        sc[(SC_DT0 * 4 + h) * 128 + 2 * lane] = d00; sc[(SC_DT0 * 4 + h) * 128 + 2 * lane + 1] = d01;
        sc[(SC_DT1 * 4 + h) * 128 + 2 * lane] = d10; sc[(SC_DT1 * 4 + h) * 128 + 2 * lane + 1] = d11;
        if (dec_f && lane == 0) { dec_f[h] = __expf(totf); dec_b[h] = __expf(totb); }
    }
}

DI f32x16 zero16() { f32x16 z;
#pragma unroll
    for (int i = 0; i < 16; ++i) z[i] = 0.f;
    return z; }
template <int KSTEPS> DI f32x16 mma_lds(f32x16 acc, const LAS bf16* Ap, int pa, const LAS bf16* Bp, int pb, int lane) {
    const int r32 = lane & 31, hi = lane >> 5;
    Ap += r32 * pa + 8 * hi; Bp += r32 * pb + 8 * hi;
#pragma unroll
    for (int ks = 0; ks < KSTEPS; ++ks) { const bf16x8 a = *(const LAS bf16x8*)(Ap + 16 * ks), bq = *(const LAS bf16x8*)(Bp + 16 * ks); acc = MFMA32(a, bq, acc); }
    return acc;
}

template <int C, bool SCALED> DI void stage_T(LAS bf16* d0, LAS bf16* d1, const bf16* __restrict__ src, int spitch, const LAS float* w0, const LAS float* w1, int tid) {
    constexpr int OC = C / 8;
#pragma unroll
    for (int it0 = 0; it0 < 64 * OC; it0 += NTHREADS) {
        const int it = it0 + tid, oct = it % OC, tp = it / OC;
        const u32x4 r0 = *(const u32x4*)(src + (size_t)(2 * tp) * spitch + oct * 8), r1 = *(const u32x4*)(src + (size_t)(2 * tp + 1) * spitch + oct * 8);
        const unsigned a[4] = {r0.x, r0.y, r0.z, r0.w}, bq[4] = {r1.x, r1.y, r1.z, r1.w};
        if (!SCALED) {
#pragma unroll
            for (int k = 0; k < 4; ++k) {
                *(LAS unsigned*)(d0 + (oct * 8 + 2 * k) * TP + 2 * tp) = (a[k] & 0xffffu) | (bq[k] << 16);
                *(LAS unsigned*)(d0 + (oct * 8 + 2 * k + 1) * TP + 2 * tp) = (a[k] >> 16) | (bq[k] & 0xffff0000u);
            }
        } else {
            const float u0 = w0[2 * tp], u1 = w0[2 * tp + 1], v0 = w1[2 * tp], v1 = w1[2 * tp + 1];
#pragma unroll
            for (int k = 0; k < 4; ++k) {
                const float e0 = bflo(a[k]), e1 = bfhi(a[k]), f0 = bflo(bq[k]), f1 = bfhi(bq[k]);
                *(LAS unsigned*)(d0 + (oct * 8 + 2 * k) * TP + 2 * tp) = pk2(e0 * u0, f0 * u1);
                *(LAS unsigned*)(d0 + (oct * 8 + 2 * k + 1) * TP + 2 * tp) = pk2(e1 * u0, f1 * u1);
                *(LAS unsigned*)(d1 + (oct * 8 + 2 * k) * TP + 2 * tp) = pk2(e0 * v0, f0 * v1);
                *(LAS unsigned*)(d1 + (oct * 8 + 2 * k + 1) * TP + 2 * tp) = pk2(e1 * v0, f1 * v1);
            }
        }
    }
}
template <int R, int C> DI void stage_N(LAS bf16* d, int dp, const bf16* __restrict__ src, int spitch, int tid) {
    constexpr int OC = C / 8;
#pragma unroll
    for (int it0 = 0; it0 < R * OC; it0 += NTHREADS) { const int it = it0 + tid, oct = it % OC, r = it / OC; *(LAS u32x4*)(d + r * dp + oct * 8) = *(const u32x4*)(src + (size_t)r * spitch + oct * 8); }
}

DI void s1_ssd_unit(LAS unsigned char* lds, int tid, const ScanCtx& C, int b, int vc) {
    asm volatile("" : "+v"(tid));
    const int lane = tid & 63, wave = tid >> 6, r32 = lane & 31, hi = lane >> 5;
    LAS float* sc = (LAS float*)lds; LAS float* wts = (LAS float*)(lds + L_STAT);
    LAS bf16* BkT = (LAS bf16*)(lds + L_BUF); LAS bf16* XF = (LAS bf16*)(lds + L_BUF + 34816); LAS bf16* XB = (LAS bf16*)(lds + L_BUF + 34816 + 17408);
    const int row0 = vc_row0(b, vc);
    float* decp = C.dec + (size_t)((b * NVC + vc) * 2) * 8;
    __syncthreads();
    ssd_scalars(sc, tid, C.DT, row0, C.alog, C.dtb, decp, decp + 8);
    __syncthreads();
    { const int h = tid >> 7, s = tid & 127;
      wts[h * 128 + s] = __expf(sc[(SC_ACF * 4 + h) * 128 + 127] - sc[(SC_ACF * 4 + h) * 128 + s]) * sc[(SC_DT0 * 4 + h) * 128 + s];
      wts[(4 + h) * 128 + s] = __expf(sc[(SC_ACB * 4 + h) * 128 + 0] - sc[(SC_ACB * 4 + h) * 128 + s]) * sc[(SC_DT1 * 4 + h) * 128 + s]; }
    const bf16* Urow = C.U + (size_t)row0 * UW;
    for (int g = 0; g < 2; ++g) {
        __syncthreads();
        stage_T<128, false>(BkT, BkT, Urow + 256 + g * 128, UW, nullptr, nullptr, tid);
        for (int hh = 0; hh < 2; ++hh) {
            const int h = 2 * g + hh;
            if (hh) __syncthreads();
            stage_T<64, true>(XF, XB, Urow + h * 64, UW, wts + h * 128, wts + (4 + h) * 128, tid);
            __syncthreads();
            const int pt = wave >> 2, nt = wave & 3;
            f32x16 af = zero16(), ab = zero16();
            { const LAS bf16* Bp = BkT + (nt * 32 + r32) * TP + 8 * hi; const LAS bf16* Af = XF + (pt * 32 + r32) * TP + 8 * hi; const LAS bf16* Ab = XB + (pt * 32 + r32) * TP + 8 * hi;
#pragma unroll
              for (int ks = 0; ks < 8; ++ks) { const bf16x8 bq = *(const LAS bf16x8*)(Bp + 16 * ks); af = MFMA32(*(const LAS bf16x8*)(Af + 16 * ks), bq, af); ab = MFMA32(*(const LAS bf16x8*)(Ab + 16 * ks), bq, ab); } }
            bf16* of = C.sts + ((size_t)(((b * NVC + vc) * 2 + 0) * 4 + h)) * 8192; bf16* ob = C.sts + ((size_t)(((b * NVC + vc) * 2 + 1) * 4 + h)) * 8192;
#pragma unroll
            for (int i = 0; i < 16; ++i) { const int p = pt * 32 + 8 * (i >> 2) + 4 * hi + (i & 3), n = nt * 32 + r32; of[p * 128 + n] = f2bf(af[i]); ob[p * 128 + n] = f2bf(ab[i]); }
        }
    }
}
DI void s1_ret_unit(LAS unsigned char* lds, int tid, const ScanCtx& C, int b, int vc, int h0, int nh) {
    asm volatile("" : "+v"(tid));
    const int lane = tid & 63, wave = tid >> 6, r32 = lane & 31, hi = lane >> 5;
    LAS float* wts = (LAS float*)(lds + L_STAT);
    LAS bf16* KT = (LAS bf16*)(lds + L_BUF); LAS bf16* VF = (LAS bf16*)(lds + L_BUF + 17408); LAS bf16* VB = (LAS bf16*)(lds + L_BUF + 2 * 17408);
    const int row0 = vc_row0(b, vc);
    float* decp = C.dec + (size_t)((b * NVC + vc) * 2) * 8;
    __syncthreads();
    { const int h = tid >> 7, s = tid & 127; const float lg0 = C.rlg[h], lg1 = C.rlg[4 + h];
      wts[h * 128 + s] = __expf((float)(127 - s) * lg0); wts[(4 + h) * 128 + s] = __expf((float)s * lg1);
      if (s == 0) { decp[4 + h] = __expf(128.f * lg0); decp[8 + 4 + h] = __expf(128.f * lg1); } }
    const bf16* Prow = C.P + (size_t)row0 * NIN;
#pragma unroll 1
    for (int h = h0; h < h0 + nh; ++h) {
        __syncthreads();
        stage_T<64, false>(KT, KT, Prow + 2816 + h * 64, NIN, nullptr, nullptr, tid);
        stage_T<64, true>(VF, VB, Prow + 3072 + h * 64, NIN, wts + h * 128, wts + (4 + h) * 128, tid);
        __syncthreads();
        const int dir = wave >> 2, pt = (wave >> 1) & 1, nt = wave & 1;
        const f32x16 a = mma_lds<8>(zero16(), (dir ? VB : VF) + pt * 32 * TP, TP, KT + nt * 32 * TP, TP, lane);
        bf16* o = C.str + ((size_t)(((b * NVC + vc) * 2 + dir) * 4 + h)) * 4096;
#pragma unroll
        for (int i = 0; i < 16; ++i) { const int p = pt * 32 + 8 * (i >> 2) + 4 * hi + (i & 3), n = nt * 32 + r32; o[p * 64 + n] = f2bf(a[i]); }
    }
}

DI int s2_order(int dir, int step) { return dir == 0 ? step : (step == 0 ? 1 : (step == 1 ? 0 : 35 - step)); }
DI void s2_item(const ScanCtx& C, int gt) {
    bf16* base; int hh, dir, b; size_t vcstride;
    if (gt < 65536) { const int v = gt & 1023, h = (gt >> 10) & 3; dir = (gt >> 12) & 1; b = gt >> 13; hh = h; base = C.sts + (size_t)((b * NVC * 2 + dir) * 4 + h) * 8192 + v * 8; vcstride = (size_t)2 * 4 * 8192; }
    else if (gt < 65536 + 32768) { const int g2 = gt - 65536; const int v = g2 & 511, h = (g2 >> 9) & 3; dir = (g2 >> 11) & 1; b = g2 >> 12; hh = 4 + h; base = C.str + (size_t)((b * NVC * 2 + dir) * 4 + h) * 4096 + v * 8; vcstride = (size_t)2 * 4 * 4096; }
    else return;
    float s[8]; float zf = 0.f; asm volatile("" : "+v"(zf));
#pragma unroll
    for (int i = 0; i < 8; ++i) s[i] = zf;
#define S2_LD(k, st_) { const int vc_ = s2_order(dir, (st_)); v##k = *(const u32x4*)(base + (size_t)vc_ * vcstride); d##k = C.dec[(size_t)((b * NVC + vc_) * 2 + dir) * 8 + hh]; }
#define S2_ST(k, st_) { const int vc_ = s2_order(dir, (st_)); u32x4 w_; w_.x = pk2(s[0], s[1]); w_.y = pk2(s[2], s[3]); w_.z = pk2(s[4], s[5]); w_.w = pk2(s[6], s[7]); \
        *(u32x4*)(base + (size_t)vc_ * vcstride) = w_; \
        s[0] = s[0] * d##k + bflo(v##k.x); s[1] = s[1] * d##k + bfhi(v##k.x); s[2] = s[2] * d##k + bflo(v##k.y); s[3] = s[3] * d##k + bfhi(v##k.y); \
        s[4] = s[4] * d##k + bflo(v##k.z); s[5] = s[5] * d##k + bfhi(v##k.z); s[6] = s[6] * d##k + bflo(v##k.w); s[7] = s[7] * d##k + bfhi(v##k.w); }
    u32x4 v0, v1, v2, v3, v4, v5, v6, v7; float d0, d1, d2, d3, d4, d5, d6, d7;
    S2_LD(0, 0) S2_LD(1, 1) S2_LD(2, 2) S2_LD(3, 3) S2_LD(4, 4) S2_LD(5, 5) S2_LD(6, 6) S2_LD(7, 7)
#pragma unroll 1
    for (int step = 0; step < 32; step += 8) {
        S2_ST(0, step) if (step + 8 < NVC) S2_LD(0, step + 8)
        S2_ST(1, step + 1) if (step + 9 < NVC) S2_LD(1, step + 9)
        S2_ST(2, step + 2) if (step + 10 < NVC) S2_LD(2, step + 10)
        S2_ST(3, step + 3) if (step + 11 < NVC) S2_LD(3, step + 11)
        S2_ST(4, step + 4) if (step + 12 < NVC) S2_LD(4, step + 12)
        S2_ST(5, step + 5) if (step + 13 < NVC) S2_LD(5, step + 13)
        S2_ST(6, step + 6) if (step + 14 < NVC) S2_LD(6, step + 14)
        S2_ST(7, step + 7) if (step + 15 < NVC) S2_LD(7, step + 15)
    }
    S2_ST(0, 32) S2_ST(1, 33)
#undef S2_LD
#undef S2_ST
}

DI void s2_phase(const ScanCtx& C, int tid, int bid, int G) {
#pragma unroll 1
    for (int gt = bid * NTHREADS + tid; gt < 65536 + 32768; gt += G * NTHREADS) s2_item(C, gt);
}

DI void s3_ssd_unit(LAS unsigned char* lds, int tid, const ScanCtx& C, int b, int vc) {
    asm volatile("" : "+v"(tid));
    const int lane = tid & 63, wave = tid >> 6, r32 = lane & 31, hi = lane >> 5;
    LAS float* sc = (LAS float*)lds; LAS float* stat = (LAS float*)(lds + L_STAT);
    LAS bf16* Cq = (LAS bf16*)(lds + L_BUF); LAS bf16* BkM = (LAS bf16*)(lds + L_BUF + 34816); LAS bf16* XsT = (LAS bf16*)(lds + L_BUF + 2 * 34816);
    LAS bf16* Hf = (LAS bf16*)(lds + L_BUF + 2 * 34816 + 17408); LAS bf16* Hb = (LAS bf16*)(lds + L_BUF + 2 * 34816 + 2 * 17408);
    const int row0 = vc_row0(b, vc);
    const int pt = wave & 1, tt = wave >> 1;
    const bf16* Urow = C.U + (size_t)row0 * UW;
    __syncthreads();
    ssd_scalars(sc, tid, C.DT, row0, C.alog, C.dtb, nullptr, nullptr);
    float ssq = 0.f;
    const int tq_ = tt * 32 + r32; const int rowq = row0 + tq_;
#pragma unroll 1
    for (int g = 0; g < 2; ++g) {
        __syncthreads();
        stage_N<128, 128>(Cq, TP, Urow + 512 + g * 128, UW, tid);
        stage_N<128, 128>(BkM, TP, Urow + 256 + g * 128, UW, tid);
        __syncthreads();
        f32x16 gacc0, gacc1;
        { const int id = 2 * wave, st = id & 3, tq = id >> 2; gacc0 = mma_lds<8>(zero16(), BkM + st * 32 * TP, TP, Cq + tq * 32 * TP, TP, lane); }
        { const int id = 2 * wave + 1, st = id & 3, tq = id >> 2; gacc1 = mma_lds<8>(zero16(), BkM + st * 32 * TP, TP, Cq + tq * 32 * TP, TP, lane); }
#pragma unroll 1
        for (int hh = 0; hh < 2; ++hh) {
            const int h = 2 * g + hh;
            __syncthreads();
            const int oct_ = tid & 7, tp_ = tid >> 3;
            const u32x4 xr0 = *(const u32x4*)(Urow + h * 64 + (size_t)(2 * tp_) * UW + oct_ * 8), xr1 = *(const u32x4*)(Urow + h * 64 + (size_t)(2 * tp_ + 1) * UW + oct_ * 8);
            const bf16* sfp = C.sts + ((size_t)(((b * NVC + vc) * 2 + 0) * 4 + h)) * 8192; const bf16* sbp = C.sts + ((size_t)(((b * NVC + vc) * 2 + 1) * 4 + h)) * 8192;
            u32x4 hfv[2], hbv[2];
#pragma unroll
            for (int i = 0; i < 2; ++i) { const int itn = tid + NTHREADS * i, octn = itn & 15, rn = itn >> 4; hfv[i] = *(const u32x4*)(sfp + rn * 128 + octn * 8); hbv[i] = *(const u32x4*)(sbp + rn * 128 + octn * 8); }
            u32x2 zz[4];
#pragma unroll
            for (int g4 = 0; g4 < 4; ++g4) zz[g4] = *(const u32x2*)(C.P + (size_t)rowq * NIN + 1536 + h * 64 + pt * 32 + 8 * g4 + 4 * hi);
            { const LAS float* acf = sc + (SC_ACF * 4 + h) * 128; const LAS float* acb = sc + (SC_ACB * 4 + h) * 128; const LAS float* d0 = sc + (SC_DT0 * 4 + h) * 128; const LAS float* d1 = sc + (SC_DT1 * 4 + h) * 128;
#pragma unroll
              for (int q = 0; q < 2; ++q) { const int id = 2 * wave + q, st = id & 3, tq = id >> 2; const int t = tq * 32 + r32; const float aft = acf[t], abt = acb[t];
#pragma unroll
                  for (int g4 = 0; g4 < 4; ++g4) { float mv[4];
#pragma unroll
                      for (int j = 0; j < 4; ++j) { const int s = st * 32 + 8 * g4 + 4 * hi + j;
                          float f; if (s < t) f = __expf(aft - acf[s]) * d0[s]; else if (s > t) f = __expf(abt - acb[s]) * d1[s]; else f = d0[s] + d1[s];
                          mv[j] = (q ? gacc1[4 * g4 + j] : gacc0[4 * g4 + j]) * f; }
                      u32x2 w; w.x = pk2(mv[0], mv[1]); w.y = pk2(mv[2], mv[3]);
                      *(LAS u32x2*)(BkM + t * TP + st * 32 + 8 * g4 + 4 * hi) = w; } } }
            { const unsigned a_[4] = {xr0.x, xr0.y, xr0.z, xr0.w}, b_[4] = {xr1.x, xr1.y, xr1.z, xr1.w};
#pragma unroll
              for (int k = 0; k < 4; ++k) {
                  *(LAS unsigned*)(XsT + (oct_ * 8 + 2 * k) * TP + 2 * tp_) = (a_[k] & 0xffffu) | (b_[k] << 16);
                  *(LAS unsigned*)(XsT + (oct_ * 8 + 2 * k + 1) * TP + 2 * tp_) = (a_[k] >> 16) | (b_[k] & 0xffff0000u); }
#pragma unroll
              for (int i = 0; i < 2; ++i) { const int itn = tid + NTHREADS * i, octn = itn & 15, rn = itn >> 4; *(LAS u32x4*)(Hf + rn * TP + octn * 8) = hfv[i]; *(LAS u32x4*)(Hb + rn * TP + octn * 8) = hbv[i]; } }
            __syncthreads();
            f32x16 y = mma_lds<8>(zero16(), XsT + pt * 32 * TP, TP, BkM + tt * 32 * TP, TP, lane);
            { const float dsum = C.ssmd[h] + C.ssmd[4 + h];
#pragma unroll
              for (int i = 0; i < 16; ++i) { const int p = pt * 32 + 8 * (i >> 2) + 4 * hi + (i & 3); y[i] += dsum * bf2f(XsT[p * TP + tq_]); } }
            __builtin_amdgcn_sched_barrier(0);
            { const f32x16 af = mma_lds<8>(zero16(), Hf + pt * 32 * TP, TP, Cq + tt * 32 * TP, TP, lane);
              const float ef = __expf(sc[(SC_ACF * 4 + h) * 128 + tq_]);
#pragma unroll
              for (int i = 0; i < 16; ++i) y[i] += ef * af[i]; }
            __builtin_amdgcn_sched_barrier(0);
            { const f32x16 ab = mma_lds<8>(zero16(), Hb + pt * 32 * TP, TP, Cq + tt * 32 * TP, TP, lane);
              const float eb = __expf(sc[(SC_ACB * 4 + h) * 128 + tq_]);
#pragma unroll
              for (int i = 0; i < 16; ++i) y[i] += eb * ab[i]; }
#pragma unroll
            for (int g4 = 0; g4 < 4; ++g4) {
                const int p = pt * 32 + 8 * g4 + 4 * hi;
                const float v0 = y[4 * g4] * silu_f(bflo(zz[g4].x)), v1 = y[4 * g4 + 1] * silu_f(bfhi(zz[g4].x)), v2 = y[4 * g4 + 2] * silu_f(bflo(zz[g4].y)), v3 = y[4 * g4 + 3] * silu_f(bfhi(zz[g4].y));
                ssq += v0 * v0 + v1 * v1 + v2 * v2 + v3 * v3;
                u32x2 w; w.x = pk2(v0, v1); w.y = pk2(v2, v3);
                *(u32x2*)(C.MG + (size_t)rowq * DM + 512 + h * 64 + p) = w;
            }
        }
    }
    ssq += __shfl_xor(ssq, 32);
    __syncthreads();
    if (hi == 0) stat[tq_ * 2 + pt] = ssq;
    __syncthreads();
    const float rn = 1.0f / sqrtf((stat[tq_ * 2] + stat[tq_ * 2 + 1]) * (1.0f / 256.0f) + 1e-6f);
#pragma unroll
    for (int h = 0; h < 4; ++h)
#pragma unroll
        for (int g4 = 0; g4 < 4; ++g4) {
            const int p = pt * 32 + 8 * g4 + 4 * hi;
            const f32x4 gv = *(const f32x4*)(C.ssmg + h * 64 + p);
            u32x2* mp = (u32x2*)(C.MG + (size_t)rowq * DM + 512 + h * 64 + p);
            const u32x2 v = *mp;
            u32x2 w; w.x = pk2(bflo(v.x) * rn * gv.x, bfhi(v.x) * rn * gv.y); w.y = pk2(bflo(v.y) * rn * gv.z, bfhi(v.y) * rn * gv.w);
            *mp = w;
        }
}
DI void s3_ret_unit(LAS unsigned char* lds, int tid, const ScanCtx& C, int b, int vc, int h0, int nh) {
    asm volatile("" : "+v"(tid));
    const int lane = tid & 63, wave = tid >> 6, r32 = lane & 31, hi = lane >> 5;
    LAS float* stat = (LAS float*)(lds + L_STAT);
    LAS bf16* Q = (LAS bf16*)(lds + L_BUF); LAS bf16* K = (LAS bf16*)(lds + L_BUF + 18432); LAS bf16* VT = (LAS bf16*)(lds + L_BUF + 2 * 18432);
    LAS bf16* Hf = (LAS bf16*)(lds + L_BUF + 2 * 18432 + 17408); LAS bf16* Hb = (LAS bf16*)(lds + L_BUF + 2 * 18432 + 17408 + 9216); LAS bf16* MB = (LAS bf16*)(lds + L_BUF + 2 * 18432 + 17408 + 2 * 9216);
    const int row0 = vc_row0(b, vc);
    const int pt = wave & 1, tt = wave >> 1;
    const bf16* Prow = C.P + (size_t)row0 * NIN;
    const int t = tt * 32 + r32; const int row = row0 + t;
#pragma unroll 1
    for (int h = h0; h < h0 + nh; ++h) {
        const float lg0 = C.rlg[h], lg1 = C.rlg[4 + h];
        __syncthreads();
        stage_N<128, 64>(Q, QP, Prow + 2560 + h * 64, NIN, tid);
        stage_N<128, 64>(K, QP, Prow + 2816 + h * 64, NIN, tid);
        stage_T<64, false>(VT, VT, Prow + 3072 + h * 64, NIN, nullptr, nullptr, tid);
        stage_N<64, 64>(Hf, QP, C.str + ((size_t)(((b * NVC + vc) * 2 + 0) * 4 + h)) * 4096, 64, tid);
        stage_N<64, 64>(Hb, QP, C.str + ((size_t)(((b * NVC + vc) * 2 + 1) * 4 + h)) * 4096, 64, tid);
        __syncthreads();
#pragma unroll
        for (int q = 0; q < 2; ++q) { const int id = 2 * wave + q, st = id & 3, tq = id >> 2;
            const f32x16 gacc = mma_lds<4>(zero16(), K + st * 32 * QP, QP, Q + tq * 32 * QP, QP, lane);
            const int t2 = tq * 32 + r32;
#pragma unroll
            for (int g4 = 0; g4 < 4; ++g4) { float mv[4];
#pragma unroll
                for (int j = 0; j < 4; ++j) { const int s = st * 32 + 8 * g4 + 4 * hi + j;
                    const float f = (s < t2) ? __expf((float)(t2 - s) * lg0) : ((s > t2) ? __expf((float)(s - t2) * lg1) : 2.0f);
                    mv[j] = gacc[4 * g4 + j] * f; }
                u32x2 w; w.x = pk2(mv[0], mv[1]); w.y = pk2(mv[2], mv[3]);
                *(LAS u32x2*)(MB + t2 * TP + st * 32 + 8 * g4 + 4 * hi) = w; } }
        __syncthreads();
        u32x2 ggv[4];
#pragma unroll
        for (int g4 = 0; g4 < 4; ++g4) ggv[g4] = *(const u32x2*)(C.P + (size_t)row * NIN + 3328 + h * 64 + pt * 32 + 8 * g4 + 4 * hi);
        f32x16 y = mma_lds<8>(zero16(), VT + pt * 32 * TP, TP, MB + tt * 32 * TP, TP, lane);
        { const f32x16 af = mma_lds<4>(zero16(), Hf + pt * 32 * QP, QP, Q + tt * 32 * QP, QP, lane);
          const float ef = __expf((float)(t + 1) * lg0);
#pragma unroll
          for (int i = 0; i < 16; ++i) y[i] += ef * af[i]; }
        { const f32x16 ab = mma_lds<4>(zero16(), Hb + pt * 32 * QP, QP, Q + tt * 32 * QP, QP, lane);
          const float eb = __expf((float)(128 - t) * lg1);
#pragma unroll
          for (int i = 0; i < 16; ++i) y[i] += eb * ab[i]; }
        float s1 = 0.f, s2 = 0.f;
#pragma unroll
        for (int i = 0; i < 16; ++i) { s1 += y[i]; s2 += y[i] * y[i]; }
        s1 += __shfl_xor(s1, 32); s2 += __shfl_xor(s2, 32);
        if (hi == 0) { stat[(t * 2 + pt) * 2] = s1; stat[(t * 2 + pt) * 2 + 1] = s2; }
        __syncthreads();
        const float t1 = stat[(t * 2) * 2] + stat[(t * 2 + 1) * 2], t2s = stat[(t * 2) * 2 + 1] + stat[(t * 2 + 1) * 2 + 1];
        const float mean = t1 * (1.0f / 64.0f), var = fmaxf(t2s * (1.0f / 64.0f) - mean * mean, 0.f), rs = 1.0f / sqrtf(var + 1e-5f);
#pragma unroll
        for (int g4 = 0; g4 < 4; ++g4) {
            const int p = pt * 32 + 8 * g4 + 4 * hi;
            const float g0 = silu_f(bflo(ggv[g4].x)), g1 = silu_f(bfhi(ggv[g4].x)), g2 = silu_f(bflo(ggv[g4].y)), g3 = silu_f(bfhi(ggv[g4].y));
            u32x2 w; w.x = pk2((y[4 * g4] - mean) * rs * g0, (y[4 * g4 + 1] - mean) * rs * g1); w.y = pk2((y[4 * g4 + 2] - mean) * rs * g2, (y[4 * g4 + 3] - mean) * rs * g3);
            *(u32x2*)(C.MG + (size_t)row * DM + 768 + h * 64 + p) = w;
        }
    }
}

constexpr int NPP = 13, NPH = 2 + NPP * DEPTH;
#ifndef PMASK
#define PMASK 0xffff
#endif
#define PEN(k) ((PMASK >> (k)) & 1)
#ifndef PROBE_LASTONLY
#define PROBE_LASTONLY 0
#endif
#ifndef PROBE_N
#define PROBE_N 1
#endif
#ifndef REP_SPLIT
#define REP_SPLIT 1
#endif
#ifndef REP_P0
#define REP_P0 1
#endif
#ifndef REP_LN
#define REP_LN 1
#endif
#ifndef REP_SYNC
#define REP_SYNC 1
#endif
#ifndef REP_ATTN
#define REP_ATTN 1
#endif
#ifndef REP_UP
#define REP_UP 1
#endif
#ifndef REP_IN
#define REP_IN 1
#endif
#ifndef REP_SCAN
#define REP_SCAN 1
#endif

#define GAS __attribute__((address_space(1)))
#define XB_TMO      128
#define XB_XCNT(j)  (256  + 64 * (j))
#define XB_XSUB(j)  (1280 + 64 * (j))
#define XB_XGEN(j)  (2304 + 64 * (j))
#define XB_TOP      3328
#define XB_TOPGEN   3392
#define XCD_BAR_WORDS 3456
#define XB_SPIN_CAP (1u << 18)

__device__ __forceinline__ unsigned xb_ld(unsigned* p)              { return __hip_atomic_load(p, __ATOMIC_RELAXED, __HIP_MEMORY_SCOPE_AGENT); }
__device__ __forceinline__ unsigned xb_add(unsigned* p, unsigned v) { return __hip_atomic_fetch_add(p, v, __ATOMIC_RELAXED, __HIP_MEMORY_SCOPE_AGENT); }
__device__ __forceinline__ unsigned xb_xcc_id() { return (unsigned)__builtin_amdgcn_s_getreg((3 << 11) | 20) & 0xFu; }
#define XB_SPIN(cond, bar) do { unsigned _sp = 0; while (cond) { __builtin_amdgcn_s_sleep(1); \
    if ((++_sp & 255u) == 0u) { if (xb_ld(&(bar)[XB_TMO])) break; if (_sp > XB_SPIN_CAP) { atomicAdd(&(bar)[XB_TMO], 1u); break; } } } } while (0)

struct XcdBarrier {
    unsigned* bar; unsigned x;
    volatile LAS unsigned* st;
};

__device__ __forceinline__ XcdBarrier xcd_barrier_post(unsigned* bar, volatile LAS unsigned* st) {
    XcdBarrier b; b.bar = bar; b.x = xb_xcc_id(); b.st = st;
    if (threadIdx.x == 0) (void)xb_add(&bar[XB_XCNT(b.x)], 1u);
    return b;
}
__device__ __forceinline__ void xcd_barrier_complete(unsigned* bar, unsigned x, unsigned& nloc, unsigned& nx) {
    const unsigned G = gridDim.x * gridDim.y * gridDim.z;
    unsigned sum, cnt, mine, sp = 0u;
    for (;;) {
        sum = 0u; cnt = 0u; mine = 0u;
#pragma unroll
        for (unsigned j = 0; j < 16; ++j) { const unsigned c = xb_ld(&bar[XB_XCNT(j)]); sum += c; cnt += (c > 0u) ? 1u : 0u; mine = (j == x) ? c : mine; }
        if (sum == G) break;
        __builtin_amdgcn_s_sleep(1);
        if ((++sp & 255u) == 0u) { if (xb_ld(&bar[XB_TMO])) break; if (sp > XB_SPIN_CAP) { atomicAdd(&bar[XB_TMO], 1u); break; } }
    }
    nloc = mine > 0u ? mine : 1u; nx = cnt > 0u ? cnt : 1u;
}

__device__ __forceinline__ void xcd_barrier(const XcdBarrier& b) {
    asm volatile("s_waitcnt vmcnt(0)" ::: "memory");
    __syncthreads();
    if (threadIdx.x == 0) {
        unsigned* bar = b.bar;
        __builtin_amdgcn_s_waitcnt(0);
        unsigned nloc = b.st[0], nx = b.st[1];
        if (nloc == 0u) { xcd_barrier_complete(bar, b.x, nloc, nx); b.st[0] = nloc; b.st[1] = nx; }
        const unsigned old = xb_add(&bar[XB_XSUB(b.x)], 1u);
        const unsigned gen = old / nloc;
        if (old + 1u == (gen + 1u) * nloc) {
            __builtin_amdgcn_fence(__ATOMIC_RELEASE, "agent");
            asm volatile("s_waitcnt vmcnt(0)" ::: "memory");
            const unsigned og = xb_add(&bar[XB_TOP], 1u);
            const unsigned tg = og / nx;
            if (og + 1u == (tg + 1u) * nx) xb_add(&bar[XB_TOPGEN], 1u);
            else XB_SPIN(xb_ld(&bar[XB_TOPGEN]) == tg, bar);
            __builtin_amdgcn_fence(__ATOMIC_ACQUIRE, "agent");
            xb_add(&bar[XB_XGEN(b.x)], 1u);
            asm volatile("s_waitcnt vmcnt(0)" ::: "memory");
        } else {
            XB_SPIN(xb_ld(&bar[XB_XGEN(b.x)]) == gen, bar);
            __builtin_amdgcn_fence(__ATOMIC_ACQUIRE, "agent");
            asm volatile("s_waitcnt vmcnt(0)" ::: "memory");
        }
    }
    __syncthreads();
}
template <class Epi> DI void run_gemm(LAS unsigned char* lds, int tid, const bf16* Ap, const bf16* Bt, int M, int N, int K, int G, int bid, const Epi& E, int ld = 0) {
    pg8::Gemm g{Ap, Bt, M, N, K, ld ? ld : K}; pg8::StaticOrder S; S.init(M, N, G, bid);
    pg8::gemm_phase<Epi, pg8::StaticOrder, true, true>(lds, g, S, E, tid);
}

__global__ void __launch_bounds__(NTHREADS, 2) mega(Args A) {
    extern __shared__ __attribute__((aligned(16))) unsigned char lds_raw[];
    LAS unsigned char* lds = (LAS unsigned char*)lds_raw;
    cg::grid_group grid = cg::this_grid();
    const int tid0 = threadIdx.x, bid0 = blockIdx.x, G0 = gridDim.x;
    { volatile LAS unsigned* bst0 = (volatile LAS unsigned*)(lds + LDS_BYTES - 64); if (tid0 < 16) bst0[tid0] = 0u;
      if (bid0 == 0) { unsigned* bw = (unsigned*)(A.ws + WS_BAR); for (int i = tid0; i < XCD_BAR_WORDS; i += NTHREADS) bw[i] = 0u; } }
    __syncthreads();
    int rep_done = 0; (void)rep_done;
    for (int ph = A.ph_lo; ph < A.ph_hi; ++ph) {
        if (ph > A.ph_lo) {
            if (ph == A.ph_lo + 1) { grid.sync(); (void)xcd_barrier_post((unsigned*)(A.ws + WS_BAR), (volatile LAS unsigned*)(lds + LDS_BYTES - 64)); }
            else { for (int rs_ = 0; rs_ < REP_SYNC; ++rs_) { XcdBarrier xb_; xb_.bar = (unsigned*)(A.ws + WS_BAR); xb_.x = xb_xcc_id(); xb_.st = (volatile LAS unsigned*)(lds + LDS_BYTES - 64); xcd_barrier(xb_); } }
        }
        int tid = tid0, bid = bid0, G = G0; size_t zoff = 0;
        asm volatile("" : "+v"(tid)); asm volatile("" : "+s"(bid)); asm volatile("" : "+s"(G)); asm volatile("" : "+s"(zoff));
        unsigned char* ws = A.ws + zoff;
        float* xc = (float*)(ws + WS_XC);
        bf16* Abuf = (bf16*)(ws + WS_A); bf16* HP = (bf16*)(ws + WS_HP); bf16* Vt = (bf16*)(ws + WS_VT);
        const float* MOD = (const float*)(ws + WS_MOD);
        if (ph == 0) { if (PEN(0)) for (int rp_ = 0; rp_ < REP_P0; ++rp_) { p0a_phase(A, lds, tid, bid, G); __syncthreads(); } continue; }
        if (ph == 1) { if (PEN(1)) for (int rp_ = 0; rp_ < REP_LN; ++rp_) lnmod_phase(A, lds, tid, bid, G, true, -1, 0, 0, 0, false, M_ALL, false, nullptr, nullptr); continue; }
        const int q = ph - 2, l = q / NPP; int s = q % NPP; const bool is_conv = (s == 4); if (s >= 4) s -= 1; if (is_conv) s = 100;
        const bool last = (l == DEPTH - 1);
        const int Mpost = last ? M_LAT : M_ALL;
        if ((s == 0 || s == 9) && PEN(2)) {
            const int f = (s == 9); EpiSwiglu E{HP};
            for (int rp_ = 0; rp_ < REP_UP; ++rp_) run_gemm(lds, tid, Abuf, (const bf16*)(ws + WS_WGU) + (size_t)f * NGU * DM, f ? Mpost : M_ALL, NGU, DM, G, bid, E);
        } else if ((s == 1 || s == 10 || s == 7) && PEN(3)) {
            const int i = (s == 1) ? 0 : (s == 7 ? 1 : 2);
            const int prev_idx = (i == 0) ? (l == 0 ? -1 : (l - 1) * 3 + 2) : l * 3 + (i - 1);
            const float* modg_p = MOD + (size_t)l * 9 * 9216 + i * 3072 + 2048;
            const float* scale_v = (s == 7) ? (const float*)(ws + WS_ONES) : (const float*)(ws + WS_HALVES);
            const float* gprev_p = prev_idx < 0 ? (const float*)(ws + WS_ONES) : A.in[I_NG] + prev_idx * DM; const float* bprev_p = prev_idx < 0 ? (const float*)(ws + WS_ZEROS) : A.in[I_NB] + prev_idx * DM;
            EpiResid E{(bf16*)(ws + WS_X16), modg_p, scale_v, (const f32x2*)(ws + WS_STAT), gprev_p, bprev_p};
            const bool has_ctx = (s == 1) || !last;
            const bf16* Ap = (s == 7) ? Abuf : HP; const bf16* Bp = (s == 7) ? (const bf16*)(ws + WS_WOUT) : (const bf16*)(ws + WS_WDN) + (size_t)(s == 10) * DM * DFF;
            const int Kd = (s == 7) ? DM : DFF;
            const int ldd = (s == 7) ? DM : DFF;
            run_gemm(lds, tid, Ap, Bp, M_LAT, DM, Kd, G, bid, E, ldd);
            if (has_ctx) {
                const int sb = (G == 256 && ((bid >> 3) & 7) < 4 && bid < 256) ? ((bid & 7) | (((bid >> 3) & 3) << 3) | ((bid >> 6) << 5)) : (G == 256 ? 999 : (bid + G - 64) % G);
                const int qd = (sb >> 5) & 3;
                const int kt0 = (s == 7) ? 4 * qd : (qd < 2 ? 12 * qd : 24 + 10 * (qd - 2));
                const int ktn = (s == 7) ? 4 : (qd < 2 ? 12 : 10);
                OneUnit S1u; S1u.have = sb < 128; S1u.u.pm = 128 + (sb & 7); S1u.u.pn = (sb >> 3) & 3;
                EpiPartial Ep{(float*)(ws + WS_T) + (size_t)qd * M_CTX * DM, modg_p, scale_v};
                pg8::Gemm g2{Ap + (size_t)kt0 * 64, Bp + (size_t)kt0 * 64, M_ALL, DM, ktn * 64, ldd};
                pg8::gemm_phase<EpiPartial, OneUnit, true, true>(lds, g2, S1u, Ep, tid);
            }
        } else if (s == 2 && PEN(1)) {
            lnmod_phase(A, lds, tid, bid, G, false, l, 0, l, 1, true, M_ALL, true, l == 0 ? (const float*)(ws + WS_ONES) : A.in[I_NG] + ((l - 1) * 3 + 2) * DM, l == 0 ? (const float*)(ws + WS_ZEROS) : A.in[I_NB] + ((l - 1) * 3 + 2) * DM);
        } else if (s == 3 && PEN(4)) {
            EpiIn E{HP, Vt, (const f32x2*)(ws + WS_TATT), (const f32x2*)(ws + WS_TRET)};
            for (int rp_ = 0; rp_ < REP_IN; ++rp_) run_gemm(lds, tid, Abuf, (const bf16*)(ws + WS_WIN), M_ALL, NIN, DM, G, bid, E);
        } else if (is_conv || s == 4 || s == 5 || s == 6) {
            ScanCtx C{HP, (const bf16*)(ws + WS_U), (const float*)(ws + WS_DT), (bf16*)(ws + WS_STS), (bf16*)(ws + WS_STR), (float*)(ws + WS_DEC), Abuf,
                      A.in[I_CONVW] + (size_t)l * 5 * 768, A.in[I_CONVB] + l * 768, A.in[I_ALOG] + l * 8, A.in[I_DTB] + l * 8, A.in[I_SSMD] + l * 8, A.in[I_SSMG] + l * 256, A.in[I_RLG] + l * 8};
            const float lam = ((const float*)(ws + WS_LAM))[l];
            const float lam_init = 0.8f - 0.6f * expf(-0.3f * (float)l);
            const float* subg = A.in[I_SUBG] + l * 128;
            const int r = is_conv ? 0 : s - 3;
            if (PEN(7)) for (int rp_ = 0; rp_ < REP_ATTN; ++rp_) for (int u = bid; u < 256; u += G) { const int bh = r * 8 + (u & 7), qb = u >> 3;
                attn_unit(lds, tid, HP, Vt, Abuf, bh >> 2, bh & 3, (bh >> 2) * SEQ + qb * 128, 0, 68, lam, 1.0f - lam_init, subg); }
            if (is_conv) {
                if (PEN(10)) conv_phase(HP, (bf16*)(ws + WS_U), C.cw, C.cb, tid, bid, G);
            } else if (s == 4) {
                { const int nS1 = NB * NVC, extra1 = (nS1 > G && nS1 < 2 * G) ? nS1 - G : 0;
                  if (PEN(5)) { for (int u = bid; u < nS1; u += G) s1_ssd_unit(lds, tid, C, u / NVC, u % NVC);
                      if (bid >= extra1) for (int r = bid - extra1; r < 4 * nS1; r += G - extra1) { const int v = r >> 2; s1_ret_unit(lds, tid, C, v / NVC, v % NVC, r & 3, 1); } } }
            } else if (s == 5) {
                if (PEN(6)) s2_phase(C, tid, bid, G);
            } else {
                const int vc0 = last ? 2 : 0, nvc = NVC - vc0;
                const int nS = NB * nvc, extra = (nS > G && nS < 2 * G) ? nS - G : 0;
                if (PEN(8)) for (int u = bid; u < nS; u += G) s3_ssd_unit(lds, tid, C, u / nvc, vc0 + u % nvc);
                if (PEN(9) && bid >= extra) for (int r = bid - extra; r < 4 * nS; r += G - extra) { const int v = r >> 2; s3_ret_unit(lds, tid, C, v / nvc, vc0 + v % nvc, r & 3, 1); }
                if (!last && PEN(7)) for (int u = (bid + G - 64) % G; u < 64; u += G) { const int bh = u >> 1; attn_unit(lds, tid, HP, Vt, Abuf, bh >> 2, bh & 3, M_LAT + (bh >> 2) * CTXL + (u & 1) * 128, 64, 68, lam, 1.0f - lam_init, subg); }
            }
        } else if (s == 8 && PEN(1)) {
            lnmod_phase(A, lds, tid, bid, G, false, l, 1, l, 2, false, Mpost, !last, A.in[I_NG] + (l * 3) * DM, A.in[I_NB] + (l * 3) * DM);
        } else if (s == 11 && PEN(1)) {
            lnmod_phase(A, lds, tid, bid, G, false, l, 2, last ? -1 : l + 1, 0, false, Mpost, !last, A.in[I_NG] + (l * 3 + 1) * DM, A.in[I_NB] + (l * 3 + 1) * DM);
            if (!last) convw_phase(A, l + 1, lds, tid, bid, G);
        }
#ifdef PROBE_S
        if ((s == (PROBE_S) || s == (PROBE_S2)) && (PROBE_LASTONLY == 0 || last) && rep_done < PROBE_N) { ++rep_done; --ph; } else rep_done = 0;
#endif
    }
}

extern "C" void kernel_launch(void* const* d_in, const int* in_sizes, int n_in, void* d_out, int out_size, void* d_ws, size_t ws_size, hipStream_t stream) {
    static int grid = 0;
    if (grid == 0) {
        if (n_in != 22 || in_sizes[0] != M_LAT * DM || out_size != M_LAT * DM || ws_size < WS_END) { fprintf(stderr, "kernel_launch: unexpected shapes (n_in %d, out %d, ws %zu)\n", n_in, out_size, ws_size); grid = -1; return; }
        int dev = 0, cus = 0, per_cu = 0;
        hipGetDevice(&dev); hipDeviceGetAttribute(&cus, hipDeviceAttributeMultiprocessorCount, dev);
        if (hipFuncSetAttribute((const void*)mega, hipFuncAttributeMaxDynamicSharedMemorySize, LDS_BYTES) != hipSuccess) { fprintf(stderr, "kernel_launch: hipFuncSetAttribute failed\n"); grid = -1; return; }
        if (hipOccupancyMaxActiveBlocksPerMultiprocessor(&per_cu, (const void*)mega, NTHREADS, LDS_BYTES) != hipSuccess || per_cu < 1) { fprintf(stderr, "kernel_launch: occupancy query says %d\n", per_cu); per_cu = 1; }
        (void)hipGetLastError();
        grid = cus * 1;
    }
    if (grid < 0) return;
    Args a{};
    for (int i = 0; i < 22; ++i) a.in[i] = (const float*)d_in[i];
    a.out = (float*)d_out; a.ws = (unsigned char*)d_ws;
    for (int i = 0; i < 16; ++i) a.afreq[i] = 1.0f / powf(10000.0f, (float)(2 * i) / 32.0f);
    for (int i = 0; i < 32; ++i) a.rfreq[i] = 1.0f / powf(10000.0f, (float)i / 31.0f);
#ifdef MK_MULTI
    for (int ph = 0; ph < NPH; ++ph) { a.ph_lo = ph; a.ph_hi = ph + 1; hipLaunchKernelGGL(mega, dim3(grid), dim3(NTHREADS), LDS_BYTES, stream, a); }
#else
    a.ph_lo = 0; a.ph_hi = NPH;
    void* args[] = {&a};
    hipError_t e = hipLaunchCooperativeKernel((const void*)mega, dim3(grid), dim3(NTHREADS), args, LDS_BYTES, stream);
    if (e != hipSuccess) fprintf(stderr, "cooperative launch failed: %s (grid %d)\n", hipGetErrorString(e), grid);
#endif
}
```

```cpp
#include <hip/hip_runtime.h>
#include <hip/hip_cooperative_groups.h>
#include <cstdio>
#include <cstdint>
#include <cmath>
namespace cg = cooperative_groups;

namespace pg8 {
#define PG8_LAS __attribute__((address_space(3)))
typedef unsigned short bf16_t;
typedef short bf16x8 __attribute__((ext_vector_type(8)));
typedef float f32x4 __attribute__((ext_vector_type(4)));
typedef unsigned u32x4 __attribute__((ext_vector_type(4)));
constexpr int BM = 256, BK = 64, HALF = 128, HTB = HALF * BK * 2  , STAGE_BYTES = 8 * HTB, NXCD = 8, WGM = 8;

__host__ __device__ __forceinline__ int lds_byte(int r, int c) { const int st = (r >> 4) * 2 + (c >> 5), rr = r & 15, cc = c & 31, ob = rr * 64 + cc * 2; return st * 1024 + (ob ^ (((ob >> 9) & 1) << 5)); }
__host__ __device__ __forceinline__ void stage_rc(int b, int& R, int& C) { const int st = b / 1024, sb = b % 1024, swz = sb ^ (((sb >> 9) & 1) << 5); R = (st >> 1) * 16 + swz / 64; C = (st & 1) * 32 + (swz % 64) / 2; }
__host__ __device__ __forceinline__ int perm32(int rho) { const int n = rho >> 4, i = rho & 15; return 8 * (i >> 2) + 4 * n + (i & 3); }

struct Unit { int pm, pn; };
struct Gemm { const bf16_t* A; const bf16_t* Bt; int M, N, K, ld; };

struct StaticOrder {
    int nM, nN, nwg, G, c;
    __host__ __device__ void init(int M, int N, int G_, int c_) { nM = M / BM; nN = N / BM; nwg = nM * nN; G = G_; c = c_; }
    __host__ __device__ bool next(int i, Unit& u) const {
        const long L = (long)i * G + c; if (L >= nwg) return false;
        int wgid = (int)L; { const int q = nwg / NXCD, r = nwg % NXCD, xcd = wgid % NXCD, off = wgid / NXCD; wgid = (xcd < r ? xcd * (q + 1) : r * (q + 1) + (xcd - r) * q) + off; }
        const int nig = WGM * nN, gid = wgid / nig, fm = gid * WGM, gsz = (nM - fm) < WGM ? (nM - fm) : WGM;
        u.pm = fm + ((wgid % nig) % gsz); u.pn = (wgid % nig) / gsz; return true;
    }
    __device__ __forceinline__ void a_ready(const Unit&) const {}
    __device__ __forceinline__ void done(const Unit&) const {}
};

__device__ __forceinline__ unsigned cvt_pk_bf16(float lo, float hi) { unsigned r; asm volatile("v_cvt_pk_bf16_f32 %0, %1, %2" : "=v"(r) : "v"(lo), "v"(hi)); return r; }
template <class Epi, class Sched, bool ALIGN_EPI = false, bool SP2 = false>
__device__ __forceinline__ void gemm_phase(PG8_LAS unsigned char* lds, const Gemm g, const Sched& S, const Epi& E, const int tid) {
    const int wid = __builtin_amdgcn_readfirstlane(tid >> 6), lane = tid & 63, wr = wid >> 2, wc = wid & 3, fr = lane & 15, fq = lane >> 4;
    const int K = g.K, nt = K / BK;
    unsigned voffA[2], voffB[2];
#pragma unroll
    for (int i = 0; i < 2; ++i) { int R, C; stage_rc(tid * 16 + i * 8192, R, C); const int Rb = Epi::PERM ? ((R & ~31) + perm32(R & 31)) : R;
        voffA[i] = (unsigned)(R * g.ld + C) * 2u; voffB[i] = (unsigned)(Rb * g.ld + C) * 2u; }
    const size_t kstep = (size_t)(BK * 2);
    const size_t hstep = (size_t)HALF * g.ld * 2;
    const size_t tstep = 2 * hstep;
    const unsigned ldsw = (unsigned)wid * 1024u;
    const int aoff = lds_byte(wr * 64 + fr, fq * 8), boff = lds_byte(wc * 32 + fr, fq * 8);
#define PG8_SA(b, h) (((b) * 2 + (h)) * HTB)
#define PG8_SB(b, h) ((4 + (b) * 2 + (h)) * HTB)
#define PG8_STAGE(bufoff, gbase, voff) do { _Pragma("unroll") for (int _i = 0; _i < 2; ++_i) \
        __builtin_amdgcn_global_load_lds((const unsigned*)((const char*)(gbase) + (voff)[_i]), (PG8_LAS unsigned*)(lds + (bufoff) + ldsw + _i * 8192), 16, 0, 0); } while (0)
#define PG8_LDA(dst, b, h) do { _Pragma("unroll") for (int m = 0; m < 4; ++m) _Pragma("unroll") for (int k = 0; k < 2; ++k) dst[m][k] = *(const PG8_LAS bf16x8*)(lds + PG8_SA(b, h) + aoff + m * 2048 + k * 1024); } while (0)
#define PG8_LDB(dst, b, h) do { _Pragma("unroll") for (int n = 0; n < 2; ++n) _Pragma("unroll") for (int k = 0; k < 2; ++k) dst[n][k] = *(const PG8_LAS bf16x8*)(lds + PG8_SB(b, h) + boff + n * 2048 + k * 1024); } while (0)
#define PG8_MMA(ai, bj, At, Bt) do { __builtin_amdgcn_s_setprio(1); _Pragma("unroll") for (int m = 0; m < 4; ++m) _Pragma("unroll") for (int n = 0; n < 2; ++n) _Pragma("unroll") for (int k = 0; k < 2; ++k) \
        acc[ai][bj][m][n] = __builtin_amdgcn_mfma_f32_16x16x32_bf16(Bt[n][k], At[m][k], acc[ai][bj][m][n], 0, 0, 0); __builtin_amdgcn_s_setprio(0); } while (0)
#define PG8_WAIT_V(n) asm volatile("s_waitcnt vmcnt(" #n ")" ::: "memory")
#define PG8_WAIT_L(n) asm volatile("s_waitcnt lgkmcnt(" #n ")" ::: "memory")
#define PG8_BAR __builtin_amdgcn_s_barrier()
#define PG8_SCHED __builtin_amdgcn_sched_barrier(0)
    Unit cur, nxt; int ui = 0;
    if (!S.next(0, cur)) return;
    f32x4 acc[2][2][4][2];
#pragma unroll
    for (int a = 0; a < 2; ++a)
#pragma unroll
        for (int b = 0; b < 2; ++b)
#pragma unroll
            for (int m = 0; m < 4; ++m)
#pragma unroll
                for (int n = 0; n < 2; ++n) acc[a][b][m][n] = (f32x4){0.f, 0.f, 0.f, 0.f};
    bf16x8 At[4][2], B0[2][2], B1[2][2];
    const char* cA = (const char*)g.A + (size_t)cur.pm * tstep; const char* cB = (const char*)g.Bt + (size_t)cur.pn * tstep;
    S.a_ready(cur);
    if constexpr (SP2) {
        PG8_STAGE(PG8_SB(0, 0), cB, voffB); PG8_STAGE(PG8_SB(0, 1), cB + hstep, voffB); PG8_STAGE(PG8_SA(0, 0), cA, voffA); PG8_STAGE(PG8_SA(0, 1), cA + hstep, voffA);
        if (wr == 1) PG8_BAR;
        PG8_WAIT_V(2); PG8_BAR;
        PG8_STAGE(PG8_SB(1, 0), cB + kstep, voffB); PG8_STAGE(PG8_SA(1, 0), cA + kstep, voffA); PG8_STAGE(PG8_SB(1, 1), cB + hstep + kstep, voffB);
        PG8_WAIT_V(6); PG8_BAR;
    } else {
        PG8_STAGE(PG8_SB(0, 0), cB, voffB); PG8_STAGE(PG8_SA(0, 0), cA, voffA); PG8_STAGE(PG8_SB(0, 1), cB + hstep, voffB); PG8_STAGE(PG8_SA(0, 1), cA + hstep, voffA);
        if (wr == 1) PG8_BAR;
        PG8_WAIT_V(4); PG8_BAR;
        PG8_STAGE(PG8_SB(1, 0), cB + kstep, voffB); PG8_STAGE(PG8_SA(1, 0), cA + kstep, voffA); PG8_STAGE(PG8_SB(1, 1), cB + hstep + kstep, voffB);
        PG8_WAIT_V(6); PG8_BAR;
    }
    for (;;) {
        const bool has_next = S.next(ui + 1, nxt);
        const char* nA = has_next ? (const char*)g.A + (size_t)nxt.pm * tstep : cA; const char* nB = has_next ? (const char*)g.Bt + (size_t)nxt.pn * tstep : cB;
        for (int t = 0; t < nt; t += 2) {
            const bool last = (t == nt - 2);
            const char* a1 = cA + (size_t)(t + 1) * kstep;
            const char* a2 = last ? nA : cA + (size_t)(t + 2) * kstep; const char* b2 = last ? nB : cB + (size_t)(t + 2) * kstep;
            const char* a3 = a2 + kstep; const char* b3 = b2 + kstep;
            if (last && has_next) S.a_ready(nxt);
            if constexpr (SP2) {
            PG8_LDB(B0, 0, 0); PG8_LDB(B1, 0, 1); PG8_SCHED; PG8_LDA(At, 0, 0); PG8_STAGE(PG8_SA(1, 1), a1 + hstep, voffA);
            PG8_WAIT_V(8); PG8_WAIT_L(0); PG8_BAR; PG8_MMA(0, 0, At, B0); PG8_MMA(0, 1, At, B1); PG8_BAR; PG8_SCHED;
            PG8_LDA(At, 0, 1); PG8_STAGE(PG8_SB(0, 0), b2, voffB); PG8_STAGE(PG8_SB(0, 1), b2 + hstep, voffB); PG8_STAGE(PG8_SA(0, 0), a2, voffA);
            PG8_WAIT_V(8); PG8_WAIT_L(0); PG8_BAR; PG8_MMA(1, 0, At, B0); PG8_MMA(1, 1, At, B1); PG8_BAR; PG8_SCHED;
            PG8_LDB(B0, 1, 0); PG8_LDB(B1, 1, 1); PG8_SCHED; PG8_LDA(At, 1, 0); PG8_STAGE(PG8_SA(0, 1), a2 + hstep, voffA);
            PG8_WAIT_V(8); PG8_WAIT_L(0); PG8_BAR; PG8_MMA(0, 0, At, B0); PG8_MMA(0, 1, At, B1); PG8_BAR; PG8_SCHED;
            PG8_LDA(At, 1, 1); PG8_STAGE(PG8_SB(1, 0), b3, voffB); PG8_STAGE(PG8_SB(1, 1), b3 + hstep, voffB); PG8_STAGE(PG8_SA(1, 0), a3, voffA);
            PG8_WAIT_V(8); PG8_WAIT_L(0); PG8_BAR; PG8_MMA(1, 0, At, B0); PG8_MMA(1, 1, At, B1); PG8_BAR; PG8_SCHED;
            } else {
            PG8_LDB(B0, 0, 0); PG8_SCHED; PG8_LDA(At, 0, 0); PG8_STAGE(PG8_SA(1, 1), a1 + hstep, voffA);
            PG8_WAIT_L(8); PG8_BAR; PG8_WAIT_L(0); PG8_MMA(0, 0, At, B0); PG8_BAR; PG8_SCHED;
            PG8_LDB(B1, 0, 1); PG8_STAGE(PG8_SB(0, 0), b2, voffB);
            PG8_BAR; PG8_WAIT_L(0); PG8_MMA(0, 1, At, B1); PG8_BAR;
            PG8_LDA(At, 0, 1); PG8_STAGE(PG8_SA(0, 0), a2, voffA);
            PG8_BAR; PG8_WAIT_L(0); PG8_MMA(1, 0, At, B0); PG8_BAR; PG8_SCHED;
            PG8_STAGE(PG8_SB(0, 1), b2 + hstep, voffB);
            PG8_WAIT_V(6); PG8_BAR; PG8_MMA(1, 1, At, B1); PG8_BAR;
            PG8_LDB(B0, 1, 0); PG8_SCHED; PG8_LDA(At, 1, 0); PG8_STAGE(PG8_SA(0, 1), a2 + hstep, voffA);
            PG8_WAIT_L(8); PG8_BAR; PG8_WAIT_L(0); PG8_MMA(0, 0, At, B0); PG8_BAR; PG8_SCHED;
            PG8_LDB(B1, 1, 1); PG8_STAGE(PG8_SB(1, 0), b3, voffB);
            PG8_BAR; PG8_WAIT_L(0); PG8_MMA(0, 1, At, B1); PG8_BAR;
            PG8_LDA(At, 1, 1); PG8_STAGE(PG8_SA(1, 0), a3, voffA);
            PG8_BAR; PG8_WAIT_L(0); PG8_MMA(1, 0, At, B0); PG8_BAR; PG8_SCHED;
            PG8_STAGE(PG8_SB(1, 1), b3 + hstep, voffB);
            PG8_WAIT_V(6); PG8_BAR; PG8_MMA(1, 1, At, B1); PG8_BAR;
            }
        }
        if constexpr (ALIGN_EPI) { if (wr == 0) PG8_BAR; }
        if constexpr (!Epi::AFTER_DRAIN) { E(acc, cur, wr, wc, fr, fq); S.done(cur); }
        if (!has_next) break;
#pragma unroll
        for (int a = 0; a < 2; ++a)
#pragma unroll
            for (int b = 0; b < 2; ++b)
#pragma unroll
                for (int m = 0; m < 4; ++m)
#pragma unroll
                    for (int n = 0; n < 2; ++n) acc[a][b][m][n] = (f32x4){0.f, 0.f, 0.f, 0.f};
        cur = nxt; cA = nA; cB = nB; ++ui;
        if constexpr (ALIGN_EPI) { if (wr == 1) PG8_BAR; }
    }
    PG8_WAIT_V(0);
    if constexpr (!ALIGN_EPI) { if (wr == 0) PG8_BAR; }
    PG8_BAR;
    if constexpr (Epi::AFTER_DRAIN) { E.fused(acc, cur, wr, wc, fr, fq, lds, wid, lane); S.done(cur); }
#undef PG8_SA
#undef PG8_SB
#undef PG8_STAGE
#undef PG8_LDA
#undef PG8_LDB
#undef PG8_MMA
#undef PG8_WAIT_V
#undef PG8_WAIT_L
#undef PG8_BAR
#undef PG8_SCHED
}
}

#define DI __device__ __forceinline__
#define LAS __attribute__((address_space(3)))
typedef unsigned short bf16;
typedef short bf16x8 __attribute__((ext_vector_type(8)));
typedef float f32x4 __attribute__((ext_vector_type(4)));
typedef float f32x2 __attribute__((ext_vector_type(2)));
typedef float f32x16 __attribute__((ext_vector_type(16)));
typedef unsigned u32x4 __attribute__((ext_vector_type(4)));
typedef unsigned u32x2 __attribute__((ext_vector_type(2)));
typedef __bf16 bf16x2_t __attribute__((ext_vector_type(2)));

DI unsigned pk2(float lo, float hi) { f32x2 v = {lo, hi}; bf16x2_t b = __builtin_convertvector(v, bf16x2_t); return __builtin_bit_cast(unsigned, b); }
DI bf16 f2bf(float f) { return (bf16)(pk2(f, 0.f) & 0xffffu); }
DI float bf2f(bf16 v) { return __builtin_bit_cast(float, (unsigned)v << 16); }
DI float bflo(unsigned u) { return __builtin_bit_cast(float, u << 16); }
DI float bfhi(unsigned u) { return __builtin_bit_cast(float, u & 0xffff0000u); }
typedef _Float16 f16x2_t __attribute__((ext_vector_type(2)));
typedef __fp16 fp16x2_t __attribute__((ext_vector_type(2)));
DI unsigned pkh2(float lo, float hi) { return __builtin_bit_cast(unsigned, __builtin_amdgcn_cvt_pkrtz(lo, hi)); }
DI float hlo(unsigned u) { return (float)__builtin_bit_cast(f16x2_t, u).x; }
DI float hhi(unsigned u) { return (float)__builtin_bit_cast(f16x2_t, u).y; }
DI float silu_f(float x) { return x * __builtin_amdgcn_rcpf(1.f + __expf(-x)); }
DI float ex2(float x) { return __builtin_amdgcn_exp2f(x); }
#define MFMA32(a, b, c) __builtin_amdgcn_mfma_f32_32x32x16_bf16((a), (b), (c), 0, 0, 0)

constexpr int DM = 1024, NB = 8, SEQ = 4096, CTXL = 256, DEPTH = 4;
constexpr int M_LAT = NB * SEQ, M_CTX = NB * CTXL, M_ALL = M_LAT + M_CTX;
constexpr int DFF = 2816, NGU = 2 * DFF, NIN = 3584, INC = 3588, NKEY = SEQ + CTXL, NVC = 34;
constexpr int XBC0 = 1792;
constexpr float ALPHA = 1.6817928305074290f;
constexpr float QSCALE = 0.125f * 1.4426950408889634f;
constexpr size_t MiB = 1u << 20;
constexpr size_t WS_MOD = 0, WS_TATT = 2 * MiB, WS_LAM = 2 * MiB + 65536, WS_BAR = 2 * MiB + 131072, WS_STAT = 2 * MiB + 262144, WS_ONES = 2 * MiB + 655360, WS_ZEROS = 2 * MiB + 655360 + 4096, WS_HALVES = 2 * MiB + 655360 + 8192, WS_TRET = 3 * MiB, WS_DT = 4 * MiB, WS_DEC = 5 * MiB, WS_XC = 6 * MiB,
                 WS_WGU = 14 * MiB, WS_WDN = 36 * MiB, WS_WIN = 47 * MiB, WS_WOUT = 54 * MiB, WS_A = 56 * MiB, WS_HP = 124 * MiB,
                 WS_VT = 362 * MiB, WS_STS = 396 * MiB, WS_STR = 430 * MiB, WS_U = 447 * MiB, WS_T = 498 * MiB, WS_X16 = 530 * MiB, WS_END = 598 * MiB;
constexpr int LDS_BYTES = 147456;
constexpr int NTHREADS = 512;

struct Args { const float* in[22]; float* out; unsigned char* ws; float afreq[16]; float rfreq[32]; int ph_lo, ph_hi; };
enum { I_X = 0, I_C, I_CTX, I_CCTX, I_ADAW, I_ADAB, I_NG, I_NB, I_WG, I_WU, I_WD, I_WIN, I_CONVW, I_CONVB, I_LAMBDA, I_SUBG, I_ALOG, I_DTB, I_SSMD, I_SSMG, I_RLG, I_WOUT };

DI float* xrow_ptr(float* xlat, float* xctx, int row) { return row < M_LAT ? xlat + (size_t)row * DM : xctx + (size_t)(row - M_LAT) * DM; }
DI int swap23(int o) { return (o & 3) | (((o >> 3) & 1) << 2) | (((o >> 2) & 1) << 3); }

struct EpiSwiglu {
    static constexpr bool PERM = true, AFTER_DRAIN = false;
    bf16* H;
    DI void operator()(const pg8::f32x4 (&acc)[2][2][4][2], const pg8::Unit& u, int wr, int wc, int fr, int fq) const {
        const int row0 = u.pm * 256 + wr * 64 + fr, col = u.pn * 128 + wc * 32 + 8 * fq;
#pragma unroll
        for (int ai = 0; ai < 2; ++ai)
#pragma unroll
            for (int m = 0; m < 4; ++m) {
                bf16* p = H + (size_t)(row0 + ai * 128 + m * 16) * DFF + col;
                float h[8];
#pragma unroll
                for (int n = 0; n < 2; ++n)
#pragma unroll
                    for (int j = 0; j < 4; ++j) h[n * 4 + j] = silu_f(acc[ai][0][m][n][j]) * acc[ai][1][m][n][j];
                u32x4 w; w.x = pk2(h[0], h[1]); w.y = pk2(h[2], h[3]); w.z = pk2(h[4], h[5]); w.w = pk2(h[6], h[7]);
                *(u32x4*)p = w;
                __builtin_amdgcn_sched_barrier(0);
            }
    }
};

struct EpiResid {
    static constexpr bool PERM = true, AFTER_DRAIN = false;
    bf16* X; const float* modg; const float* scale_p; const f32x2* stat; const float* gprev; const float* bprev;
    DI void operator()(const pg8::f32x4 (&acc)[2][2][4][2], const pg8::Unit& u, int wr, int wc, int fr, int fq) const {
        const int mi = (u.pm < 128) ? (u.pm >> 4) : 8;
        const float* gp = modg + (size_t)mi * 9216;
        const int row0 = u.pm * 256 + wr * 64 + fr, col0 = u.pn * 256 + wc * 32 + 8 * fq;
        const float scale = *scale_p;
#pragma unroll
        for (int bj = 0; bj < 2; ++bj) {
            f32x4 gs[2], gq[2], bq[2];
#pragma unroll
            for (int n = 0; n < 2; ++n) { const f32x4 g = *(const f32x4*)(gp + col0 + bj * 128 + 4 * n); gs[n] = (g + 1.0f) * scale;
                gq[n] = *(const f32x4*)(gprev + col0 + bj * 128 + 4 * n) * ALPHA; bq[n] = *(const f32x4*)(bprev + col0 + bj * 128 + 4 * n) * ALPHA; }
#pragma unroll
            for (int ai = 0; ai < 2; ++ai) {
                u32x4 xv[4]; f32x2 st[4];
#pragma unroll
                for (int m = 0; m < 4; ++m) { const int row = row0 + ai * 128 + m * 16; xv[m] = *(const u32x4*)(X + (size_t)row * DM + col0 + bj * 128); st[m] = stat[row]; }
                __builtin_amdgcn_sched_barrier(0);
#pragma unroll
                for (int m = 0; m < 4; ++m) {
                    const f32x4 x0 = {hlo(xv[m].x), hhi(xv[m].x), hlo(xv[m].y), hhi(xv[m].y)}, x1 = {hlo(xv[m].z), hhi(xv[m].z), hlo(xv[m].w), hhi(xv[m].w)};
                    const f32x4 y0 = (x0 - st[m].x) * st[m].y * gq[0] + bq[0] + gs[0] * acc[ai][bj][m][0];
                    const f32x4 y1 = (x1 - st[m].x) * st[m].y * gq[1] + bq[1] + gs[1] * acc[ai][bj][m][1];
                    u32x4 w; w.x = pkh2(y0.x, y0.y); w.y = pkh2(y0.z, y0.w); w.z = pkh2(y1.x, y1.y); w.w = pkh2(y1.z, y1.w);
                    *(u32x4*)(X + (size_t)(row0 + ai * 128 + m * 16) * DM + col0 + bj * 128) = w;
                }
                __builtin_amdgcn_sched_barrier(0);
            }
        }
    }
};
struct EpiPartial {
    static constexpr bool PERM = true, AFTER_DRAIN = false;
    float* T; const float* modg; const float* scale_p;
    DI void operator()(const pg8::f32x4 (&acc)[2][2][4][2], const pg8::Unit& u, int wr, int wc, int fr, int fq) const {
        const float* gp = modg + (size_t)8 * 9216; const float scale = *scale_p;
        const int row0 = u.pm * 256 + wr * 64 + fr - M_LAT, col0 = u.pn * 256 + wc * 32 + 8 * fq;
        f32x4 gs[2][2];
#pragma unroll
        for (int bj = 0; bj < 2; ++bj)
#pragma unroll
            for (int n = 0; n < 2; ++n) { f32x4 g = *(const f32x4*)(gp + col0 + bj * 128 + 4 * n); gs[bj][n] = (g + 1.0f) * scale; }
#pragma unroll
        for (int ai = 0; ai < 2; ++ai)
#pragma unroll
            for (int m = 0; m < 4; ++m) {
                float* tp = T + (size_t)(row0 + ai * 128 + m * 16) * DM + col0;
#pragma unroll
                for (int bj = 0; bj < 2; ++bj)
#pragma unroll
                    for (int n = 0; n < 2; ++n) *(f32x4*)(tp + bj * 128 + 4 * n) = gs[bj][n] * acc[ai][bj][m][n];
                __builtin_amdgcn_sched_barrier(0);
            }
    }
};
struct OneUnit {
    int have; pg8::Unit u;
    DI bool next(int i, pg8::Unit& o) const { if (i == 0 && have) { o = u; return true; } return false; }
    DI void a_ready(const pg8::Unit&) const {}
    DI void done(const pg8::Unit&) const {}
};

struct EpiIn {
    static constexpr bool PERM = true, AFTER_DRAIN = false;
    bf16* P; bf16* Vt; const f32x2* tatt; const f32x2* tret;
    DI void operator()(const pg8::f32x4 (&acc)[2][2][4][2], const pg8::Unit& u, int wr, int wc, int fr, int fq) const {
        const int pn = u.pn;
        const int row0 = u.pm * 256 + wr * 64 + fr;
        if (pn == 4 || pn == 5) {
#pragma unroll
            for (int ai = 0; ai < 2; ++ai)
#pragma unroll
                for (int m = 0; m < 4; ++m) {
                    const int row = row0 + ai * 128 + m * 16;
                    int b, key;
                    if (row < M_LAT) { b = row >> 12; key = row & 4095; } else { const int r2 = row - M_LAT; b = r2 >> 8; key = 4096 + (r2 & 255); }
                    const int kp = (key & ~15) | swap23(key & 15);
#pragma unroll
                    for (int bj = 0; bj < 2; ++bj) {
                        const int h = 2 * (pn - 4) + bj;
                        bf16* vp = Vt + ((size_t)(b * 4 + h) * 128 + wc * 32 + 8 * fq) * NKEY + kp;
#pragma unroll
                        for (int n = 0; n < 2; ++n)
#pragma unroll
                            for (int j = 0; j < 4; ++j) vp[(size_t)(n * 4 + j) * NKEY] = f2bf(acc[ai][bj][m][n][j]);
                    }
                    __builtin_amdgcn_sched_barrier(0);
                }
            return;
        }
        const bool att = pn < 4, ret = (pn == 10 || pn == 11);
        const float sc = (pn < 2) ? QSCALE : (pn == 11 ? 0.125f : 1.0f);
#pragma unroll
        for (int ai = 0; ai < 2; ++ai)
#pragma unroll
            for (int m = 0; m < 4; ++m) {
                const int row = row0 + ai * 128 + m * 16;
                f32x2 cs[4];
                bool rot = false;
                if ((att || ret) && row < M_LAT) {
                    rot = true;
                    const int s = row & 4095;
                    const f32x2* tp;
                    if (att) { const int pos = (wc & 1) ? (s & 63) : (s >> 6); tp = tatt + pos * 16 + 4 * fq; }
                    else { tp = tret + (size_t)s * 32 + 16 * (wc & 1) + 4 * fq; }
                    const f32x4 t0 = *(const f32x4*)tp, t1 = *(const f32x4*)(tp + 2);
                    cs[0] = (f32x2){t0.x, t0.y}; cs[1] = (f32x2){t0.z, t0.w}; cs[2] = (f32x2){t1.x, t1.y}; cs[3] = (f32x2){t1.z, t1.w};
                }
#pragma unroll
                for (int bj = 0; bj < 2; ++bj) {
                    float v[8];
#pragma unroll
                    for (int n = 0; n < 2; ++n)
#pragma unroll
                        for (int j = 0; j < 4; ++j) v[n * 4 + j] = acc[ai][bj][m][n][j];
                    if (rot) {
#pragma unroll
                        for (int q = 0; q < 4; ++q) { const float h1 = v[2 * q], h2 = v[2 * q + 1]; v[2 * q] = h1 * cs[q].x - h2 * cs[q].y; v[2 * q + 1] = h2 * cs[q].x + h1 * cs[q].y; }
                    }
                    u32x4 w; w.x = pk2(v[0] * sc, v[1] * sc); w.y = pk2(v[2] * sc, v[3] * sc); w.z = pk2(v[4] * sc, v[5] * sc); w.w = pk2(v[6] * sc, v[7] * sc);
                    *(u32x4*)(P + (size_t)row * NIN + pn * 256 + bj * 128 + wc * 32 + 8 * fq) = w;
                }
                __builtin_amdgcn_sched_barrier(0);
            }
    }
};

DI void sincos_d(float angf, float& c, float& s) {
    const double a = (double)angf;
    const double k = rint(a * 0.15915494309189535);
    double r = fma(-k, 6.283185307179586, a); r = fma(-k, 2.4492935982947064e-16, r);
    const double r2 = r * r;
    double ts = r, ss = r, tc = 1.0, sc = 1.0;
#pragma unroll 1
    for (int n = 1; n <= 15; ++n) {
        tc = -tc * r2 / (double)((2 * n - 1) * (2 * n)); sc += tc;
        ts = -ts * r2 / (double)((2 * n) * (2 * n + 1)); ss += ts;
    }
    c = (float)sc; s = (float)ss;
}

DI int in_srccol(int j) {
    if (j < 1024) { const int blk = j >> 6, dp = j & 63, half = dp >> 5, i = (dp & 31) >> 1, sec = dp & 1; return blk * 64 + half * 32 + i + 16 * sec; }
    if (j < 2560) return j;
    if (j < 3072) { const int jj = j - 2560, blk = jj >> 6, dp = jj & 63, i = dp >> 1, sec = dp & 1; return 2564 + blk * 64 + i + 32 * sec; }
    return j + 4;
}

DI void transpose_item(const float* W, int ldw, int K, int srccol_lane, bf16* WT, int n0, int k0, LAS float* scr, int lane) {
#pragma unroll 8
    for (int i = 0; i < 32; ++i) { const int kk = 2 * i + (lane >> 5); scr[kk * 33 + (lane & 31)] = W[(size_t)(k0 + kk) * ldw + srccol_lane]; }
    asm volatile("s_waitcnt lgkmcnt(0)" ::: "memory");
    const int c = lane & 7;
#pragma unroll
    for (int j = 0; j < 4; ++j) {
        const int n = (lane >> 3) + 8 * j; const LAS float* s = scr + (8 * c) * 33 + n;
        u32x4 o; o.x = pk2(s[0 * 33], s[1 * 33]); o.y = pk2(s[2 * 33], s[3 * 33]); o.z = pk2(s[4 * 33], s[5 * 33]); o.w = pk2(s[6 * 33], s[7 * 33]);
        *(u32x4*)(WT + (size_t)(n0 + n) * K + k0 + 8 * c) = o;
    }
    asm volatile("s_waitcnt lgkmcnt(0)" ::: "memory");
}

DI void convw_phase(const Args& A, int l, LAS unsigned char* lds, int tid, int bid, int G) {
    const int lane = tid & 63, wave = tid >> 6;
    LAS float* scr = (LAS float*)(lds + 65536 + wave * 8448);
    const int gw = bid * 8 + wave, NGW = G * 8;
    constexpr int I_GU = 2 * 16 * (NGU / 32), I_DN = 2 * (DFF / 64) * (DM / 32), I_IN = 16 * (NIN / 32), I_OUT = 16 * 32;
    bf16* wgu = (bf16*)(A.ws + WS_WGU); bf16* wdn = (bf16*)(A.ws + WS_WDN); bf16* win = (bf16*)(A.ws + WS_WIN); bf16* wout = (bf16*)(A.ws + WS_WOUT);
    for (int it = gw; it < I_GU + I_DN + I_IN + I_OUT; it += NGW) {
        int r = it;
        if (r < I_GU) {
            const int f = r / (16 * (NGU / 32)); r -= f * 16 * (NGU / 32);
            const int kb = r / (NGU / 32), nb = r % (NGU / 32), n0 = nb * 32, pn = n0 >> 8, cc = n0 & 255;
            const float* src = (cc < 128 ? A.in[I_WG] : A.in[I_WU]) + (size_t)(l * 2 + f) * DM * DFF;
            transpose_item(src, DFF, DM, 128 * pn + (cc & 127) + (lane & 31), wgu + (size_t)f * NGU * DM, n0, kb * 64, scr, lane);
            continue;
        }
        r -= I_GU;
        if (r < I_DN) {
            const int f = r / ((DFF / 64) * 32); r -= f * (DFF / 64) * 32;
            const int kb = r / 32, nb = r % 32;
            transpose_item(A.in[I_WD] + (size_t)(l * 2 + f) * DFF * DM, DM, DFF, nb * 32 + (lane & 31), wdn + (size_t)f * DM * DFF, nb * 32, kb * 64, scr, lane);
            continue;
        }
        r -= I_DN;
        if (r < I_IN) {
            const int kb = r / (NIN / 32), nb = r % (NIN / 32);
            transpose_item(A.in[I_WIN] + (size_t)l * DM * INC, INC, DM, in_srccol(nb * 32 + (lane & 31)), win, nb * 32, kb * 64, scr, lane);
            continue;
        }
        r -= I_IN;
        { const int kb = r / 32, nb = r % 32;
          transpose_item(A.in[I_WOUT] + (size_t)l * DM * DM, DM, DM, nb * 32 + (lane & 31), wout, nb * 32, kb * 64, scr, lane); }
    }
}

DI void p0a_phase(const Args& A, LAS unsigned char* lds, int tid, int bid, int G) {
    const int lane = tid & 63, wave = tid >> 6;
    { const int gt = bid * NTHREADS + tid;
      f32x2* tatt = (f32x2*)(A.ws + WS_TATT); f32x2* tret = (f32x2*)(A.ws + WS_TRET);
      if (gt < 1024) { ((float*)(A.ws + WS_ONES))[gt] = 1.0f; ((float*)(A.ws + WS_ZEROS))[gt] = 0.0f; ((float*)(A.ws + WS_HALVES))[gt] = 0.5f; }
      if (gt < 1024) { const int pos = gt >> 4, i = gt & 15; float c, s; sincos_d((float)pos * A.afreq[i], c, s); tatt[gt] = (f32x2){c, s}; }
      for (int e = gt; e < SEQ * 32; e += G * NTHREADS) { const int sidx = e >> 5, i = e & 31; float c, s; sincos_d((float)sidx * A.rfreq[i], c, s); tret[e] = (f32x2){c, s}; }
      if (gt < DEPTH) {
          const float* lv = A.in[I_LAMBDA] + gt * 256; float d0 = 0.f, d1 = 0.f;
          for (int i = 0; i < 64; ++i) { d0 += lv[i] * lv[64 + i]; d1 += lv[128 + i] * lv[192 + i]; }
          const float lam_init = 0.8f - 0.6f * expf(-0.3f * (float)gt);
          ((float*)(A.ws + WS_LAM))[gt] = expf(d0) - expf(d1) + lam_init;
      }
    }
    LAS float* scs = (LAS float*)lds;
    LAS float* red = (LAS float*)(lds + 36864);
    for (int e = tid; e < 9 * 1024; e += NTHREADS) { const int mi = e >> 10, k = e & 1023; const float v = (mi < 8) ? A.in[I_C][mi * 1024 + k] : A.in[I_CCTX][k]; scs[e] = silu_f(v); }
    __syncthreads();
    float* MOD = (float*)(A.ws + WS_MOD);
    for (int it = bid; it < DEPTH * 144; it += G) {
        const int l = it / 144, cg0 = (it % 144) * 64;
        const float* w = A.in[I_ADAW] + (size_t)l * DM * 9216 + cg0 + lane;
        float acc[9];
#pragma unroll
        for (int mi = 0; mi < 9; ++mi) acc[mi] = 0.f;
#pragma unroll 4
        for (int k = wave * 128; k < wave * 128 + 128; ++k) {
            const float wv = w[(size_t)k * 9216];
#pragma unroll
            for (int mi = 0; mi < 9; ++mi) acc[mi] += scs[mi * 1024 + k] * wv;
        }
#pragma unroll
        for (int mi = 0; mi < 9; ++mi) red[(wave * 9 + mi) * 64 + lane] = acc[mi];
        __syncthreads();
        for (int e = tid; e < 576; e += NTHREADS) {
            const int mi = e >> 6, cl = e & 63; float s = A.in[I_ADAB][l * 9216 + cg0 + cl];
#pragma unroll
            for (int w8 = 0; w8 < 8; ++w8) s += red[(w8 * 9 + mi) * 64 + cl];
            MOD[((size_t)l * 9 + mi) * 9216 + cg0 + cl] = s;
        }
        __syncthreads();
    }
    convw_phase(A, 0, lds, tid, bid, G);
}

DI float wave_sum(float v) {
#pragma unroll
    for (int o = 1; o < 64; o <<= 1) v += __shfl_xor(v, o);
    return v;
}
DI void lnmod_phase(const Args& A, LAS unsigned char* lds, int tid, int bid, int G, bool init, int l_norm, int i_norm, int l_mod, int i_mod, bool want_dt, int nrows, bool ctx_partial, const float* gprev, const float* bprev) {
    const int lane = tid & 63, wave = tid >> 6;
    LAS f32x4* wdt = (LAS f32x4*)lds;
    if (want_dt) {
        for (int k = tid; k < 1024; k += NTHREADS) wdt[k] = *(const f32x4*)(A.in[I_WIN] + ((size_t)l_mod * DM + k) * INC + 2560);
        __syncthreads();
    }
    const float* MOD = (const float*)(A.ws + WS_MOD);
    bf16* Abuf = (bf16*)(A.ws + WS_A);
    float* DT = (float*)(A.ws + WS_DT);
    f32x4 g[4], bb[4];
    if (l_norm >= 0) {
#pragma unroll
        for (int j = 0; j < 4; ++j) { g[j] = *(const f32x4*)(A.in[I_NG] + (l_norm * 3 + i_norm) * DM + 256 * j + 4 * lane); bb[j] = *(const f32x4*)(A.in[I_NB] + (l_norm * 3 + i_norm) * DM + 256 * j + 4 * lane); }
    }
    bf16* X16 = (bf16*)(A.ws + WS_X16);
    u32x2 un[4]; f32x4 fn[4];
    int mi_cur = -1; f32x4 shv[4], sclv[4];
    { const int row = bid * 8 + wave;
      if (row < nrows) {
          if (init) { const float* xin = row < M_LAT ? A.in[I_X] + (size_t)row * DM : A.in[I_CTX] + (size_t)(row - M_LAT) * DM;
#pragma unroll
              for (int j = 0; j < 4; ++j) fn[j] = *(const f32x4*)(xin + 256 * j + 4 * lane); }
          else {
#pragma unroll
              for (int j = 0; j < 4; ++j) un[j] = *(const u32x2*)(X16 + (size_t)row * DM + 256 * j + 4 * lane); } } }
    for (int row = bid * 8 + wave; row < nrows; row += G * 8) {
        bf16* xout = X16 + (size_t)row * DM;
        f32x4 v[4];
#pragma unroll
        for (int j = 0; j < 4; ++j) v[j] = init ? fn[j] : (f32x4){hlo(un[j].x), hhi(un[j].x), hlo(un[j].y), hhi(un[j].y)};
        { const int rown = row + G * 8;
          if (rown < nrows) {
              if (init) { const float* xin = rown < M_LAT ? A.in[I_X] + (size_t)rown * DM : A.in[I_CTX] + (size_t)(rown - M_LAT) * DM;
#pragma unroll
                  for (int j = 0; j < 4; ++j) fn[j] = *(const f32x4*)(xin + 256 * j + 4 * lane); }
              else {
#pragma unroll
                  for (int j = 0; j < 4; ++j) un[j] = *(const u32x2*)(X16 + (size_t)rown * DM + 256 * j + 4 * lane); } } }
        f32x2* STAT = (f32x2*)(A.ws + WS_STAT);
        if (ctx_partial && row >= M_LAT) {
            { const f32x2 st = STAT[row];
#pragma unroll
              for (int j = 0; j < 4; ++j) v[j] = (v[j] - st.x) * st.y * *(const f32x4*)(gprev + 256 * j + 4 * lane) + *(const f32x4*)(bprev + 256 * j + 4 * lane); }
            const float* t0 = (const float*)(A.ws + WS_T) + (size_t)(row - M_LAT) * DM; const float* t1 = t0 + (size_t)M_CTX * DM; const float* t2 = t1 + (size_t)M_CTX * DM; const float* t3 = t2 + (size_t)M_CTX * DM;
#pragma unroll
            for (int j = 0; j < 4; ++j) { v[j] = v[j] * ALPHA + (*(const f32x4*)(t0 + 256 * j + 4 * lane) + *(const f32x4*)(t1 + 256 * j + 4 * lane)) + (*(const f32x4*)(t2 + 256 * j + 4 * lane) + *(const f32x4*)(t3 + 256 * j + 4 * lane)); u32x2 w_; w_.x = pkh2(v[j].x, v[j].y); w_.y = pkh2(v[j].z, v[j].w); *(u32x2*)(xout + 256 * j + 4 * lane) = w_; }
        }
        if (l_norm >= 0) {
            float s = 0.f;
#pragma unroll
            for (int j = 0; j < 4; ++j) s += (v[j].x + v[j].y) + (v[j].z + v[j].w);
            const float mean = wave_sum(s) * (1.f / DM);
            float s2 = 0.f;
#pragma unroll
            for (int j = 0; j < 4; ++j) { v[j] = v[j] - mean; s2 += (v[j].x * v[j].x + v[j].y * v[j].y) + (v[j].z * v[j].z + v[j].w * v[j].w); }
            const float rstd = 1.0f / sqrtf(wave_sum(s2) * (1.f / DM) + 1e-5f);
            if (l_mod >= 0 && lane == 0) STAT[row] = (f32x2){mean, rstd};
#pragma unroll
            for (int j = 0; j < 4; ++j) v[j] = v[j] * rstd * g[j] + bb[j];
        }
        if (init && lane == 0) STAT[row] = (f32x2){0.f, 1.f};
        if (init) {
#pragma unroll
            for (int j = 0; j < 4; ++j) { u32x2 w_; w_.x = pkh2(v[j].x, v[j].y); w_.y = pkh2(v[j].z, v[j].w); *(u32x2*)(xout + 256 * j + 4 * lane) = w_; }
        }
        if (l_norm >= 0 && l_mod < 0) {
#pragma unroll
            for (int j = 0; j < 4; ++j) *(f32x4*)(A.out + (size_t)row * DM + 256 * j + 4 * lane) = v[j];
        }
        if (l_mod >= 0) {
            const int mi = row < M_LAT ? (row >> 12) : 8;
            const float* mp = MOD + ((size_t)l_mod * 9 + mi) * 9216 + i_mod * 3072;
            if (mi != mi_cur) { mi_cur = mi;
#pragma unroll
                for (int j = 0; j < 4; ++j) { shv[j] = *(const f32x4*)(mp + 256 * j + 4 * lane); sclv[j] = *(const f32x4*)(mp + 1024 + 256 * j + 4 * lane) + 1.0f; } }
            float d0 = 0.f, d1 = 0.f, d2 = 0.f, d3 = 0.f;
#pragma unroll
            for (int j = 0; j < 4; ++j) {
                const f32x4 a = v[j] * sclv[j] + shv[j];
                u32x2 w; w.x = pk2(a.x, a.y); w.y = pk2(a.z, a.w);
                *(u32x2*)(Abuf + (size_t)row * DM + 256 * j + 4 * lane) = w;
                if (want_dt) {
                    const int k0 = 256 * j + 4 * lane;
                    const f32x4 w0 = wdt[k0], w1 = wdt[k0 + 1], w2 = wdt[k0 + 2], w3 = wdt[k0 + 3];
                    d0 += a.x * w0.x + a.y * w1.x + a.z * w2.x + a.w * w3.x;
                    d1 += a.x * w0.y + a.y * w1.y + a.z * w2.y + a.w * w3.y;
                    d2 += a.x * w0.z + a.y * w1.z + a.z * w2.z + a.w * w3.z;
                    d3 += a.x * w0.w + a.y * w1.w + a.z * w2.w + a.w * w3.w;
                }
            }
            if (want_dt) {
                d0 = wave_sum(d0); d1 = wave_sum(d1); d2 = wave_sum(d2); d3 = wave_sum(d3);
                if (lane == 0) *(f32x4*)(DT + (size_t)row * 4) = (f32x4){d0, d1, d2, d3};
            }
        }
    }
}

DI float max3f(float a, float b, float c) { float r; asm("v_max3_f32 %0, %1, %2, %3" : "=v"(r) : "v"(a), "v"(b), "v"(c)); return r; }
DI float max3f_mfma(float a, float b, float c) { float r; asm("s_nop 15\n\ts_nop 7\n\tv_max3_f32 %0, %1, %2, %3" : "=v"(r) : "v"(a), "v"(b), "v"(c)); return r; }
DI void attn_unit(LAS unsigned char* lds, int tid, const bf16* __restrict__ P, const bf16* __restrict__ Vt, bf16* MG, int b, int h, int qrow0, int jt0, int jt1,
                  float lam, float oscale, const float* subg) {
    asm volatile("" : "+v"(tid));
    constexpr int KP = 136, VP = 72, KBYTES = 64 * KP * 2, VBYTES = 128 * VP * 2;
    const int lane = tid & 63, wave = tid >> 6, r32 = lane & 31, hi = lane >> 5;
    const int qb = wave >> 1, m = wave & 1;
    const int qrow = qrow0 + qb * 32 + r32;
    bf16x8 qf[4];
#pragma unroll
    for (int ks = 0; ks < 4; ++ks) qf[ks] = *(const bf16x8*)(P + (size_t)qrow * NIN + h * 128 + m * 64 + ks * 16 + hi * 8);
    f32x16 O[4];
#pragma unroll
    for (int es = 0; es < 4; ++es)
#pragma unroll
        for (int i = 0; i < 16; ++i) O[es][i] = 0.f;
    float mrun = 0.f, lrun = 0.f;
    u32x4 kreg[2], vreg[2];
    const bf16* vbase = Vt + (size_t)(b * 4 + h) * 128 * NKEY;
#define ATT_LOADG(j) do { _Pragma("unroll") for (int i_ = 0; i_ < 2; ++i_) { const int c_ = tid + 512 * i_; const int key_ = c_ >> 4, part_ = c_ & 15; \
        const int row_ = ((j) < 64) ? b * SEQ + (j) * 64 + key_ : M_LAT + b * CTXL + ((j) - 64) * 64 + key_; \
        kreg[i_] = *(const u32x4*)(P + (size_t)row_ * NIN + 512 + h * 128 + part_ * 8); \
        const int e_ = c_ >> 3, vp_ = c_ & 7; vreg[i_] = *(const u32x4*)(vbase + (size_t)e_ * NKEY + (j) * 64 + vp_ * 8); } } while (0)
#define ATT_STORE(buf) do { _Pragma("unroll") for (int i_ = 0; i_ < 2; ++i_) { const int c_ = tid + 512 * i_; const int key_ = c_ >> 4, part_ = c_ & 15, e_ = c_ >> 3, vp_ = c_ & 7; \
        *(LAS u32x4*)(lds + (buf) * KBYTES + (key_ * KP + part_ * 8) * 2) = kreg[i_]; \
        *(LAS u32x4*)(lds + 2 * KBYTES + (buf) * VBYTES + (e_ * VP + vp_ * 8) * 2) = vreg[i_]; } } while (0)
    const bool halfB = wave >= 4;
    bf16x8 pf[4];
#define ATT_QKS(bufk, first_) do { \
        const LAS bf16* Kb = (const LAS bf16*)(lds + (bufk) * KBYTES) + m * 64 + hi * 8; \
        f32x16 s0, s1; \
        { const float ninit = -mrun; _Pragma("unroll") for (int i = 0; i < 16; ++i) { s0[i] = ninit; s1[i] = ninit; } } \
        _Pragma("unroll") for (int ks = 0; ks < 4; ++ks) { \
            const bf16x8 a0 = *(const LAS bf16x8*)(Kb + r32 * KP + ks * 16); \
            const bf16x8 a1 = *(const LAS bf16x8*)(Kb + (32 + r32) * KP + ks * 16); \
            s0 = MFMA32(a0, qf[ks], s0); s1 = MFMA32(a1, qf[ks], s1); } \
        float mx = max3f_mfma(s0[0], s1[0], s0[1]); \
        mx = max3f(mx, s1[1], s0[2]); mx = max3f(mx, s1[2], s0[3]); mx = max3f(mx, s1[3], s0[4]); mx = max3f(mx, s1[4], s0[5]); \
        mx = max3f(mx, s1[5], s0[6]); mx = max3f(mx, s1[6], s0[7]); mx = max3f(mx, s1[7], s0[8]); mx = max3f(mx, s1[8], s0[9]); \
        mx = max3f(mx, s1[9], s0[10]); mx = max3f(mx, s1[10], s0[11]); mx = max3f(mx, s1[11], s0[12]); mx = max3f(mx, s1[12], s0[13]); \
        mx = max3f(mx, s1[13], s0[14]); mx = max3f(mx, s1[14], s0[15]); mx = max3f(mx, s1[15], mx); \
        mx = max3f(mx, __shfl_xor(mx, 32), mx); \
        if ((first_) || __builtin_amdgcn_ballot_w64(mx > 8.0f) != 0ull) { \
            const float d = (first_) ? mx : (mx > 8.0f ? mx : 0.f); \
            mrun += d; \
            if (!(first_)) { const float alpha = ex2(-d); lrun *= alpha; _Pragma("unroll") for (int es = 0; es < 4; ++es) O[es] = O[es] * alpha; } \
            _Pragma("unroll") for (int i = 0; i < 16; ++i) { s0[i] -= d; s1[i] -= d; } } \
        float sum = 0.f; \
        _Pragma("unroll") for (int i = 0; i < 16; ++i) { s0[i] = ex2(s0[i]); s1[i] = ex2(s1[i]); sum += s0[i] + s1[i]; } \
        lrun += sum; \
        _Pragma("unroll") for (int s2 = 0; s2 < 2; ++s2) { u32x4 w0, w1; \
            w0.x = pk2(s0[8 * s2 + 0], s0[8 * s2 + 1]); w0.y = pk2(s0[8 * s2 + 2], s0[8 * s2 + 3]); w0.z = pk2(s0[8 * s2 + 4], s0[8 * s2 + 5]); w0.w = pk2(s0[8 * s2 + 6], s0[8 * s2 + 7]); \
            w1.x = pk2(s1[8 * s2 + 0], s1[8 * s2 + 1]); w1.y = pk2(s1[8 * s2 + 2], s1[8 * s2 + 3]); w1.z = pk2(s1[8 * s2 + 4], s1[8 * s2 + 5]); w1.w = pk2(s1[8 * s2 + 6], s1[8 * s2 + 7]); \
            pf[s2] = __builtin_bit_cast(bf16x8, w0); pf[2 + s2] = __builtin_bit_cast(bf16x8, w1); } } while (0)
#define ATT_PV(bufv) do { \
        const LAS bf16* Vb = (const LAS bf16*)(lds + 2 * KBYTES + (bufv) * VBYTES) + hi * 8; \
        _Pragma("unroll") for (int es = 0; es < 4; ++es) _Pragma("unroll") for (int kk = 0; kk < 4; ++kk) { \
            const bf16x8 a = *(const LAS bf16x8*)(Vb + (es * 32 + r32) * VP + kk * 16); O[es] = MFMA32(a, pf[kk], O[es]); } } while (0)
    __syncthreads();
    ATT_LOADG(jt0);
    for (int j = jt0; j < jt1; ++j) {
        const int buf = (j - jt0) & 1;
        ATT_STORE(buf);
        __syncthreads();
        if (j + 1 < jt1) ATT_LOADG(j + 1);
        if (!halfB) { ATT_QKS(buf, j == jt0); } else if (j > jt0) { ATT_PV(buf ^ 1); }
        __syncthreads();
        if (!halfB) { ATT_PV(buf); } else { ATT_QKS(buf, j == jt0); }
    }
    if (halfB) { ATT_PV((jt1 - 1 - jt0) & 1); }
#undef ATT_QKS
#undef ATT_PV
#undef ATT_LOADG
#undef ATT_STORE
    __syncthreads();
    const float l = lrun + __shfl_xor(lrun, 32);
    const float inv = (m ? lam : 1.0f) / l;
    LAS float* X = (LAS float*)lds + qb * 4096 + lane;
    if (m) {
#pragma unroll
        for (int es = 0; es < 4; ++es)
#pragma unroll
            for (int i = 0; i < 16; ++i) X[(es * 16 + i) * 64] = O[es][i] * inv;
    }
    __syncthreads();
    if (!m) {
        float ss = 0.f;
#pragma unroll
        for (int es = 0; es < 4; ++es)
#pragma unroll
            for (int i = 0; i < 16; ++i) { const float o = O[es][i] * inv - X[(es * 16 + i) * 64]; O[es][i] = o; ss += o * o; }
        ss += __shfl_xor(ss, 32);
        const float rn = (1.0f / sqrtf(ss * (1.0f / 128.0f) + 1e-6f)) * oscale;
#pragma unroll
        for (int es = 0; es < 4; ++es)
#pragma unroll
            for (int g4 = 0; g4 < 4; ++g4) {
                const int e = es * 32 + 8 * g4 + 4 * hi;
                const f32x4 gv = *(const f32x4*)(subg + e);
                u32x2 w; w.x = pk2(O[es][4 * g4 + 0] * rn * gv.x, O[es][4 * g4 + 1] * rn * gv.y); w.y = pk2(O[es][4 * g4 + 2] * rn * gv.z, O[es][4 * g4 + 3] * rn * gv.w);
                *(u32x2*)(MG + (size_t)qrow * DM + h * 128 + e) = w;
            }
    }
}

constexpr int SC_ACF = 0, SC_ACB = 1, SC_DT0 = 2, SC_DT1 = 3;
constexpr int L_STAT = 8192, L_BUF = 16384;
constexpr int TP = 136;
constexpr int QP = 72;
constexpr int UW = 768;

DI int vc_row0(int b, int vc) { return vc < 2 ? M_LAT + b * CTXL + vc * 128 : b * SEQ + (vc - 2) * 128; }
DI float softplus_f(float x) { return fmaxf(x, 0.f) + log1pf(__expf(-fabsf(x))); }

struct ScanCtx { const bf16* P; const bf16* U; const float* DT; bf16* sts; bf16* str; float* dec; bf16* MG; const float* cw; const float* cb; const float* alog; const float* dtb; const float* ssmd; const float* ssmg; const float* rlg; };

DI void conv_phase(const bf16* __restrict__ P, bf16* __restrict__ U, const float* cw, const float* cb, int tid, int bid, int G) {
    const int lane = tid & 63, wave = tid >> 6;
    for (int it = bid * 8 + wave; it < (M_ALL / 16) * 3; it += G * 8) {
        const int run = it / 3, cgp = it % 3, row0 = run * 16, ch = cgp * 256 + 4 * lane;
        int s0, L; if (row0 < M_LAT) { s0 = row0 & (SEQ - 1); L = SEQ; } else { s0 = (row0 - M_LAT) & (CTXL - 1); L = CTXL; }
        f32x4 w[5];
#pragma unroll
        for (int k = 0; k < 5; ++k) w[k] = *(const f32x4*)(cw + k * UW + ch);
        const f32x4 bias = *(const f32x4*)(cb + ch);
        f32x4 x[20];
#pragma unroll
        for (int i = 0; i < 20; ++i) { const int s = s0 - 2 + i; u32x2 v = {0u, 0u}; if (s >= 0 && s < L) v = *(const u32x2*)(P + (size_t)(row0 - 2 + i) * NIN + XBC0 + ch);
            x[i] = (f32x4){bflo(v.x), bfhi(v.x), bflo(v.y), bfhi(v.y)}; }
#pragma unroll
        for (int t = 0; t < 16; ++t) {
            const f32x4 a = bias + w[0] * x[t] + w[1] * x[t + 1] + w[2] * x[t + 2] + w[3] * x[t + 3] + w[4] * x[t + 4];
            u32x2 o; o.x = pk2(silu_f(a.x), silu_f(a.y)); o.y = pk2(silu_f(a.z), silu_f(a.w));
            *(u32x2*)(U + (size_t)(row0 + t) * UW + ch) = o;
        }
    }
}

DI void ssd_scalars(LAS float* sc, int tid, const float* DT, int row0, const float* alog, const float* dtb, float* dec_f, float* dec_b) {
    const int lane = tid & 63, wave = tid >> 6;
    if (wave < 4) {
        const int h = wave;
        const float r0 = DT[(size_t)(row0 + 2 * lane) * 4 + h], r1 = DT[(size_t)(row0 + 2 * lane + 1) * 4 + h];
        const float ea0 = __expf(alog[h]), ea1 = __expf(alog[4 + h]);
        const float d00 = softplus_f(r0 + dtb[h]), d01 = softplus_f(r1 + dtb[h]);
        const float d10 = softplus_f(r0 + dtb[4 + h]), d11 = softplus_f(r1 + dtb[4 + h]);
        const float la00 = -d00 * ea0, la01 = -d01 * ea0, la10 = -d10 * ea1, la11 = -d11 * ea1;
        float pf = la00 + la01, pb = la10 + la11;
#pragma unroll
        for (int o = 1; o < 64; o <<= 1) { const float tf = __shfl_up(pf, o), tb = __shfl_up(pb, o); if (lane >= o) { pf += tf; pb += tb; } }
        const float totb = __shfl(pb, 63), totf = __shfl(pf, 63);
        sc[(SC_ACF * 4 + h) * 128 + 2 * lane + 1] = pf; sc[(SC_ACF * 4 + h) * 128 + 2 * lane] = pf - la01;
        sc[(SC_ACB * 4 + h) * 128 + 2 * lane + 1] = totb - pb + la11; sc[(SC_ACB * 4 + h) * 128 + 2 * lane] = totb - (pb - la11) + la10;
        sc[(SC_DT0 * 4 + h) * 128 + 2 * lane] = d00; sc[(SC_DT0 * 4 + h) * 128 + 2 * lane + 1] = d01;
        sc[(SC_DT1 * 4 + h) * 128 + 2 * lane] = d10; sc[(SC_DT1 * 4 + h) * 128 + 2 * lane + 1] = d11;
        if (dec_f && lane == 0) { dec_f[h] = __expf(totf); dec_b[h] = __expf(totb); }
    }
}

DI f32x16 zero16() { f32x16 z;
#pragma unroll
    for (int i = 0; i < 16; ++i) z[i] = 0.f;
    return z; }
template <int KSTEPS> DI f32x16 mma_lds(f32x16 acc, const LAS bf16* Ap, int pa, const LAS bf16* Bp, int pb, int lane) {
    const int r32 = lane & 31, hi = lane >> 5;
    Ap += r32 * pa + 8 * hi; Bp += r32 * pb + 8 * hi;
#pragma unroll
    for (int ks = 0; ks < KSTEPS; ++ks) { const bf16x8 a = *(const LAS bf16x8*)(Ap + 16 * ks), bq = *(const LAS bf16x8*)(Bp + 16 * ks); acc = MFMA32(a, bq, acc); }
    return acc;
}

template <int C, bool SCALED> DI void stage_T(LAS bf16* d0, LAS bf16* d1, const bf16* __restrict__ src, int spitch, const LAS float* w0, const LAS float* w1, int tid) {
    constexpr int OC = C / 8;
#pragma unroll
    for (int it0 = 0; it0 < 64 * OC; it0 += NTHREADS) {
        const int it = it0 + tid, oct = it % OC, tp = it / OC;
        const u32x4 r0 = *(const u32x4*)(src + (size_t)(2 * tp) * spitch + oct * 8), r1 = *(const u32x4*)(src + (size_t)(2 * tp + 1) * spitch + oct * 8);
        const unsigned a[4] = {r0.x, r0.y, r0.z, r0.w}, bq[4] = {r1.x, r1.y, r1.z, r1.w};
        if (!SCALED) {
#pragma unroll
            for (int k = 0; k < 4; ++k) {
                *(LAS unsigned*)(d0 + (oct * 8 + 2 * k) * TP + 2 * tp) = (a[k] & 0xffffu) | (bq[k] << 16);
                *(LAS unsigned*)(d0 + (oct * 8 + 2 * k + 1) * TP + 2 * tp) = (a[k] >> 16) | (bq[k] & 0xffff0000u);
            }
        } else {
            const float u0 = w0[2 * tp], u1 = w0[2 * tp + 1], v0 = w1[2 * tp], v1 = w1[2 * tp + 1];
#pragma unroll
            for (int k = 0; k < 4; ++k) {
                const float e0 = bflo(a[k]), e1 = bfhi(a[k]), f0 = bflo(bq[k]), f1 = bfhi(bq[k]);
                *(LAS unsigned*)(d0 + (oct * 8 + 2 * k) * TP + 2 * tp) = pk2(e0 * u0, f0 * u1);
                *(LAS unsigned*)(d0 + (oct * 8 + 2 * k + 1) * TP + 2 * tp) = pk2(e1 * u0, f1 * u1);
                *(LAS unsigned*)(d1 + (oct * 8 + 2 * k) * TP + 2 * tp) = pk2(e0 * v0, f0 * v1);
                *(LAS unsigned*)(d1 + (oct * 8 + 2 * k + 1) * TP + 2 * tp) = pk2(e1 * v0, f1 * v1);
            }
        }
    }
}
template <int R, int C> DI void stage_N(LAS bf16* d, int dp, const bf16* __restrict__ src, int spitch, int tid) {
    constexpr int OC = C / 8;
#pragma unroll
    for (int it0 = 0; it0 < R * OC; it0 += NTHREADS) { const int it = it0 + tid, oct = it % OC, r = it / OC; *(LAS u32x4*)(d + r * dp + oct * 8) = *(const u32x4*)(src + (size_t)r * spitch + oct * 8); }
}

DI void s1_ssd_unit(LAS unsigned char* lds, int tid, const ScanCtx& C, int b, int vc) {
    asm volatile("" : "+v"(tid));
    const int lane = tid & 63, wave = tid >> 6, r32 = lane & 31, hi = lane >> 5;
    LAS float* sc = (LAS float*)lds; LAS float* wts = (LAS float*)(lds + L_STAT);
    LAS bf16* BkT = (LAS bf16*)(lds + L_BUF); LAS bf16* XF = (LAS bf16*)(lds + L_BUF + 34816); LAS bf16* XB = (LAS bf16*)(lds + L_BUF + 34816 + 17408);
    const int row0 = vc_row0(b, vc);
    float* decp = C.dec + (size_t)((b * NVC + vc) * 2) * 8;
    __syncthreads();
    ssd_scalars(sc, tid, C.DT, row0, C.alog, C.dtb, decp, decp + 8);
    __syncthreads();
    { const int h = tid >> 7, s = tid & 127;
      wts[h * 128 + s] = __expf(sc[(SC_ACF * 4 + h) * 128 + 127] - sc[(SC_ACF * 4 + h) * 128 + s]) * sc[(SC_DT0 * 4 + h) * 128 + s];
      wts[(4 + h) * 128 + s] = __expf(sc[(SC_ACB * 4 + h) * 128 + 0] - sc[(SC_ACB * 4 + h) * 128 + s]) * sc[(SC_DT1 * 4 + h) * 128 + s]; }
    const bf16* Urow = C.U + (size_t)row0 * UW;
    for (int g = 0; g < 2; ++g) {
        __syncthreads();
        stage_T<128, false>(BkT, BkT, Urow + 256 + g * 128, UW, nullptr, nullptr, tid);
        for (int hh = 0; hh < 2; ++hh) {
            const int h = 2 * g + hh;
            if (hh) __syncthreads();
            stage_T<64, true>(XF, XB, Urow + h * 64, UW, wts + h * 128, wts + (4 + h) * 128, tid);
            __syncthreads();
            const int pt = wave >> 2, nt = wave & 3;
            f32x16 af = zero16(), ab = zero16();
            { const LAS bf16* Bp = BkT + (nt * 32 + r32) * TP + 8 * hi; const LAS bf16* Af = XF + (pt * 32 + r32) * TP + 8 * hi; const LAS bf16* Ab = XB + (pt * 32 + r32) * TP + 8 * hi;
#pragma unroll
              for (int ks = 0; ks < 8; ++ks) { const bf16x8 bq = *(const LAS bf16x8*)(Bp + 16 * ks); af = MFMA32(*(const LAS bf16x8*)(Af + 16 * ks), bq, af); ab = MFMA32(*(const LAS bf16x8*)(Ab + 16 * ks), bq, ab); } }
            bf16* of = C.sts + ((size_t)(((b * NVC + vc) * 2 + 0) * 4 + h)) * 8192; bf16* ob = C.sts + ((size_t)(((b * NVC + vc) * 2 + 1) * 4 + h)) * 8192;
#pragma unroll
            for (int i = 0; i < 16; ++i) { const int p = pt * 32 + 8 * (i >> 2) + 4 * hi + (i & 3), n = nt * 32 + r32; of[p * 128 + n] = f2bf(af[i]); ob[p * 128 + n] = f2bf(ab[i]); }
        }
    }
}
DI void s1_ret_unit(LAS unsigned char* lds, int tid, const ScanCtx& C, int b, int vc, int h0, int nh) {
    asm volatile("" : "+v"(tid));
    const int lane = tid & 63, wave = tid >> 6, r32 = lane & 31, hi = lane >> 5;
    LAS float* wts = (LAS float*)(lds + L_STAT);
    LAS bf16* KT = (LAS bf16*)(lds + L_BUF); LAS bf16* VF = (LAS bf16*)(lds + L_BUF + 17408); LAS bf16* VB = (LAS bf16*)(lds + L_BUF + 2 * 17408);
    const int row0 = vc_row0(b, vc);
    float* decp = C.dec + (size_t)((b * NVC + vc) * 2) * 8;
    __syncthreads();
    { const int h = tid >> 7, s = tid & 127; const float lg0 = C.rlg[h], lg1 = C.rlg[4 + h];
      wts[h * 128 + s] = __expf((float)(127 - s) * lg0); wts[(4 + h) * 128 + s] = __expf((float)s * lg1);
      if (s == 0) { decp[4 + h] = __expf(128.f * lg0); decp[8 + 4 + h] = __expf(128.f * lg1); } }
    const bf16* Prow = C.P + (size_t)row0 * NIN;
#pragma unroll 1
    for (int h = h0; h < h0 + nh; ++h) {
        __syncthreads();
        stage_T<64, false>(KT, KT, Prow + 2816 + h * 64, NIN, nullptr, nullptr, tid);
        stage_T<64, true>(VF, VB, Prow + 3072 + h * 64, NIN, wts + h * 128, wts + (4 + h) * 128, tid);
        __syncthreads();
        const int dir = wave >> 2, pt = (wave >> 1) & 1, nt = wave & 1;
        const f32x16 a = mma_lds<8>(zero16(), (dir ? VB : VF) + pt * 32 * TP, TP, KT + nt * 32 * TP, TP, lane);
        bf16* o = C.str + ((size_t)(((b * NVC + vc) * 2 + dir) * 4 + h)) * 4096;
#pragma unroll
        for (int i = 0; i < 16; ++i) { const int p = pt * 32 + 8 * (i >> 2) + 4 * hi + (i & 3), n = nt * 32 + r32; o[p * 64 + n] = f2bf(a[i]); }
    }
}

DI int s2_order(int dir, int step) { return dir == 0 ? step : (step == 0 ? 1 : (step == 1 ? 0 : 35 - step)); }
DI void s2_item(const ScanCtx& C, int gt) {
    bf16* base; int hh, dir, b; size_t vcstride;
    if (gt < 65536) { const int v = gt & 1023, h = (gt >> 10) & 3; dir = (gt >> 12) & 1; b = gt >> 13; hh = h; base = C.sts + (size_t)((b * NVC * 2 + dir) * 4 + h) * 8192 + v * 8; vcstride = (size_t)2 * 4 * 8192; }
    else if (gt < 65536 + 32768) { const int g2 = gt - 65536; const int v = g2 & 511, h = (g2 >> 9) & 3; dir = (g2 >> 11) & 1; b = g2 >> 12; hh = 4 + h; base = C.str + (size_t)((b * NVC * 2 + dir) * 4 + h) * 4096 + v * 8; vcstride = (size_t)2 * 4 * 4096; }
    else return;
    float s[8]; float zf = 0.f; asm volatile("" : "+v"(zf));
#pragma unroll
    for (int i = 0; i < 8; ++i) s[i] = zf;
#define S2_LD(k, st_) { const int vc_ = s2_order(dir, (st_)); v##k = *(const u32x4*)(base + (size_t)vc_ * vcstride); d##k = C.dec[(size_t)((b * NVC + vc_) * 2 + dir) * 8 + hh]; }
#define S2_ST(k, st_) { const int vc_ = s2_order(dir, (st_)); u32x4 w_; w_.x = pk2(s[0], s[1]); w_.y = pk2(s[2], s[3]); w_.z = pk2(s[4], s[5]); w_.w = pk2(s[6], s[7]); \
        *(u32x4*)(base + (size_t)vc_ * vcstride) = w_; \
        s[0] = s[0] * d##k + bflo(v##k.x); s[1] = s[1] * d##k + bfhi(v##k.x); s[2] = s[2] * d##k + bflo(v##k.y); s[3] = s[3] * d##k + bfhi(v##k.y); \
        s[4] = s[4] * d##k + bflo(v##k.z); s[5] = s[5] * d##k + bfhi(v##k.z); s[6] = s[6] * d##k + bflo(v##k.w); s[7] = s[7] * d##k + bfhi(v##k.w); }
    u32x4 v0, v1, v2, v3, v4, v5, v6, v7; float d0, d1, d2, d3, d4, d5, d6, d7;
    S2_LD(0, 0) S2_LD(1, 1) S2_LD(2, 2) S2_LD(3, 3) S2_LD(4, 4) S2_LD(5, 5) S2_LD(6, 6) S2_LD(7, 7)
#pragma unroll 1
    for (int step = 0; step < 32; step += 8) {
        S2_ST(0, step) if (step + 8 < NVC) S2_LD(0, step + 8)
        S2_ST(1, step + 1) if (step + 9 < NVC) S2_LD(1, step + 9)
        S2_ST(2, step + 2) if (step + 10 < NVC) S2_LD(2, step + 10)
        S2_ST(3, step + 3) if (step + 11 < NVC) S2_LD(3, step + 11)
        S2_ST(4, step + 4) if (step + 12 < NVC) S2_LD(4, step + 12)
        S2_ST(5, step + 5) if (step + 13 < NVC) S2_LD(5, step + 13)
        S2_ST(6, step + 6) if (step + 14 < NVC) S2_LD(6, step + 14)
        S2_ST(7, step + 7) if (step + 15 < NVC) S2_LD(7, step + 15)
    }
    S2_ST(0, 32) S2_ST(1, 33)
#undef S2_LD
#undef S2_ST
}

DI void s2_phase(const ScanCtx& C, int tid, int bid, int G) {
#pragma unroll 1
    for (int gt = bid * NTHREADS + tid; gt < 65536 + 32768; gt += G * NTHREADS) s2_item(C, gt);
}

DI void s3_ssd_unit(LAS unsigned char* lds, int tid, const ScanCtx& C, int b, int vc) {
    asm volatile("" : "+v"(tid));
    const int lane = tid & 63, wave = tid >> 6, r32 = lane & 31, hi = lane >> 5;
    LAS float* sc = (LAS float*)lds; LAS float* stat = (LAS float*)(lds + L_STAT);
    LAS bf16* Cq = (LAS bf16*)(lds + L_BUF); LAS bf16* BkM = (LAS bf16*)(lds + L_BUF + 34816); LAS bf16* XsT = (LAS bf16*)(lds + L_BUF + 2 * 34816);
    LAS bf16* Hf = (LAS bf16*)(lds + L_BUF + 2 * 34816 + 17408); LAS bf16* Hb = (LAS bf16*)(lds + L_BUF + 2 * 34816 + 2 * 17408);
    const int row0 = vc_row0(b, vc);
    const int pt = wave & 1, tt = wave >> 1;
    const bf16* Urow = C.U + (size_t)row0 * UW;
    __syncthreads();
    ssd_scalars(sc, tid, C.DT, row0, C.alog, C.dtb, nullptr, nullptr);
    float ssq = 0.f;
    const int tq_ = tt * 32 + r32; const int rowq = row0 + tq_;
#pragma unroll 1
    for (int g = 0; g < 2; ++g) {
        __syncthreads();
        stage_N<128, 128>(Cq, TP, Urow + 512 + g * 128, UW, tid);
        stage_N<128, 128>(BkM, TP, Urow + 256 + g * 128, UW, tid);
        __syncthreads();
        f32x16 gacc0, gacc1;
        { const int id = 2 * wave, st = id & 3, tq = id >> 2; gacc0 = mma_lds<8>(zero16(), BkM + st * 32 * TP, TP, Cq + tq * 32 * TP, TP, lane); }
        { const int id = 2 * wave + 1, st = id & 3, tq = id >> 2; gacc1 = mma_lds<8>(zero16(), BkM + st * 32 * TP, TP, Cq + tq * 32 * TP, TP, lane); }
#pragma unroll 1
        for (int hh = 0; hh < 2; ++hh) {
            const int h = 2 * g + hh;
            __syncthreads();
            const int oct_ = tid & 7, tp_ = tid >> 3;
            const u32x4 xr0 = *(const u32x4*)(Urow + h * 64 + (size_t)(2 * tp_) * UW + oct_ * 8), xr1 = *(const u32x4*)(Urow + h * 64 + (size_t)(2 * tp_ + 1) * UW + oct_ * 8);
            const bf16* sfp = C.sts + ((size_t)(((b * NVC + vc) * 2 + 0) * 4 + h)) * 8192; const bf16* sbp = C.sts + ((size_t)(((b * NVC + vc) * 2 + 1) * 4 + h)) * 8192;
            u32x4 hfv[2], hbv[2];
#pragma unroll
            for (int i = 0; i < 2; ++i) { const int itn = tid + NTHREADS * i, octn = itn & 15, rn = itn >> 4; hfv[i] = *(const u32x4*)(sfp + rn * 128 + octn * 8); hbv[i] = *(const u32x4*)(sbp + rn * 128 + octn * 8); }
            u32x2 zz[4];
#pragma unroll
            for (int g4 = 0; g4 < 4; ++g4) zz[g4] = *(const u32x2*)(C.P + (size_t)rowq * NIN + 1536 + h * 64 + pt * 32 + 8 * g4 + 4 * hi);
            { const LAS float* acf = sc + (SC_ACF * 4 + h) * 128; const LAS float* acb = sc + (SC_ACB * 4 + h) * 128; const LAS float* d0 = sc + (SC_DT0 * 4 + h) * 128; const LAS float* d1 = sc + (SC_DT1 * 4 + h) * 128;
#pragma unroll
              for (int q = 0; q < 2; ++q) { const int id = 2 * wave + q, st = id & 3, tq = id >> 2; const int t = tq * 32 + r32; const float aft = acf[t], abt = acb[t];
#pragma unroll
                  for (int g4 = 0; g4 < 4; ++g4) { float mv[4];
#pragma unroll
                      for (int j = 0; j < 4; ++j) { const int s = st * 32 + 8 * g4 + 4 * hi + j;
                          float f; if (s < t) f = __expf(aft - acf[s]) * d0[s]; else if (s > t) f = __expf(abt - acb[s]) * d1[s]; else f = d0[s] + d1[s];
                          mv[j] = (q ? gacc1[4 * g4 + j] : gacc0[4 * g4 + j]) * f; }
                      u32x2 w; w.x = pk2(mv[0], mv[1]); w.y = pk2(mv[2], mv[3]);
                      *(LAS u32x2*)(BkM + t * TP + st * 32 + 8 * g4 + 4 * hi) = w; } } }
            { const unsigned a_[4] = {xr0.x, xr0.y, xr0.z, xr0.w}, b_[4] = {xr1.x, xr1.y, xr1.z, xr1.w};
#pragma unroll
              for (int k = 0; k < 4; ++k) {
                  *(LAS unsigned*)(XsT + (oct_ * 8 + 2 * k) * TP + 2 * tp_) = (a_[k] & 0xffffu) | (b_[k] << 16);
                  *(LAS unsigned*)(XsT + (oct_ * 8 + 2 * k + 1) * TP + 2 * tp_) = (a_[k] >> 16) | (b_[k] & 0xffff0000u); }
#pragma unroll
              for (int i = 0; i < 2; ++i) { const int itn = tid + NTHREADS * i, octn = itn & 15, rn = itn >> 4; *(LAS u32x4*)(Hf + rn * TP + octn * 8) = hfv[i]; *(LAS u32x4*)(Hb + rn * TP + octn * 8) = hbv[i]; } }
            __syncthreads();
            f32x16 y = mma_lds<8>(zero16(), XsT + pt * 32 * TP, TP, BkM + tt * 32 * TP, TP, lane);
            { const float dsum = C.ssmd[h] + C.ssmd[4 + h];
#pragma unroll
              for (int i = 0; i < 16; ++i) { const int p = pt * 32 + 8 * (i >> 2) + 4 * hi + (i & 3); y[i] += dsum * bf2f(XsT[p * TP + tq_]); } }
            __builtin_amdgcn_sched_barrier(0);
            { const f32x16 af = mma_lds<8>(zero16(), Hf + pt * 32 * TP, TP, Cq + tt * 32 * TP, TP, lane);
              const float ef = __expf(sc[(SC_ACF * 4 + h) * 128 + tq_]);
#pragma unroll
              for (int i = 0; i < 16; ++i) y[i] += ef * af[i]; }
            __builtin_amdgcn_sched_barrier(0);
            { const f32x16 ab = mma_lds<8>(zero16(), Hb + pt * 32 * TP, TP, Cq + tt * 32 * TP, TP, lane);
              const float eb = __expf(sc[(SC_ACB * 4 + h) * 128 + tq_]);
#pragma unroll
              for (int i = 0; i < 16; ++i) y[i] += eb * ab[i]; }
#pragma unroll
            for (int g4 = 0; g4 < 4; ++g4) {
                const int p = pt * 32 + 8 * g4 + 4 * hi;
                const float v0 = y[4 * g4] * silu_f(bflo(zz[g4].x)), v1 = y[4 * g4 + 1] * silu_f(bfhi(zz[g4].x)), v2 = y[4 * g4 + 2] * silu_f(bflo(zz[g4].y)), v3 = y[4 * g4 + 3] * silu_f(bfhi(zz[g4].y));
                ssq += v0 * v0 + v1 * v1 + v2 * v2 + v3 * v3;
                u32x2 w; w.x = pk2(v0, v1); w.y = pk2(v2, v3);
                *(u32x2*)(C.MG + (size_t)rowq * DM + 512 + h * 64 + p) = w;
            }
        }
    }
    ssq += __shfl_xor(ssq, 32);
    __syncthreads();
    if (hi == 0) stat[tq_ * 2 + pt] = ssq;
    __syncthreads();
    const float rn = 1.0f / sqrtf((stat[tq_ * 2] + stat[tq_ * 2 + 1]) * (1.0f / 256.0f) + 1e-6f);
#pragma unroll
    for (int h = 0; h < 4; ++h)
#pragma unroll
        for (int g4 = 0; g4 < 4; ++g4) {
            const int p = pt * 32 + 8 * g4 + 4 * hi;
            const f32x4 gv = *(const f32x4*)(C.ssmg + h * 64 + p);
            u32x2* mp = (u32x2*)(C.MG + (size_t)rowq * DM + 512 + h * 64 + p);
            const u32x2 v = *mp;
            u32x2 w; w.x = pk2(bflo(v.x) * rn * gv.x, bfhi(v.x) * rn * gv.y); w.y = pk2(bflo(v.y) * rn * gv.z, bfhi(v.y) * rn * gv.w);
            *mp = w;
        }
}
DI void s3_ret_unit(LAS unsigned char* lds, int tid, const ScanCtx& C, int b, int vc, int h0, int nh) {
    asm volatile("" : "+v"(tid));
    const int lane = tid & 63, wave = tid >> 6, r32 = lane & 31, hi = lane >> 5;
    LAS float* stat = (LAS float*)(lds + L_STAT);
    LAS bf16* Q = (LAS bf16*)(lds + L_BUF); LAS bf16* K = (LAS bf16*)(lds + L_BUF + 18432); LAS bf16* VT = (LAS bf16*)(lds + L_BUF + 2 * 18432);
    LAS bf16* Hf = (LAS bf16*)(lds + L_BUF + 2 * 18432 + 17408); LAS bf16* Hb = (LAS bf16*)(lds + L_BUF + 2 * 18432 + 17408 + 9216); LAS bf16* MB = (LAS bf16*)(lds + L_BUF + 2 * 18432 + 17408 + 2 * 9216);
    const int row0 = vc_row0(b, vc);
    const int pt = wave & 1, tt = wave >> 1;
    const bf16* Prow = C.P + (size_t)row0 * NIN;
    const int t = tt * 32 + r32; const int row = row0 + t;
#pragma unroll 1
    for (int h = h0; h < h0 + nh; ++h) {
        const float lg0 = C.rlg[h], lg1 = C.rlg[4 + h];
        __syncthreads();
        stage_N<128, 64>(Q, QP, Prow + 2560 + h * 64, NIN, tid);
        stage_N<128, 64>(K, QP, Prow + 2816 + h * 64, NIN, tid);
        stage_T<64, false>(VT, VT, Prow + 3072 + h * 64, NIN, nullptr, nullptr, tid);
        stage_N<64, 64>(Hf, QP, C.str + ((size_t)(((b * NVC + vc) * 2 + 0) * 4 + h)) * 4096, 64, tid);
        stage_N<64, 64>(Hb, QP, C.str + ((size_t)(((b * NVC + vc) * 2 + 1) * 4 + h)) * 4096, 64, tid);
        __syncthreads();
#pragma unroll
        for (int q = 0; q < 2; ++q) { const int id = 2 * wave + q, st = id & 3, tq = id >> 2;
            const f32x16 gacc = mma_lds<4>(zero16(), K + st * 32 * QP, QP, Q + tq * 32 * QP, QP, lane);
            const int t2 = tq * 32 + r32;
#pragma unroll
            for (int g4 = 0; g4 < 4; ++g4) { float mv[4];
#pragma unroll
                for (int j = 0; j < 4; ++j) { const int s = st * 32 + 8 * g4 + 4 * hi + j;
                    const float f = (s < t2) ? __expf((float)(t2 - s) * lg0) : ((s > t2) ? __expf((float)(s - t2) * lg1) : 2.0f);
                    mv[j] = gacc[4 * g4 + j] * f; }
                u32x2 w; w.x = pk2(mv[0], mv[1]); w.y = pk2(mv[2], mv[3]);
                *(LAS u32x2*)(MB + t2 * TP + st * 32 + 8 * g4 + 4 * hi) = w; } }
        __syncthreads();
        u32x2 ggv[4];
#pragma unroll
        for (int g4 = 0; g4 < 4; ++g4) ggv[g4] = *(const u32x2*)(C.P + (size_t)row * NIN + 3328 + h * 64 + pt * 32 + 8 * g4 + 4 * hi);
        f32x16 y = mma_lds<8>(zero16(), VT + pt * 32 * TP, TP, MB + tt * 32 * TP, TP, lane);
        { const f32x16 af = mma_lds<4>(zero16(), Hf + pt * 32 * QP, QP, Q + tt * 32 * QP, QP, lane);
          const float ef = __expf((float)(t + 1) * lg0);
#pragma unroll
          for (int i = 0; i < 16; ++i) y[i] += ef * af[i]; }
        { const f32x16 ab = mma_lds<4>(zero16(), Hb + pt * 32 * QP, QP, Q + tt * 32 * QP, QP, lane);
          const float eb = __expf((float)(128 - t) * lg1);
#pragma unroll
          for (int i = 0; i < 16; ++i) y[i] += eb * ab[i]; }
        float s1 = 0.f, s2 = 0.f;
#pragma unroll
        for (int i = 0; i < 16; ++i) { s1 += y[i]; s2 += y[i] * y[i]; }
        s1 += __shfl_xor(s1, 32); s2 += __shfl_xor(s2, 32);
        if (hi == 0) { stat[(t * 2 + pt) * 2] = s1; stat[(t * 2 + pt) * 2 + 1] = s2; }
        __syncthreads();
        const float t1 = stat[(t * 2) * 2] + stat[(t * 2 + 1) * 2], t2s = stat[(t * 2) * 2 + 1] + stat[(t * 2 + 1) * 2 + 1];
        const float mean = t1 * (1.0f / 64.0f), var = fmaxf(t2s * (1.0f / 64.0f) - mean * mean, 0.f), rs = 1.0f / sqrtf(var + 1e-5f);
#pragma unroll
        for (int g4 = 0; g4 < 4; ++g4) {
            const int p = pt * 32 + 8 * g4 + 4 * hi;
            const float g0 = silu_f(bflo(ggv[g4].x)), g1 = silu_f(bfhi(ggv[g4].x)), g2 = silu_f(bflo(ggv[g4].y)), g3 = silu_f(bfhi(ggv[g4].y));
            u32x2 w; w.x = pk2((y[4 * g4] - mean) * rs * g0, (y[4 * g4 + 1] - mean) * rs * g1); w.y = pk2((y[4 * g4 + 2] - mean) * rs * g2, (y[4 * g4 + 3] - mean) * rs * g3);
            *(u32x2*)(C.MG + (size_t)row * DM + 768 + h * 64 + p) = w;
        }
    }
}

constexpr int NPP = 13, NPH = 2 + NPP * DEPTH;
#ifndef PMASK
#define PMASK 0xffff
#endif
#define PEN(k) ((PMASK >> (k)) & 1)
#ifndef PROBE_LASTONLY
#define PROBE_LASTONLY 0
#endif
#ifndef PROBE_N
#define PROBE_N 1
#endif
#ifndef REP_SPLIT
#define REP_SPLIT 1
#endif
#ifndef REP_P0
#define REP_P0 1
#endif
#ifndef REP_LN
#define REP_LN 1
#endif
#ifndef REP_SYNC
#define REP_SYNC 1
#endif
#ifndef REP_ATTN
#define REP_ATTN 1
#endif
#ifndef REP_UP
#define REP_UP 1
#endif
#ifndef REP_IN
#define REP_IN 1
#endif
#ifndef REP_SCAN
#define REP_SCAN 1
#endif

#define GAS __attribute__((address_space(1)))
#define XB_TMO      128
#define XB_XCNT(j)  (256  + 64 * (j))
#define XB_XSUB(j)  (1280 + 64 * (j))
#define XB_XGEN(j)  (2304 + 64 * (j))
#define XB_TOP      3328
#define XB_TOPGEN   3392
#define XCD_BAR_WORDS 3456
#define XB_SPIN_CAP (1u << 18)

__device__ __forceinline__ unsigned xb_ld(unsigned* p)              { return __hip_atomic_load(p, __ATOMIC_RELAXED, __HIP_MEMORY_SCOPE_AGENT); }
__device__ __forceinline__ unsigned xb_add(unsigned* p, unsigned v) { return __hip_atomic_fetch_add(p, v, __ATOMIC_RELAXED, __HIP_MEMORY_SCOPE_AGENT); }
__device__ __forceinline__ unsigned xb_xcc_id() { return (unsigned)__builtin_amdgcn_s_getreg((3 << 11) | 20) & 0xFu; }
#define XB_SPIN(cond, bar) do { unsigned _sp = 0; while (cond) { __builtin_amdgcn_s_sleep(1); \
    if ((++_sp & 255u) == 0u) { if (xb_ld(&(bar)[XB_TMO])) break; if (_sp > XB_SPIN_CAP) { atomicAdd(&(bar)[XB_TMO], 1u); break; } } } } while (0)

struct XcdBarrier {
    unsigned* bar; unsigned x;
    volatile LAS unsigned* st;
};

__device__ __forceinline__ XcdBarrier xcd_barrier_post(unsigned* bar, volatile LAS unsigned* st) {
    XcdBarrier b; b.bar = bar; b.x = xb_xcc_id(); b.st = st;
    if (threadIdx.x == 0) (void)xb_add(&bar[XB_XCNT(b.x)], 1u);
    return b;
}
__device__ __forceinline__ void xcd_barrier_complete(unsigned* bar, unsigned x, unsigned& nloc, unsigned& nx) {
    const unsigned G = gridDim.x * gridDim.y * gridDim.z;
    unsigned sum, cnt, mine, sp = 0u;
    for (;;) {
        sum = 0u; cnt = 0u; mine = 0u;
#pragma unroll
        for (unsigned j = 0; j < 16; ++j) { const unsigned c = xb_ld(&bar[XB_XCNT(j)]); sum += c; cnt += (c > 0u) ? 1u : 0u; mine = (j == x) ? c : mine; }
        if (sum == G) break;
        __builtin_amdgcn_s_sleep(1);
        if ((++sp & 255u) == 0u) { if (xb_ld(&bar[XB_TMO])) break; if (sp > XB_SPIN_CAP) { atomicAdd(&bar[XB_TMO], 1u); break; } }
    }
    nloc = mine > 0u ? mine : 1u; nx = cnt > 0u ? cnt : 1u;
}

__device__ __forceinline__ void xcd_barrier(const XcdBarrier& b) {
    asm volatile("s_waitcnt vmcnt(0)" ::: "memory");
    __syncthreads();
    if (threadIdx.x == 0) {
        unsigned* bar = b.bar;
        __builtin_amdgcn_s_waitcnt(0);
        unsigned nloc = b.st[0], nx = b.st[1];
        if (nloc == 0u) { xcd_barrier_complete(bar, b.x, nloc, nx); b.st[0] = nloc; b.st[1] = nx; }
        const unsigned old = xb_add(&bar[XB_XSUB(b.x)], 1u);
        const unsigned gen = old / nloc;
        if (old + 1u == (gen + 1u) * nloc) {
            __builtin_amdgcn_fence(__ATOMIC_RELEASE, "agent");
            asm volatile("s_waitcnt vmcnt(0)" ::: "memory");
            const unsigned og = xb_add(&bar[XB_TOP], 1u);
            const unsigned tg = og / nx;
            if (og + 1u == (tg + 1u) * nx) xb_add(&bar[XB_TOPGEN], 1u);
            else XB_SPIN(xb_ld(&bar[XB_TOPGEN]) == tg, bar);
            __builtin_amdgcn_fence(__ATOMIC_ACQUIRE, "agent");
            xb_add(&bar[XB_XGEN(b.x)], 1u);
            asm volatile("s_waitcnt vmcnt(0)" ::: "memory");
        } else {
            XB_SPIN(xb_ld(&bar[XB_XGEN(b.x)]) == gen, bar);
            __builtin_amdgcn_fence(__ATOMIC_ACQUIRE, "agent");
            asm volatile("s_waitcnt vmcnt(0)" ::: "memory");
        }
    }
    __syncthreads();
}
template <class Epi> DI void run_gemm(LAS unsigned char* lds, int tid, const bf16* Ap, const bf16* Bt, int M, int N, int K, int G, int bid, const Epi& E, int ld = 0) {
    pg8::Gemm g{Ap, Bt, M, N, K, ld ? ld : K}; pg8::StaticOrder S; S.init(M, N, G, bid);
    pg8::gemm_phase<Epi, pg8::StaticOrder, true, true>(lds, g, S, E, tid);
}

__global__ void __launch_bounds__(NTHREADS, 2) mega(Args A) {
    extern __shared__ __attribute__((aligned(16))) unsigned char lds_raw[];
    LAS unsigned char* lds = (LAS unsigned char*)lds_raw;
    cg::grid_group grid = cg::this_grid();
    const int tid0 = threadIdx.x, bid0 = blockIdx.x, G0 = gridDim.x;
    { volatile LAS unsigned* bst0 = (volatile LAS unsigned*)(lds + LDS_BYTES - 64); if (tid0 < 16) bst0[tid0] = 0u;
      if (bid0 == 0) { unsigned* bw = (unsigned*)(A.ws + WS_BAR); for (int i = tid0; i < XCD_BAR_WORDS; i += NTHREADS) bw[i] = 0u; } }
    __syncthreads();
    int rep_done = 0; (void)rep_done;
    for (int ph = A.ph_lo; ph < A.ph_hi; ++ph) {
        if (ph > A.ph_lo) {
            if (ph == A.ph_lo + 1) { grid.sync(); (void)xcd_barrier_post((unsigned*)(A.ws + WS_BAR), (volatile LAS unsigned*)(lds + LDS_BYTES - 64)); }
            else { for (int rs_ = 0; rs_ < REP_SYNC; ++rs_) { XcdBarrier xb_; xb_.bar = (unsigned*)(A.ws + WS_BAR); xb_.x = xb_xcc_id(); xb_.st = (volatile LAS unsigned*)(lds + LDS_BYTES - 64); xcd_barrier(xb_); } }
        }
        int tid = tid0, bid = bid0, G = G0; size_t zoff = 0;
        asm volatile("" : "+v"(tid)); asm volatile("" : "+s"(bid)); asm volatile("" : "+s"(G)); asm volatile("" : "+s"(zoff));
        unsigned char* ws = A.ws + zoff;
        float* xc = (float*)(ws + WS_XC);
        bf16* Abuf = (bf16*)(ws + WS_A); bf16* HP = (bf16*)(ws + WS_HP); bf16* Vt = (bf16*)(ws + WS_VT);
        const float* MOD = (const float*)(ws + WS_MOD);
        if (ph == 0) { if (PEN(0)) for (int rp_ = 0; rp_ < REP_P0; ++rp_) { p0a_phase(A, lds, tid, bid, G); __syncthreads(); } continue; }
        if (ph == 1) { if (PEN(1)) for (int rp_ = 0; rp_ < REP_LN; ++rp_) lnmod_phase(A, lds, tid, bid, G, true, -1, 0, 0, 0, false, M_ALL, false, nullptr, nullptr); continue; }
        const int q = ph - 2, l = q / NPP; int s = q % NPP; const bool is_conv = (s == 4); if (s >= 4) s -= 1; if (is_conv) s = 100;
        const bool last = (l == DEPTH - 1);
        const int Mpost = last ? M_LAT : M_ALL;
        if ((s == 0 || s == 9) && PEN(2)) {
            const int f = (s == 9); EpiSwiglu E{HP};
            for (int rp_ = 0; rp_ < REP_UP; ++rp_) run_gemm(lds, tid, Abuf, (const bf16*)(ws + WS_WGU) + (size_t)f * NGU * DM, f ? Mpost : M_ALL, NGU, DM, G, bid, E);
        } else if ((s == 1 || s == 10 || s == 7) && PEN(3)) {
            const int i = (s == 1) ? 0 : (s == 7 ? 1 : 2);
            const int prev_idx = (i == 0) ? (l == 0 ? -1 : (l - 1) * 3 + 2) : l * 3 + (i - 1);
            const float* modg_p = MOD + (size_t)l * 9 * 9216 + i * 3072 + 2048;
            const float* scale_v = (s == 7) ? (const float*)(ws + WS_ONES) : (const float*)(ws + WS_HALVES);
            const float* gprev_p = prev_idx < 0 ? (const float*)(ws + WS_ONES) : A.in[I_NG] + prev_idx * DM; const float* bprev_p = prev_idx < 0 ? (const float*)(ws + WS_ZEROS) : A.in[I_NB] + prev_idx * DM;
            EpiResid E{(bf16*)(ws + WS_X16), modg_p, scale_v, (const f32x2*)(ws + WS_STAT), gprev_p, bprev_p};
            const bool has_ctx = (s == 1) || !last;
            const bf16* Ap = (s == 7) ? Abuf : HP; const bf16* Bp = (s == 7) ? (const bf16*)(ws + WS_WOUT) : (const bf16*)(ws + WS_WDN) + (size_t)(s == 10) * DM * DFF;
            const int Kd = (s == 7) ? DM : DFF;
            const int ldd = (s == 7) ? DM : DFF;
            run_gemm(lds, tid, Ap, Bp, M_LAT, DM, Kd, G, bid, E, ldd);
            if (has_ctx) {
                const int sb = (G == 256 && ((bid >> 3) & 7) < 4 && bid < 256) ? ((bid & 7) | (((bid >> 3) & 3) << 3) | ((bid >> 6) << 5)) : (G == 256 ? 999 : (bid + G - 64) % G);
                const int qd = (sb >> 5) & 3;
                const int kt0 = (s == 7) ? 4 * qd : (qd < 2 ? 12 * qd : 24 + 10 * (qd - 2));
                const int ktn = (s == 7) ? 4 : (qd < 2 ? 12 : 10);
                OneUnit S1u; S1u.have = sb < 128; S1u.u.pm = 128 + (sb & 7); S1u.u.pn = (sb >> 3) & 3;
                EpiPartial Ep{(float*)(ws + WS_T) + (size_t)qd * M_CTX * DM, modg_p, scale_v};
                pg8::Gemm g2{Ap + (size_t)kt0 * 64, Bp + (size_t)kt0 * 64, M_ALL, DM, ktn * 64, ldd};
                pg8::gemm_phase<EpiPartial, OneUnit, true, true>(lds, g2, S1u, Ep, tid);
            }
        } else if (s == 2 && PEN(1)) {
            lnmod_phase(A, lds, tid, bid, G, false, l, 0, l, 1, true, M_ALL, true, l == 0 ? (const float*)(ws + WS_ONES) : A.in[I_NG] + ((l - 1) * 3 + 2) * DM, l == 0 ? (const float*)(ws + WS_ZEROS) : A.in[I_NB] + ((l - 1) * 3 + 2) * DM);
        } else if (s == 3 && PEN(4)) {
            EpiIn E{HP, Vt, (const f32x2*)(ws + WS_TATT), (const f32x2*)(ws + WS_TRET)};
            for (int rp_ = 0; rp_ < REP_IN; ++rp_) run_gemm(lds, tid, Abuf, (const bf16*)(ws + WS_WIN), M_ALL, NIN, DM, G, bid, E);
        } else if (is_conv || s == 4 || s == 5 || s == 6) {
            ScanCtx C{HP, (const bf16*)(ws + WS_U), (const float*)(ws + WS_DT), (bf16*)(ws + WS_STS), (bf16*)(ws + WS_STR), (float*)(ws + WS_DEC), Abuf,
                      A.in[I_CONVW] + (size_t)l * 5 * 768, A.in[I_CONVB] + l * 768, A.in[I_ALOG] + l * 8, A.in[I_DTB] + l * 8, A.in[I_SSMD] + l * 8, A.in[I_SSMG] + l * 256, A.in[I_RLG] + l * 8};
            const float lam = ((const float*)(ws + WS_LAM))[l];
            const float lam_init = 0.8f - 0.6f * expf(-0.3f * (float)l);
            const float* subg = A.in[I_SUBG] + l * 128;
            const int r = is_conv ? 0 : s - 3;
            if (PEN(7)) for (int rp_ = 0; rp_ < REP_ATTN; ++rp_) for (int u = bid; u < 256; u += G) { const int bh = r * 8 + (u & 7), qb = u >> 3;
                attn_unit(lds, tid, HP, Vt, Abuf, bh >> 2, bh & 3, (bh >> 2) * SEQ + qb * 128, 0, 68, lam, 1.0f - lam_init, subg); }
            if (is_conv) {
                if (PEN(10)) conv_phase(HP, (bf16*)(ws + WS_U), C.cw, C.cb, tid, bid, G);
            } else if (s == 4) {
                { const int nS1 = NB * NVC, extra1 = (nS1 > G && nS1 < 2 * G) ? nS1 - G : 0;
                  if (PEN(5)) { for (int u = bid; u < nS1; u += G) s1_ssd_unit(lds, tid, C, u / NVC, u % NVC);
                      if (bid >= extra1) for (int r = bid - extra1; r < 4 * nS1; r += G - extra1) { const int v = r >> 2; s1_ret_unit(lds, tid, C, v / NVC, v % NVC, r & 3, 1); } } }
            } else if (s == 5) {
                if (PEN(6)) s2_phase(C, tid, bid, G);
            } else {
                const int vc0 = last ? 2 : 0, nvc = NVC - vc0;
                const int nS = NB * nvc, extra = (nS > G && nS < 2 * G) ? nS - G : 0;
                if (PEN(8)) for (int u = bid; u < nS; u += G) s3_ssd_unit(lds, tid, C, u / nvc, vc0 + u % nvc);
                if (PEN(9) && bid >= extra) for (int r = bid - extra; r < 4 * nS; r += G - extra) { const int v = r >> 2; s3_ret_unit(lds, tid, C, v / nvc, vc0 + v % nvc, r & 3, 1); }
                if (!last && PEN(7)) for (int u = (bid + G - 64) % G; u < 64; u += G) { const int bh = u >> 1; attn_unit(lds, tid, HP, Vt, Abuf, bh >> 2, bh & 3, M_LAT + (bh >> 2) * CTXL + (u & 1) * 128, 64, 68, lam, 1.0f - lam_init, subg); }
            }
        } else if (s == 8 && PEN(1)) {
            lnmod_phase(A, lds, tid, bid, G, false, l, 1, l, 2, false, Mpost, !last, A.in[I_NG] + (l * 3) * DM, A.in[I_NB] + (l * 3) * DM);
        } else if (s == 11 && PEN(1)) {
            lnmod_phase(A, lds, tid, bid, G, false, l, 2, last ? -1 : l + 1, 0, false, Mpost, !last, A.in[I_NG] + (l * 3 + 1) * DM, A.in[I_NB] + (l * 3 + 1) * DM);
            if (!last) convw_phase(A, l + 1, lds, tid, bid, G);
        }
#ifdef PROBE_S
        if ((s == (PROBE_S) || s == (PROBE_S2)) && (PROBE_LASTONLY == 0 || last) && rep_done < PROBE_N) { ++rep_done; --ph; } else rep_done = 0;
#endif
    }
}

extern "C" void kernel_launch(void* const* d_in, const int* in_sizes, int n_in, void* d_out, int out_size, void* d_ws, size_t ws_size, hipStream_t stream) {
    static int grid = 0;
    if (grid == 0) {
        if (n_in != 22 || in_sizes[0] != M_LAT * DM || out_size != M_LAT * DM || ws_size < WS_END) { fprintf(stderr, "kernel_launch: unexpected shapes (n_in %d, out %d, ws %zu)\n", n_in, out_size, ws_size); grid = -1; return; }
        int dev = 0, cus = 0, per_cu = 0;
        hipGetDevice(&dev); hipDeviceGetAttribute(&cus, hipDeviceAttributeMultiprocessorCount, dev);
        if (hipFuncSetAttribute((const void*)mega, hipFuncAttributeMaxDynamicSharedMemorySize, LDS_BYTES) != hipSuccess) { fprintf(stderr, "kernel_launch: hipFuncSetAttribute failed\n"); grid = -1; return; }
        if (hipOccupancyMaxActiveBlocksPerMultiprocessor(&per_cu, (const void*)mega, NTHREADS, LDS_BYTES) != hipSuccess || per_cu < 1) { fprintf(stderr, "kernel_launch: occupancy query says %d\n", per_cu); per_cu = 1; }
        (void)hipGetLastError();
        grid = cus * 1;
    }
    if (grid < 0) return;
    Args a{};
    for (int i = 0; i < 22; ++i) a.in[i] = (const float*)d_in[i];
    a.out = (float*)d_out; a.ws = (unsigned char*)d_ws;
    for (int i = 0; i < 16; ++i) a.afreq[i] = 1.0f / powf(10000.0f, (float)(2 * i) / 32.0f);
    for (int i = 0; i < 32; ++i) a.rfreq[i] = 1.0f / powf(10000.0f, (float)i / 31.0f);
#ifdef MK_MULTI
    for (int ph = 0; ph < NPH; ++ph) { a.ph_lo = ph; a.ph_hi = ph + 1; hipLaunchKernelGGL(mega, dim3(grid), dim3(NTHREADS), LDS_BYTES, stream, a); }
#else
    a.ph_lo = 0; a.ph_hi = NPH;
    void* args[] = {&a};
    hipError_t e = hipLaunchCooperativeKernel((const void*)mega, dim3(grid), dim3(NTHREADS), args, LDS_BYTES, stream);
    if (e != hipSuccess) fprintf(stderr, "cooperative launch failed: %s (grid %d)\n", hipGetErrorString(e), grid);
#endif
}
```

```cpp
#include <hip/hip_runtime.h>
#include <hip/hip_cooperative_groups.h>
#include <cstdio>
#include <cstdint>
#include <cmath>
namespace cg = cooperative_groups;

namespace pg8 {
#define PG8_LAS __attribute__((address_space(3)))
typedef unsigned short bf16_t;
typedef short bf16x8 __attribute__((ext_vector_type(8)));
typedef float f32x4 __attribute__((ext_vector_type(4)));
typedef unsigned u32x4 __attribute__((ext_vector_type(4)));
constexpr int BM = 256, BK = 64, HALF = 128, HTB = HALF * BK * 2  , STAGE_BYTES = 8 * HTB, NXCD = 8, WGM = 8;

__host__ __device__ __forceinline__ int lds_byte(int r, int c) { const int st = (r >> 4) * 2 + (c >> 5), rr = r & 15, cc = c & 31, ob = rr * 64 + cc * 2; return st * 1024 + (ob ^ (((ob >> 9) & 1) << 5)); }
__host__ __device__ __forceinline__ void stage_rc(int b, int& R, int& C) { const int st = b / 1024, sb = b % 1024, swz = sb ^ (((sb >> 9) & 1) << 5); R = (st >> 1) * 16 + swz / 64; C = (st & 1) * 32 + (swz % 64) / 2; }
__host__ __device__ __forceinline__ int perm32(int rho) { const int n = rho >> 4, i = rho & 15; return 8 * (i >> 2) + 4 * n + (i & 3); }

struct Unit { int pm, pn; };
struct Gemm { const bf16_t* A; const bf16_t* Bt; int M, N, K, ld; };

struct StaticOrder {
    int nM, nN, nwg, G, c;
    __host__ __device__ void init(int M, int N, int G_, int c_) { nM = M / BM; nN = N / BM; nwg = nM * nN; G = G_; c = c_; }
    __host__ __device__ bool next(int i, Unit& u) const {
        const long L = (long)i * G + c; if (L >= nwg) return false;
        int wgid = (int)L; { const int q = nwg / NXCD, r = nwg % NXCD, xcd = wgid % NXCD, off = wgid / NXCD; wgid = (xcd < r ? xcd * (q + 1) : r * (q + 1) + (xcd - r) * q) + off; }
        const int nig = WGM * nN, gid = wgid / nig, fm = gid * WGM, gsz = (nM - fm) < WGM ? (nM - fm) : WGM;
        u.pm = fm + ((wgid % nig) % gsz); u.pn = (wgid % nig) / gsz; return true;
    }
    __device__ __forceinline__ void a_ready(const Unit&) const {}
    __device__ __forceinline__ void done(const Unit&) const {}
};

__device__ __forceinline__ unsigned cvt_pk_bf16(float lo, float hi) { unsigned r; asm volatile("v_cvt_pk_bf16_f32 %0, %1, %2" : "=v"(r) : "v"(lo), "v"(hi)); return r; }
template <class Epi, class Sched, bool ALIGN_EPI = false, bool SP2 = false>
__device__ __forceinline__ void gemm_phase(PG8_LAS unsigned char* lds, const Gemm g, const Sched& S, const Epi& E, const int tid) {
    const int wid = __builtin_amdgcn_readfirstlane(tid >> 6), lane = tid & 63, wr = wid >> 2, wc = wid & 3, fr = lane & 15, fq = lane >> 4;
    const int K = g.K, nt = K / BK;
    unsigned voffA[2], voffB[2];
#pragma unroll
    for (int i = 0; i < 2; ++i) { int R, C; stage_rc(tid * 16 + i * 8192, R, C); const int Rb = Epi::PERM ? ((R & ~31) + perm32(R & 31)) : R;
        voffA[i] = (unsigned)(R * g.ld + C) * 2u; voffB[i] = (unsigned)(Rb * g.ld + C) * 2u; }
    const size_t kstep = (size_t)(BK * 2);
    const size_t hstep = (size_t)HALF * g.ld * 2;
    const size_t tstep = 2 * hstep;
    const unsigned ldsw = (unsigned)wid * 1024u;
    const int aoff = lds_byte(wr * 64 + fr, fq * 8), boff = lds_byte(wc * 32 + fr, fq * 8);
#define PG8_SA(b, h) (((b) * 2 + (h)) * HTB)
#define PG8_SB(b, h) ((4 + (b) * 2 + (h)) * HTB)
#define PG8_STAGE(bufoff, gbase, voff) do { _Pragma("unroll") for (int _i = 0; _i < 2; ++_i) \
        __builtin_amdgcn_global_load_lds((const unsigned*)((const char*)(gbase) + (voff)[_i]), (PG8_LAS unsigned*)(lds + (bufoff) + ldsw + _i * 8192), 16, 0, 0); } while (0)
#define PG8_LDA(dst, b, h) do { _Pragma("unroll") for (int m = 0; m < 4; ++m) _Pragma("unroll") for (int k = 0; k < 2; ++k) dst[m][k] = *(const PG8_LAS bf16x8*)(lds + PG8_SA(b, h) + aoff + m * 2048 + k * 1024); } while (0)
#define PG8_LDB(dst, b, h) do { _Pragma("unroll") for (int n = 0; n < 2; ++n) _Pragma("unroll") for (int k = 0; k < 2; ++k) dst[n][k] = *(const PG8_LAS bf16x8*)(lds + PG8_SB(b, h) + boff + n * 2048 + k * 1024); } while (0)
#define PG8_MMA(ai, bj, At, Bt) do { __builtin_amdgcn_s_setprio(1); _Pragma("unroll") for (int m = 0; m < 4; ++m) _Pragma("unroll") for (int n = 0; n < 2; ++n) _Pragma("unroll") for (int k = 0; k < 2; ++k) \
        acc[ai][bj][m][n] = __builtin_amdgcn_mfma_f32_16x16x32_bf16(Bt[n][k], At[m][k], acc[ai][bj][m][n], 0, 0, 0); __builtin_amdgcn_s_setprio(0); } while (0)
#define PG8_WAIT_V(n) asm volatile("s_waitcnt vmcnt(" #n ")" ::: "memory")
#define PG8_WAIT_L(n) asm volatile("s_waitcnt lgkmcnt(" #n ")" ::: "memory")
#define PG8_BAR __builtin_amdgcn_s_barrier()
#define PG8_SCHED __builtin_amdgcn_sched_barrier(0)
    Unit cur, nxt; int ui = 0;
    if (!S.next(0, cur)) return;
    f32x4 acc[2][2][4][2];
#pragma unroll
    for (int a = 0; a < 2; ++a)
#pragma unroll
        for (int b = 0; b < 2; ++b)
#pragma unroll
            for (int m = 0; m < 4; ++m)
#pragma unroll
                for (int n = 0; n < 2; ++n) acc[a][b][m][n] = (f32x4){0.f, 0.f, 0.f, 0.f};
    bf16x8 At[4][2], B0[2][2], B1[2][2];
    const char* cA = (const char*)g.A + (size_t)cur.pm * tstep; const char* cB = (const char*)g.Bt + (size_t)cur.pn * tstep;
    S.a_ready(cur);
    if constexpr (SP2) {
        PG8_STAGE(PG8_SB(0, 0), cB, voffB); PG8_STAGE(PG8_SB(0, 1), cB + hstep, voffB); PG8_STAGE(PG8_SA(0, 0), cA, voffA); PG8_STAGE(PG8_SA(0, 1), cA + hstep, voffA);
        if (wr == 1) PG8_BAR;
        PG8_WAIT_V(2); PG8_BAR;
        PG8_STAGE(PG8_SB(1, 0), cB + kstep, voffB); PG8_STAGE(PG8_SA(1, 0), cA + kstep, voffA); PG8_STAGE(PG8_SB(1, 1), cB + hstep + kstep, voffB);
        PG8_WAIT_V(6); PG8_BAR;
    } else {
        PG8_STAGE(PG8_SB(0, 0), cB, voffB); PG8_STAGE(PG8_SA(0, 0), cA, voffA); PG8_STAGE(PG8_SB(0, 1), cB + hstep, voffB); PG8_STAGE(PG8_SA(0, 1), cA + hstep, voffA);
        if (wr == 1) PG8_BAR;
        PG8_WAIT_V(4); PG8_BAR;
        PG8_STAGE(PG8_SB(1, 0), cB + kstep, voffB); PG8_STAGE(PG8_SA(1, 0), cA + kstep, voffA); PG8_STAGE(PG8_SB(1, 1), cB + hstep + kstep, voffB);
        PG8_WAIT_V(6); PG8_BAR;
    }
    for (;;) {
        const bool has_next = S.next(ui + 1, nxt);
        const char* nA = has_next ? (const char*)g.A + (size_t)nxt.pm * tstep : cA; const char* nB = has_next ? (const char*)g.Bt + (size_t)nxt.pn * tstep : cB;
        for (int t = 0; t < nt; t += 2) {
            const bool last = (t == nt - 2);
            const char* a1 = cA + (size_t)(t + 1) * kstep;
            const char* a2 = last ? nA : cA + (size_t)(t + 2) * kstep; const char* b2 = last ? nB : cB + (size_t)(t + 2) * kstep;
            const char* a3 = a2 + kstep; const char* b3 = b2 + kstep;
            if (last && has_next) S.a_ready(nxt);
            if constexpr (SP2) {
            PG8_LDB(B0, 0, 0); PG8_LDB(B1, 0, 1); PG8_SCHED; PG8_LDA(At, 0, 0); PG8_STAGE(PG8_SA(1, 1), a1 + hstep, voffA);
            PG8_WAIT_V(8); PG8_WAIT_L(0); PG8_BAR; PG8_MMA(0, 0, At, B0); PG8_MMA(0, 1, At, B1); PG8_BAR; PG8_SCHED;
            PG8_LDA(At, 0, 1); PG8_STAGE(PG8_SB(0, 0), b2, voffB); PG8_STAGE(PG8_SB(0, 1), b2 + hstep, voffB); PG8_STAGE(PG8_SA(0, 0), a2, voffA);
            PG8_WAIT_V(8); PG8_WAIT_L(0); PG8_BAR; PG8_MMA(1, 0, At, B0); PG8_MMA(1, 1, At, B1); PG8_BAR; PG8_SCHED;
            PG8_LDB(B0, 1, 0); PG8_LDB(B1, 1, 1); PG8_SCHED; PG8_LDA(At, 1, 0); PG8_STAGE(PG8_SA(0, 1), a2 + hstep, voffA);
            PG8_WAIT_V(8); PG8_WAIT_L(0); PG8_BAR; PG8_MMA(0, 0, At, B0); PG8_MMA(0, 1, At, B1); PG8_BAR; PG8_SCHED;
            PG8_LDA(At, 1, 1); PG8_STAGE(PG8_SB(1, 0), b3, voffB); PG8_STAGE(PG8_SB(1, 1), b3 + hstep, voffB); PG8_STAGE(PG8_SA(1, 0), a3, voffA);
            PG8_WAIT_V(8); PG8_WAIT_L(0); PG8_BAR; PG8_MMA(1, 0, At, B0); PG8_MMA(1, 1, At, B1); PG8_BAR; PG8_SCHED;
            } else {
            PG8_LDB(B0, 0, 0); PG8_SCHED; PG8_LDA(At, 0, 0); PG8_STAGE(PG8_SA(1, 1), a1 + hstep, voffA);
            PG8_WAIT_L(8); PG8_BAR; PG8_WAIT_L(0); PG8_MMA(0, 0, At, B0); PG8_BAR; PG8_SCHED;
            PG8_LDB(B1, 0, 1); PG8_STAGE(PG8_SB(0, 0), b2, voffB);
            PG8_BAR; PG8_WAIT_L(0); PG8_MMA(0, 1, At, B1); PG8_BAR;
            PG8_LDA(At, 0, 1); PG8_STAGE(PG8_SA(0, 0), a2, voffA);
            PG8_BAR; PG8_WAIT_L(0); PG8_MMA(1, 0, At, B0); PG8_BAR; PG8_SCHED;
            PG8_STAGE(PG8_SB(0, 1), b2 + hstep, voffB);
            PG8_WAIT_V(6); PG8_BAR; PG8_MMA(1, 1, At, B1); PG8_BAR;
            PG8_LDB(B0, 1, 0); PG8_SCHED; PG8_LDA(At, 1, 0); PG8_STAGE(PG8_SA(0, 1), a2 + hstep, voffA);
            PG8_WAIT_L(8); PG8_BAR; PG8_WAIT_L(0); PG8_MMA(0, 0, At, B0); PG8_BAR; PG8_SCHED;
            PG8_LDB(B1, 1, 1); PG8_STAGE(PG8_SB(1, 0), b3, voffB);
            PG8_BAR; PG8_WAIT_L(0); PG8_MMA(0, 1, At, B1); PG8_BAR;
            PG8_LDA(At, 1, 1); PG8_STAGE(PG8_SA(1, 0), a3, voffA);
            PG8_BAR; PG8_WAIT_L(0); PG8_MMA(1, 0, At, B0); PG8_BAR; PG8_SCHED;
            PG8_STAGE(PG8_SB(1, 1), b3 + hstep, voffB);
            PG8_WAIT_V(6); PG8_BAR; PG8_MMA(1, 1, At, B1); PG8_BAR;
            }
        }
        if constexpr (ALIGN_EPI) { if (wr == 0) PG8_BAR; }
        if constexpr (!Epi::AFTER_DRAIN) { E(acc, cur, wr, wc, fr, fq); S.done(cur); }
        if (!has_next) break;
#pragma unroll
        for (int a = 0; a < 2; ++a)
#pragma unroll
            for (int b = 0; b < 2; ++b)
#pragma unroll
                for (int m = 0; m < 4; ++m)
#pragma unroll
                    for (int n = 0; n < 2; ++n) acc[a][b][m][n] = (f32x4){0.f, 0.f, 0.f, 0.f};
        cur = nxt; cA = nA; cB = nB; ++ui;
        if constexpr (ALIGN_EPI) { if (wr == 1) PG8_BAR; }
    }
    PG8_WAIT_V(0);
    if constexpr (!ALIGN_EPI) { if (wr == 0) PG8_BAR; }
    PG8_BAR;
    if constexpr (Epi::AFTER_DRAIN) { E.fused(acc, cur, wr, wc, fr, fq, lds, wid, lane); S.done(cur); }
#undef PG8_SA
#undef PG8_SB
#undef PG8_STAGE
#undef PG8_LDA
#undef PG8_LDB
#undef PG8_MMA
#undef PG8_WAIT_V
#undef PG8_WAIT_L
#undef PG8_BAR
#undef PG8_SCHED
}
}

#define DI __device__ __forceinline__
#define LAS __attribute__((address_space(3)))
typedef unsigned short bf16;
typedef short bf16x8 __attribute__((ext_vector_type(8)));
typedef float f32x4 __attribute__((ext_vector_type(4)));
typedef float f32x2 __attribute__((ext_vector_type(2)));
typedef float f32x16 __attribute__((ext_vector_type(16)));
typedef unsigned u32x4 __attribute__((ext_vector_type(4)));
typedef unsigned u32x2 __attribute__((ext_vector_type(2)));
typedef __bf16 bf16x2_t __attribute__((ext_vector_type(2)));

DI unsigned pk2(float lo, float hi) { f32x2 v = {lo, hi}; bf16x2_t b = __builtin_convertvector(v, bf16x2_t); return __builtin_bit_cast(unsigned, b); }
DI bf16 f2bf(float f) { return (bf16)(pk2(f, 0.f) & 0xffffu); }
DI float bf2f(bf16 v) { return __builtin_bit_cast(float, (unsigned)v << 16); }
DI float bflo(unsigned u) { return __builtin_bit_cast(float, u << 16); }
DI float bfhi(unsigned u) { return __builtin_bit_cast(float, u & 0xffff0000u); }
typedef _Float16 f16x2_t __attribute__((ext_vector_type(2)));
typedef __fp16 fp16x2_t __attribute__((ext_vector_type(2)));
DI unsigned pkh2(float lo, float hi) { return __builtin_bit_cast(unsigned, __builtin_amdgcn_cvt_pkrtz(lo, hi)); }
DI float hlo(unsigned u) { return (float)__builtin_bit_cast(f16x2_t, u).x; }
DI float hhi(unsigned u) { return (float)__builtin_bit_cast(f16x2_t, u).y; }
DI float silu_f(float x) { return x * __builtin_amdgcn_rcpf(1.f + __expf(-x)); }
DI float ex2(float x) { return __builtin_amdgcn_exp2f(x); }
#define MFMA32(a, b, c) __builtin_amdgcn_mfma_f32_32x32x16_bf16((a), (b), (c), 0, 0, 0)

constexpr int DM = 1024, NB = 8, SEQ = 4096, CTXL = 256, DEPTH = 4;
constexpr int M_LAT = NB * SEQ, M_CTX = NB * CTXL, M_ALL = M_LAT + M_CTX;
constexpr int DFF = 2816, NGU = 2 * DFF, NIN = 3584, INC = 3588, NKEY = SEQ + CTXL, NVC = 34;
constexpr int XBC0 = 1792;
constexpr float ALPHA = 1.6817928305074290f;
constexpr float QSCALE = 0.125f * 1.4426950408889634f;
constexpr size_t MiB = 1u << 20;
constexpr size_t WS_MOD = 0, WS_TATT = 2 * MiB, WS_LAM = 2 * MiB + 65536, WS_BAR = 2 * MiB + 131072, WS_STAT = 2 * MiB + 262144, WS_ONES = 2 * MiB + 655360, WS_ZEROS = 2 * MiB + 655360 + 4096, WS_HALVES = 2 * MiB + 655360 + 8192, WS_TRET = 3 * MiB, WS_DT = 4 * MiB, WS_DEC = 5 * MiB, WS_XC = 6 * MiB,
                 WS_WGU = 14 * MiB, WS_WDN = 36 * MiB, WS_WIN = 47 * MiB, WS_WOUT = 54 * MiB, WS_A = 56 * MiB, WS_HP = 124 * MiB,
                 WS_VT = 362 * MiB, WS_STS = 396 * MiB, WS_STR = 430 * MiB, WS_U = 447 * MiB, WS_T = 498 * MiB, WS_X16 = 530 * MiB, WS_END = 598 * MiB;
constexpr int LDS_BYTES = 147456;
constexpr int NTHREADS = 512;

struct Args { const float* in[22]; float* out; unsigned char* ws; float afreq[16]; float rfreq[32]; int ph_lo, ph_hi; };
enum { I_X = 0, I_C, I_CTX, I_CCTX, I_ADAW, I_ADAB, I_NG, I_NB, I_WG, I_WU, I_WD, I_WIN, I_CONVW, I_CONVB, I_LAMBDA, I_SUBG, I_ALOG, I_DTB, I_SSMD, I_SSMG, I_RLG, I_WOUT };

DI float* xrow_ptr(float* xlat, float* xctx, int row) { return row < M_LAT ? xlat + (size_t)row * DM : xctx + (size_t)(row - M_LAT) * DM; }
DI int swap23(int o) { return (o & 3) | (((o >> 3) & 1) << 2) | (((o >> 2) & 1) << 3); }

struct EpiSwiglu {
    static constexpr bool PERM = true, AFTER_DRAIN = false;
    bf16* H;
    DI void operator()(const pg8::f32x4 (&acc)[2][2][4][2], const pg8::Unit& u, int wr, int wc, int fr, int fq) const {
        const int row0 = u.pm * 256 + wr * 64 + fr, col = u.pn * 128 + wc * 32 + 8 * fq;
#pragma unroll
        for (int ai = 0; ai < 2; ++ai)
#pragma unroll
            for (int m = 0; m < 4; ++m) {
                bf16* p = H + (size_t)(row0 + ai * 128 + m * 16) * DFF + col;
                float h[8];
#pragma unroll
                for (int n = 0; n < 2; ++n)
#pragma unroll
                    for (int j = 0; j < 4; ++j) h[n * 4 + j] = silu_f(acc[ai][0][m][n][j]) * acc[ai][1][m][n][j];
                u32x4 w; w.x = pk2(h[0], h[1]); w.y = pk2(h[2], h[3]); w.z = pk2(h[4], h[5]); w.w = pk2(h[6], h[7]);
                *(u32x4*)p = w;
                __builtin_amdgcn_sched_barrier(0);
            }
    }
};

struct EpiResid {
    static constexpr bool PERM = true, AFTER_DRAIN = false;
    bf16* X; const float* modg; const float* scale_p; const f32x2* stat; const float* gprev; const float* bprev;
    DI void operator()(const pg8::f32x4 (&acc)[2][2][4][2], const pg8::Unit& u, int wr, int wc, int fr, int fq) const {
        const int mi = (u.pm < 128) ? (u.pm >> 4) : 8;
        const float* gp = modg + (size_t)mi * 9216;
        const int row0 = u.pm * 256 + wr * 64 + fr, col0 = u.pn * 256 + wc * 32 + 8 * fq;
        const float scale = *scale_p;
#pragma unroll
        for (int bj = 0; bj < 2; ++bj) {
            f32x4 gs[2], gq[2], bq[2];
#pragma unroll
            for (int n = 0; n < 2; ++n) { const f32x4 g = *(const f32x4*)(gp + col0 + bj * 128 + 4 * n); gs[n] = (g + 1.0f) * scale;
                gq[n] = *(const f32x4*)(gprev + col0 + bj * 128 + 4 * n) * ALPHA; bq[n] = *(const f32x4*)(bprev + col0 + bj * 128 + 4 * n) * ALPHA; }
#pragma unroll
            for (int ai = 0; ai < 2; ++ai) {
                u32x4 xv[4]; f32x2 st[4];
#pragma unroll
                for (int m = 0; m < 4; ++m) { const int row = row0 + ai * 128 + m * 16; xv[m] = *(const u32x4*)(X + (size_t)row * DM + col0 + bj * 128); st[m] = stat[row]; }
                __builtin_amdgcn_sched_barrier(0);
#pragma unroll
                for (int m = 0; m < 4; ++m) {
                    const f32x4 x0 = {hlo(xv[m].x), hhi(xv[m].x), hlo(xv[m].y), hhi(xv[m].y)}, x1 = {hlo(xv[m].z), hhi(xv[m].z), hlo(xv[m].w), hhi(xv[m].w)};
                    const f32x4 y0 = (x0 - st[m].x) * st[m].y * gq[0] + bq[0] + gs[0] * acc[ai][bj][m][0];
                    const f32x4 y1 = (x1 - st[m].x) * st[m].y * gq[1] + bq[1] + gs[1] * acc[ai][bj][m][1];
                    u32x4 w; w.x = pkh2(y0.x, y0.y); w.y = pkh2(y0.z, y0.w); w.z = pkh2(y1.x, y1.y); w.w = pkh2(y1.z, y1.w);
                    *(u32x4*)(X + (size_t)(row0 + ai * 128 + m * 16) * DM + col0 + bj * 128) = w;
                }
                __builtin_amdgcn_sched_barrier(0);
            }
        }
    }
};
struct EpiPartial {
    static constexpr bool PERM = true, AFTER_DRAIN = false;
    float* T; const float* modg; const float* scale_p;
    DI void operator()(const pg8::f32x4 (&acc)[2][2][4][2], const pg8::Unit& u, int wr, int wc, int fr, int fq) const {
        const float* gp = modg + (size_t)8 * 9216; const float scale = *scale_p;
        const int row0 = u.pm * 256 + wr * 64 + fr - M_LAT, col0 = u.pn * 256 + wc * 32 + 8 * fq;
        f32x4 gs[2][2];
#pragma unroll
        for (int bj = 0; bj < 2; ++bj)
#pragma unroll
            for (int n = 0; n < 2; ++n) { f32x4 g = *(const f32x4*)(gp + col0 + bj * 128 + 4 * n); gs[bj][n] = (g + 1.0f) * scale; }
#pragma unroll
        for (int ai = 0; ai < 2; ++ai)
#pragma unroll
            for (int m = 0; m < 4; ++m) {
                float* tp = T + (size_t)(row0 + ai * 128 + m * 16) * DM + col0;
#pragma unroll
                for (int bj = 0; bj < 2; ++bj)
#pragma unroll
                    for (int n = 0; n < 2; ++n) *(f32x4*)(tp + bj * 128 + 4 * n) = gs[bj][n] * acc[ai][bj][m][n];
                __builtin_amdgcn_sched_barrier(0);
            }
    }
};
struct OneUnit {
    int have; pg8::Unit u;
    DI bool next(int i, pg8::Unit& o) const { if (i == 0 && have) { o = u; return true; } return false; }
    DI void a_ready(const pg8::Unit&) const {}
    DI void done(const pg8::Unit&) const {}
};

struct EpiIn {
    static constexpr bool PERM = true, AFTER_DRAIN = false;
    bf16* P; bf16* Vt; const f32x2* tatt; const f32x2* tret;
    DI void operator()(const pg8::f32x4 (&acc)[2][2][4][2], const pg8::Unit& u, int wr, int wc, int fr, int fq) const {
        const int pn = u.pn;
        const int row0 = u.pm * 256 + wr * 64 + fr;
        if (pn == 4 || pn == 5) {
#pragma unroll
            for (int ai = 0; ai < 2; ++ai)
#pragma unroll
                for (int m = 0; m < 4; ++m) {
                    const int row = row0 + ai * 128 + m * 16;
                    int b, key;
                    if (row < M_LAT) { b = row >> 12; key = row & 4095; } else { const int r2 = row - M_LAT; b = r2 >> 8; key = 4096 + (r2 & 255); }
                    const int kp = (key & ~15) | swap23(key & 15);
#pragma unroll
                    for (int bj = 0; bj < 2; ++bj) {
                        const int h = 2 * (pn - 4) + bj;
                        bf16* vp = Vt + ((size_t)(b * 4 + h) * 128 + wc * 32 + 8 * fq) * NKEY + kp;
#pragma unroll
                        for (int n = 0; n < 2; ++n)
#pragma unroll
                            for (int j = 0; j < 4; ++j) vp[(size_t)(n * 4 + j) * NKEY] = f2bf(acc[ai][bj][m][n][j]);
                    }
                    __builtin_amdgcn_sched_barrier(0);
                }
            return;
        }
        const bool att = pn < 4, ret = (pn == 10 || pn == 11);
        const float sc = (pn < 2) ? QSCALE : (pn == 11 ? 0.125f : 1.0f);
#pragma unroll
        for (int ai = 0; ai < 2; ++ai)
#pragma unroll
            for (int m = 0; m < 4; ++m) {
                const int row = row0 + ai * 128 + m * 16;
                f32x2 cs[4];
                bool rot = false;
                if ((att || ret) && row < M_LAT) {
                    rot = true;
                    const int s = row & 4095;
                    const f32x2* tp;
                    if (att) { const int pos = (wc & 1) ? (s & 63) : (s >> 6); tp = tatt + pos * 16 + 4 * fq; }
                    else { tp = tret + (size_t)s * 32 + 16 * (wc & 1) + 4 * fq; }
                    const f32x4 t0 = *(const f32x4*)tp, t1 = *(const f32x4*)(tp + 2);
                    cs[0] = (f32x2){t0.x, t0.y}; cs[1] = (f32x2){t0.z, t0.w}; cs[2] = (f32x2){t1.x, t1.y}; cs[3] = (f32x2){t1.z, t1.w};
                }
#pragma unroll
                for (int bj = 0; bj < 2; ++bj) {
                    float v[8];
#pragma unroll
                    for (int n = 0; n < 2; ++n)
#pragma unroll
                        for (int j = 0; j < 4; ++j) v[n * 4 + j] = acc[ai][bj][m][n][j];
                    if (rot) {
#pragma unroll
                        for (int q = 0; q < 4; ++q) { const float h1 = v[2 * q], h2 = v[2 * q + 1]; v[2 * q] = h1 * cs[q].x - h2 * cs[q].y; v[2 * q + 1] = h2 * cs[q].x + h1 * cs[q].y; }
                    }
                    u32x4 w; w.x = pk2(v[0] * sc, v[1] * sc); w.y = pk2(v[2] * sc, v[3] * sc); w.z = pk2(v[4] * sc, v[5] * sc); w.w = pk2(v[6] * sc, v[7] * sc);
                    *(u32x4*)(P + (size_t)row * NIN + pn * 256 + bj * 128 + wc * 32 + 8 * fq) = w;
                }
                __builtin_amdgcn_sched_barrier(0);
            }
    }
};

DI void sincos_d(float angf, float& c, float& s) {
    const double a = (double)angf;
    const double k = rint(a * 0.15915494309189535);
    double r = fma(-k, 6.283185307179586, a); r = fma(-k, 2.4492935982947064e-16, r);
    const double r2 = r * r;
    double ts = r, ss = r, tc = 1.0, sc = 1.0;
#pragma unroll 1
    for (int n = 1; n <= 15; ++n) {
        tc = -tc * r2 / (double)((2 * n - 1) * (2 * n)); sc += tc;
        ts = -ts * r2 / (double)((2 * n) * (2 * n + 1)); ss += ts;
    }
    c = (float)sc; s = (float)ss;
}

DI int in_srccol(int j) {
    if (j < 1024) { const int blk = j >> 6, dp = j & 63, half = dp >> 5, i = (dp & 31) >> 1, sec = dp & 1; return blk * 64 + half * 32 + i + 16 * sec; }
    if (j < 2560) return j;
    if (j < 3072) { const int jj = j - 2560, blk = jj >> 6, dp = jj & 63, i = dp >> 1, sec = dp & 1; return 2564 + blk * 64 + i + 32 * sec; }
    return j + 4;
}

DI void transpose_item(const float* W, int ldw, int K, int srccol_lane, bf16* WT, int n0, int k0, LAS float* scr, int lane) {
#pragma unroll 8
    for (int i = 0; i < 32; ++i) { const int kk = 2 * i + (lane >> 5); scr[kk * 33 + (lane & 31)] = W[(size_t)(k0 + kk) * ldw + srccol_lane]; }
    asm volatile("s_waitcnt lgkmcnt(0)" ::: "memory");
    const int c = lane & 7;
#pragma unroll
    for (int j = 0; j < 4; ++j) {
        const int n = (lane >> 3) + 8 * j; const LAS float* s = scr + (8 * c) * 33 + n;
        u32x4 o; o.x = pk2(s[0 * 33], s[1 * 33]); o.y = pk2(s[2 * 33], s[3 * 33]); o.z = pk2(s[4 * 33], s[5 * 33]); o.w = pk2(s[6 * 33], s[7 * 33]);
        *(u32x4*)(WT + (size_t)(n0 + n) * K + k0 + 8 * c) = o;
    }
    asm volatile("s_waitcnt lgkmcnt(0)" ::: "memory");
}

DI void convw_phase(const Args& A, int l, LAS unsigned char* lds, int tid, int bid, int G) {
    const int lane = tid & 63, wave = tid >> 6;
    LAS float* scr = (LAS float*)(lds + 65536 + wave * 8448);
    const int gw = bid * 8 + wave, NGW = G * 8;
    constexpr int I_GU = 2 * 16 * (NGU / 32), I_DN = 2 * (DFF / 64) * (DM / 32), I_IN = 16 * (NIN / 32), I_OUT = 16 * 32;
    bf16* wgu = (bf16*)(A.ws + WS_WGU); bf16* wdn = (bf16*)(A.ws + WS_WDN); bf16* win = (bf16*)(A.ws + WS_WIN); bf16* wout = (bf16*)(A.ws + WS_WOUT);
    for (int it = gw; it < I_GU + I_DN + I_IN + I_OUT; it += NGW) {
        int r = it;
        if (r < I_GU) {
            const int f = r / (16 * (NGU / 32)); r -= f * 16 * (NGU / 32);
            const int kb = r / (NGU / 32), nb = r % (NGU / 32), n0 = nb * 32, pn = n0 >> 8, cc = n0 & 255;
            const float* src = (cc < 128 ? A.in[I_WG] : A.in[I_WU]) + (size_t)(l * 2 + f) * DM * DFF;
            transpose_item(src, DFF, DM, 128 * pn + (cc & 127) + (lane & 31), wgu + (size_t)f * NGU * DM, n0, kb * 64, scr, lane);
            continue;
        }
        r -= I_GU;
        if (r < I_DN) {
            const int f = r / ((DFF / 64) * 32); r -= f * (DFF / 64) * 32;
            const int kb = r / 32, nb = r % 32;
            transpose_item(A.in[I_WD] + (size_t)(l * 2 + f) * DFF * DM, DM, DFF, nb * 32 + (lane & 31), wdn + (size_t)f * DM * DFF, nb * 32, kb * 64, scr, lane);
            continue;
        }
        r -= I_DN;
        if (r < I_IN) {
            const int kb = r / (NIN / 32), nb = r % (NIN / 32);
            transpose_item(A.in[I_WIN] + (size_t)l * DM * INC, INC, DM, in_srccol(nb * 32 + (lane & 31)), win, nb * 32, kb * 64, scr, lane);
            continue;
        }
        r -= I_IN;
        { const int kb = r / 32, nb = r % 32;
          transpose_item(A.in[I_WOUT] + (size_t)l * DM * DM, DM, DM, nb * 32 + (lane & 31), wout, nb * 32, kb * 64, scr, lane); }
    }
}

DI void p0a_phase(const Args& A, LAS unsigned char* lds, int tid, int bid, int G) {
    const int lane = tid & 63, wave = tid >> 6;
    { const int gt = bid * NTHREADS + tid;
      f32x2* tatt = (f32x2*)(A.ws + WS_TATT); f32x2* tret = (f32x2*)(A.ws + WS_TRET);
      if (gt < 1024) { ((float*)(A.ws + WS_ONES))[gt] = 1.0f; ((float*)(A.ws + WS_ZEROS))[gt] = 0.0f; ((float*)(A.ws + WS_HALVES))[gt] = 0.5f; }
      if (gt < 1024) { const int pos = gt >> 4, i = gt & 15; float c, s; sincos_d((float)pos * A.afreq[i], c, s); tatt[gt] = (f32x2){c, s}; }
      for (int e = gt; e < SEQ * 32; e += G * NTHREADS) { const int sidx = e >> 5, i = e & 31; float c, s; sincos_d((float)sidx * A.rfreq[i], c, s); tret[e] = (f32x2){c, s}; }
      if (gt < DEPTH) {
          const float* lv = A.in[I_LAMBDA] + gt * 256; float d0 = 0.f, d1 = 0.f;
          for (int i = 0; i < 64; ++i) { d0 += lv[i] * lv[64 + i]; d1 += lv[128 + i] * lv[192 + i]; }
          const float lam_init = 0.8f - 0.6f * expf(-0.3f * (float)gt);
          ((float*)(A.ws + WS_LAM))[gt] = expf(d0) - expf(d1) + lam_init;
      }
    }
    LAS float* scs = (LAS float*)lds;
    LAS float* red = (LAS float*)(lds + 36864);
    for (int e = tid; e < 9 * 1024; e += NTHREADS) { const int mi = e >> 10, k = e & 1023; const float v = (mi < 8) ? A.in[I_C][mi * 1024 + k] : A.in[I_CCTX][k]; scs[e] = silu_f(v); }
    __syncthreads();
    float* MOD = (float*)(A.ws + WS_MOD);
    for (int it = bid; it < DEPTH * 144; it += G) {
        const int l = it / 144, cg0 = (it % 144) * 64;
        const float* w = A.in[I_ADAW] + (size_t)l * DM * 9216 + cg0 + lane;
        float acc[9];
#pragma unroll
        for (int mi = 0; mi < 9; ++mi) acc[mi] = 0.f;
#pragma unroll 4
        for (int k = wave * 128; k < wave * 128 + 128; ++k) {
            const float wv = w[(size_t)k * 9216];
#pragma unroll
            for (int mi = 0; mi < 9; ++mi) acc[mi] += scs[mi * 1024 + k] * wv;
        }
#pragma unroll
        for (int mi = 0; mi < 9; ++mi) red[(wave * 9 + mi) * 64 + lane] = acc[mi];
        __syncthreads();
        for (int e = tid; e < 576; e += NTHREADS) {
            const int mi = e >> 6, cl = e & 63; float s = A.in[I_ADAB][l * 9216 + cg0 + cl];
#pragma unroll
            for (int w8 = 0; w8 < 8; ++w8) s += red[(w8 * 9 + mi) * 64 + cl];
            MOD[((size_t)l * 9 + mi) * 9216 + cg0 + cl] = s;
        }
        __syncthreads();
    }
    convw_phase(A, 0, lds, tid, bid, G);
}

DI void wave_sum2(float& a, float& b) {
#pragma unroll
    for (int o = 1; o < 64; o <<= 1) { const float ta = __shfl_xor(a, o), tb = __shfl_xor(b, o); a += ta; b += tb; }
}
DI void wave_sum4(float& a, float& b, float& c, float& d) {
#pragma unroll
    for (int o = 1; o < 64; o <<= 1) { const float ta = __shfl_xor(a, o), tb = __shfl_xor(b, o), tc = __shfl_xor(c, o), td = __shfl_xor(d, o); a += ta; b += tb; c += tc; d += td; }
}
DI float wave_sum(float v) {
#pragma unroll
    for (int o = 1; o < 64; o <<= 1) v += __shfl_xor(v, o);
    return v;
}
DI void lnmod_phase(const Args& A, LAS unsigned char* lds, int tid, int bid, int G, bool init, int l_norm, int i_norm, int l_mod, int i_mod, bool want_dt, int nrows, bool ctx_partial, const float* gprev, const float* bprev) {
    const int lane = tid & 63, wave = tid >> 6;
    LAS f32x4* wdt = (LAS f32x4*)lds;
    if (want_dt) {
        for (int k = tid; k < 1024; k += NTHREADS) wdt[k] = *(const f32x4*)(A.in[I_WIN] + ((size_t)l_mod * DM + k) * INC + 2560);
        __syncthreads();
    }
    const float* MOD = (const float*)(A.ws + WS_MOD);
    bf16* Abuf = (bf16*)(A.ws + WS_A);
    float* DT = (float*)(A.ws + WS_DT);
    f32x4 g[4], bb[4];
    if (l_norm >= 0) {
#pragma unroll
        for (int j = 0; j < 4; ++j) { g[j] = *(const f32x4*)(A.in[I_NG] + (l_norm * 3 + i_norm) * DM + 256 * j + 4 * lane); bb[j] = *(const f32x4*)(A.in[I_NB] + (l_norm * 3 + i_norm) * DM + 256 * j + 4 * lane); }
    }
    bf16* X16 = (bf16*)(A.ws + WS_X16);
    u32x2 un[4]; f32x4 fn[4];
    int mi_cur = -1; f32x4 shv[4], sclv[4];
    { const int row = bid * 8 + wave;
      if (row < nrows) {
          if (init) { const float* xin = row < M_LAT ? A.in[I_X] + (size_t)row * DM : A.in[I_CTX] + (size_t)(row - M_LAT) * DM;
#pragma unroll
              for (int j = 0; j < 4; ++j) fn[j] = *(const f32x4*)(xin + 256 * j + 4 * lane); }
          else {
#pragma unroll
              for (int j = 0; j < 4; ++j) un[j] = *(const u32x2*)(X16 + (size_t)row * DM + 256 * j + 4 * lane); } } }
    for (int row = bid * 8 + wave; row < nrows; row += G * 8) {
        bf16* xout = X16 + (size_t)row * DM;
        f32x4 v[4];
#pragma unroll
        for (int j = 0; j < 4; ++j) v[j] = init ? fn[j] : (f32x4){hlo(un[j].x), hhi(un[j].x), hlo(un[j].y), hhi(un[j].y)};
        { const int rown = row + G * 8;
          if (rown < nrows) {
              if (init) { const float* xin = rown < M_LAT ? A.in[I_X] + (size_t)rown * DM : A.in[I_CTX] + (size_t)(rown - M_LAT) * DM;
#pragma unroll
                  for (int j = 0; j < 4; ++j) fn[j] = *(const f32x4*)(xin + 256 * j + 4 * lane); }
              else {
#pragma unroll
                  for (int j = 0; j < 4; ++j) un[j] = *(const u32x2*)(X16 + (size_t)rown * DM + 256 * j + 4 * lane); } } }
        f32x2* STAT = (f32x2*)(A.ws + WS_STAT);
        if (ctx_partial && row >= M_LAT) {
            { const f32x2 st = STAT[row];
#pragma unroll
              for (int j = 0; j < 4; ++j) v[j] = (v[j] - st.x) * st.y * *(const f32x4*)(gprev + 256 * j + 4 * lane) + *(const f32x4*)(bprev + 256 * j + 4 * lane); }
            const float* t0 = (const float*)(A.ws + WS_T) + (size_t)(row - M_LAT) * DM; const float* t1 = t0 + (size_t)M_CTX * DM; const float* t2 = t1 + (size_t)M_CTX * DM; const float* t3 = t2 + (size_t)M_CTX * DM;
#pragma unroll
            for (int j = 0; j < 4; ++j) { v[j] = v[j] * ALPHA + (*(const f32x4*)(t0 + 256 * j + 4 * lane) + *(const f32x4*)(t1 + 256 * j + 4 * lane)) + (*(const f32x4*)(t2 + 256 * j + 4 * lane) + *(const f32x4*)(t3 + 256 * j + 4 * lane)); u32x2 w_; w_.x = pkh2(v[j].x, v[j].y); w_.y = pkh2(v[j].z, v[j].w); *(u32x2*)(xout + 256 * j + 4 * lane) = w_; }
        }
        if (l_norm >= 0) {
            float s = 0.f, s2 = 0.f;
#pragma unroll
            for (int j = 0; j < 4; ++j) { s += (v[j].x + v[j].y) + (v[j].z + v[j].w); s2 += (v[j].x * v[j].x + v[j].y * v[j].y) + (v[j].z * v[j].z + v[j].w * v[j].w); }
            wave_sum2(s, s2);
            const float mean = s * (1.f / DM);
            const float rstd = 1.0f / sqrtf(fmaxf(s2 * (1.f / DM) - mean * mean, 0.f) + 1e-5f);
#pragma unroll
            for (int j = 0; j < 4; ++j) v[j] = v[j] - mean;
            if (l_mod >= 0 && lane == 0) STAT[row] = (f32x2){mean, rstd};
#pragma unroll
            for (int j = 0; j < 4; ++j) v[j] = v[j] * rstd * g[j] + bb[j];
        }
        if (init && lane == 0) STAT[row] = (f32x2){0.f, 1.f};
        if (init) {
#pragma unroll
            for (int j = 0; j < 4; ++j) { u32x2 w_; w_.x = pkh2(v[j].x, v[j].y); w_.y = pkh2(v[j].z, v[j].w); *(u32x2*)(xout + 256 * j + 4 * lane) = w_; }
        }
        if (l_norm >= 0 && l_mod < 0) {
#pragma unroll
            for (int j = 0; j < 4; ++j) *(f32x4*)(A.out + (size_t)row * DM + 256 * j + 4 * lane) = v[j];
        }
        if (l_mod >= 0) {
            const int mi = row < M_LAT ? (row >> 12) : 8;
            const float* mp = MOD + ((size_t)l_mod * 9 + mi) * 9216 + i_mod * 3072;
            if (mi != mi_cur) { mi_cur = mi;
#pragma unroll
                for (int j = 0; j < 4; ++j) { shv[j] = *(const f32x4*)(mp + 256 * j + 4 * lane); sclv[j] = *(const f32x4*)(mp + 1024 + 256 * j + 4 * lane) + 1.0f; } }
            float d0 = 0.f, d1 = 0.f, d2 = 0.f, d3 = 0.f;
#pragma unroll
            for (int j = 0; j < 4; ++j) {
                const f32x4 a = v[j] * sclv[j] + shv[j];
                u32x2 w; w.x = pk2(a.x, a.y); w.y = pk2(a.z, a.w);
                *(u32x2*)(Abuf + (size_t)row * DM + 256 * j + 4 * lane) = w;
                if (want_dt) {
                    const int k0 = 256 * j + 4 * lane;
                    const f32x4 w0 = wdt[k0], w1 = wdt[k0 + 1], w2 = wdt[k0 + 2], w3 = wdt[k0 + 3];
                    d0 += a.x * w0.x + a.y * w1.x + a.z * w2.x + a.w * w3.x;
                    d1 += a.x * w0.y + a.y * w1.y + a.z * w2.y + a.w * w3.y;
                    d2 += a.x * w0.z + a.y * w1.z + a.z * w2.z + a.w * w3.z;
                    d3 += a.x * w0.w + a.y * w1.w + a.z * w2.w + a.w * w3.w;
                }
            }
            if (want_dt) {
                wave_sum4(d0, d1, d2, d3);
                if (lane == 0) *(f32x4*)(DT + (size_t)row * 4) = (f32x4){d0, d1, d2, d3};
            }
        }
    }
}

DI float max3f(float a, float b, float c) { float r; asm("v_max3_f32 %0, %1, %2, %3" : "=v"(r) : "v"(a), "v"(b), "v"(c)); return r; }
DI float max3f_mfma(float a, float b, float c) { float r; asm("s_nop 15\n\ts_nop 7\n\tv_max3_f32 %0, %1, %2, %3" : "=v"(r) : "v"(a), "v"(b), "v"(c)); return r; }
DI void attn_unit(LAS unsigned char* lds, int tid, const bf16* __restrict__ P, const bf16* __restrict__ Vt, bf16* MG, int b, int h, int qrow0, int jt0, int jt1,
                  float lam, float oscale, const float* subg) {
    asm volatile("" : "+v"(tid));
    constexpr int KP = 136, VP = 72, KBYTES = 64 * KP * 2, VBYTES = 128 * VP * 2;
    const int lane = tid & 63, wave = tid >> 6, r32 = lane & 31, hi = lane >> 5;
    const int qb = wave >> 1, m = wave & 1;
    const int qrow = qrow0 + qb * 32 + r32;
    bf16x8 qf[4];
#pragma unroll
    for (int ks = 0; ks < 4; ++ks) qf[ks] = *(const bf16x8*)(P + (size_t)qrow * NIN + h * 128 + m * 64 + ks * 16 + hi * 8);
    f32x16 O[4];
#pragma unroll
    for (int es = 0; es < 4; ++es)
#pragma unroll
        for (int i = 0; i < 16; ++i) O[es][i] = 0.f;
    float mrun = 0.f, lrun = 0.f;
    u32x4 kreg[2], vreg[2];
    const bf16* vbase = Vt + (size_t)(b * 4 + h) * 128 * NKEY;
#define ATT_LOADG(j) do { _Pragma("unroll") for (int i_ = 0; i_ < 2; ++i_) { const int c_ = tid + 512 * i_; const int key_ = c_ >> 4, part_ = c_ & 15; \
        const int row_ = ((j) < 64) ? b * SEQ + (j) * 64 + key_ : M_LAT + b * CTXL + ((j) - 64) * 64 + key_; \
        kreg[i_] = *(const u32x4*)(P + (size_t)row_ * NIN + 512 + h * 128 + part_ * 8); \
        const int e_ = c_ >> 3, vp_ = c_ & 7; vreg[i_] = *(const u32x4*)(vbase + (size_t)e_ * NKEY + (j) * 64 + vp_ * 8); } } while (0)
#define ATT_STORE(buf) do { _Pragma("unroll") for (int i_ = 0; i_ < 2; ++i_) { const int c_ = tid + 512 * i_; const int key_ = c_ >> 4, part_ = c_ & 15, e_ = c_ >> 3, vp_ = c_ & 7; \
        *(LAS u32x4*)(lds + (buf) * KBYTES + (key_ * KP + part_ * 8) * 2) = kreg[i_]; \
        *(LAS u32x4*)(lds + 2 * KBYTES + (buf) * VBYTES + (e_ * VP + vp_ * 8) * 2) = vreg[i_]; } } while (0)
    const bool halfB = wave >= 4;
    bf16x8 pf[4];
#define ATT_QKS(bufk, first_) do { \
        const LAS bf16* Kb = (const LAS bf16*)(lds + (bufk) * KBYTES) + m * 64 + hi * 8; \
        f32x16 s0, s1; \
        { const float ninit = -mrun; _Pragma("unroll") for (int i = 0; i < 16; ++i) { s0[i] = ninit; s1[i] = ninit; } } \
        _Pragma("unroll") for (int ks = 0; ks < 4; ++ks) { \
            const bf16x8 a0 = *(const LAS bf16x8*)(Kb + r32 * KP + ks * 16); \
            const bf16x8 a1 = *(const LAS bf16x8*)(Kb + (32 + r32) * KP + ks * 16); \
            s0 = MFMA32(a0, qf[ks], s0); s1 = MFMA32(a1, qf[ks], s1); } \
        float mx = max3f_mfma(s0[0], s1[0], s0[1]); \
        mx = max3f(mx, s1[1], s0[2]); mx = max3f(mx, s1[2], s0[3]); mx = max3f(mx, s1[3], s0[4]); mx = max3f(mx, s1[4], s0[5]); \
        mx = max3f(mx, s1[5], s0[6]); mx = max3f(mx, s1[6], s0[7]); mx = max3f(mx, s1[7], s0[8]); mx = max3f(mx, s1[8], s0[9]); \
        mx = max3f(mx, s1[9], s0[10]); mx = max3f(mx, s1[10], s0[11]); mx = max3f(mx, s1[11], s0[12]); mx = max3f(mx, s1[12], s0[13]); \
        mx = max3f(mx, s1[13], s0[14]); mx = max3f(mx, s1[14], s0[15]); mx = max3f(mx, s1[15], mx); \
        mx = max3f(mx, __shfl_xor(mx, 32), mx); \
        if ((first_) || __builtin_amdgcn_ballot_w64(mx > 8.0f) != 0ull) { \
            const float d = (first_) ? mx : (mx > 8.0f ? mx : 0.f); \
            mrun += d; \
            if (!(first_)) { const float alpha = ex2(-d); lrun *= alpha; _Pragma("unroll") for (int es = 0; es < 4; ++es) O[es] = O[es] * alpha; } \
            _Pragma("unroll") for (int i = 0; i < 16; ++i) { s0[i] -= d; s1[i] -= d; } } \
        float sum = 0.f; \
        _Pragma("unroll") for (int i = 0; i < 16; ++i) { s0[i] = ex2(s0[i]); s1[i] = ex2(s1[i]); sum += s0[i] + s1[i]; } \
        lrun += sum; \
        _Pragma("unroll") for (int s2 = 0; s2 < 2; ++s2) { u32x4 w0, w1; \
            w0.x = pk2(s0[8 * s2 + 0], s0[8 * s2 + 1]); w0.y = pk2(s0[8 * s2 + 2], s0[8 * s2 + 3]); w0.z = pk2(s0[8 * s2 + 4], s0[8 * s2 + 5]); w0.w = pk2(s0[8 * s2 + 6], s0[8 * s2 + 7]); \
            w1.x = pk2(s1[8 * s2 + 0], s1[8 * s2 + 1]); w1.y = pk2(s1[8 * s2 + 2], s1[8 * s2 + 3]); w1.z = pk2(s1[8 * s2 + 4], s1[8 * s2 + 5]); w1.w = pk2(s1[8 * s2 + 6], s1[8 * s2 + 7]); \
            pf[s2] = __builtin_bit_cast(bf16x8, w0); pf[2 + s2] = __builtin_bit_cast(bf16x8, w1); } } while (0)
#define ATT_PV(bufv) do { \
        const LAS bf16* Vb = (const LAS bf16*)(lds + 2 * KBYTES + (bufv) * VBYTES) + hi * 8; \
        _Pragma("unroll") for (int es = 0; es < 4; ++es) _Pragma("unroll") for (int kk = 0; kk < 4; ++kk) { \
            const bf16x8 a = *(const LAS bf16x8*)(Vb + (es * 32 + r32) * VP + kk * 16); O[es] = MFMA32(a, pf[kk], O[es]); } } while (0)
    __syncthreads();
    ATT_LOADG(jt0);
    for (int j = jt0; j < jt1; ++j) {
        const int buf = (j - jt0) & 1;
        ATT_STORE(buf);
        __syncthreads();
        if (j + 1 < jt1) ATT_LOADG(j + 1);
        if (!halfB) { ATT_QKS(buf, j == jt0); } else if (j > jt0) { ATT_PV(buf ^ 1); }
        __syncthreads();
        if (!halfB) { ATT_PV(buf); } else { ATT_QKS(buf, j == jt0); }
    }
    if (halfB) { ATT_PV((jt1 - 1 - jt0) & 1); }
#undef ATT_QKS
#undef ATT_PV
#undef ATT_LOADG
#undef ATT_STORE
    __syncthreads();
    const float l = lrun + __shfl_xor(lrun, 32);
    const float inv = (m ? lam : 1.0f) / l;
    LAS float* X = (LAS float*)lds + qb * 4096 + lane;
    if (m) {
#pragma unroll
        for (int es = 0; es < 4; ++es)
#pragma unroll
            for (int i = 0; i < 16; ++i) X[(es * 16 + i) * 64] = O[es][i] * inv;
    }
    __syncthreads();
    if (!m) {
        float ss = 0.f;
#pragma unroll
        for (int es = 0; es < 4; ++es)
#pragma unroll
            for (int i = 0; i < 16; ++i) { const float o = O[es][i] * inv - X[(es * 16 + i) * 64]; O[es][i] = o; ss += o * o; }
        ss += __shfl_xor(ss, 32);
        const float rn = (1.0f / sqrtf(ss * (1.0f / 128.0f) + 1e-6f)) * oscale;
#pragma unroll
        for (int es = 0; es < 4; ++es)
#pragma unroll
            for (int g4 = 0; g4 < 4; ++g4) {
                const int e = es * 32 + 8 * g4 + 4 * hi;
                const f32x4 gv = *(const f32x4*)(subg + e);
                u32x2 w; w.x = pk2(O[es][4 * g4 + 0] * rn * gv.x, O[es][4 * g4 + 1] * rn * gv.y); w.y = pk2(O[es][4 * g4 + 2] * rn * gv.z, O[es][4 * g4 + 3] * rn * gv.w);
                *(u32x2*)(MG + (size_t)qrow * DM + h * 128 + e) = w;
            }
    }
}

constexpr int SC_ACF = 0, SC_ACB = 1, SC_DT0 = 2, SC_DT1 = 3;
constexpr int L_STAT = 8192, L_BUF = 16384;
constexpr int TP = 136;
constexpr int QP = 72;
constexpr int UW = 768;

DI int vc_row0(int b, int vc) { return vc < 2 ? M_LAT + b * CTXL + vc * 128 : b * SEQ + (vc - 2) * 128; }
DI float softplus_f(float x) { return fmaxf(x, 0.f) + log1pf(__expf(-fabsf(x))); }

struct ScanCtx { const bf16* P; const bf16* U; const float* DT; bf16* sts; bf16* str; float* dec; bf16* MG; const float* cw; const float* cb; const float* alog; const float* dtb; const float* ssmd; const float* ssmg; const float* rlg; };

DI void conv_phase(const bf16* __restrict__ P, bf16* __restrict__ U, const float* cw, const float* cb, int tid, int bid, int G) {
    const int lane = tid & 63, wave = tid >> 6;
    for (int it = bid * 8 + wave; it < (M_ALL / 16) * 3; it += G * 8) {
        const int run = it / 3, cgp = it % 3, row0 = run * 16, ch = cgp * 256 + 4 * lane;
        int s0, L; if (row0 < M_LAT) { s0 = row0 & (SEQ - 1); L = SEQ; } else { s0 = (row0 - M_LAT) & (CTXL - 1); L = CTXL; }
        f32x4 w[5];
#pragma unroll
        for (int k = 0; k < 5; ++k) w[k] = *(const f32x4*)(cw + k * UW + ch);
        const f32x4 bias = *(const f32x4*)(cb + ch);
        f32x4 x[20];
#pragma unroll
        for (int i = 0; i < 20; ++i) { const int s = s0 - 2 + i; u32x2 v = {0u, 0u}; if (s >= 0 && s < L) v = *(const u32x2*)(P + (size_t)(row0 - 2 + i) * NIN + XBC0 + ch);
            x[i] = (f32x4){bflo(v.x), bfhi(v.x), bflo(v.y), bfhi(v.y)}; }
#pragma unroll
        for (int t = 0; t < 16; ++t) {
            const f32x4 a = bias + w[0] * x[t] + w[1] * x[t + 1] + w[2] * x[t + 2] + w[3] * x[t + 3] + w[4] * x[t + 4];
            u32x2 o; o.x = pk2(silu_f(a.x), silu_f(a.y)); o.y = pk2(silu_f(a.z), silu_f(a.w));
            *(u32x2*)(U + (size_t)(row0 + t) * UW + ch) = o;
        }
    }
}

DI void ssd_scalars(LAS float* sc, int tid, const float* DT, int row0, const float* alog, const float* dtb, float* dec_f, float* dec_b) {
    const int lane = tid & 63, wave = tid >> 6;
    if (wave < 4) {
        const int h = wave;
        const float r0 = DT[(size_t)(row0 + 2 * lane) * 4 + h], r1 = DT[(size_t)(row0 + 2 * lane + 1) * 4 + h];
        const float ea0 = __expf(alog[h]), ea1 = __expf(alog[4 + h]);
        const float d00 = softplus_f(r0 + dtb[h]), d01 = softplus_f(r1 + dtb[h]);
        const float d10 = softplus_f(r0 + dtb[4 + h]), d11 = softplus_f(r1 + dtb[4 + h]);
        const float la00 = -d00 * ea0, la01 = -d01 * ea0, la10 = -d10 * ea1, la11 = -d11 * ea1;
        float pf = la00 + la01, pb = la10 + la11;
#pragma unroll
        for (int o = 1; o < 64; o <<= 1) { const float tf = __shfl_up(pf, o), tb = __shfl_up(pb, o); if (lane >= o) { pf += tf; pb += tb; } }
        const float totb = __shfl(pb, 63), totf = __shfl(pf, 63);
        sc[(SC_ACF * 4 + h) * 128 + 2 * lane + 1] = pf; sc[(SC_ACF * 4 + h) * 128 + 2 * lane] = pf - la01;
        sc[(SC_ACB * 4 + h) * 128 + 2 * lane + 1] = totb - pb + la11; sc[(SC_ACB * 4 + h) * 128 + 2 * lane] = totb - (pb - la11) + la10;
        sc[(SC_DT0 * 4 + h) * 128 + 2 * lane] = d00; sc[(SC_DT0 * 4 + h) * 128 + 2 * lane + 1] = d01;
        sc[(SC_DT1 * 4 + h) * 128 + 2 * lane] = d10; sc[(SC_DT1 * 4 + h) * 128 + 2 * lane + 1] = d11;
        if (dec_f && lane == 0) { dec_f[h] = __expf(totf); dec_b[h] = __expf(totb); }
    }
}

DI f32x16 zero16() { f32x16 z;
#pragma unroll
    for (int i = 0; i < 16; ++i) z[i] = 0.f;
    return z; }
template <int KSTEPS> DI f32x16 mma_lds(f32x16 acc, const LAS bf16* Ap, int pa, const LAS bf16* Bp, int pb, int lane) {
    const int r32 = lane & 31, hi = lane >> 5;
    Ap += r32 * pa + 8 * hi; Bp += r32 * pb + 8 * hi;
#pragma unroll
    for (int ks = 0; ks < KSTEPS; ++ks) { const bf16x8 a = *(const LAS bf16x8*)(Ap + 16 * ks), bq = *(const LAS bf16x8*)(Bp + 16 * ks); acc = MFMA32(a, bq, acc); }
    return acc;
}

template <int C, bool SCALED> DI void stage_T(LAS bf16* d0, LAS bf16* d1, const bf16* __restrict__ src, int spitch, const LAS float* w0, const LAS float* w1, int tid) {
    constexpr int OC = C / 8;
#pragma unroll
    for (int it0 = 0; it0 < 64 * OC; it0 += NTHREADS) {
        const int it = it0 + tid, oct = it % OC, tp = it / OC;
        const u32x4 r0 = *(const u32x4*)(src + (size_t)(2 * tp) * spitch + oct * 8), r1 = *(const u32x4*)(src + (size_t)(2 * tp + 1) * spitch + oct * 8);
        const unsigned a[4] = {r0.x, r0.y, r0.z, r0.w}, bq[4] = {r1.x, r1.y, r1.z, r1.w};
        if (!SCALED) {
#pragma unroll
            for (int k = 0; k < 4; ++k) {
                *(LAS unsigned*)(d0 + (oct * 8 + 2 * k) * TP + 2 * tp) = (a[k] & 0xffffu) | (bq[k] << 16);
                *(LAS unsigned*)(d0 + (oct * 8 + 2 * k + 1) * TP + 2 * tp) = (a[k] >> 16) | (bq[k] & 0xffff0000u);
            }
        } else {
            const float u0 = w0[2 * tp], u1 = w0[2 * tp + 1], v0 = w1[2 * tp], v1 = w1[2 * tp + 1];
#pragma unroll
            for (int k = 0; k < 4; ++k) {
                const float e0 = bflo(a[k]), e1 = bfhi(a[k]), f0 = bflo(bq[k]), f1 = bfhi(bq[k]);
                *(LAS unsigned*)(d0 + (oct * 8 + 2 * k) * TP + 2 * tp) = pk2(e0 * u0, f0 * u1);
                *(LAS unsigned*)(d0 + (oct * 8 + 2 * k + 1) * TP + 2 * tp) = pk2(e1 * u0, f1 * u1);
                *(LAS unsigned*)(d1 + (oct * 8 + 2 * k) * TP + 2 * tp) = pk2(e0 * v0, f0 * v1);
                *(LAS unsigned*)(d1 + (oct * 8 + 2 * k + 1) * TP + 2 * tp) = pk2(e1 * v0, f1 * v1);
            }
        }
    }
}
template <int R, int C> DI void stage_N(LAS bf16* d, int dp, const bf16* __restrict__ src, int spitch, int tid) {
    constexpr int OC = C / 8;
#pragma unroll
    for (int it0 = 0; it0 < R * OC; it0 += NTHREADS) { const int it = it0 + tid, oct = it % OC, r = it / OC; *(LAS u32x4*)(d + r * dp + oct * 8) = *(const u32x4*)(src + (size_t)r * spitch + oct * 8); }
}

DI void s1_ssd_unit(LAS unsigned char* lds, int tid, const ScanCtx& C, int b, int vc) {
    asm volatile("" : "+v"(tid));
    const int lane = tid & 63, wave = tid >> 6, r32 = lane & 31, hi = lane >> 5;
    LAS float* sc = (LAS float*)lds; LAS float* wts = (LAS float*)(lds + L_STAT);
    LAS bf16* BkT = (LAS bf16*)(lds + L_BUF); LAS bf16* XF = (LAS bf16*)(lds + L_BUF + 34816); LAS bf16* XB = (LAS bf16*)(lds + L_BUF + 34816 + 17408);
    const int row0 = vc_row0(b, vc);
    float* decp = C.dec + (size_t)((b * NVC + vc) * 2) * 8;
    __syncthreads();
    ssd_scalars(sc, tid, C.DT, row0, C.alog, C.dtb, decp, decp + 8);
    __syncthreads();
    { const int h = tid >> 7, s = tid & 127;
      wts[h * 128 + s] = __expf(sc[(SC_ACF * 4 + h) * 128 + 127] - sc[(SC_ACF * 4 + h) * 128 + s]) * sc[(SC_DT0 * 4 + h) * 128 + s];
      wts[(4 + h) * 128 + s] = __expf(sc[(SC_ACB * 4 + h) * 128 + 0] - sc[(SC_ACB * 4 + h) * 128 + s]) * sc[(SC_DT1 * 4 + h) * 128 + s]; }
    const bf16* Urow = C.U + (size_t)row0 * UW;
    for (int g = 0; g < 2; ++g) {
        __syncthreads();
        stage_T<128, false>(BkT, BkT, Urow + 256 + g * 128, UW, nullptr, nullptr, tid);
        for (int hh = 0; hh < 2; ++hh) {
            const int h = 2 * g + hh;
            if (hh) __syncthreads();
            stage_T<64, true>(XF, XB, Urow + h * 64, UW, wts + h * 128, wts + (4 + h) * 128, tid);
            __syncthreads();
            const int pt = wave >> 2, nt = wave & 3;
            f32x16 af = zero16(), ab = zero16();
            { const LAS bf16* Bp = BkT + (nt * 32 + r32) * TP + 8 * hi; const LAS bf16* Af = XF + (pt * 32 + r32) * TP + 8 * hi; const LAS bf16* Ab = XB + (pt * 32 + r32) * TP + 8 * hi;
#pragma unroll
              for (int ks = 0; ks < 8; ++ks) { const bf16x8 bq = *(const LAS bf16x8*)(Bp + 16 * ks); af = MFMA32(*(const LAS bf16x8*)(Af + 16 * ks), bq, af); ab = MFMA32(*(const LAS bf16x8*)(Ab + 16 * ks), bq, ab); } }
            bf16* of = C.sts + ((size_t)(((b * NVC + vc) * 2 + 0) * 4 + h)) * 8192; bf16* ob = C.sts + ((size_t)(((b * NVC + vc) * 2 + 1) * 4 + h)) * 8192;
#pragma unroll
            for (int i = 0; i < 16; ++i) { const int p = pt * 32 + 8 * (i >> 2) + 4 * hi + (i & 3), n = nt * 32 + r32; of[p * 128 + n] = f2bf(af[i]); ob[p * 128 + n] = f2bf(ab[i]); }
        }
    }
}
DI void s1_ret_unit(LAS unsigned char* lds, int tid, const ScanCtx& C, int b, int vc, int h0, int nh) {
    asm volatile("" : "+v"(tid));
    const int lane = tid & 63, wave = tid >> 6, r32 = lane & 31, hi = lane >> 5;
    LAS float* wts = (LAS float*)(lds + L_STAT);
    LAS bf16* KT = (LAS bf16*)(lds + L_BUF); LAS bf16* VF = (LAS bf16*)(lds + L_BUF + 17408); LAS bf16* VB = (LAS bf16*)(lds + L_BUF + 2 * 17408);
    const int row0 = vc_row0(b, vc);
    float* decp = C.dec + (size_t)((b * NVC + vc) * 2) * 8;
    __syncthreads();
    { const int h = tid >> 7, s = tid & 127; const float lg0 = C.rlg[h], lg1 = C.rlg[4 + h];
      wts[h * 128 + s] = __expf((float)(127 - s) * lg0); wts[(4 + h) * 128 + s] = __expf((float)s * lg1);
      if (s == 0) { decp[4 + h] = __expf(128.f * lg0); decp[8 + 4 + h] = __expf(128.f * lg1); } }
    const bf16* Prow = C.P + (size_t)row0 * NIN;
#pragma unroll 1
    for (int h = h0; h < h0 + nh; ++h) {
        __syncthreads();
        stage_T<64, false>(KT, KT, Prow + 2816 + h * 64, NIN, nullptr, nullptr, tid);
        stage_T<64, true>(VF, VB, Prow + 3072 + h * 64, NIN, wts + h * 128, wts + (4 + h) * 128, tid);
        __syncthreads();
        const int dir = wave >> 2, pt = (wave >> 1) & 1, nt = wave & 1;
        const f32x16 a = mma_lds<8>(zero16(), (dir ? VB : VF) + pt * 32 * TP, TP, KT + nt * 32 * TP, TP, lane);
        bf16* o = C.str + ((size_t)(((b * NVC + vc) * 2 + dir) * 4 + h)) * 4096;
#pragma unroll
        for (int i = 0; i < 16; ++i) { const int p = pt * 32 + 8 * (i >> 2) + 4 * hi + (i & 3), n = nt * 32 + r32; o[p * 64 + n] = f2bf(a[i]); }
    }
}

DI int s2_order(int dir, int step) { return dir == 0 ? step : (step == 0 ? 1 : (step == 1 ? 0 : 35 - step)); }
DI void s2_item(const ScanCtx& C, int gt) {
    bf16* base; int hh, dir, b; size_t vcstride;
    if (gt < 65536) { const int v = gt & 1023, h = (gt >> 10) & 3; dir = (gt >> 12) & 1; b = gt >> 13; hh = h; base = C.sts + (size_t)((b * NVC * 2 + dir) * 4 + h) * 8192 + v * 8; vcstride = (size_t)2 * 4 * 8192; }
    else if (gt < 65536 + 32768) { const int g2 = gt - 65536; const int v = g2 & 511, h = (g2 >> 9) & 3; dir = (g2 >> 11) & 1; b = g2 >> 12; hh = 4 + h; base = C.str + (size_t)((b * NVC * 2 + dir) * 4 + h) * 4096 + v * 8; vcstride = (size_t)2 * 4 * 4096; }
    else return;
    float s[8]; float zf = 0.f; asm volatile("" : "+v"(zf));
#pragma unroll
    for (int i = 0; i < 8; ++i) s[i] = zf;
#define S2_LD(k, st_) { const int vc_ = s2_order(dir, (st_)); v##k = *(const u32x4*)(base + (size_t)vc_ * vcstride); d##k = C.dec[(size_t)((b * NVC + vc_) * 2 + dir) * 8 + hh]; }
#define S2_ST(k, st_) { const int vc_ = s2_order(dir, (st_)); u32x4 w_; w_.x = pk2(s[0], s[1]); w_.y = pk2(s[2], s[3]); w_.z = pk2(s[4], s[5]); w_.w = pk2(s[6], s[7]); \
        *(u32x4*)(base + (size_t)vc_ * vcstride) = w_; \
        s[0] = s[0] * d##k + bflo(v##k.x); s[1] = s[1] * d##k + bfhi(v##k.x); s[2] = s[2] * d##k + bflo(v##k.y); s[3] = s[3] * d##k + bfhi(v##k.y); \
        s[4] = s[4] * d##k + bflo(v##k.z); s[5] = s[5] * d##k + bfhi(v##k.z); s[6] = s[6] * d##k + bflo(v##k.w); s[7] = s[7] * d##k + bfhi(v##k.w); }
    u32x4 v0, v1, v2, v3, v4, v5, v6, v7; float d0, d1, d2, d3, d4, d5, d6, d7;
    S2_LD(0, 0) S2_LD(1, 1) S2_LD(2, 2) S2_LD(3, 3) S2_LD(4, 4) S2_LD(5, 5) S2_LD(6, 6) S2_LD(7, 7)
#pragma unroll 1
    for (int step = 0; step < 32; step += 8) {
        S2_ST(0, step) if (step + 8 < NVC) S2_LD(0, step + 8)
        S2_ST(1, step + 1) if (step + 9 < NVC) S2_LD(1, step + 9)
        S2_ST(2, step + 2) if (step + 10 < NVC) S2_LD(2, step + 10)
        S2_ST(3, step + 3) if (step + 11 < NVC) S2_LD(3, step + 11)
        S2_ST(4, step + 4) if (step + 12 < NVC) S2_LD(4, step + 12)
        S2_ST(5, step + 5) if (step + 13 < NVC) S2_LD(5, step + 13)
        S2_ST(6, step + 6) if (step + 14 < NVC) S2_LD(6, step + 14)
        S2_ST(7, step + 7) if (step + 15 < NVC) S2_LD(7, step + 15)
    }
    S2_ST(0, 32) S2_ST(1, 33)
#undef S2_LD
#undef S2_ST
}

DI void s2_phase(const ScanCtx& C, int tid, int bid, int G) {
#pragma unroll 1
    for (int gt = bid * NTHREADS + tid; gt < 65536 + 32768; gt += G * NTHREADS) s2_item(C, gt);
}

DI void s3_ssd_unit(LAS unsigned char* lds, int tid, const ScanCtx& C, int b, int vc) {
    asm volatile("" : "+v"(tid));
    const int lane = tid & 63, wave = tid >> 6, r32 = lane & 31, hi = lane >> 5;
    LAS float* sc = (LAS float*)lds; LAS float* stat = (LAS float*)(lds + L_STAT);
    LAS bf16* Cq = (LAS bf16*)(lds + L_BUF); LAS bf16* BkM = (LAS bf16*)(lds + L_BUF + 34816); LAS bf16* XsT = (LAS bf16*)(lds + L_BUF + 2 * 34816);
    LAS bf16* Hf = (LAS bf16*)(lds + L_BUF + 2 * 34816 + 17408); LAS bf16* Hb = (LAS bf16*)(lds + L_BUF + 2 * 34816 + 2 * 17408);
    const int row0 = vc_row0(b, vc);
    const int pt = wave & 1, tt = wave >> 1;
    const bf16* Urow = C.U + (size_t)row0 * UW;
    __syncthreads();
    ssd_scalars(sc, tid, C.DT, row0, C.alog, C.dtb, nullptr, nullptr);
    float ssq = 0.f;
    const int tq_ = tt * 32 + r32; const int rowq = row0 + tq_;
#pragma unroll 1
    for (int g = 0; g < 2; ++g) {
        __syncthreads();
        stage_N<128, 128>(Cq, TP, Urow + 512 + g * 128, UW, tid);
        stage_N<128, 128>(BkM, TP, Urow + 256 + g * 128, UW, tid);
        __syncthreads();
        f32x16 gacc0, gacc1;
        { const int id = 2 * wave, st = id & 3, tq = id >> 2; gacc0 = mma_lds<8>(zero16(), BkM + st * 32 * TP, TP, Cq + tq * 32 * TP, TP, lane); }
        { const int id = 2 * wave + 1, st = id & 3, tq = id >> 2; gacc1 = mma_lds<8>(zero16(), BkM + st * 32 * TP, TP, Cq + tq * 32 * TP, TP, lane); }
#pragma unroll 1
        for (int hh = 0; hh < 2; ++hh) {
            const int h = 2 * g + hh;
            __syncthreads();
            const int oct_ = tid & 7, tp_ = tid >> 3;
            const u32x4 xr0 = *(const u32x4*)(Urow + h * 64 + (size_t)(2 * tp_) * UW + oct_ * 8), xr1 = *(const u32x4*)(Urow + h * 64 + (size_t)(2 * tp_ + 1) * UW + oct_ * 8);
            const bf16* sfp = C.sts + ((size_t)(((b * NVC + vc) * 2 + 0) * 4 + h)) * 8192; const bf16* sbp = C.sts + ((size_t)(((b * NVC + vc) * 2 + 1) * 4 + h)) * 8192;
            u32x4 hfv[2], hbv[2];
#pragma unroll
            for (int i = 0; i < 2; ++i) { const int itn = tid + NTHREADS * i, octn = itn & 15, rn = itn >> 4; hfv[i] = *(const u32x4*)(sfp + rn * 128 + octn * 8); hbv[i] = *(const u32x4*)(sbp + rn * 128 + octn * 8); }
            u32x2 zz[4];
#pragma unroll
            for (int g4 = 0; g4 < 4; ++g4) zz[g4] = *(const u32x2*)(C.P + (size_t)rowq * NIN + 1536 + h * 64 + pt * 32 + 8 * g4 + 4 * hi);
            { const LAS float* acf = sc + (SC_ACF * 4 + h) * 128; const LAS float* acb = sc + (SC_ACB * 4 + h) * 128; const LAS float* d0 = sc + (SC_DT0 * 4 + h) * 128; const LAS float* d1 = sc + (SC_DT1 * 4 + h) * 128;
#pragma unroll
              for (int q = 0; q < 2; ++q) { const int id = 2 * wave + q, st = id & 3, tq = id >> 2; const int t = tq * 32 + r32; const float aft = acf[t], abt = acb[t];
#pragma unroll
                  for (int g4 = 0; g4 < 4; ++g4) { float mv[4];
#pragma unroll
                      for (int j = 0; j < 4; ++j) { const int s = st * 32 + 8 * g4 + 4 * hi + j;
                          float f; if (s < t) f = __expf(aft - acf[s]) * d0[s]; else if (s > t) f = __expf(abt - acb[s]) * d1[s]; else f = d0[s] + d1[s];
                          mv[j] = (q ? gacc1[4 * g4 + j] : gacc0[4 * g4 + j]) * f; }
                      u32x2 w; w.x = pk2(mv[0], mv[1]); w.y = pk2(mv[2], mv[3]);
                      *(LAS u32x2*)(BkM + t * TP + st * 32 + 8 * g4 + 4 * hi) = w; } } }
            { const unsigned a_[4] = {xr0.x, xr0.y, xr0.z, xr0.w}, b_[4] = {xr1.x, xr1.y, xr1.z, xr1.w};
#pragma unroll
              for (int k = 0; k < 4; ++k) {
                  *(LAS unsigned*)(XsT + (oct_ * 8 + 2 * k) * TP + 2 * tp_) = (a_[k] & 0xffffu) | (b_[k] << 16);
                  *(LAS unsigned*)(XsT + (oct_ * 8 + 2 * k + 1) * TP + 2 * tp_) = (a_[k] >> 16) | (b_[k] & 0xffff0000u); }
#pragma unroll
              for (int i = 0; i < 2; ++i) { const int itn = tid + NTHREADS * i, octn = itn & 15, rn = itn >> 4; *(LAS u32x4*)(Hf + rn * TP + octn * 8) = hfv[i]; *(LAS u32x4*)(Hb + rn * TP + octn * 8) = hbv[i]; } }
            __syncthreads();
            f32x16 y = mma_lds<8>(zero16(), XsT + pt * 32 * TP, TP, BkM + tt * 32 * TP, TP, lane);
            { const float dsum = C.ssmd[h] + C.ssmd[4 + h];
#pragma unroll
              for (int i = 0; i < 16; ++i) { const int p = pt * 32 + 8 * (i >> 2) + 4 * hi + (i & 3); y[i] += dsum * bf2f(XsT[p * TP + tq_]); } }
            __builtin_amdgcn_sched_barrier(0);
            { const f32x16 af = mma_lds<8>(zero16(), Hf + pt * 32 * TP, TP, Cq + tt * 32 * TP, TP, lane);
              const float ef = __expf(sc[(SC_ACF * 4 + h) * 128 + tq_]);
#pragma unroll
              for (int i = 0; i < 16; ++i) y[i] += ef * af[i]; }
            __builtin_amdgcn_sched_barrier(0);
            { const f32x16 ab = mma_lds<8>(zero16(), Hb + pt * 32 * TP, TP, Cq + tt * 32 * TP, TP, lane);
              const float eb = __expf(sc[(SC_ACB * 4 + h) * 128 + tq_]);
#pragma unroll
              for (int i = 0; i < 16; ++i) y[i] += eb * ab[i]; }
#pragma unroll
            for (int g4 = 0; g4 < 4; ++g4) {
                const int p = pt * 32 + 8 * g4 + 4 * hi;
                const float v0 = y[4 * g4] * silu_f(bflo(zz[g4].x)), v1 = y[4 * g4 + 1] * silu_f(bfhi(zz[g4].x)), v2 = y[4 * g4 + 2] * silu_f(bflo(zz[g4].y)), v3 = y[4 * g4 + 3] * silu_f(bfhi(zz[g4].y));
                ssq += v0 * v0 + v1 * v1 + v2 * v2 + v3 * v3;
                u32x2 w; w.x = pk2(v0, v1); w.y = pk2(v2, v3);
                *(u32x2*)(C.MG + (size_t)rowq * DM + 512 + h * 64 + p) = w;
            }
        }
    }
    ssq += __shfl_xor(ssq, 32);
    __syncthreads();
    if (hi == 0) stat[tq_ * 2 + pt] = ssq;
    __syncthreads();
    const float rn = 1.0f / sqrtf((stat[tq_ * 2] + stat[tq_ * 2 + 1]) * (1.0f / 256.0f) + 1e-6f);
#pragma unroll
    for (int h = 0; h < 4; ++h)
#pragma unroll
        for (int g4 = 0; g4 < 4; ++g4) {
            const int p = pt * 32 + 8 * g4 + 4 * hi;
            const f32x4 gv = *(const f32x4*)(C.ssmg + h * 64 + p);
            u32x2* mp = (u32x2*)(C.MG + (size_t)rowq * DM + 512 + h * 64 + p);
            const u32x2 v = *mp;
            u32x2 w; w.x = pk2(bflo(v.x) * rn * gv.x, bfhi(v.x) * rn * gv.y); w.y = pk2(bflo(v.y) * rn * gv.z, bfhi(v.y) * rn * gv.w);
            *mp = w;
        }
}
DI void s3_ret_unit(LAS unsigned char* lds, int tid, const ScanCtx& C, int b, int vc, int h0, int nh) {
    asm volatile("" : "+v"(tid));
    const int lane = tid & 63, wave = tid >> 6, r32 = lane & 31, hi = lane >> 5;
    LAS float* stat = (LAS float*)(lds + L_STAT);
    LAS bf16* Q = (LAS bf16*)(lds + L_BUF); LAS bf16* K = (LAS bf16*)(lds + L_BUF + 18432); LAS bf16* VT = (LAS bf16*)(lds + L_BUF + 2 * 18432);
    LAS bf16* Hf = (LAS bf16*)(lds + L_BUF + 2 * 18432 + 17408); LAS bf16* Hb = (LAS bf16*)(lds + L_BUF + 2 * 18432 + 17408 + 9216); LAS bf16* MB = (LAS bf16*)(lds + L_BUF + 2 * 18432 + 17408 + 2 * 9216);
    const int row0 = vc_row0(b, vc);
    const int pt = wave & 1, tt = wave >> 1;
    const bf16* Prow = C.P + (size_t)row0 * NIN;
    const int t = tt * 32 + r32; const int row = row0 + t;
#pragma unroll 1
    for (int h = h0; h < h0 + nh; ++h) {
        const float lg0 = C.rlg[h], lg1 = C.rlg[4 + h];
        __syncthreads();
        stage_N<128, 64>(Q, QP, Prow + 2560 + h * 64, NIN, tid);
        stage_N<128, 64>(K, QP, Prow + 2816 + h * 64, NIN, tid);
        stage_T<64, false>(VT, VT, Prow + 3072 + h * 64, NIN, nullptr, nullptr, tid);
        stage_N<64, 64>(Hf, QP, C.str + ((size_t)(((b * NVC + vc) * 2 + 0) * 4 + h)) * 4096, 64, tid);
        stage_N<64, 64>(Hb, QP, C.str + ((size_t)(((b * NVC + vc) * 2 + 1) * 4 + h)) * 4096, 64, tid);
        __syncthreads();
#pragma unroll
        for (int q = 0; q < 2; ++q) { const int id = 2 * wave + q, st = id & 3, tq = id >> 2;
            const f32x16 gacc = mma_lds<4>(zero16(), K + st * 32 * QP, QP, Q + tq * 32 * QP, QP, lane);
            const int t2 = tq * 32 + r32;
#pragma unroll
            for (int g4 = 0; g4 < 4; ++g4) { float mv[4];
#pragma unroll
                for (int j = 0; j < 4; ++j) { const int s = st * 32 + 8 * g4 + 4 * hi + j;
                    const float f = (s < t2) ? __expf((float)(t2 - s) * lg0) : ((s > t2) ? __expf((float)(s - t2) * lg1) : 2.0f);
                    mv[j] = gacc[4 * g4 + j] * f; }
                u32x2 w; w.x = pk2(mv[0], mv[1]); w.y = pk2(mv[2], mv[3]);
                *(LAS u32x2*)(MB + t2 * TP + st * 32 + 8 * g4 + 4 * hi) = w; } }
        __syncthreads();
        u32x2 ggv[4];
#pragma unroll
        for (int g4 = 0; g4 < 4; ++g4) ggv[g4] = *(const u32x2*)(C.P + (size_t)row * NIN + 3328 + h * 64 + pt * 32 + 8 * g4 + 4 * hi);
        f32x16 y = mma_lds<8>(zero16(), VT + pt * 32 * TP, TP, MB + tt * 32 * TP, TP, lane);
        { const f32x16 af = mma_lds<4>(zero16(), Hf + pt * 32 * QP, QP, Q + tt * 32 * QP, QP, lane);
          const float ef = __expf((float)(t + 1) * lg0);
#pragma unroll
          for (int i = 0; i < 16; ++i) y[i] += ef * af[i]; }
        { const f32x16 ab = mma_lds<4>(zero16(), Hb + pt * 32 * QP, QP, Q + tt * 32 * QP, QP, lane);
          const float eb = __expf((float)(128 - t) * lg1);
#pragma unroll
          for (int i = 0; i < 16; ++i) y[i] += eb * ab[i]; }
        float s1 = 0.f, s2 = 0.f;
#pragma unroll
        for (int i = 0; i < 16; ++i) { s1 += y[i]; s2 += y[i] * y[i]; }
        s1 += __shfl_xor(s1, 32); s2 += __shfl_xor(s2, 32);
        if (hi == 0) { stat[(t * 2 + pt) * 2] = s1; stat[(t * 2 + pt) * 2 + 1] = s2; }
        __syncthreads();
        const float t1 = stat[(t * 2) * 2] + stat[(t * 2 + 1) * 2], t2s = stat[(t * 2) * 2 + 1] + stat[(t * 2 + 1) * 2 + 1];
        const float mean = t1 * (1.0f / 64.0f), var = fmaxf(t2s * (1.0f / 64.0f) - mean * mean, 0.f), rs = 1.0f / sqrtf(var + 1e-5f);
#pragma unroll
        for (int g4 = 0; g4 < 4; ++g4) {
            const int p = pt * 32 + 8 * g4 + 4 * hi;
            const float g0 = silu_f(bflo(ggv[g4].x)), g1 = silu_f(bfhi(ggv[g4].x)), g2 = silu_f(bflo(ggv[g4].y)), g3 = silu_f(bfhi(ggv[g4].y));
            u32x2 w; w.x = pk2((y[4 * g4] - mean) * rs * g0, (y[4 * g4 + 1] - mean) * rs * g1); w.y = pk2((y[4 * g4 + 2] - mean) * rs * g2, (y[4 * g4 + 3] - mean) * rs * g3);
            *(u32x2*)(C.MG + (size_t)row * DM + 768 + h * 64 + p) = w;
        }
    }
}

constexpr int NPP = 13, NPH = 2 + NPP * DEPTH;
#ifndef PMASK
#define PMASK 0xffff
#endif
#define PEN(k) ((PMASK >> (k)) & 1)
#ifndef PROBE_LASTONLY
#define PROBE_LASTONLY 0
#endif
#ifndef PROBE_N
#define PROBE_N 1
#endif
#ifndef REP_SPLIT
#define REP_SPLIT 1
#endif
#ifndef REP_P0
#define REP_P0 1
#endif
#ifndef REP_LN
#define REP_LN 1
#endif
#ifndef REP_SYNC
#define REP_SYNC 1
#endif
#ifndef REP_ATTN
#define REP_ATTN 1
#endif
#ifndef REP_UP
#define REP_UP 1
#endif
#ifndef REP_IN
#define REP_IN 1
#endif
#ifndef REP_SCAN
#define REP_SCAN 1
#endif

#define GAS __attribute__((address_space(1)))
#define XB_TMO      128
#define XB_XCNT(j)  (256  + 64 * (j))
#define XB_XSUB(j)  (1280 + 64 * (j))
#define XB_XGEN(j)  (2304 + 64 * (j))
#define XB_TOP      3328
#define XB_TOPGEN   3392
#define XCD_BAR_WORDS 3456
#define XB_SPIN_CAP (1u << 18)

__device__ __forceinline__ unsigned xb_ld(unsigned* p)              { return __hip_atomic_load(p, __ATOMIC_RELAXED, __HIP_MEMORY_SCOPE_AGENT); }
__device__ __forceinline__ unsigned xb_add(unsigned* p, unsigned v) { return __hip_atomic_fetch_add(p, v, __ATOMIC_RELAXED, __HIP_MEMORY_SCOPE_AGENT); }
__device__ __forceinline__ unsigned xb_xcc_id() { return (unsigned)__builtin_amdgcn_s_getreg((3 << 11) | 20) & 0xFu; }
#define XB_SPIN(cond, bar) do { unsigned _sp = 0; while (cond) { __builtin_amdgcn_s_sleep(1); \
    if ((++_sp & 255u) == 0u) { if (xb_ld(&(bar)[XB_TMO])) break; if (_sp > XB_SPIN_CAP) { atomicAdd(&(bar)[XB_TMO], 1u); break; } } } } while (0)

struct XcdBarrier {
    unsigned* bar; unsigned x;
    volatile LAS unsigned* st;
};

__device__ __forceinline__ XcdBarrier xcd_barrier_post(unsigned* bar, volatile LAS unsigned* st) {
    XcdBarrier b; b.bar = bar; b.x = xb_xcc_id(); b.st = st;
    if (threadIdx.x == 0) (void)xb_add(&bar[XB_XCNT(b.x)], 1u);
    return b;
}
__device__ __forceinline__ void xcd_barrier_complete(unsigned* bar, unsigned x, unsigned& nloc, unsigned& nx) {
    const unsigned G = gridDim.x * gridDim.y * gridDim.z;
    unsigned sum, cnt, mine, sp = 0u;
    for (;;) {
        sum = 0u; cnt = 0u; mine = 0u;
#pragma unroll
        for (unsigned j = 0; j < 16; ++j) { const unsigned c = xb_ld(&bar[XB_XCNT(j)]); sum += c; cnt += (c > 0u) ? 1u : 0u; mine = (j == x) ? c : mine; }
        if (sum == G) break;
        __builtin_amdgcn_s_sleep(1);
        if ((++sp & 255u) == 0u) { if (xb_ld(&bar[XB_TMO])) break; if (sp > XB_SPIN_CAP) { atomicAdd(&bar[XB_TMO], 1u); break; } }
    }
    nloc = mine > 0u ? mine : 1u; nx = cnt > 0u ? cnt : 1u;
}

__device__ __forceinline__ void xcd_barrier(const XcdBarrier& b) {
    asm volatile("s_waitcnt vmcnt(0)" ::: "memory");
    __syncthreads();
    if (threadIdx.x == 0) {
        unsigned* bar = b.bar;
        __builtin_amdgcn_s_waitcnt(0);
        unsigned nloc = b.st[0], nx = b.st[1];
        if (nloc == 0u) { xcd_barrier_complete(bar, b.x, nloc, nx); b.st[0] = nloc; b.st[1] = nx; }
        const unsigned old = xb_add(&bar[XB_XSUB(b.x)], 1u);
        const unsigned gen = old / nloc;
        if (old + 1u == (gen + 1u) * nloc) {
            __builtin_amdgcn_fence(__ATOMIC_RELEASE, "agent");
            asm volatile("s_waitcnt vmcnt(0)" ::: "memory");
            const unsigned og = xb_add(&bar[XB_TOP], 1u);
            const unsigned tg = og / nx;
            if (og + 1u == (tg + 1u) * nx) xb_add(&bar[XB_TOPGEN], 1u);
            else XB_SPIN(xb_ld(&bar[XB_TOPGEN]) == tg, bar);
            __builtin_amdgcn_fence(__ATOMIC_ACQUIRE, "agent");
            xb_add(&bar[XB_XGEN(b.x)], 1u);
            asm volatile("s_waitcnt vmcnt(0)" ::: "memory");
        } else {
            XB_SPIN(xb_ld(&bar[XB_XGEN(b.x)]) == gen, bar);
            __builtin_amdgcn_fence(__ATOMIC_ACQUIRE, "agent");
            asm volatile("s_waitcnt vmcnt(0)" ::: "memory");
        }
    }
    __syncthreads();
}
template <class Epi> DI void run_gemm(LAS unsigned char* lds, int tid, const bf16* Ap, const bf16* Bt, int M, int N, int K, int G, int bid, const Epi& E, int ld = 0) {
    pg8::Gemm g{Ap, Bt, M, N, K, ld ? ld : K}; pg8::StaticOrder S; S.init(M, N, G, bid);
    pg8::gemm_phase<Epi, pg8::StaticOrder, true, true>(lds, g, S, E, tid);
}

__global__ void __launch_bounds__(NTHREADS, 2) mega(Args A) {
    extern __shared__ __attribute__((aligned(16))) unsigned char lds_raw[];
    LAS unsigned char* lds = (LAS unsigned char*)lds_raw;
    cg::grid_group grid = cg::this_grid();
    const int tid0 = threadIdx.x, bid0 = blockIdx.x, G0 = gridDim.x;
    { volatile LAS unsigned* bst0 = (volatile LAS unsigned*)(lds + LDS_BYTES - 64); if (tid0 < 16) bst0[tid0] = 0u;
      if (bid0 == 0) { unsigned* bw = (unsigned*)(A.ws + WS_BAR); for (int i = tid0; i < XCD_BAR_WORDS; i += NTHREADS) bw[i] = 0u; } }
    __syncthreads();
    int rep_done = 0; (void)rep_done;
    for (int ph = A.ph_lo; ph < A.ph_hi; ++ph) {
        if (ph > A.ph_lo) {
            if (ph == A.ph_lo + 1) { grid.sync(); (void)xcd_barrier_post((unsigned*)(A.ws + WS_BAR), (volatile LAS unsigned*)(lds + LDS_BYTES - 64)); }
            else { for (int rs_ = 0; rs_ < REP_SYNC; ++rs_) { XcdBarrier xb_; xb_.bar = (unsigned*)(A.ws + WS_BAR); xb_.x = xb_xcc_id(); xb_.st = (volatile LAS unsigned*)(lds + LDS_BYTES - 64); xcd_barrier(xb_); } }
        }
        int tid = tid0, bid = bid0, G = G0; size_t zoff = 0;
        asm volatile("" : "+v"(tid)); asm volatile("" : "+s"(bid)); asm volatile("" : "+s"(G)); asm volatile("" : "+s"(zoff));
        unsigned char* ws = A.ws + zoff;
        float* xc = (float*)(ws + WS_XC);
        bf16* Abuf = (bf16*)(ws + WS_A); bf16* HP = (bf16*)(ws + WS_HP); bf16* Vt = (bf16*)(ws + WS_VT);
        const float* MOD = (const float*)(ws + WS_MOD);
        if (ph == 0) { if (PEN(0)) for (int rp_ = 0; rp_ < REP_P0; ++rp_) { p0a_phase(A, lds, tid, bid, G); __syncthreads(); } continue; }
        if (ph == 1) { if (PEN(1)) for (int rp_ = 0; rp_ < REP_LN; ++rp_) lnmod_phase(A, lds, tid, bid, G, true, -1, 0, 0, 0, false, M_ALL, false, nullptr, nullptr); continue; }
        const int q = ph - 2, l = q / NPP; int s = q % NPP; const bool is_conv = (s == 4); if (s >= 4) s -= 1; if (is_conv) s = 100;
        const bool last = (l == DEPTH - 1);
        const int Mpost = last ? M_LAT : M_ALL;
        if ((s == 0 || s == 9) && PEN(2)) {
            const int f = (s == 9); EpiSwiglu E{HP};
            for (int rp_ = 0; rp_ < REP_UP; ++rp_) run_gemm(lds, tid, Abuf, (const bf16*)(ws + WS_WGU) + (size_t)f * NGU * DM, f ? Mpost : M_ALL, NGU, DM, G, bid, E);
        } else if ((s == 1 || s == 10 || s == 7) && PEN(3)) {
            const int i = (s == 1) ? 0 : (s == 7 ? 1 : 2);
            const int prev_idx = (i == 0) ? (l == 0 ? -1 : (l - 1) * 3 + 2) : l * 3 + (i - 1);
            const float* modg_p = MOD + (size_t)l * 9 * 9216 + i * 3072 + 2048;
            const float* scale_v = (s == 7) ? (const float*)(ws + WS_ONES) : (const float*)(ws + WS_HALVES);
            const float* gprev_p = prev_idx < 0 ? (const float*)(ws + WS_ONES) : A.in[I_NG] + prev_idx * DM; const float* bprev_p = prev_idx < 0 ? (const float*)(ws + WS_ZEROS) : A.in[I_NB] + prev_idx * DM;
            EpiResid E{(bf16*)(ws + WS_X16), modg_p, scale_v, (const f32x2*)(ws + WS_STAT), gprev_p, bprev_p};
            const bool has_ctx = (s == 1) || !last;
            const bf16* Ap = (s == 7) ? Abuf : HP; const bf16* Bp = (s == 7) ? (const bf16*)(ws + WS_WOUT) : (const bf16*)(ws + WS_WDN) + (size_t)(s == 10) * DM * DFF;
            const int Kd = (s == 7) ? DM : DFF;
            const int ldd = (s == 7) ? DM : DFF;
            run_gemm(lds, tid, Ap, Bp, M_LAT, DM, Kd, G, bid, E, ldd);
            if (has_ctx) {
                const int sb = (G == 256 && ((bid >> 3) & 7) < 4 && bid < 256) ? ((bid & 7) | (((bid >> 3) & 3) << 3) | ((bid >> 6) << 5)) : (G == 256 ? 999 : (bid + G - 64) % G);
                const int qd = (sb >> 5) & 3;
                const int kt0 = (s == 7) ? 4 * qd : (qd < 2 ? 12 * qd : 24 + 10 * (qd - 2));
                const int ktn = (s == 7) ? 4 : (qd < 2 ? 12 : 10);
                OneUnit S1u; S1u.have = sb < 128; S1u.u.pm = 128 + (sb & 7); S1u.u.pn = (sb >> 3) & 3;
                EpiPartial Ep{(float*)(ws + WS_T) + (size_t)qd * M_CTX * DM, modg_p, scale_v};
                pg8::Gemm g2{Ap + (size_t)kt0 * 64, Bp + (size_t)kt0 * 64, M_ALL, DM, ktn * 64, ldd};
                pg8::gemm_phase<EpiPartial, OneUnit, true, true>(lds, g2, S1u, Ep, tid);
            }
        } else if (s == 2 && PEN(1)) {
            lnmod_phase(A, lds, tid, bid, G, false, l, 0, l, 1, true, M_ALL, true, l == 0 ? (const float*)(ws + WS_ONES) : A.in[I_NG] + ((l - 1) * 3 + 2) * DM, l == 0 ? (const float*)(ws + WS_ZEROS) : A.in[I_NB] + ((l - 1) * 3 + 2) * DM);
        } else if (s == 3 && PEN(4)) {
            EpiIn E{HP, Vt, (const f32x2*)(ws + WS_TATT), (const f32x2*)(ws + WS_TRET)};
            for (int rp_ = 0; rp_ < REP_IN; ++rp_) run_gemm(lds, tid, Abuf, (const bf16*)(ws + WS_WIN), M_ALL, NIN, DM, G, bid, E);
        } else if (is_conv || s == 4 || s == 5 || s == 6) {
            ScanCtx C{HP, (const bf16*)(ws + WS_U), (const float*)(ws + WS_DT), (bf16*)(ws + WS_STS), (bf16*)(ws + WS_STR), (float*)(ws + WS_DEC), Abuf,
                      A.in[I_CONVW] + (size_t)l * 5 * 768, A.in[I_CONVB] + l * 768, A.in[I_ALOG] + l * 8, A.in[I_DTB] + l * 8, A.in[I_SSMD] + l * 8, A.in[I_SSMG] + l * 256, A.in[I_RLG] + l * 8};
            const float lam = ((const float*)(ws + WS_LAM))[l];
            const float lam_init = 0.8f - 0.6f * expf(-0.3f * (float)l);
            const float* subg = A.in[I_SUBG] + l * 128;
            const int r = is_conv ? 0 : s - 3;
            if (PEN(7)) for (int rp_ = 0; rp_ < REP_ATTN; ++rp_) for (int u = bid; u < 256; u += G) { const int bh = r * 8 + (u & 7), qb = u >> 3;
                attn_unit(lds, tid, HP, Vt, Abuf, bh >> 2, bh & 3, (bh >> 2) * SEQ + qb * 128, 0, 68, lam, 1.0f - lam_init, subg); }
            if (is_conv) {
                if (PEN(10)) conv_phase(HP, (bf16*)(ws + WS_U), C.cw, C.cb, tid, bid, G);
            } else if (s == 4) {
                { const int nS1 = NB * NVC, extra1 = (nS1 > G && nS1 < 2 * G) ? nS1 - G : 0;
                  if (PEN(5)) { for (int u = bid; u < nS1; u += G) s1_ssd_unit(lds, tid, C, u / NVC, u % NVC);
                      if (bid >= extra1) for (int r = bid - extra1; r < 4 * nS1; r += G - extra1) { const int v = r >> 2; s1_ret_unit(lds, tid, C, v / NVC, v % NVC, r & 3, 1); } } }
            } else if (s == 5) {
                if (PEN(6)) s2_phase(C, tid, bid, G);
            } else {
                const int vc0 = last ? 2 : 0, nvc = NVC - vc0;
                const int nS = NB * nvc, extra = (nS > G && nS < 2 * G) ? nS - G : 0;
                if (PEN(8)) for (int u = bid; u < nS; u += G) s3_ssd_unit(lds, tid, C, u / nvc, vc0 + u % nvc);
                if (PEN(9) && bid >= extra) for (int r = bid - extra; r < 4 * nS; r += G - extra) { const int v = r >> 2; s3_ret_unit(lds, tid, C, v / nvc, vc0 + v % nvc, r & 3, 1); }
                if (!last && PEN(7)) for (int u = (bid + G - 64) % G; u < 64; u += G) { const int bh = u >> 1; attn_unit(lds, tid, HP, Vt, Abuf, bh >> 2, bh & 3, M_LAT + (bh >> 2) * CTXL + (u & 1) * 128, 64, 68, lam, 1.0f - lam_init, subg); }
            }
        } else if (s == 8 && PEN(1)) {
            lnmod_phase(A, lds, tid, bid, G, false, l, 1, l, 2, false, Mpost, !last, A.in[I_NG] + (l * 3) * DM, A.in[I_NB] + (l * 3) * DM);
        } else if (s == 11 && PEN(1)) {
            lnmod_phase(A, lds, tid, bid, G, false, l, 2, last ? -1 : l + 1, 0, false, Mpost, !last, A.in[I_NG] + (l * 3 + 1) * DM, A.in[I_NB] + (l * 3 + 1) * DM);
            if (!last) convw_phase(A, l + 1, lds, tid, bid, G);
        }
#ifdef PROBE_S
        if ((s == (PROBE_S) || s == (PROBE_S2)) && (PROBE_LASTONLY == 0 || last) && rep_done < PROBE_N) { ++rep_done; --ph; } else rep_done = 0;
#endif
    }
}

extern "C" void kernel_launch(void* const* d_in, const int* in_sizes, int n_in, void* d_out, int out_size, void* d_ws, size_t ws_size, hipStream_t stream) {
    static int grid = 0;
    if (grid == 0) {
        if (n_in != 22 || in_sizes[0] != M_LAT * DM || out_size != M_LAT * DM || ws_size < WS_END) { fprintf(stderr, "kernel_launch: unexpected shapes (n_in %d, out %d, ws %zu)\n", n_in, out_size, ws_size); grid = -1; return; }
        int dev = 0, cus = 0, per_cu = 0;
        hipGetDevice(&dev); hipDeviceGetAttribute(&cus, hipDeviceAttributeMultiprocessorCount, dev);
        if (hipFuncSetAttribute((const void*)mega, hipFuncAttributeMaxDynamicSharedMemorySize, LDS_BYTES) != hipSuccess) { fprintf(stderr, "kernel_launch: hipFuncSetAttribute failed\n"); grid = -1; return; }
        if (hipOccupancyMaxActiveBlocksPerMultiprocessor(&per_cu, (const void*)mega, NTHREADS, LDS_BYTES) != hipSuccess || per_cu < 1) { fprintf(stderr, "kernel_launch: occupancy query says %d\n", per_cu); per_cu = 1; }
        (void)hipGetLastError();
        grid = cus * 1;
    }
    if (grid < 0) return;
    Args a{};
    for (int i = 0; i < 22; ++i) a.in[i] = (const float*)d_in[i];
    a.out = (float*)d_out; a.ws = (unsigned char*)d_ws;
    for (int i = 0; i < 16; ++i) a.afreq[i] = 1.0f / powf(10000.0f, (float)(2 * i) / 32.0f);
    for (int i = 0; i < 32; ++i) a.rfreq[i] = 1.0f / powf(10000.0f, (float)i / 31.0f);
#ifdef MK_MULTI
    for (int ph = 0; ph < NPH; ++ph) { a.ph_lo = ph; a.ph_hi = ph + 1; hipLaunchKernelGGL(mega, dim3(grid), dim3(NTHREADS), LDS_BYTES, stream, a); }
#else
    a.ph_lo = 0; a.ph_hi = NPH;
    void* args[] = {&a};
    hipError_t e = hipLaunchCooperativeKernel((const void*)mega, dim3(grid), dim3(NTHREADS), args, LDS_BYTES, stream);
    if (e != hipSuccess) fprintf(stderr, "cooperative launch failed: %s (grid %d)\n", hipGetErrorString(e), grid);
#endif
}
```

```cpp
#include <hip/hip_runtime.h>
#include <hip/hip_cooperative_groups.h>
#include <cstdio>
#include <cstdint>
#include <cmath>
namespace cg = cooperative_groups;

namespace pg8 {
#define PG8_LAS __attribute__((address_space(3)))
typedef unsigned short bf16_t;
typedef short bf16x8 __attribute__((ext_vector_type(8)));
typedef float f32x4 __attribute__((ext_vector_type(4)));
typedef unsigned u32x4 __attribute__((ext_vector_type(4)));
constexpr int BM = 256, BK = 64, HALF = 128, HTB = HALF * BK * 2  , STAGE_BYTES = 8 * HTB, NXCD = 8, WGM = 8;

__host__ __device__ __forceinline__ int lds_byte(int r, int c) { const int st = (r >> 4) * 2 + (c >> 5), rr = r & 15, cc = c & 31, ob = rr * 64 + cc * 2; return st * 1024 + (ob ^ (((ob >> 9) & 1) << 5)); }
__host__ __device__ __forceinline__ void stage_rc(int b, int& R, int& C) { const int st = b / 1024, sb = b % 1024, swz = sb ^ (((sb >> 9) & 1) << 5); R = (st >> 1) * 16 + swz / 64; C = (st & 1) * 32 + (swz % 64) / 2; }
__host__ __device__ __forceinline__ int perm32(int rho) { const int n = rho >> 4, i = rho & 15; return 8 * (i >> 2) + 4 * n + (i & 3); }

struct Unit { int pm, pn; };
struct Gemm { const bf16_t* A; const bf16_t* Bt; int M, N, K, ld; };

struct StaticOrder {
    int nM, nN, nwg, G, c;
    __host__ __device__ void init(int M, int N, int G_, int c_) { nM = M / BM; nN = N / BM; nwg = nM * nN; G = G_; c = c_; }
    __host__ __device__ bool next(int i, Unit& u) const {
        const long L = (long)i * G + c; if (L >= nwg) return false;
        int wgid = (int)L; { const int q = nwg / NXCD, r = nwg % NXCD, xcd = wgid % NXCD, off = wgid / NXCD; wgid = (xcd < r ? xcd * (q + 1) : r * (q + 1) + (xcd - r) * q) + off; }
        const int nig = WGM * nN, gid = wgid / nig, fm = gid * WGM, gsz = (nM - fm) < WGM ? (nM - fm) : WGM;
        u.pm = fm + ((wgid % nig) % gsz); u.pn = (wgid % nig) / gsz; return true;
    }
    __device__ __forceinline__ void a_ready(const Unit&) const {}
    __device__ __forceinline__ void done(const Unit&) const {}
};

__device__ __forceinline__ unsigned cvt_pk_bf16(float lo, float hi) { unsigned r; asm volatile("v_cvt_pk_bf16_f32 %0, %1, %2" : "=v"(r) : "v"(lo), "v"(hi)); return r; }
template <class Epi, class Sched, bool ALIGN_EPI = false, bool SP2 = false>
__device__ __forceinline__ void gemm_phase(PG8_LAS unsigned char* lds, const Gemm g, const Sched& S, const Epi& E, const int tid) {
    const int wid = __builtin_amdgcn_readfirstlane(tid >> 6), lane = tid & 63, wr = wid >> 2, wc = wid & 3, fr = lane & 15, fq = lane >> 4;
    const int K = g.K, nt = K / BK;
    unsigned voffA[2], voffB[2];
#pragma unroll
    for (int i = 0; i < 2; ++i) { int R, C; stage_rc(tid * 16 + i * 8192, R, C); const int Rb = Epi::PERM ? ((R & ~31) + perm32(R & 31)) : R;
        voffA[i] = (unsigned)(R * g.ld + C) * 2u; voffB[i] = (unsigned)(Rb * g.ld + C) * 2u; }
    const size_t kstep = (size_t)(BK * 2);
    const size_t hstep = (size_t)HALF * g.ld * 2;
    const size_t tstep = 2 * hstep;
    const unsigned ldsw = (unsigned)wid * 1024u;
    const int aoff = lds_byte(wr * 64 + fr, fq * 8), boff = lds_byte(wc * 32 + fr, fq * 8);
#define PG8_SA(b, h) (((b) * 2 + (h)) * HTB)
#define PG8_SB(b, h) ((4 + (b) * 2 + (h)) * HTB)
#define PG8_STAGE(bufoff, gbase, voff) do { _Pragma("unroll") for (int _i = 0; _i < 2; ++_i) \
        __builtin_amdgcn_global_load_lds((const unsigned*)((const char*)(gbase) + (voff)[_i]), (PG8_LAS unsigned*)(lds + (bufoff) + ldsw + _i * 8192), 16, 0, 0); } while (0)
#define PG8_LDA(dst, b, h) do { _Pragma("unroll") for (int m = 0; m < 4; ++m) _Pragma("unroll") for (int k = 0; k < 2; ++k) dst[m][k] = *(const PG8_LAS bf16x8*)(lds + PG8_SA(b, h) + aoff + m * 2048 + k * 1024); } while (0)
#define PG8_LDB(dst, b, h) do { _Pragma("unroll") for (int n = 0; n < 2; ++n) _Pragma("unroll") for (int k = 0; k < 2; ++k) dst[n][k] = *(const PG8_LAS bf16x8*)(lds + PG8_SB(b, h) + boff + n * 2048 + k * 1024); } while (0)
#define PG8_MMA(ai, bj, At, Bt) do { __builtin_amdgcn_s_setprio(1); _Pragma("unroll") for (int m = 0; m < 4; ++m) _Pragma("unroll") for (int n = 0; n < 2; ++n) _Pragma("unroll") for (int k = 0; k < 2; ++k) \
        acc[ai][bj][m][n] = __builtin_amdgcn_mfma_f32_16x16x32_bf16(Bt[n][k], At[m][k], acc[ai][bj][m][n], 0, 0, 0); __builtin_amdgcn_s_setprio(0); } while (0)
#define PG8_WAIT_V(n) asm volatile("s_waitcnt vmcnt(" #n ")" ::: "memory")
#define PG8_WAIT_L(n) asm volatile("s_waitcnt lgkmcnt(" #n ")" ::: "memory")
#define PG8_BAR __builtin_amdgcn_s_barrier()
#define PG8_SCHED __builtin_amdgcn_sched_barrier(0)
    Unit cur, nxt; int ui = 0;
    if (!S.next(0, cur)) return;
    f32x4 acc[2][2][4][2];
#pragma unroll
    for (int a = 0; a < 2; ++a)
#pragma unroll
        for (int b = 0; b < 2; ++b)
#pragma unroll
            for (int m = 0; m < 4; ++m)
#pragma unroll
                for (int n = 0; n < 2; ++n) acc[a][b][m][n] = (f32x4){0.f, 0.f, 0.f, 0.f};
    bf16x8 At[4][2], B0[2][2], B1[2][2];
    const char* cA = (const char*)g.A + (size_t)cur.pm * tstep; const char* cB = (const char*)g.Bt + (size_t)cur.pn * tstep;
    S.a_ready(cur);
    if constexpr (SP2) {
        PG8_STAGE(PG8_SB(0, 0), cB, voffB); PG8_STAGE(PG8_SB(0, 1), cB + hstep, voffB); PG8_STAGE(PG8_SA(0, 0), cA, voffA); PG8_STAGE(PG8_SA(0, 1), cA + hstep, voffA);
        if (wr == 1) PG8_BAR;
        PG8_WAIT_V(2); PG8_BAR;
        PG8_STAGE(PG8_SB(1, 0), cB + kstep, voffB); PG8_STAGE(PG8_SA(1, 0), cA + kstep, voffA); PG8_STAGE(PG8_SB(1, 1), cB + hstep + kstep, voffB);
        PG8_WAIT_V(6); PG8_BAR;
    } else {
        PG8_STAGE(PG8_SB(0, 0), cB, voffB); PG8_STAGE(PG8_SA(0, 0), cA, voffA); PG8_STAGE(PG8_SB(0, 1), cB + hstep, voffB); PG8_STAGE(PG8_SA(0, 1), cA + hstep, voffA);
        if (wr == 1) PG8_BAR;
        PG8_WAIT_V(4); PG8_BAR;
        PG8_STAGE(PG8_SB(1, 0), cB + kstep, voffB); PG8_STAGE(PG8_SA(1, 0), cA + kstep, voffA); PG8_STAGE(PG8_SB(1, 1), cB + hstep + kstep, voffB);
        PG8_WAIT_V(6); PG8_BAR;
    }
    for (;;) {
        const bool has_next = S.next(ui + 1, nxt);
        const char* nA = has_next ? (const char*)g.A + (size_t)nxt.pm * tstep : cA; const char* nB = has_next ? (const char*)g.Bt + (size_t)nxt.pn * tstep : cB;
        for (int t = 0; t < nt; t += 2) {
            const bool last = (t == nt - 2);
            const char* a1 = cA + (size_t)(t + 1) * kstep;
            const char* a2 = last ? nA : cA + (size_t)(t + 2) * kstep; const char* b2 = last ? nB : cB + (size_t)(t + 2) * kstep;
            const char* a3 = a2 + kstep; const char* b3 = b2 + kstep;
            if (last && has_next) S.a_ready(nxt);
            if constexpr (SP2) {
            PG8_LDB(B0, 0, 0); PG8_LDB(B1, 0, 1); PG8_SCHED; PG8_LDA(At, 0, 0); PG8_STAGE(PG8_SA(1, 1), a1 + hstep, voffA);
            PG8_WAIT_V(8); PG8_WAIT_L(0); PG8_BAR; PG8_MMA(0, 0, At, B0); PG8_MMA(0, 1, At, B1); PG8_BAR; PG8_SCHED;
            PG8_LDA(At, 0, 1); PG8_STAGE(PG8_SB(0, 0), b2, voffB); PG8_STAGE(PG8_SB(0, 1), b2 + hstep, voffB); PG8_STAGE(PG8_SA(0, 0), a2, voffA);
            PG8_WAIT_V(8); PG8_WAIT_L(0); PG8_BAR; PG8_MMA(1, 0, At, B0); PG8_MMA(1, 1, At, B1); PG8_BAR; PG8_SCHED;
            PG8_LDB(B0, 1, 0); PG8_LDB(B1, 1, 1); PG8_SCHED; PG8_LDA(At, 1, 0); PG8_STAGE(PG8_SA(0, 1), a2 + hstep, voffA);
            PG8_WAIT_V(8); PG8_WAIT_L(0); PG8_BAR; PG8_MMA(0, 0, At, B0); PG8_MMA(0, 1, At, B1); PG8_BAR; PG8_SCHED;
            PG8_LDA(At, 1, 1); PG8_STAGE(PG8_SB(1, 0), b3, voffB); PG8_STAGE(PG8_SB(1, 1), b3 + hstep, voffB); PG8_STAGE(PG8_SA(1, 0), a3, voffA);
            PG8_WAIT_V(8); PG8_WAIT_L(0); PG8_BAR; PG8_MMA(1, 0, At, B0); PG8_MMA(1, 1, At, B1); PG8_BAR; PG8_SCHED;
            } else {
            PG8_LDB(B0, 0, 0); PG8_SCHED; PG8_LDA(At, 0, 0); PG8_STAGE(PG8_SA(1, 1), a1 + hstep, voffA);
            PG8_WAIT_L(8); PG8_BAR; PG8_WAIT_L(0); PG8_MMA(0, 0, At, B0); PG8_BAR; PG8_SCHED;
            PG8_LDB(B1, 0, 1); PG8_STAGE(PG8_SB(0, 0), b2, voffB);
            PG8_BAR; PG8_WAIT_L(0); PG8_MMA(0, 1, At, B1); PG8_BAR;
            PG8_LDA(At, 0, 1); PG8_STAGE(PG8_SA(0, 0), a2, voffA);
            PG8_BAR; PG8_WAIT_L(0); PG8_MMA(1, 0, At, B0); PG8_BAR; PG8_SCHED;
            PG8_STAGE(PG8_SB(0, 1), b2 + hstep, voffB);
            PG8_WAIT_V(6); PG8_BAR; PG8_MMA(1, 1, At, B1); PG8_BAR;
            PG8_LDB(B0, 1, 0); PG8_SCHED; PG8_LDA(At, 1, 0); PG8_STAGE(PG8_SA(0, 1), a2 + hstep, voffA);
            PG8_WAIT_L(8); PG8_BAR; PG8_WAIT_L(0); PG8_MMA(0, 0, At, B0); PG8_BAR; PG8_SCHED;
            PG8_LDB(B1, 1, 1); PG8_STAGE(PG8_SB(1, 0), b3, voffB);
            PG8_BAR; PG8_WAIT_L(0); PG8_MMA(0, 1, At, B1); PG8_BAR;
            PG8_LDA(At, 1, 1); PG8_STAGE(PG8_SA(1, 0), a3, voffA);
            PG8_BAR; PG8_WAIT_L(0); PG8_MMA(1, 0, At, B0); PG8_BAR; PG8_SCHED;
            PG8_STAGE(PG8_SB(1, 1), b3 + hstep, voffB);
            PG8_WAIT_V(6); PG8_BAR; PG8_MMA(1, 1, At, B1); PG8_BAR;
            }
        }
        if constexpr (ALIGN_EPI) { if (wr == 0) PG8_BAR; }
        if constexpr (!Epi::AFTER_DRAIN) { E(acc, cur, wr, wc, fr, fq); S.done(cur); }
        if (!has_next) break;
#pragma unroll
        for (int a = 0; a < 2; ++a)
#pragma unroll
            for (int b = 0; b < 2; ++b)
#pragma unroll
                for (int m = 0; m < 4; ++m)
#pragma unroll
                    for (int n = 0; n < 2; ++n) acc[a][b][m][n] = (f32x4){0.f, 0.f, 0.f, 0.f};
        cur = nxt; cA = nA; cB = nB; ++ui;
        if constexpr (ALIGN_EPI) { if (wr == 1) PG8_BAR; }
    }
    PG8_WAIT_V(0);
    if constexpr (!ALIGN_EPI) { if (wr == 0) PG8_BAR; }
    PG8_BAR;
    if constexpr (Epi::AFTER_DRAIN) { E.fused(acc, cur, wr, wc, fr, fq, lds, wid, lane); S.done(cur); }
#undef PG8_SA
#undef PG8_SB
#undef PG8_STAGE
#undef PG8_LDA
#undef PG8_LDB
#undef PG8_MMA
#undef PG8_WAIT_V
#undef PG8_WAIT_L
#undef PG8_BAR
#undef PG8_SCHED
}
}

#define DI __device__ __forceinline__
#define LAS __attribute__((address_space(3)))
typedef unsigned short bf16;
typedef short bf16x8 __attribute__((ext_vector_type(8)));
typedef float f32x4 __attribute__((ext_vector_type(4)));
typedef float f32x2 __attribute__((ext_vector_type(2)));
typedef float f32x16 __attribute__((ext_vector_type(16)));
typedef unsigned u32x4 __attribute__((ext_vector_type(4)));
typedef unsigned u32x2 __attribute__((ext_vector_type(2)));
typedef __bf16 bf16x2_t __attribute__((ext_vector_type(2)));

DI unsigned pk2(float lo, float hi) { f32x2 v = {lo, hi}; bf16x2_t b = __builtin_convertvector(v, bf16x2_t); return __builtin_bit_cast(unsigned, b); }
DI bf16 f2bf(float f) { return (bf16)(pk2(f, 0.f) & 0xffffu); }
DI float bf2f(bf16 v) { return __builtin_bit_cast(float, (unsigned)v << 16); }
DI float bflo(unsigned u) { return __builtin_bit_cast(float, u << 16); }
DI float bfhi(unsigned u) { return __builtin_bit_cast(float, u & 0xffff0000u); }
typedef _Float16 f16x2_t __attribute__((ext_vector_type(2)));
typedef __fp16 fp16x2_t __attribute__((ext_vector_type(2)));
DI unsigned pkh2(float lo, float hi) { return __builtin_bit_cast(unsigned, __builtin_amdgcn_cvt_pkrtz(lo, hi)); }
DI float hlo(unsigned u) { return (float)__builtin_bit_cast(f16x2_t, u).x; }
DI float hhi(unsigned u) { return (float)__builtin_bit_cast(f16x2_t, u).y; }
DI float silu_f(float x) { return x * __builtin_amdgcn_rcpf(1.f + __expf(-x)); }
DI float ex2(float x) { return __builtin_amdgcn_exp2f(x); }
#define MFMA32(a, b, c) __builtin_amdgcn_mfma_f32_32x32x16_bf16((a), (b), (c), 0, 0, 0)

constexpr int DM = 1024, NB = 8, SEQ = 4096, CTXL = 256, DEPTH = 4;
constexpr int M_LAT = NB * SEQ, M_CTX = NB * CTXL, M_ALL = M_LAT + M_CTX;
constexpr int DFF = 2816, NGU = 2 * DFF, NIN = 3584, INC = 3588, NKEY = SEQ + CTXL, NVC = 34;
constexpr int XBC0 = 1792;
constexpr float ALPHA = 1.6817928305074290f;
constexpr float QSCALE = 0.125f * 1.4426950408889634f;
constexpr size_t MiB = 1u << 20;
constexpr size_t WS_MOD = 0, WS_TATT = 2 * MiB, WS_LAM = 2 * MiB + 65536, WS_BAR = 2 * MiB + 131072, WS_STAT = 2 * MiB + 262144, WS_ONES = 2 * MiB + 655360, WS_ZEROS = 2 * MiB + 655360 + 4096, WS_HALVES = 2 * MiB + 655360 + 8192, WS_TRET = 3 * MiB, WS_DT = 4 * MiB, WS_DEC = 5 * MiB, WS_XC = 6 * MiB,
                 WS_WGU = 14 * MiB, WS_WDN = 36 * MiB, WS_WIN = 47 * MiB, WS_WOUT = 54 * MiB, WS_A = 56 * MiB, WS_HP = 124 * MiB,
                 WS_VT = 362 * MiB, WS_STS = 396 * MiB, WS_STR = 430 * MiB, WS_U = 447 * MiB, WS_T = 498 * MiB, WS_X16 = 530 * MiB, WS_END = 598 * MiB;
constexpr int LDS_BYTES = 147456;
constexpr int NTHREADS = 512;

struct Args { const float* in[22]; float* out; unsigned char* ws; float afreq[16]; float rfreq[32]; int ph_lo, ph_hi; };
enum { I_X = 0, I_C, I_CTX, I_CCTX, I_ADAW, I_ADAB, I_NG, I_NB, I_WG, I_WU, I_WD, I_WIN, I_CONVW, I_CONVB, I_LAMBDA, I_SUBG, I_ALOG, I_DTB, I_SSMD, I_SSMG, I_RLG, I_WOUT };

DI float* xrow_ptr(float* xlat, float* xctx, int row) { return row < M_LAT ? xlat + (size_t)row * DM : xctx + (size_t)(row - M_LAT) * DM; }
DI int swap23(int o) { return (o & 3) | (((o >> 3) & 1) << 2) | (((o >> 2) & 1) << 3); }

struct EpiSwiglu {
    static constexpr bool PERM = true, AFTER_DRAIN = false;
    bf16* H;
    DI void operator()(const pg8::f32x4 (&acc)[2][2][4][2], const pg8::Unit& u, int wr, int wc, int fr, int fq) const {
        const int row0 = u.pm * 256 + wr * 64 + fr, col = u.pn * 128 + wc * 32 + 8 * fq;
#pragma unroll
        for (int ai = 0; ai < 2; ++ai)
#pragma unroll
            for (int m = 0; m < 4; ++m) {
                bf16* p = H + (size_t)(row0 + ai * 128 + m * 16) * DFF + col;
                float h[8];
#pragma unroll
                for (int n = 0; n < 2; ++n)
#pragma unroll
                    for (int j = 0; j < 4; ++j) h[n * 4 + j] = silu_f(acc[ai][0][m][n][j]) * acc[ai][1][m][n][j];
                u32x4 w; w.x = pk2(h[0], h[1]); w.y = pk2(h[2], h[3]); w.z = pk2(h[4], h[5]); w.w = pk2(h[6], h[7]);
                *(u32x4*)p = w;
                __builtin_amdgcn_sched_barrier(0);
            }
    }
};

struct EpiResid {
    static constexpr bool PERM = true, AFTER_DRAIN = false;
    bf16* X; const float* modg; const float* scale_p; const f32x2* stat; const float* gprev; const float* bprev;
    DI void operator()(const pg8::f32x4 (&acc)[2][2][4][2], const pg8::Unit& u, int wr, int wc, int fr, int fq) const {
        const int mi = (u.pm < 128) ? (u.pm >> 4) : 8;
        const float* gp = modg + (size_t)mi * 9216;
        const int row0 = u.pm * 256 + wr * 64 + fr, col0 = u.pn * 256 + wc * 32 + 8 * fq;
        const float scale = *scale_p;
#pragma unroll
        for (int bj = 0; bj < 2; ++bj) {
            f32x4 gs[2], gq[2], bq[2];
#pragma unroll
            for (int n = 0; n < 2; ++n) { const f32x4 g = *(const f32x4*)(gp + col0 + bj * 128 + 4 * n); gs[n] = (g + 1.0f) * scale;
                gq[n] = *(const f32x4*)(gprev + col0 + bj * 128 + 4 * n) * ALPHA; bq[n] = *(const f32x4*)(bprev + col0 + bj * 128 + 4 * n) * ALPHA; }
#pragma unroll
            for (int ai = 0; ai < 2; ++ai) {
                u32x4 xv[4]; f32x2 st[4];
#pragma unroll
                for (int m = 0; m < 4; ++m) { const int row = row0 + ai * 128 + m * 16; xv[m] = *(const u32x4*)(X + (size_t)row * DM + col0 + bj * 128); st[m] = stat[row]; }
                __builtin_amdgcn_sched_barrier(0);
#pragma unroll
                for (int m = 0; m < 4; ++m) {
                    const f32x4 x0 = {hlo(xv[m].x), hhi(xv[m].x), hlo(xv[m].y), hhi(xv[m].y)}, x1 = {hlo(xv[m].z), hhi(xv[m].z), hlo(xv[m].w), hhi(xv[m].w)};
                    const f32x4 y0 = (x0 - st[m].x) * st[m].y * gq[0] + bq[0] + gs[0] * acc[ai][bj][m][0];
                    const f32x4 y1 = (x1 - st[m].x) * st[m].y * gq[1] + bq[1] + gs[1] * acc[ai][bj][m][1];
                    u32x4 w; w.x = pkh2(y0.x, y0.y); w.y = pkh2(y0.z, y0.w); w.z = pkh2(y1.x, y1.y); w.w = pkh2(y1.z, y1.w);
                    *(u32x4*)(X + (size_t)(row0 + ai * 128 + m * 16) * DM + col0 + bj * 128) = w;
                }
                __builtin_amdgcn_sched_barrier(0);
            }
        }
    }
};
struct EpiPartial {
    static constexpr bool PERM = true, AFTER_DRAIN = false;
    float* T; const float* modg; const float* scale_p;
    DI void operator()(const pg8::f32x4 (&acc)[2][2][4][2], const pg8::Unit& u, int wr, int wc, int fr, int fq) const {
        const float* gp = modg + (size_t)8 * 9216; const float scale = *scale_p;
        const int row0 = u.pm * 256 + wr * 64 + fr - M_LAT, col0 = u.pn * 256 + wc * 32 + 8 * fq;
        f32x4 gs[2][2];
#pragma unroll
        for (int bj = 0; bj < 2; ++bj)
#pragma unroll
            for (int n = 0; n < 2; ++n) { f32x4 g = *(const f32x4*)(gp + col0 + bj * 128 + 4 * n); gs[bj][n] = (g + 1.0f) * scale; }
#pragma unroll
        for (int ai = 0; ai < 2; ++ai)
#pragma unroll
            for (int m = 0; m < 4; ++m) {
                float* tp = T + (size_t)(row0 + ai * 128 + m * 16) * DM + col0;
#pragma unroll
                for (int bj = 0; bj < 2; ++bj)
#pragma unroll
                    for (int n = 0; n < 2; ++n) *(f32x4*)(tp + bj * 128 + 4 * n) = gs[bj][n] * acc[ai][bj][m][n];
                __builtin_amdgcn_sched_barrier(0);
            }
    }
};
struct OneUnit {
    int have; pg8::Unit u;
    DI bool next(int i, pg8::Unit& o) const { if (i == 0 && have) { o = u; return true; } return false; }
    DI void a_ready(const pg8::Unit&) const {}
    DI void done(const pg8::Unit&) const {}
};

struct EpiIn {
    static constexpr bool PERM = true, AFTER_DRAIN = false;
    bf16* P; bf16* Vt; const f32x2* tatt; const f32x2* tret;
    DI void operator()(const pg8::f32x4 (&acc)[2][2][4][2], const pg8::Unit& u, int wr, int wc, int fr, int fq) const {
        const int pn = u.pn;
        const int row0 = u.pm * 256 + wr * 64 + fr;
        if (pn == 4 || pn == 5) {
#pragma unroll
            for (int ai = 0; ai < 2; ++ai)
#pragma unroll
                for (int m = 0; m < 4; ++m) {
                    const int row = row0 + ai * 128 + m * 16;
                    int b, key;
                    if (row < M_LAT) { b = row >> 12; key = row & 4095; } else { const int r2 = row - M_LAT; b = r2 >> 8; key = 4096 + (r2 & 255); }
                    const int kp = (key & ~15) | swap23(key & 15);
#pragma unroll
                    for (int bj = 0; bj < 2; ++bj) {
                        const int h = 2 * (pn - 4) + bj;
                        bf16* vp = Vt + ((size_t)(b * 4 + h) * 128 + wc * 32 + 8 * fq) * NKEY + kp;
#pragma unroll
                        for (int n = 0; n < 2; ++n)
#pragma unroll
                            for (int j = 0; j < 4; ++j) vp[(size_t)(n * 4 + j) * NKEY] = f2bf(acc[ai][bj][m][n][j]);
                    }
                    __builtin_amdgcn_sched_barrier(0);
                }
            return;
        }
        const bool att = pn < 4, ret = (pn == 10 || pn == 11);
        const float sc = (pn < 2) ? QSCALE : (pn == 11 ? 0.125f : 1.0f);
#pragma unroll
        for (int ai = 0; ai < 2; ++ai)
#pragma unroll
            for (int m = 0; m < 4; ++m) {
                const int row = row0 + ai * 128 + m * 16;
                f32x2 cs[4];
                bool rot = false;
                if ((att || ret) && row < M_LAT) {
                    rot = true;
                    const int s = row & 4095;
                    const f32x2* tp;
                    if (att) { const int pos = (wc & 1) ? (s & 63) : (s >> 6); tp = tatt + pos * 16 + 4 * fq; }
                    else { tp = tret + (size_t)s * 32 + 16 * (wc & 1) + 4 * fq; }
                    const f32x4 t0 = *(const f32x4*)tp, t1 = *(const f32x4*)(tp + 2);
                    cs[0] = (f32x2){t0.x, t0.y}; cs[1] = (f32x2){t0.z, t0.w}; cs[2] = (f32x2){t1.x, t1.y}; cs[3] = (f32x2){t1.z, t1.w};
                }
#pragma unroll
                for (int bj = 0; bj < 2; ++bj) {
                    float v[8];
#pragma unroll
                    for (int n = 0; n < 2; ++n)
#pragma unroll
                        for (int j = 0; j < 4; ++j) v[n * 4 + j] = acc[ai][bj][m][n][j];
                    if (rot) {
#pragma unroll
                        for (int q = 0; q < 4; ++q) { const float h1 = v[2 * q], h2 = v[2 * q + 1]; v[2 * q] = h1 * cs[q].x - h2 * cs[q].y; v[2 * q + 1] = h2 * cs[q].x + h1 * cs[q].y; }
                    }
                    u32x4 w; w.x = pk2(v[0] * sc, v[1] * sc); w.y = pk2(v[2] * sc, v[3] * sc); w.z = pk2(v[4] * sc, v[5] * sc); w.w = pk2(v[6] * sc, v[7] * sc);
                    *(u32x4*)(P + (size_t)row * NIN + pn * 256 + bj * 128 + wc * 32 + 8 * fq) = w;
                }
                __builtin_amdgcn_sched_barrier(0);
            }
    }
};

DI void sincos_d(float angf, float& c, float& s) {
    const double a = (double)angf;
    const double k = rint(a * 0.15915494309189535);
    double r = fma(-k, 6.283185307179586, a); r = fma(-k, 2.4492935982947064e-16, r);
    const double r2 = r * r;
    double ts = r, ss = r, tc = 1.0, sc = 1.0;
#pragma unroll 1
    for (int n = 1; n <= 15; ++n) {
        tc = -tc * r2 / (double)((2 * n - 1) * (2 * n)); sc += tc;
        ts = -ts * r2 / (double)((2 * n) * (2 * n + 1)); ss += ts;
    }
    c = (float)sc; s = (float)ss;
}

DI int in_srccol(int j) {
    if (j < 1024) { const int blk = j >> 6, dp = j & 63, half = dp >> 5, i = (dp & 31) >> 1, sec = dp & 1; return blk * 64 + half * 32 + i + 16 * sec; }
    if (j < 2560) return j;
    if (j < 3072) { const int jj = j - 2560, blk = jj >> 6, dp = jj & 63, i = dp >> 1, sec = dp & 1; return 2564 + blk * 64 + i + 32 * sec; }
    return j + 4;
}

DI void transpose_item(const float* W, int ldw, int K, int srccol_lane, bf16* WT, int n0, int k0, LAS float* scr, int lane) {
#pragma unroll 8
    for (int i = 0; i < 32; ++i) { const int kk = 2 * i + (lane >> 5); scr[kk * 33 + (lane & 31)] = W[(size_t)(k0 + kk) * ldw + srccol_lane]; }
    asm volatile("s_waitcnt lgkmcnt(0)" ::: "memory");
    const int c = lane & 7;
#pragma unroll
    for (int j = 0; j < 4; ++j) {
        const int n = (lane >> 3) + 8 * j; const LAS float* s = scr + (8 * c) * 33 + n;
        u32x4 o; o.x = pk2(s[0 * 33], s[1 * 33]); o.y = pk2(s[2 * 33], s[3 * 33]); o.z = pk2(s[4 * 33], s[5 * 33]); o.w = pk2(s[6 * 33], s[7 * 33]);
        *(u32x4*)(WT + (size_t)(n0 + n) * K + k0 + 8 * c) = o;
    }
    asm volatile("s_waitcnt lgkmcnt(0)" ::: "memory");
}

DI void transpose_item_wide(const float* W, int ldw, int K, int src0, bf16* WT, int n0, int k0, LAS float* scr, int lane) {
    const int c4 = lane & 7, kr = lane >> 3;
#pragma unroll
    for (int i = 0; i < 8; ++i) { const int kk = kr + 8 * i; const f32x4 v = *(const f32x4*)(W + (size_t)(k0 + kk) * ldw + src0 + 4 * c4);
        LAS float* d = scr + kk * 33 + 4 * c4; d[0] = v.x; d[1] = v.y; d[2] = v.z; d[3] = v.w; }
    asm volatile("s_waitcnt lgkmcnt(0)" ::: "memory");
    const int c = lane & 7;
#pragma unroll
    for (int j = 0; j < 4; ++j) {
        const int n = (lane >> 3) + 8 * j; const LAS float* sp = scr + (8 * c) * 33 + n;
        u32x4 o; o.x = pk2(sp[0 * 33], sp[1 * 33]); o.y = pk2(sp[2 * 33], sp[3 * 33]); o.z = pk2(sp[4 * 33], sp[5 * 33]); o.w = pk2(sp[6 * 33], sp[7 * 33]);
        *(u32x4*)(WT + (size_t)(n0 + n) * K + k0 + 8 * c) = o;
    }
    asm volatile("s_waitcnt lgkmcnt(0)" ::: "memory");
}

DI void convw_phase(const Args& A, int l, LAS unsigned char* lds, int tid, int bid, int G) {
    const int lane = tid & 63, wave = tid >> 6;
    LAS float* scr = (LAS float*)(lds + 65536 + wave * 8448);
    const int gw = bid * 8 + wave, NGW = G * 8;
    constexpr int I_GU = 2 * 16 * (NGU / 32), I_DN = 2 * (DFF / 64) * (DM / 32), I_IN = 16 * (NIN / 32), I_OUT = 16 * 32;
    bf16* wgu = (bf16*)(A.ws + WS_WGU); bf16* wdn = (bf16*)(A.ws + WS_WDN); bf16* win = (bf16*)(A.ws + WS_WIN); bf16* wout = (bf16*)(A.ws + WS_WOUT);
    for (int it = gw; it < I_GU + I_DN + I_IN + I_OUT; it += NGW) {
        int r = it;
        if (r < I_GU) {
            const int f = r / (16 * (NGU / 32)); r -= f * 16 * (NGU / 32);
            const int kb = r / (NGU / 32), nb = r % (NGU / 32), n0 = nb * 32, pn = n0 >> 8, cc = n0 & 255;
            const float* src = (cc < 128 ? A.in[I_WG] : A.in[I_WU]) + (size_t)(l * 2 + f) * DM * DFF;
            transpose_item_wide(src, DFF, DM, 128 * pn + (cc & 127), wgu + (size_t)f * NGU * DM, n0, kb * 64, scr, lane);
            continue;
        }
        r -= I_GU;
        if (r < I_DN) {
            const int f = r / ((DFF / 64) * 32); r -= f * (DFF / 64) * 32;
            const int kb = r / 32, nb = r % 32;
            transpose_item_wide(A.in[I_WD] + (size_t)(l * 2 + f) * DFF * DM, DM, DFF, nb * 32, wdn + (size_t)f * DM * DFF, nb * 32, kb * 64, scr, lane);
            continue;
        }
        r -= I_DN;
        if (r < I_IN) {
            const int kb = r / (NIN / 32), nb = r % (NIN / 32);
            transpose_item(A.in[I_WIN] + (size_t)l * DM * INC, INC, DM, in_srccol(nb * 32 + (lane & 31)), win, nb * 32, kb * 64, scr, lane);
            continue;
        }
        r -= I_IN;
        { const int kb = r / 32, nb = r % 32;
          transpose_item_wide(A.in[I_WOUT] + (size_t)l * DM * DM, DM, DM, nb * 32, wout, nb * 32, kb * 64, scr, lane); }
    }
}

DI void p0a_phase(const Args& A, LAS unsigned char* lds, int tid, int bid, int G) {
    const int lane = tid & 63, wave = tid >> 6;
    { const int gt = bid * NTHREADS + tid;
      f32x2* tatt = (f32x2*)(A.ws + WS_TATT); f32x2* tret = (f32x2*)(A.ws + WS_TRET);
      if (gt < 1024) { ((float*)(A.ws + WS_ONES))[gt] = 1.0f; ((float*)(A.ws + WS_ZEROS))[gt] = 0.0f; ((float*)(A.ws + WS_HALVES))[gt] = 0.5f; }
      if (gt < 1024) { const int pos = gt >> 4, i = gt & 15; float c, s; sincos_d((float)pos * A.afreq[i], c, s); tatt[gt] = (f32x2){c, s}; }
      for (int e = gt; e < SEQ * 32; e += G * NTHREADS) { const int sidx = e >> 5, i = e & 31; float c, s; sincos_d((float)sidx * A.rfreq[i], c, s); tret[e] = (f32x2){c, s}; }
      if (gt < DEPTH) {
          const float* lv = A.in[I_LAMBDA] + gt * 256; float d0 = 0.f, d1 = 0.f;
          for (int i = 0; i < 64; ++i) { d0 += lv[i] * lv[64 + i]; d1 += lv[128 + i] * lv[192 + i]; }
          const float lam_init = 0.8f - 0.6f * expf(-0.3f * (float)gt);
          ((float*)(A.ws + WS_LAM))[gt] = expf(d0) - expf(d1) + lam_init;
      }
    }
    LAS float* scs = (LAS float*)lds;
    LAS float* red = (LAS float*)(lds + 36864);
    for (int e = tid; e < 9 * 1024; e += NTHREADS) { const int mi = e >> 10, k = e & 1023; const float v = (mi < 8) ? A.in[I_C][mi * 1024 + k] : A.in[I_CCTX][k]; scs[e] = silu_f(v); }
    __syncthreads();
    float* MOD = (float*)(A.ws + WS_MOD);
    for (int it = bid; it < DEPTH * 144; it += G) {
        const int l = it / 144, cg0 = (it % 144) * 64;
        const float* w = A.in[I_ADAW] + (size_t)l * DM * 9216 + cg0 + lane;
        float acc[9];
#pragma unroll
        for (int mi = 0; mi < 9; ++mi) acc[mi] = 0.f;
#pragma unroll 4
        for (int k = wave * 128; k < wave * 128 + 128; ++k) {
            const float wv = w[(size_t)k * 9216];
#pragma unroll
            for (int mi = 0; mi < 9; ++mi) acc[mi] += scs[mi * 1024 + k] * wv;
        }
#pragma unroll
        for (int mi = 0; mi < 9; ++mi) red[(wave * 9 + mi) * 64 + lane] = acc[mi];
        __syncthreads();
        for (int e = tid; e < 576; e += NTHREADS) {
            const int mi = e >> 6, cl = e & 63; float s = A.in[I_ADAB][l * 9216 + cg0 + cl];
#pragma unroll
            for (int w8 = 0; w8 < 8; ++w8) s += red[(w8 * 9 + mi) * 64 + cl];
            MOD[((size_t)l * 9 + mi) * 9216 + cg0 + cl] = s;
        }
        __syncthreads();
    }
    convw_phase(A, 0, lds, tid, bid, G);
}

DI void wave_sum2(float& a, float& b) {
#pragma unroll
    for (int o = 1; o < 64; o <<= 1) { const float ta = __shfl_xor(a, o), tb = __shfl_xor(b, o); a += ta; b += tb; }
}
DI void wave_sum4(float& a, float& b, float& c, float& d) {
#pragma unroll
    for (int o = 1; o < 64; o <<= 1) { const float ta = __shfl_xor(a, o), tb = __shfl_xor(b, o), tc = __shfl_xor(c, o), td = __shfl_xor(d, o); a += ta; b += tb; c += tc; d += td; }
}
DI float wave_sum(float v) {
#pragma unroll
    for (int o = 1; o < 64; o <<= 1) v += __shfl_xor(v, o);
    return v;
}
DI void lnmod_phase(const Args& A, LAS unsigned char* lds, int tid, int bid, int G, bool init, int l_norm, int i_norm, int l_mod, int i_mod, bool want_dt, int nrows, bool ctx_partial, const float* gprev, const float* bprev) {
    const int lane = tid & 63, wave = tid >> 6;
    LAS f32x4* wdt = (LAS f32x4*)lds;
    if (want_dt) {
        for (int k = tid; k < 1024; k += NTHREADS) wdt[k] = *(const f32x4*)(A.in[I_WIN] + ((size_t)l_mod * DM + k) * INC + 2560);
        __syncthreads();
    }
    const float* MOD = (const float*)(A.ws + WS_MOD);
    bf16* Abuf = (bf16*)(A.ws + WS_A);
    float* DT = (float*)(A.ws + WS_DT);
    f32x4 g[4], bb[4];
    if (l_norm >= 0) {
#pragma unroll
        for (int j = 0; j < 4; ++j) { g[j] = *(const f32x4*)(A.in[I_NG] + (l_norm * 3 + i_norm) * DM + 256 * j + 4 * lane); bb[j] = *(const f32x4*)(A.in[I_NB] + (l_norm * 3 + i_norm) * DM + 256 * j + 4 * lane); }
    }
    bf16* X16 = (bf16*)(A.ws + WS_X16);
    u32x2 un[4]; f32x4 fn[4];
    int mi_cur = -1; f32x4 shv[4], sclv[4];
    { const int row = bid * 8 + wave;
      if (row < nrows) {
          if (init) { const float* xin = row < M_LAT ? A.in[I_X] + (size_t)row * DM : A.in[I_CTX] + (size_t)(row - M_LAT) * DM;
#pragma unroll
              for (int j = 0; j < 4; ++j) fn[j] = *(const f32x4*)(xin + 256 * j + 4 * lane); }
          else {
#pragma unroll
              for (int j = 0; j < 4; ++j) un[j] = *(const u32x2*)(X16 + (size_t)row * DM + 256 * j + 4 * lane); } } }
    for (int row = bid * 8 + wave; row < nrows; row += G * 8) {
        bf16* xout = X16 + (size_t)row * DM;
        f32x4 v[4];
#pragma unroll
        for (int j = 0; j < 4; ++j) v[j] = init ? fn[j] : (f32x4){hlo(un[j].x), hhi(un[j].x), hlo(un[j].y), hhi(un[j].y)};
        { const int rown = row + G * 8;
          if (rown < nrows) {
              if (init) { const float* xin = rown < M_LAT ? A.in[I_X] + (size_t)rown * DM : A.in[I_CTX] + (size_t)(rown - M_LAT) * DM;
#pragma unroll
                  for (int j = 0; j < 4; ++j) fn[j] = *(const f32x4*)(xin + 256 * j + 4 * lane); }
              else {
#pragma unroll
                  for (int j = 0; j < 4; ++j) un[j] = *(const u32x2*)(X16 + (size_t)rown * DM + 256 * j + 4 * lane); } } }
        f32x2* STAT = (f32x2*)(A.ws + WS_STAT);
        if (ctx_partial && row >= M_LAT) {
            { const f32x2 st = STAT[row];
#pragma unroll
              for (int j = 0; j < 4; ++j) v[j] = (v[j] - st.x) * st.y * *(const f32x4*)(gprev + 256 * j + 4 * lane) + *(const f32x4*)(bprev + 256 * j + 4 * lane); }
            const float* t0 = (const float*)(A.ws + WS_T) + (size_t)(row - M_LAT) * DM; const float* t1 = t0 + (size_t)M_CTX * DM; const float* t2 = t1 + (size_t)M_CTX * DM; const float* t3 = t2 + (size_t)M_CTX * DM;
#pragma unroll
            for (int j = 0; j < 4; ++j) { v[j] = v[j] * ALPHA + (*(const f32x4*)(t0 + 256 * j + 4 * lane) + *(const f32x4*)(t1 + 256 * j + 4 * lane)) + (*(const f32x4*)(t2 + 256 * j + 4 * lane) + *(const f32x4*)(t3 + 256 * j + 4 * lane)); u32x2 w_; w_.x = pkh2(v[j].x, v[j].y); w_.y = pkh2(v[j].z, v[j].w); *(u32x2*)(xout + 256 * j + 4 * lane) = w_; }
        }
        if (l_norm >= 0) {
            float s = 0.f, s2 = 0.f;
#pragma unroll
            for (int j = 0; j < 4; ++j) { s += (v[j].x + v[j].y) + (v[j].z + v[j].w); s2 += (v[j].x * v[j].x + v[j].y * v[j].y) + (v[j].z * v[j].z + v[j].w * v[j].w); }
            wave_sum2(s, s2);
            const float mean = s * (1.f / DM);
            const float rstd = 1.0f / sqrtf(fmaxf(s2 * (1.f / DM) - mean * mean, 0.f) + 1e-5f);
#pragma unroll
            for (int j = 0; j < 4; ++j) v[j] = v[j] - mean;
            if (l_mod >= 0 && lane == 0) STAT[row] = (f32x2){mean, rstd};
#pragma unroll
            for (int j = 0; j < 4; ++j) v[j] = v[j] * rstd * g[j] + bb[j];
        }
        if (init && lane == 0) STAT[row] = (f32x2){0.f, 1.f};
        if (init) {
#pragma unroll
            for (int j = 0; j < 4; ++j) { u32x2 w_; w_.x = pkh2(v[j].x, v[j].y); w_.y = pkh2(v[j].z, v[j].w); *(u32x2*)(xout + 256 * j + 4 * lane) = w_; }
        }
        if (l_norm >= 0 && l_mod < 0) {
#pragma unroll
            for (int j = 0; j < 4; ++j) *(f32x4*)(A.out + (size_t)row * DM + 256 * j + 4 * lane) = v[j];
        }
        if (l_mod >= 0) {
            const int mi = row < M_LAT ? (row >> 12) : 8;
            const float* mp = MOD + ((size_t)l_mod * 9 + mi) * 9216 + i_mod * 3072;
            if (mi != mi_cur) { mi_cur = mi;
#pragma unroll
                for (int j = 0; j < 4; ++j) { shv[j] = *(const f32x4*)(mp + 256 * j + 4 * lane); sclv[j] = *(const f32x4*)(mp + 1024 + 256 * j + 4 * lane) + 1.0f; } }
            float d0 = 0.f, d1 = 0.f, d2 = 0.f, d3 = 0.f;
#pragma unroll
            for (int j = 0; j < 4; ++j) {
                const f32x4 a = v[j] * sclv[j] + shv[j];
                u32x2 w; w.x = pk2(a.x, a.y); w.y = pk2(a.z, a.w);
                *(u32x2*)(Abuf + (size_t)row * DM + 256 * j + 4 * lane) = w;
                if (want_dt) {
                    const int k0 = 256 * j + 4 * lane;
                    const f32x4 w0 = wdt[k0], w1 = wdt[k0 + 1], w2 = wdt[k0 + 2], w3 = wdt[k0 + 3];
                    d0 += a.x * w0.x + a.y * w1.x + a.z * w2.x + a.w * w3.x;
                    d1 += a.x * w0.y + a.y * w1.y + a.z * w2.y + a.w * w3.y;
                    d2 += a.x * w0.z + a.y * w1.z + a.z * w2.z + a.w * w3.z;
                    d3 += a.x * w0.w + a.y * w1.w + a.z * w2.w + a.w * w3.w;
                }
            }
            if (want_dt) {
                wave_sum4(d0, d1, d2, d3);
                if (lane == 0) *(f32x4*)(DT + (size_t)row * 4) = (f32x4){d0, d1, d2, d3};
            }
        }
    }
}

DI float max3f(float a, float b, float c) { float r; asm("v_max3_f32 %0, %1, %2, %3" : "=v"(r) : "v"(a), "v"(b), "v"(c)); return r; }
DI float max3f_mfma(float a, float b, float c) { float r; asm("s_nop 15\n\ts_nop 7\n\tv_max3_f32 %0, %1, %2, %3" : "=v"(r) : "v"(a), "v"(b), "v"(c)); return r; }
DI void attn_unit(LAS unsigned char* lds, int tid, const bf16* __restrict__ P, const bf16* __restrict__ Vt, bf16* MG, int b, int h, int qrow0, int jt0, int jt1,
                  float lam, float oscale, const float* subg) {
    asm volatile("" : "+v"(tid));
    constexpr int KP = 136, VP = 72, KBYTES = 64 * KP * 2, VBYTES = 128 * VP * 2;
    const int lane = tid & 63, wave = tid >> 6, r32 = lane & 31, hi = lane >> 5;
    const int qb = wave >> 1, m = wave & 1;
    const int qrow = qrow0 + qb * 32 + r32;
    bf16x8 qf[4];
#pragma unroll
    for (int ks = 0; ks < 4; ++ks) qf[ks] = *(const bf16x8*)(P + (size_t)qrow * NIN + h * 128 + m * 64 + ks * 16 + hi * 8);
    f32x16 O[4];
#pragma unroll
    for (int es = 0; es < 4; ++es)
#pragma unroll
        for (int i = 0; i < 16; ++i) O[es][i] = 0.f;
    float mrun = 0.f, lrun = 0.f;
    u32x4 kreg[2], vreg[2];
    const bf16* vbase = Vt + (size_t)(b * 4 + h) * 128 * NKEY;
#define ATT_LOADG(j) do { _Pragma("unroll") for (int i_ = 0; i_ < 2; ++i_) { const int c_ = tid + 512 * i_; const int key_ = c_ >> 4, part_ = c_ & 15; \
        const int row_ = ((j) < 64) ? b * SEQ + (j) * 64 + key_ : M_LAT + b * CTXL + ((j) - 64) * 64 + key_; \
        kreg[i_] = *(const u32x4*)(P + (size_t)row_ * NIN + 512 + h * 128 + part_ * 8); \
        const int e_ = c_ >> 3, vp_ = c_ & 7; vreg[i_] = *(const u32x4*)(vbase + (size_t)e_ * NKEY + (j) * 64 + vp_ * 8); } } while (0)
#define ATT_STORE(buf) do { _Pragma("unroll") for (int i_ = 0; i_ < 2; ++i_) { const int c_ = tid + 512 * i_; const int key_ = c_ >> 4, part_ = c_ & 15, e_ = c_ >> 3, vp_ = c_ & 7; \
        *(LAS u32x4*)(lds + (buf) * KBYTES + (key_ * KP + part_ * 8) * 2) = kreg[i_]; \
        *(LAS u32x4*)(lds + 2 * KBYTES + (buf) * VBYTES + (e_ * VP + vp_ * 8) * 2) = vreg[i_]; } } while (0)
    const bool halfB = wave >= 4;
    bf16x8 pf[4];
#define ATT_QKS(bufk, first_) do { \
        const LAS bf16* Kb = (const LAS bf16*)(lds + (bufk) * KBYTES) + m * 64 + hi * 8; \
        f32x16 s0, s1; \
        { const float ninit = -mrun; _Pragma("unroll") for (int i = 0; i < 16; ++i) { s0[i] = ninit; s1[i] = ninit; } } \
        _Pragma("unroll") for (int ks = 0; ks < 4; ++ks) { \
            const bf16x8 a0 = *(const LAS bf16x8*)(Kb + r32 * KP + ks * 16); \
            const bf16x8 a1 = *(const LAS bf16x8*)(Kb + (32 + r32) * KP + ks * 16); \
            s0 = MFMA32(a0, qf[ks], s0); s1 = MFMA32(a1, qf[ks], s1); } \
        float mx = max3f_mfma(s0[0], s1[0], s0[1]); \
        mx = max3f(mx, s1[1], s0[2]); mx = max3f(mx, s1[2], s0[3]); mx = max3f(mx, s1[3], s0[4]); mx = max3f(mx, s1[4], s0[5]); \
        mx = max3f(mx, s1[5], s0[6]); mx = max3f(mx, s1[6], s0[7]); mx = max3f(mx, s1[7], s0[8]); mx = max3f(mx, s1[8], s0[9]); \
        mx = max3f(mx, s1[9], s0[10]); mx = max3f(mx, s1[10], s0[11]); mx = max3f(mx, s1[11], s0[12]); mx = max3f(mx, s1[12], s0[13]); \
        mx = max3f(mx, s1[13], s0[14]); mx = max3f(mx, s1[14], s0[15]); mx = max3f(mx, s1[15], mx); \
        mx = max3f(mx, __shfl_xor(mx, 32), mx); \
        if ((first_) || __builtin_amdgcn_ballot_w64(mx > 8.0f) != 0ull) { \
            const float d = (first_) ? mx : (mx > 8.0f ? mx : 0.f); \
            mrun += d; \
            if (!(first_)) { const float alpha = ex2(-d); lrun *= alpha; _Pragma("unroll") for (int es = 0; es < 4; ++es) O[es] = O[es] * alpha; } \
            _Pragma("unroll") for (int i = 0; i < 16; ++i) { s0[i] -= d; s1[i] -= d; } } \
        float sum = 0.f; \
        _Pragma("unroll") for (int i = 0; i < 16; ++i) { s0[i] = ex2(s0[i]); s1[i] = ex2(s1[i]); sum += s0[i] + s1[i]; } \
        lrun += sum; \
        _Pragma("unroll") for (int s2 = 0; s2 < 2; ++s2) { u32x4 w0, w1; \
            w0.x = pk2(s0[8 * s2 + 0], s0[8 * s2 + 1]); w0.y = pk2(s0[8 * s2 + 2], s0[8 * s2 + 3]); w0.z = pk2(s0[8 * s2 + 4], s0[8 * s2 + 5]); w0.w = pk2(s0[8 * s2 + 6], s0[8 * s2 + 7]); \
            w1.x = pk2(s1[8 * s2 + 0], s1[8 * s2 + 1]); w1.y = pk2(s1[8 * s2 + 2], s1[8 * s2 + 3]); w1.z = pk2(s1[8 * s2 + 4], s1[8 * s2 + 5]); w1.w = pk2(s1[8 * s2 + 6], s1[8 * s2 + 7]); \
            pf[s2] = __builtin_bit_cast(bf16x8, w0); pf[2 + s2] = __builtin_bit_cast(bf16x8, w1); } } while (0)
#define ATT_PV(bufv) do { \
        const LAS bf16* Vb = (const LAS bf16*)(lds + 2 * KBYTES + (bufv) * VBYTES) + hi * 8; \
        _Pragma("unroll") for (int es = 0; es < 4; ++es) _Pragma("unroll") for (int kk = 0; kk < 4; ++kk) { \
            const bf16x8 a = *(const LAS bf16x8*)(Vb + (es * 32 + r32) * VP + kk * 16); O[es] = MFMA32(a, pf[kk], O[es]); } } while (0)
    __syncthreads();
    ATT_LOADG(jt0);
    for (int j = jt0; j < jt1; ++j) {
        const int buf = (j - jt0) & 1;
        ATT_STORE(buf);
        __syncthreads();
        if (j + 1 < jt1) ATT_LOADG(j + 1);
        if (!halfB) { ATT_QKS(buf, j == jt0); } else if (j > jt0) { ATT_PV(buf ^ 1); }
        __syncthreads();
        if (!halfB) { ATT_PV(buf); } else { ATT_QKS(buf, j == jt0); }
    }
    if (halfB) { ATT_PV((jt1 - 1 - jt0) & 1); }
#undef ATT_QKS
#undef ATT_PV
#undef ATT_LOADG
#undef ATT_STORE
    __syncthreads();
    const float l = lrun + __shfl_xor(lrun, 32);
    const float inv = (m ? lam : 1.0f) / l;
    LAS float* X = (LAS float*)lds + qb * 4096 + lane;
    if (m) {
#pragma unroll
        for (int es = 0; es < 4; ++es)
#pragma unroll
            for (int i = 0; i < 16; ++i) X[(es * 16 + i) * 64] = O[es][i] * inv;
    }
    __syncthreads();
    if (!m) {
        float ss = 0.f;
#pragma unroll
        for (int es = 0; es < 4; ++es)
#pragma unroll
            for (int i = 0; i < 16; ++i) { const float o = O[es][i] * inv - X[(es * 16 + i) * 64]; O[es][i] = o; ss += o * o; }
        ss += __shfl_xor(ss, 32);
        const float rn = (1.0f / sqrtf(ss * (1.0f / 128.0f) + 1e-6f)) * oscale;
#pragma unroll
        for (int es = 0; es < 4; ++es)
#pragma unroll
            for (int g4 = 0; g4 < 4; ++g4) {
                const int e = es * 32 + 8 * g4 + 4 * hi;
                const f32x4 gv = *(const f32x4*)(subg + e);
                u32x2 w; w.x = pk2(O[es][4 * g4 + 0] * rn * gv.x, O[es][4 * g4 + 1] * rn * gv.y); w.y = pk2(O[es][4 * g4 + 2] * rn * gv.z, O[es][4 * g4 + 3] * rn * gv.w);
                *(u32x2*)(MG + (size_t)qrow * DM + h * 128 + e) = w;
            }
    }
}

constexpr int SC_ACF = 0, SC_ACB = 1, SC_DT0 = 2, SC_DT1 = 3;
constexpr int L_STAT = 8192, L_BUF = 16384;
constexpr int TP = 136;
constexpr int QP = 72;
constexpr int UW = 768;

DI int vc_row0(int b, int vc) { return vc < 2 ? M_LAT + b * CTXL + vc * 128 : b * SEQ + (vc - 2) * 128; }
DI float softplus_f(float x) { return fmaxf(x, 0.f) + log1pf(__expf(-fabsf(x))); }

struct ScanCtx { const bf16* P; const bf16* U; const float* DT; bf16* sts; bf16* str; float* dec; bf16* MG; const float* cw; const float* cb; const float* alog; const float* dtb; const float* ssmd; const float* ssmg; const float* rlg; };

DI void conv_phase(const bf16* __restrict__ P, bf16* __restrict__ U, const float* cw, const float* cb, int tid, int bid, int G) {
    const int lane = tid & 63, wave = tid >> 6;
    for (int it = bid * 8 + wave; it < (M_ALL / 16) * 3; it += G * 8) {
        const int run = it / 3, cgp = it % 3, row0 = run * 16, ch = cgp * 256 + 4 * lane;
        int s0, L; if (row0 < M_LAT) { s0 = row0 & (SEQ - 1); L = SEQ; } else { s0 = (row0 - M_LAT) & (CTXL - 1); L = CTXL; }
        f32x4 w[5];
#pragma unroll
        for (int k = 0; k < 5; ++k) w[k] = *(const f32x4*)(cw + k * UW + ch);
        const f32x4 bias = *(const f32x4*)(cb + ch);
        f32x4 x[20];
#pragma unroll
        for (int i = 0; i < 20; ++i) { const int s = s0 - 2 + i; u32x2 v = {0u, 0u}; if (s >= 0 && s < L) v = *(const u32x2*)(P + (size_t)(row0 - 2 + i) * NIN + XBC0 + ch);
            x[i] = (f32x4){bflo(v.x), bfhi(v.x), bflo(v.y), bfhi(v.y)}; }
#pragma unroll
        for (int t = 0; t < 16; ++t) {
            const f32x4 a = bias + w[0] * x[t] + w[1] * x[t + 1] + w[2] * x[t + 2] + w[3] * x[t + 3] + w[4] * x[t + 4];
            u32x2 o; o.x = pk2(silu_f(a.x), silu_f(a.y)); o.y = pk2(silu_f(a.z), silu_f(a.w));
            *(u32x2*)(U + (size_t)(row0 + t) * UW + ch) = o;
        }
    }
}

DI void ssd_scalars(LAS float* sc, int tid, const float* DT, int row0, const float* alog, const float* dtb, float* dec_f, float* dec_b) {
    const int lane = tid & 63, wave = tid >> 6;
    if (wave < 4) {
        const int h = wave;
        const float r0 = DT[(size_t)(row0 + 2 * lane) * 4 + h], r1 = DT[(size_t)(row0 + 2 * lane + 1) * 4 + h];
        const float ea0 = __expf(alog[h]), ea1 = __expf(alog[4 + h]);
        const float d00 = softplus_f(r0 + dtb[h]), d01 = softplus_f(r1 + dtb[h]);
        const float d10 = softplus_f(r0 + dtb[4 + h]), d11 = softplus_f(r1 + dtb[4 + h]);
        const float la00 = -d00 * ea0, la01 = -d01 * ea0, la10 = -d10 * ea1, la11 = -d11 * ea1;
        float pf = la00 + la01, pb = la10 + la11;
#pragma unroll
        for (int o = 1; o < 64; o <<= 1) { const float tf = __shfl_up(pf, o), tb = __shfl_up(pb, o); if (lane >= o) { pf += tf; pb += tb; } }
        const float totb = __shfl(pb, 63), totf = __shfl(pf, 63);
        sc[(SC_ACF * 4 + h) * 128 + 2 * lane + 1] = pf; sc[(SC_ACF * 4 + h) * 128 + 2 * lane] = pf - la01;
        sc[(SC_ACB * 4 + h) * 128 + 2 * lane + 1] = totb - pb + la11; sc[(SC_ACB * 4 + h) * 128 + 2 * lane] = totb - (pb - la11) + la10;
        sc[(SC_DT0 * 4 + h) * 128 + 2 * lane] = d00; sc[(SC_DT0 * 4 + h) * 128 + 2 * lane + 1] = d01;
        sc[(SC_DT1 * 4 + h) * 128 + 2 * lane] = d10; sc[(SC_DT1 * 4 + h) * 128 + 2 * lane + 1] = d11;
        if (dec_f && lane == 0) { dec_f[h] = __expf(totf); dec_b[h] = __expf(totb); }
    }
}

DI f32x16 zero16() { f32x16 z;
#pragma unroll
    for (int i = 0; i < 16; ++i) z[i] = 0.f;
    return z; }
template <int KSTEPS> DI f32x16 mma_lds(f32x16 acc, const LAS bf16* Ap, int pa, const LAS bf16* Bp, int pb, int lane) {
    const int r32 = lane & 31, hi = lane >> 5;
    Ap += r32 * pa + 8 * hi; Bp += r32 * pb + 8 * hi;
#pragma unroll
    for (int ks = 0; ks < KSTEPS; ++ks) { const bf16x8 a = *(const LAS bf16x8*)(Ap + 16 * ks), bq = *(const LAS bf16x8*)(Bp + 16 * ks); acc = MFMA32(a, bq, acc); }
    return acc;
}

template <int C, bool SCALED> DI void stage_T(LAS bf16* d0, LAS bf16* d1, const bf16* __restrict__ src, int spitch, const LAS float* w0, const LAS float* w1, int tid) {
    constexpr int OC = C / 8;
#pragma unroll
    for (int it0 = 0; it0 < 64 * OC; it0 += NTHREADS) {
        const int it = it0 + tid, oct = it % OC, tp = it / OC;
        const u32x4 r0 = *(const u32x4*)(src + (size_t)(2 * tp) * spitch + oct * 8), r1 = *(const u32x4*)(src + (size_t)(2 * tp + 1) * spitch + oct * 8);
        const unsigned a[4] = {r0.x, r0.y, r0.z, r0.w}, bq[4] = {r1.x, r1.y, r1.z, r1.w};
        if (!SCALED) {
#pragma unroll
            for (int k = 0; k < 4; ++k) {
                *(LAS unsigned*)(d0 + (oct * 8 + 2 * k) * TP + 2 * tp) = (a[k] & 0xffffu) | (bq[k] << 16);
                *(LAS unsigned*)(d0 + (oct * 8 + 2 * k + 1) * TP + 2 * tp) = (a[k] >> 16) | (bq[k] & 0xffff0000u);
            }
        } else {
            const float u0 = w0[2 * tp], u1 = w0[2 * tp + 1], v0 = w1[2 * tp], v1 = w1[2 * tp + 1];
#pragma unroll
            for (int k = 0; k < 4; ++k) {
                const float e0 = bflo(a[k]), e1 = bfhi(a[k]), f0 = bflo(bq[k]), f1 = bfhi(bq[k]);
                *(LAS unsigned*)(d0 + (oct * 8 + 2 * k) * TP + 2 * tp) = pk2(e0 * u0, f0 * u1);
                *(LAS unsigned*)(d0 + (oct * 8 + 2 * k + 1) * TP + 2 * tp) = pk2(e1 * u0, f1 * u1);
                *(LAS unsigned*)(d1 + (oct * 8 + 2 * k) * TP + 2 * tp) = pk2(e0 * v0, f0 * v1);
                *(LAS unsigned*)(d1 + (oct * 8 + 2 * k + 1) * TP + 2 * tp) = pk2(e1 * v0, f1 * v1);
            }
        }
    }
}
template <int R, int C> DI void stage_N(LAS bf16* d, int dp, const bf16* __restrict__ src, int spitch, int tid) {
    constexpr int OC = C / 8;
#pragma unroll
    for (int it0 = 0; it0 < R * OC; it0 += NTHREADS) { const int it = it0 + tid, oct = it % OC, r = it / OC; *(LAS u32x4*)(d + r * dp + oct * 8) = *(const u32x4*)(src + (size_t)r * spitch + oct * 8); }
}

DI void s1_ssd_unit(LAS unsigned char* lds, int tid, const ScanCtx& C, int b, int vc) {
    asm volatile("" : "+v"(tid));
    const int lane = tid & 63, wave = tid >> 6, r32 = lane & 31, hi = lane >> 5;
    LAS float* sc = (LAS float*)lds; LAS float* wts = (LAS float*)(lds + L_STAT);
    LAS bf16* BkT = (LAS bf16*)(lds + L_BUF); LAS bf16* XF = (LAS bf16*)(lds + L_BUF + 34816); LAS bf16* XB = (LAS bf16*)(lds + L_BUF + 34816 + 17408);
    const int row0 = vc_row0(b, vc);
    float* decp = C.dec + (size_t)((b * NVC + vc) * 2) * 8;
    __syncthreads();
    ssd_scalars(sc, tid, C.DT, row0, C.alog, C.dtb, decp, decp + 8);
    __syncthreads();
    { const int h = tid >> 7, s = tid & 127;
      wts[h * 128 + s] = __expf(sc[(SC_ACF * 4 + h) * 128 + 127] - sc[(SC_ACF * 4 + h) * 128 + s]) * sc[(SC_DT0 * 4 + h) * 128 + s];
      wts[(4 + h) * 128 + s] = __expf(sc[(SC_ACB * 4 + h) * 128 + 0] - sc[(SC_ACB * 4 + h) * 128 + s]) * sc[(SC_DT1 * 4 + h) * 128 + s]; }
    const bf16* Urow = C.U + (size_t)row0 * UW;
    for (int g = 0; g < 2; ++g) {
        __syncthreads();
        stage_T<128, false>(BkT, BkT, Urow + 256 + g * 128, UW, nullptr, nullptr, tid);
        for (int hh = 0; hh < 2; ++hh) {
            const int h = 2 * g + hh;
            if (hh) __syncthreads();
            stage_T<64, true>(XF, XB, Urow + h * 64, UW, wts + h * 128, wts + (4 + h) * 128, tid);
            __syncthreads();
            const int pt = wave >> 2, nt = wave & 3;
            f32x16 af = zero16(), ab = zero16();
            { const LAS bf16* Bp = BkT + (nt * 32 + r32) * TP + 8 * hi; const LAS bf16* Af = XF + (pt * 32 + r32) * TP + 8 * hi; const LAS bf16* Ab = XB + (pt * 32 + r32) * TP + 8 * hi;
#pragma unroll
              for (int ks = 0; ks < 8; ++ks) { const bf16x8 bq = *(const LAS bf16x8*)(Bp + 16 * ks); af = MFMA32(*(const LAS bf16x8*)(Af + 16 * ks), bq, af); ab = MFMA32(*(const LAS bf16x8*)(Ab + 16 * ks), bq, ab); } }
            bf16* of = C.sts + ((size_t)(((b * NVC + vc) * 2 + 0) * 4 + h)) * 8192; bf16* ob = C.sts + ((size_t)(((b * NVC + vc) * 2 + 1) * 4 + h)) * 8192;
#pragma unroll
            for (int i = 0; i < 16; ++i) { const int p = pt * 32 + 8 * (i >> 2) + 4 * hi + (i & 3), n = nt * 32 + r32; of[p * 128 + n] = f2bf(af[i]); ob[p * 128 + n] = f2bf(ab[i]); }
        }
    }
}
DI void s1_ret_unit(LAS unsigned char* lds, int tid, const ScanCtx& C, int b, int vc, int h0, int nh) {
    asm volatile("" : "+v"(tid));
    const int lane = tid & 63, wave = tid >> 6, r32 = lane & 31, hi = lane >> 5;
    LAS float* wts = (LAS float*)(lds + L_STAT);
    LAS bf16* KT = (LAS bf16*)(lds + L_BUF); LAS bf16* VF = (LAS bf16*)(lds + L_BUF + 17408); LAS bf16* VB = (LAS bf16*)(lds + L_BUF + 2 * 17408);
    const int row0 = vc_row0(b, vc);
    float* decp = C.dec + (size_t)((b * NVC + vc) * 2) * 8;
    __syncthreads();
    { const int h = tid >> 7, s = tid & 127; const float lg0 = C.rlg[h], lg1 = C.rlg[4 + h];
      wts[h * 128 + s] = __expf((float)(127 - s) * lg0); wts[(4 + h) * 128 + s] = __expf((float)s * lg1);
      if (s == 0) { decp[4 + h] = __expf(128.f * lg0); decp[8 + 4 + h] = __expf(128.f * lg1); } }
    const bf16* Prow = C.P + (size_t)row0 * NIN;
#pragma unroll 1
    for (int h = h0; h < h0 + nh; ++h) {
        __syncthreads();
        stage_T<64, false>(KT, KT, Prow + 2816 + h * 64, NIN, nullptr, nullptr, tid);
        stage_T<64, true>(VF, VB, Prow + 3072 + h * 64, NIN, wts + h * 128, wts + (4 + h) * 128, tid);
        __syncthreads();
        const int dir = wave >> 2, pt = (wave >> 1) & 1, nt = wave & 1;
        const f32x16 a = mma_lds<8>(zero16(), (dir ? VB : VF) + pt * 32 * TP, TP, KT + nt * 32 * TP, TP, lane);
        bf16* o = C.str + ((size_t)(((b * NVC + vc) * 2 + dir) * 4 + h)) * 4096;
#pragma unroll
        for (int i = 0; i < 16; ++i) { const int p = pt * 32 + 8 * (i >> 2) + 4 * hi + (i & 3), n = nt * 32 + r32; o[p * 64 + n] = f2bf(a[i]); }
    }
}

DI int s2_order(int dir, int step) { return dir == 0 ? step : (step == 0 ? 1 : (step == 1 ? 0 : 35 - step)); }
DI void s2_item(const ScanCtx& C, int gt) {
    bf16* base; int hh, dir, b; size_t vcstride;
    if (gt < 65536) { const int v = gt & 1023, h = (gt >> 10) & 3; dir = (gt >> 12) & 1; b = gt >> 13; hh = h; base = C.sts + (size_t)((b * NVC * 2 + dir) * 4 + h) * 8192 + v * 8; vcstride = (size_t)2 * 4 * 8192; }
    else if (gt < 65536 + 32768) { const int g2 = gt - 65536; const int v = g2 & 511, h = (g2 >> 9) & 3; dir = (g2 >> 11) & 1; b = g2 >> 12; hh = 4 + h; base = C.str + (size_t)((b * NVC * 2 + dir) * 4 + h) * 4096 + v * 8; vcstride = (size_t)2 * 4 * 4096; }
    else return;
    float s[8]; float zf = 0.f; asm volatile("" : "+v"(zf));
#pragma unroll
    for (int i = 0; i < 8; ++i) s[i] = zf;
#define S2_LD(k, st_) { const int vc_ = s2_order(dir, (st_)); v##k = *(const u32x4*)(base + (size_t)vc_ * vcstride); d##k = C.dec[(size_t)((b * NVC + vc_) * 2 + dir) * 8 + hh]; }
#define S2_ST(k, st_) { const int vc_ = s2_order(dir, (st_)); u32x4 w_; w_.x = pk2(s[0], s[1]); w_.y = pk2(s[2], s[3]); w_.z = pk2(s[4], s[5]); w_.w = pk2(s[6], s[7]); \
        *(u32x4*)(base + (size_t)vc_ * vcstride) = w_; \
        s[0] = s[0] * d##k + bflo(v##k.x); s[1] = s[1] * d##k + bfhi(v##k.x); s[2] = s[2] * d##k + bflo(v##k.y); s[3] = s[3] * d##k + bfhi(v##k.y); \
        s[4] = s[4] * d##k + bflo(v##k.z); s[5] = s[5] * d##k + bfhi(v##k.z); s[6] = s[6] * d##k + bflo(v##k.w); s[7] = s[7] * d##k + bfhi(v##k.w); }
    u32x4 v0, v1, v2, v3, v4, v5, v6, v7; float d0, d1, d2, d3, d4, d5, d6, d7;
    S2_LD(0, 0) S2_LD(1, 1) S2_LD(2, 2) S2_LD(3, 3) S2_LD(4, 4) S2_LD(5, 5) S2_LD(6, 6) S2_LD(7, 7)
#pragma unroll 1
    for (int step = 0; step < 32; step += 8) {
        S2_ST(0, step) if (step + 8 < NVC) S2_LD(0, step + 8)
        S2_ST(1, step + 1) if (step + 9 < NVC) S2_LD(1, step + 9)
        S2_ST(2, step + 2) if (step + 10 < NVC) S2_LD(2, step + 10)
        S2_ST(3, step + 3) if (step + 11 < NVC) S2_LD(3, step + 11)
        S2_ST(4, step + 4) if (step + 12 < NVC) S2_LD(4, step + 12)
        S2_ST(5, step + 5) if (step + 13 < NVC) S2_LD(5, step + 13)
        S2_ST(6, step + 6) if (step + 14 < NVC) S2_LD(6, step + 14)
        S2_ST(7, step + 7) if (step + 15 < NVC) S2_LD(7, step + 15)
    }
    S2_ST(0, 32) S2_ST(1, 33)
#undef S2_LD
#undef S2_ST
}

DI void s2_phase(const ScanCtx& C, int tid, int bid, int G) {
#pragma unroll 1
    for (int gt = bid * NTHREADS + tid; gt < 65536 + 32768; gt += G * NTHREADS) s2_item(C, gt);
}

DI void s3_ssd_unit(LAS unsigned char* lds, int tid, const ScanCtx& C, int b, int vc) {
    asm volatile("" : "+v"(tid));
    const int lane = tid & 63, wave = tid >> 6, r32 = lane & 31, hi = lane >> 5;
    LAS float* sc = (LAS float*)lds; LAS float* stat = (LAS float*)(lds + L_STAT);
    LAS bf16* Cq = (LAS bf16*)(lds + L_BUF); LAS bf16* BkM = (LAS bf16*)(lds + L_BUF + 34816); LAS bf16* XsT = (LAS bf16*)(lds + L_BUF + 2 * 34816);
    LAS bf16* Hf = (LAS bf16*)(lds + L_BUF + 2 * 34816 + 17408); LAS bf16* Hb = (LAS bf16*)(lds + L_BUF + 2 * 34816 + 2 * 17408);
    const int row0 = vc_row0(b, vc);
    const int pt = wave & 1, tt = wave >> 1;
    const bf16* Urow = C.U + (size_t)row0 * UW;
    __syncthreads();
    ssd_scalars(sc, tid, C.DT, row0, C.alog, C.dtb, nullptr, nullptr);
    float ssq = 0.f;
    const int tq_ = tt * 32 + r32; const int rowq = row0 + tq_;
#pragma unroll 1
    for (int g = 0; g < 2; ++g) {
        __syncthreads();
        stage_N<128, 128>(Cq, TP, Urow + 512 + g * 128, UW, tid);
        stage_N<128, 128>(BkM, TP, Urow + 256 + g * 128, UW, tid);
        __syncthreads();
        f32x16 gacc0, gacc1;
        { const int id = 2 * wave, st = id & 3, tq = id >> 2; gacc0 = mma_lds<8>(zero16(), BkM + st * 32 * TP, TP, Cq + tq * 32 * TP, TP, lane); }
        { const int id = 2 * wave + 1, st = id & 3, tq = id >> 2; gacc1 = mma_lds<8>(zero16(), BkM + st * 32 * TP, TP, Cq + tq * 32 * TP, TP, lane); }
#pragma unroll 1
        for (int hh = 0; hh < 2; ++hh) {
            const int h = 2 * g + hh;
            __syncthreads();
            const int oct_ = tid & 7, tp_ = tid >> 3;
            const u32x4 xr0 = *(const u32x4*)(Urow + h * 64 + (size_t)(2 * tp_) * UW + oct_ * 8), xr1 = *(const u32x4*)(Urow + h * 64 + (size_t)(2 * tp_ + 1) * UW + oct_ * 8);
            const bf16* sfp = C.sts + ((size_t)(((b * NVC + vc) * 2 + 0) * 4 + h)) * 8192; const bf16* sbp = C.sts + ((size_t)(((b * NVC + vc) * 2 + 1) * 4 + h)) * 8192;
            u32x4 hfv[2], hbv[2];
#pragma unroll
            for (int i = 0; i < 2; ++i) { const int itn = tid + NTHREADS * i, octn = itn & 15, rn = itn >> 4; hfv[i] = *(const u32x4*)(sfp + rn * 128 + octn * 8); hbv[i] = *(const u32x4*)(sbp + rn * 128 + octn * 8); }
            u32x2 zz[4];
#pragma unroll
            for (int g4 = 0; g4 < 4; ++g4) zz[g4] = *(const u32x2*)(C.P + (size_t)rowq * NIN + 1536 + h * 64 + pt * 32 + 8 * g4 + 4 * hi);
            { const LAS float* acf = sc + (SC_ACF * 4 + h) * 128; const LAS float* acb = sc + (SC_ACB * 4 + h) * 128; const LAS float* d0 = sc + (SC_DT0 * 4 + h) * 128; const LAS float* d1 = sc + (SC_DT1 * 4 + h) * 128;
#pragma unroll
              for (int q = 0; q < 2; ++q) { const int id = 2 * wave + q, st = id & 3, tq = id >> 2; const int t = tq * 32 + r32; const float aft = acf[t], abt = acb[t];
#pragma unroll
                  for (int g4 = 0; g4 < 4; ++g4) { float mv[4];
#pragma unroll
                      for (int j = 0; j < 4; ++j) { const int s = st * 32 + 8 * g4 + 4 * hi + j;
                          float f; if (s < t) f = __expf(aft - acf[s]) * d0[s]; else if (s > t) f = __expf(abt - acb[s]) * d1[s]; else f = d0[s] + d1[s];
                          mv[j] = (q ? gacc1[4 * g4 + j] : gacc0[4 * g4 + j]) * f; }
                      u32x2 w; w.x = pk2(mv[0], mv[1]); w.y = pk2(mv[2], mv[3]);
                      *(LAS u32x2*)(BkM + t * TP + st * 32 + 8 * g4 + 4 * hi) = w; } } }
            { const unsigned a_[4] = {xr0.x, xr0.y, xr0.z, xr0.w}, b_[4] = {xr1.x, xr1.y, xr1.z, xr1.w};
#pragma unroll
              for (int k = 0; k < 4; ++k) {
                  *(LAS unsigned*)(XsT + (oct_ * 8 + 2 * k) * TP + 2 * tp_) = (a_[k] & 0xffffu) | (b_[k] << 16);
                  *(LAS unsigned*)(XsT + (oct_ * 8 + 2 * k + 1) * TP + 2 * tp_) = (a_[k] >> 16) | (b_[k] & 0xffff0000u); }
#pragma unroll
              for (int i = 0; i < 2; ++i) { const int itn = tid + NTHREADS * i, octn = itn & 15, rn = itn >> 4; *(LAS u32x4*)(Hf + rn * TP + octn * 8) = hfv[i]; *(LAS u32x4*)(Hb + rn * TP + octn * 8) = hbv[i]; } }
            __syncthreads();
            f32x16 y = mma_lds<8>(zero16(), XsT + pt * 32 * TP, TP, BkM + tt * 32 * TP, TP, lane);
            { const float dsum = C.ssmd[h] + C.ssmd[4 + h];
#pragma unroll
              for (int i = 0; i < 16; ++i) { const int p = pt * 32 + 8 * (i >> 2) + 4 * hi + (i & 3); y[i] += dsum * bf2f(XsT[p * TP + tq_]); } }
            __builtin_amdgcn_sched_barrier(0);
            { const f32x16 af = mma_lds<8>(zero16(), Hf + pt * 32 * TP, TP, Cq + tt * 32 * TP, TP, lane);
              const float ef = __expf(sc[(SC_ACF * 4 + h) * 128 + tq_]);
#pragma unroll
              for (int i = 0; i < 16; ++i) y[i] += ef * af[i]; }
            __builtin_amdgcn_sched_barrier(0);
            { const f32x16 ab = mma_lds<8>(zero16(), Hb + pt * 32 * TP, TP, Cq + tt * 32 * TP, TP, lane);
              const float eb = __expf(sc[(SC_ACB * 4 + h) * 128 + tq_]);
#pragma unroll
              for (int i = 0; i < 16; ++i) y[i] += eb * ab[i]; }
#pragma unroll
            for (int g4 = 0; g4 < 4; ++g4) {
                const int p = pt * 32 + 8 * g4 + 4 * hi;
                const float v0 = y[4 * g4] * silu_f(bflo(zz[g4].x)), v1 = y[4 * g4 + 1] * silu_f(bfhi(zz[g4].x)), v2 = y[4 * g4 + 2] * silu_f(bflo(zz[g4].y)), v3 = y[4 * g4 + 3] * silu_f(bfhi(zz[g4].y));
                ssq += v0 * v0 + v1 * v1 + v2 * v2 + v3 * v3;
                u32x2 w; w.x = pk2(v0, v1); w.y = pk2(v2, v3);
                *(u32x2*)(C.MG + (size_t)rowq * DM + 512 + h * 64 + p) = w;
            }
        }
    }
    ssq += __shfl_xor(ssq, 32);
    __syncthreads();
    if (hi == 0) stat[tq_ * 2 + pt] = ssq;
    __syncthreads();
    const float rn = 1.0f / sqrtf((stat[tq_ * 2] + stat[tq_ * 2 + 1]) * (1.0f / 256.0f) + 1e-6f);
#pragma unroll
    for (int h = 0; h < 4; ++h)
#pragma unroll
        for (int g4 = 0; g4 < 4; ++g4) {
            const int p = pt * 32 + 8 * g4 + 4 * hi;
            const f32x4 gv = *(const f32x4*)(C.ssmg + h * 64 + p);
            u32x2* mp = (u32x2*)(C.MG + (size_t)rowq * DM + 512 + h * 64 + p);
            const u32x2 v = *mp;
            u32x2 w; w.x = pk2(bflo(v.x) * rn * gv.x, bfhi(v.x) * rn * gv.y); w.y = pk2(bflo(v.y) * rn * gv.z, bfhi(v.y) * rn * gv.w);
            *mp = w;
        }
}
DI void s3_ret_unit(LAS unsigned char* lds, int tid, const ScanCtx& C, int b, int vc, int h0, int nh) {
    asm volatile("" : "+v"(tid));
    const int lane = tid & 63, wave = tid >> 6, r32 = lane & 31, hi = lane >> 5;
    LAS float* stat = (LAS float*)(lds + L_STAT);
    LAS bf16* Q = (LAS bf16*)(lds + L_BUF); LAS bf16* K = (LAS bf16*)(lds + L_BUF + 18432); LAS bf16* VT = (LAS bf16*)(lds + L_BUF + 2 * 18432);
    LAS bf16* Hf = (LAS bf16*)(lds + L_BUF + 2 * 18432 + 17408); LAS bf16* Hb = (LAS bf16*)(lds + L_BUF + 2 * 18432 + 17408 + 9216); LAS bf16* MB = (LAS bf16*)(lds + L_BUF + 2 * 18432 + 17408 + 2 * 9216);
    const int row0 = vc_row0(b, vc);
    const int pt = wave & 1, tt = wave >> 1;
    const bf16* Prow = C.P + (size_t)row0 * NIN;
    const int t = tt * 32 + r32; const int row = row0 + t;
#pragma unroll 1
    for (int h = h0; h < h0 + nh; ++h) {
        const float lg0 = C.rlg[h], lg1 = C.rlg[4 + h];
        __syncthreads();
        stage_N<128, 64>(Q, QP, Prow + 2560 + h * 64, NIN, tid);
        stage_N<128, 64>(K, QP, Prow + 2816 + h * 64, NIN, tid);
        stage_T<64, false>(VT, VT, Prow + 3072 + h * 64, NIN, nullptr, nullptr, tid);
        stage_N<64, 64>(Hf, QP, C.str + ((size_t)(((b * NVC + vc) * 2 + 0) * 4 + h)) * 4096, 64, tid);
        stage_N<64, 64>(Hb, QP, C.str + ((size_t)(((b * NVC + vc) * 2 + 1) * 4 + h)) * 4096, 64, tid);
        __syncthreads();
#pragma unroll
        for (int q = 0; q < 2; ++q) { const int id = 2 * wave + q, st = id & 3, tq = id >> 2;
            const f32x16 gacc = mma_lds<4>(zero16(), K + st * 32 * QP, QP, Q + tq * 32 * QP, QP, lane);
            const int t2 = tq * 32 + r32;
#pragma unroll
            for (int g4 = 0; g4 < 4; ++g4) { float mv[4];
#pragma unroll
                for (int j = 0; j < 4; ++j) { const int s = st * 32 + 8 * g4 + 4 * hi + j;
                    const float f = (s < t2) ? __expf((float)(t2 - s) * lg0) : ((s > t2) ? __expf((float)(s - t2) * lg1) : 2.0f);
                    mv[j] = gacc[4 * g4 + j] * f; }
                u32x2 w; w.x = pk2(mv[0], mv[1]); w.y = pk2(mv[2], mv[3]);
                *(LAS u32x2*)(MB + t2 * TP + st * 32 + 8 * g4 + 4 * hi) = w; } }
        __syncthreads();
        u32x2 ggv[4];
#pragma unroll
        for (int g4 = 0; g4 < 4; ++g4) ggv[g4] = *(const u32x2*)(C.P + (size_t)row * NIN + 3328 + h * 64 + pt * 32 + 8 * g4 + 4 * hi);
        f32x16 y = mma_lds<8>(zero16(), VT + pt * 32 * TP, TP, MB + tt * 32 * TP, TP, lane);
        { const f32x16 af = mma_lds<4>(zero16(), Hf + pt * 32 * QP, QP, Q + tt * 32 * QP, QP, lane);
          const float ef = __expf((float)(t + 1) * lg0);
#pragma unroll
          for (int i = 0; i < 16; ++i) y[i] += ef * af[i]; }
        { const f32x16 ab = mma_lds<4>(zero16(), Hb + pt * 32 * QP, QP, Q + tt * 32 * QP, QP, lane);
          const float eb = __expf((float)(128 - t) * lg1);
#pragma unroll
          for (int i = 0; i < 16; ++i) y[i] += eb * ab[i]; }
        float s1 = 0.f, s2 = 0.f;
#pragma unroll
        for (int i = 0; i < 16; ++i) { s1 += y[i]; s2 += y[i] * y[i]; }
        s1 += __shfl_xor(s1, 32); s2 += __shfl_xor(s2, 32);
        if (hi == 0) { stat[(t * 2 + pt) * 2] = s1; stat[(t * 2 + pt) * 2 + 1] = s2; }
        __syncthreads();
        const float t1 = stat[(t * 2) * 2] + stat[(t * 2 + 1) * 2], t2s = stat[(t * 2) * 2 + 1] + stat[(t * 2 + 1) * 2 + 1];
        const float mean = t1 * (1.0f / 64.0f), var = fmaxf(t2s * (1.0f / 64.0f) - mean * mean, 0.f), rs = 1.0f / sqrtf(var + 1e-5f);
#pragma unroll
        for (int g4 = 0; g4 < 4; ++g4) {
            const int p = pt * 32 + 8 * g4 + 4 * hi;
            const float g0 = silu_f(bflo(ggv[g4].x)), g1 = silu_f(bfhi(ggv[g4].x)), g2 = silu_f(bflo(ggv[g4].y)), g3 = silu_f(bfhi(ggv[g4].y));
            u32x2 w; w.x = pk2((y[4 * g4] - mean) * rs * g0, (y[4 * g4 + 1] - mean) * rs * g1); w.y = pk2((y[4 * g4 + 2] - mean) * rs * g2, (y[4 * g4 + 3] - mean) * rs * g3);
            *(u32x2*)(C.MG + (size_t)row * DM + 768 + h * 64 + p) = w;
        }
    }
}

constexpr int NPP = 13, NPH = 2 + NPP * DEPTH;
#ifndef PMASK
#define PMASK 0xffff
#endif
#define PEN(k) ((PMASK >> (k)) & 1)
#ifndef PROBE_LASTONLY
#define PROBE_LASTONLY 0
#endif
#ifndef PROBE_N
#define PROBE_N 1
#endif
#ifndef REP_SPLIT
#define REP_SPLIT 1
#endif
#ifndef REP_P0
#define REP_P0 1
#endif
#ifndef REP_LN
#define REP_LN 1
#endif
#ifndef REP_SYNC
#define REP_SYNC 1
#endif
#ifndef REP_ATTN
#define REP_ATTN 1
#endif
#ifndef REP_UP
#define REP_UP 1
#endif
#ifndef REP_IN
#define REP_IN 1
#endif
#ifndef REP_SCAN
#define REP_SCAN 1
#endif

#define GAS __attribute__((address_space(1)))
#define XB_TMO      128
#define XB_XCNT(j)  (256  + 64 * (j))
#define XB_XSUB(j)  (1280 + 64 * (j))
#define XB_XGEN(j)  (2304 + 64 * (j))
#define XB_TOP      3328
#define XB_TOPGEN   3392
#define XCD_BAR_WORDS 3456
#define XB_SPIN_CAP (1u << 18)

__device__ __forceinline__ unsigned xb_ld(unsigned* p)              { return __hip_atomic_load(p, __ATOMIC_RELAXED, __HIP_MEMORY_SCOPE_AGENT); }
__device__ __forceinline__ unsigned xb_add(unsigned* p, unsigned v) { return __hip_atomic_fetch_add(p, v, __ATOMIC_RELAXED, __HIP_MEMORY_SCOPE_AGENT); }
__device__ __forceinline__ unsigned xb_xcc_id() { return (unsigned)__builtin_amdgcn_s_getreg((3 << 11) | 20) & 0xFu; }
#define XB_SPIN(cond, bar) do { unsigned _sp = 0; while (cond) { __builtin_amdgcn_s_sleep(1); \
    if ((++_sp & 255u) == 0u) { if (xb_ld(&(bar)[XB_TMO])) break; if (_sp > XB_SPIN_CAP) { atomicAdd(&(bar)[XB_TMO], 1u); break; } } } } while (0)

struct XcdBarrier {
    unsigned* bar; unsigned x;
    volatile LAS unsigned* st;
};

__device__ __forceinline__ XcdBarrier xcd_barrier_post(unsigned* bar, volatile LAS unsigned* st) {
    XcdBarrier b; b.bar = bar; b.x = xb_xcc_id(); b.st = st;
    if (threadIdx.x == 0) (void)xb_add(&bar[XB_XCNT(b.x)], 1u);
    return b;
}
__device__ __forceinline__ void xcd_barrier_complete(unsigned* bar, unsigned x, unsigned& nloc, unsigned& nx) {
    const unsigned G = gridDim.x * gridDim.y * gridDim.z;
    unsigned sum, cnt, mine, sp = 0u;
    for (;;) {
        sum = 0u; cnt = 0u; mine = 0u;
#pragma unroll
        for (unsigned j = 0; j < 16; ++j) { const unsigned c = xb_ld(&bar[XB_XCNT(j)]); sum += c; cnt += (c > 0u) ? 1u : 0u; mine = (j == x) ? c : mine; }
        if (sum == G) break;
        __builtin_amdgcn_s_sleep(1);
        if ((++sp & 255u) == 0u) { if (xb_ld(&bar[XB_TMO])) break; if (sp > XB_SPIN_CAP) { atomicAdd(&bar[XB_TMO], 1u); break; } }
    }
    nloc = mine > 0u ? mine : 1u; nx = cnt > 0u ? cnt : 1u;
}

__device__ __forceinline__ void xcd_barrier(const XcdBarrier& b) {
    asm volatile("s_waitcnt vmcnt(0)" ::: "memory");
    __syncthreads();
    if (threadIdx.x == 0) {
        unsigned* bar = b.bar;
        __builtin_amdgcn_s_waitcnt(0);
        unsigned nloc = b.st[0], nx = b.st[1];
        if (nloc == 0u) { xcd_barrier_complete(bar, b.x, nloc, nx); b.st[0] = nloc; b.st[1] = nx; }
        const unsigned old = xb_add(&bar[XB_XSUB(b.x)], 1u);
        const unsigned gen = old / nloc;
        if (old + 1u == (gen + 1u) * nloc) {
            __builtin_amdgcn_fence(__ATOMIC_RELEASE, "agent");
            asm volatile("s_waitcnt vmcnt(0)" ::: "memory");
            const unsigned og = xb_add(&bar[XB_TOP], 1u);
            const unsigned tg = og / nx;
            if (og + 1u == (tg + 1u) * nx) xb_add(&bar[XB_TOPGEN], 1u);
            else XB_SPIN(xb_ld(&bar[XB_TOPGEN]) == tg, bar);
            __builtin_amdgcn_fence(__ATOMIC_ACQUIRE, "agent");
            xb_add(&bar[XB_XGEN(b.x)], 1u);
            asm volatile("s_waitcnt vmcnt(0)" ::: "memory");
        } else {
            XB_SPIN(xb_ld(&bar[XB_XGEN(b.x)]) == gen, bar);
            __builtin_amdgcn_fence(__ATOMIC_ACQUIRE, "agent");
            asm volatile("s_waitcnt vmcnt(0)" ::: "memory");
        }
    }
    __syncthreads();
}
template <class Epi> DI void run_gemm(LAS unsigned char* lds, int tid, const bf16* Ap, const bf16* Bt, int M, int N, int K, int G, int bid, const Epi& E, int ld = 0) {
    pg8::Gemm g{Ap, Bt, M, N, K, ld ? ld : K}; pg8::StaticOrder S; S.init(M, N, G, bid);
    pg8::gemm_phase<Epi, pg8::StaticOrder, true, true>(lds, g, S, E, tid);
}

__global__ void __launch_bounds__(NTHREADS, 2) mega(Args A) {
    extern __shared__ __attribute__((aligned(16))) unsigned char lds_raw[];
    LAS unsigned char* lds = (LAS unsigned char*)lds_raw;
    cg::grid_group grid = cg::this_grid();
    const int tid0 = threadIdx.x, bid0 = blockIdx.x, G0 = gridDim.x;
    { volatile LAS unsigned* bst0 = (volatile LAS unsigned*)(lds + LDS_BYTES - 64); if (tid0 < 16) bst0[tid0] = 0u;
      if (bid0 == 0) { unsigned* bw = (unsigned*)(A.ws + WS_BAR); for (int i = tid0; i < XCD_BAR_WORDS; i += NTHREADS) bw[i] = 0u; } }
    __syncthreads();
    int rep_done = 0; (void)rep_done;
    for (int ph = A.ph_lo; ph < A.ph_hi; ++ph) {
        if (ph > A.ph_lo) {
            if (ph == A.ph_lo + 1) { grid.sync(); (void)xcd_barrier_post((unsigned*)(A.ws + WS_BAR), (volatile LAS unsigned*)(lds + LDS_BYTES - 64)); }
            else { for (int rs_ = 0; rs_ < REP_SYNC; ++rs_) { XcdBarrier xb_; xb_.bar = (unsigned*)(A.ws + WS_BAR); xb_.x = xb_xcc_id(); xb_.st = (volatile LAS unsigned*)(lds + LDS_BYTES - 64); xcd_barrier(xb_); } }
        }
        int tid = tid0, bid = bid0, G = G0; size_t zoff = 0;
        asm volatile("" : "+v"(tid)); asm volatile("" : "+s"(bid)); asm volatile("" : "+s"(G)); asm volatile("" : "+s"(zoff));
        unsigned char* ws = A.ws + zoff;
        float* xc = (float*)(ws + WS_XC);
        bf16* Abuf = (bf16*)(ws + WS_A); bf16* HP = (bf16*)(ws + WS_HP); bf16* Vt = (bf16*)(ws + WS_VT);
        const float* MOD = (const float*)(ws + WS_MOD);
        if (ph == 0) { if (PEN(0)) for (int rp_ = 0; rp_ < REP_P0; ++rp_) { p0a_phase(A, lds, tid, bid, G); __syncthreads(); } continue; }
        if (ph == 1) { if (PEN(1)) for (int rp_ = 0; rp_ < REP_LN; ++rp_) lnmod_phase(A, lds, tid, bid, G, true, -1, 0, 0, 0, false, M_ALL, false, nullptr, nullptr); continue; }
        const int q = ph - 2, l = q / NPP; int s = q % NPP; const bool is_conv = (s == 4); if (s >= 4) s -= 1; if (is_conv) s = 100;
        const bool last = (l == DEPTH - 1);
        const int Mpost = last ? M_LAT : M_ALL;
        if ((s == 0 || s == 9) && PEN(2)) {
            const int f = (s == 9); EpiSwiglu E{HP};
            for (int rp_ = 0; rp_ < REP_UP; ++rp_) run_gemm(lds, tid, Abuf, (const bf16*)(ws + WS_WGU) + (size_t)f * NGU * DM, f ? Mpost : M_ALL, NGU, DM, G, bid, E);
        } else if ((s == 1 || s == 10 || s == 7) && PEN(3)) {
            const int i = (s == 1) ? 0 : (s == 7 ? 1 : 2);
            const int prev_idx = (i == 0) ? (l == 0 ? -1 : (l - 1) * 3 + 2) : l * 3 + (i - 1);
            const float* modg_p = MOD + (size_t)l * 9 * 9216 + i * 3072 + 2048;
            const float* scale_v = (s == 7) ? (const float*)(ws + WS_ONES) : (const float*)(ws + WS_HALVES);
            const float* gprev_p = prev_idx < 0 ? (const float*)(ws + WS_ONES) : A.in[I_NG] + prev_idx * DM; const float* bprev_p = prev_idx < 0 ? (const float*)(ws + WS_ZEROS) : A.in[I_NB] + prev_idx * DM;
            EpiResid E{(bf16*)(ws + WS_X16), modg_p, scale_v, (const f32x2*)(ws + WS_STAT), gprev_p, bprev_p};
            const bool has_ctx = (s == 1) || !last;
            const bf16* Ap = (s == 7) ? Abuf : HP; const bf16* Bp = (s == 7) ? (const bf16*)(ws + WS_WOUT) : (const bf16*)(ws + WS_WDN) + (size_t)(s == 10) * DM * DFF;
            const int Kd = (s == 7) ? DM : DFF;
            const int ldd = (s == 7) ? DM : DFF;
            run_gemm(lds, tid, Ap, Bp, M_LAT, DM, Kd, G, bid, E, ldd);
            if (has_ctx) {
                const int sb = (G == 256 && ((bid >> 3) & 7) < 4 && bid < 256) ? ((bid & 7) | (((bid >> 3) & 3) << 3) | ((bid >> 6) << 5)) : (G == 256 ? 999 : (bid + G - 64) % G);
                const int qd = (sb >> 5) & 3;
                const int kt0 = (s == 7) ? 4 * qd : (qd < 2 ? 12 * qd : 24 + 10 * (qd - 2));
                const int ktn = (s == 7) ? 4 : (qd < 2 ? 12 : 10);
                OneUnit S1u; S1u.have = sb < 128; S1u.u.pm = 128 + (sb & 7); S1u.u.pn = (sb >> 3) & 3;
                EpiPartial Ep{(float*)(ws + WS_T) + (size_t)qd * M_CTX * DM, modg_p, scale_v};
                pg8::Gemm g2{Ap + (size_t)kt0 * 64, Bp + (size_t)kt0 * 64, M_ALL, DM, ktn * 64, ldd};
                pg8::gemm_phase<EpiPartial, OneUnit, true, true>(lds, g2, S1u, Ep, tid);
            }
        } else if (s == 2 && PEN(1)) {
            lnmod_phase(A, lds, tid, bid, G, false, l, 0, l, 1, true, M_ALL, true, l == 0 ? (const float*)(ws + WS_ONES) : A.in[I_NG] + ((l - 1) * 3 + 2) * DM, l == 0 ? (const float*)(ws + WS_ZEROS) : A.in[I_NB] + ((l - 1) * 3 + 2) * DM);
        } else if (s == 3 && PEN(4)) {
            EpiIn E{HP, Vt, (const f32x2*)(ws + WS_TATT), (const f32x2*)(ws + WS_TRET)};
            for (int rp_ = 0; rp_ < REP_IN; ++rp_) run_gemm(lds, tid, Abuf, (const bf16*)(ws + WS_WIN), M_ALL, NIN, DM, G, bid, E);
        } else if (is_conv || s == 4 || s == 5 || s == 6) {
            ScanCtx C{HP, (const bf16*)(ws + WS_U), (const float*)(ws + WS_DT), (bf16*)(ws + WS_STS), (bf16*)(ws + WS_STR), (float*)(ws + WS_DEC), Abuf,
                      A.in[I_CONVW] + (size_t)l * 5 * 768, A.in[I_CONVB] + l * 768, A.in[I_ALOG] + l * 8, A.in[I_DTB] + l * 8, A.in[I_SSMD] + l * 8, A.in[I_SSMG] + l * 256, A.in[I_RLG] + l * 8};
            const float lam = ((const float*)(ws + WS_LAM))[l];
            const float lam_init = 0.8f - 0.6f * expf(-0.3f * (float)l);
            const float* subg = A.in[I_SUBG] + l * 128;
            const int r = is_conv ? 0 : s - 3;
            if (PEN(7)) for (int rp_ = 0; rp_ < REP_ATTN; ++rp_) for (int u = bid; u < 256; u += G) { const int bh = r * 8 + (u & 7), qb = u >> 3;
                attn_unit(lds, tid, HP, Vt, Abuf, bh >> 2, bh & 3, (bh >> 2) * SEQ + qb * 128, 0, 68, lam, 1.0f - lam_init, subg); }
            if (is_conv) {
                if (PEN(10)) conv_phase(HP, (bf16*)(ws + WS_U), C.cw, C.cb, tid, bid, G);
            } else if (s == 4) {
                { const int nS1 = NB * NVC, extra1 = (nS1 > G && nS1 < 2 * G) ? nS1 - G : 0;
                  if (PEN(5)) { for (int u = bid; u < nS1; u += G) s1_ssd_unit(lds, tid, C, u / NVC, u % NVC);
                      if (bid >= extra1) for (int r = bid - extra1; r < 4 * nS1; r += G - extra1) { const int v = r >> 2; s1_ret_unit(lds, tid, C, v / NVC, v % NVC, r & 3, 1); } } }
            } else if (s == 5) {
                if (PEN(6)) s2_phase(C, tid, bid, G);
            } else {
                const int vc0 = last ? 2 : 0, nvc = NVC - vc0;
                const int nS = NB * nvc, extra = (nS > G && nS < 2 * G) ? nS - G : 0;
                if (PEN(8)) for (int u = bid; u < nS; u += G) s3_ssd_unit(lds, tid, C, u / nvc, vc0 + u % nvc);
                if (PEN(9) && bid >= extra) for (int r = bid - extra; r < 4 * nS; r += G - extra) { const int v = r >> 2; s3_ret_unit(lds, tid, C, v / nvc, vc0 + v % nvc, r & 3, 1); }
                if (!last && PEN(7)) for (int u = (bid + G - 64) % G; u < 64; u += G) { const int bh = u >> 1; attn_unit(lds, tid, HP, Vt, Abuf, bh >> 2, bh & 3, M_LAT + (bh >> 2) * CTXL + (u & 1) * 128, 64, 68, lam, 1.0f - lam_init, subg); }
            }
        } else if (s == 8 && PEN(1)) {
            lnmod_phase(A, lds, tid, bid, G, false, l, 1, l, 2, false, Mpost, !last, A.in[I_NG] + (l * 3) * DM, A.in[I_NB] + (l * 3) * DM);
        } else if (s == 11 && PEN(1)) {
            lnmod_phase(A, lds, tid, bid, G, false, l, 2, last ? -1 : l + 1, 0, false, Mpost, !last, A.in[I_NG] + (l * 3 + 1) * DM, A.in[I_NB] + (l * 3 + 1) * DM);
            if (!last) convw_phase(A, l + 1, lds, tid, bid, G);
        }
#ifdef PROBE_S
        if ((s == (PROBE_S) || s == (PROBE_S2)) && (PROBE_LASTONLY == 0 || last) && rep_done < PROBE_N) { ++rep_done; --ph; } else rep_done = 0;
#endif
    }
}

extern "C" void kernel_launch(void* const* d_in, const int* in_sizes, int n_in, void* d_out, int out_size, void* d_ws, size_t ws_size, hipStream_t stream) {
    static int grid = 0;
    if (grid == 0) {
        if (n_in != 22 || in_sizes[0] != M_LAT * DM || out_size != M_LAT * DM || ws_size < WS_END) { fprintf(stderr, "kernel_launch: unexpected shapes (n_in %d, out %d, ws %zu)\n", n_in, out_size, ws_size); grid = -1; return; }
        int dev = 0, cus = 0, per_cu = 0;
        hipGetDevice(&dev); hipDeviceGetAttribute(&cus, hipDeviceAttributeMultiprocessorCount, dev);
        if (hipFuncSetAttribute((const void*)mega, hipFuncAttributeMaxDynamicSharedMemorySize, LDS_BYTES) != hipSuccess) { fprintf(stderr, "kernel_launch: hipFuncSetAttribute failed\n"); grid = -1; return; }
        if (hipOccupancyMaxActiveBlocksPerMultiprocessor(&per_cu, (const void*)mega, NTHREADS, LDS_BYTES) != hipSuccess || per_cu < 1) { fprintf(stderr, "kernel_launch: occupancy query says %d\n", per_cu); per_cu = 1; }
        (void)hipGetLastError();
        grid = cus * 1;
    }
    if (grid < 0) return;
    Args a{};
    for (int i = 0; i < 22; ++i) a.in[i] = (const float*)d_in[i];
    a.out = (float*)d_out; a.ws = (unsigned char*)d_ws;
    for (int i = 0; i < 16; ++i) a.afreq[i] = 1.0f / powf(10000.0f, (float)(2 * i) / 32.0f);
    for (int i = 0; i < 32; ++i) a.rfreq[i] = 1.0f / powf(10000.0f, (float)i / 31.0f);
#ifdef MK_MULTI
    for (int ph = 0; ph < NPH; ++ph) { a.ph_lo = ph; a.ph_hi = ph + 1; hipLaunchKernelGGL(mega, dim3(grid), dim3(NTHREADS), LDS_BYTES, stream, a); }
#else
    a.ph_lo = 0; a.ph_hi = NPH;
    void* args[] = {&a};
    hipError_t e = hipLaunchCooperativeKernel((const void*)mega, dim3(grid), dim3(NTHREADS), args, LDS_BYTES, stream);
    if (e != hipSuccess) fprintf(stderr, "cooperative launch failed: %s (grid %d)\n", hipGetErrorString(e), grid);
#endif
}
```

```cpp
#include <hip/hip_runtime.h>
#include <hip/hip_cooperative_groups.h>
#include <cstdio>
#include <cstdint>
#include <cmath>
namespace cg = cooperative_groups;

namespace pg8 {
#define PG8_LAS __attribute__((address_space(3)))
typedef unsigned short bf16_t;
typedef short bf16x8 __attribute__((ext_vector_type(8)));
typedef float f32x4 __attribute__((ext_vector_type(4)));
typedef unsigned u32x4 __attribute__((ext_vector_type(4)));
constexpr int BM = 256, BK = 64, HALF = 128, HTB = HALF * BK * 2  , STAGE_BYTES = 8 * HTB, NXCD = 8, WGM = 8;

__host__ __device__ __forceinline__ int lds_byte(int r, int c) { const int st = (r >> 4) * 2 + (c >> 5), rr = r & 15, cc = c & 31, ob = rr * 64 + cc * 2; return st * 1024 + (ob ^ (((ob >> 9) & 1) << 5)); }
__host__ __device__ __forceinline__ void stage_rc(int b, int& R, int& C) { const int st = b / 1024, sb = b % 1024, swz = sb ^ (((sb >> 9) & 1) << 5); R = (st >> 1) * 16 + swz / 64; C = (st & 1) * 32 + (swz % 64) / 2; }
__host__ __device__ __forceinline__ int perm32(int rho) { const int n = rho >> 4, i = rho & 15; return 8 * (i >> 2) + 4 * n + (i & 3); }

struct Unit { int pm, pn; };
struct Gemm { const bf16_t* A; const bf16_t* Bt; int M, N, K, ld; };

struct StaticOrder {
    int nM, nN, nwg, G, c;
    __host__ __device__ void init(int M, int N, int G_, int c_) { nM = M / BM; nN = N / BM; nwg = nM * nN; G = G_; c = c_; }
    __host__ __device__ bool next(int i, Unit& u) const {
        const long L = (long)i * G + c; if (L >= nwg) return false;
        int wgid = (int)L; { const int q = nwg / NXCD, r = nwg % NXCD, xcd = wgid % NXCD, off = wgid / NXCD; wgid = (xcd < r ? xcd * (q + 1) : r * (q + 1) + (xcd - r) * q) + off; }
        const int nig = WGM * nN, gid = wgid / nig, fm = gid * WGM, gsz = (nM - fm) < WGM ? (nM - fm) : WGM;
        u.pm = fm + ((wgid % nig) % gsz); u.pn = (wgid % nig) / gsz; return true;
    }
    __device__ __forceinline__ void a_ready(const Unit&) const {}
    __device__ __forceinline__ void done(const Unit&) const {}
};

__device__ __forceinline__ unsigned cvt_pk_bf16(float lo, float hi) { unsigned r; asm volatile("v_cvt_pk_bf16_f32 %0, %1, %2" : "=v"(r) : "v"(lo), "v"(hi)); return r; }
template <class Epi, class Sched, bool ALIGN_EPI = false, bool SP2 = false>
__device__ __forceinline__ void gemm_phase(PG8_LAS unsigned char* lds, const Gemm g, const Sched& S, const Epi& E, const int tid) {
    const int wid = __builtin_amdgcn_readfirstlane(tid >> 6), lane = tid & 63, wr = wid >> 2, wc = wid & 3, fr = lane & 15, fq = lane >> 4;
    const int K = g.K, nt = K / BK;
    unsigned voffA[2], voffB[2];
#pragma unroll
    for (int i = 0; i < 2; ++i) { int R, C; stage_rc(tid * 16 + i * 8192, R, C); const int Rb = Epi::PERM ? ((R & ~31) + perm32(R & 31)) : R;
        voffA[i] = (unsigned)(R * g.ld + C) * 2u; voffB[i] = (unsigned)(Rb * g.ld + C) * 2u; }
    const size_t kstep = (size_t)(BK * 2);
    const size_t hstep = (size_t)HALF * g.ld * 2;
    const size_t tstep = 2 * hstep;
    const unsigned ldsw = (unsigned)wid * 1024u;
    const int aoff = lds_byte(wr * 64 + fr, fq * 8), boff = lds_byte(wc * 32 + fr, fq * 8);
#define PG8_SA(b, h) (((b) * 2 + (h)) * HTB)
#define PG8_SB(b, h) ((4 + (b) * 2 + (h)) * HTB)
#define PG8_STAGE(bufoff, gbase, voff) do { _Pragma("unroll") for (int _i = 0; _i < 2; ++_i) \
        __builtin_amdgcn_global_load_lds((const unsigned*)((const char*)(gbase) + (voff)[_i]), (PG8_LAS unsigned*)(lds + (bufoff) + ldsw + _i * 8192), 16, 0, 0); } while (0)
#define PG8_LDA(dst, b, h) do { _Pragma("unroll") for (int m = 0; m < 4; ++m) _Pragma("unroll") for (int k = 0; k < 2; ++k) dst[m][k] = *(const PG8_LAS bf16x8*)(lds + PG8_SA(b, h) + aoff + m * 2048 + k * 1024); } while (0)
#define PG8_LDB(dst, b, h) do { _Pragma("unroll") for (int n = 0; n < 2; ++n) _Pragma("unroll") for (int k = 0; k < 2; ++k) dst[n][k] = *(const PG8_LAS bf16x8*)(lds + PG8_SB(b, h) + boff + n * 2048 + k * 1024); } while (0)
#define PG8_MMA(ai, bj, At, Bt) do { __builtin_amdgcn_s_setprio(1); _Pragma("unroll") for (int m = 0; m < 4; ++m) _Pragma("unroll") for (int n = 0; n < 2; ++n) _Pragma("unroll") for (int k = 0; k < 2; ++k) \
        acc[ai][bj][m][n] = __builtin_amdgcn_mfma_f32_16x16x32_bf16(Bt[n][k], At[m][k], acc[ai][bj][m][n], 0, 0, 0); __builtin_amdgcn_s_setprio(0); } while (0)
#define PG8_WAIT_V(n) asm volatile("s_waitcnt vmcnt(" #n ")" ::: "memory")
#define PG8_WAIT_L(n) asm volatile("s_waitcnt lgkmcnt(" #n ")" ::: "memory")
#define PG8_BAR __builtin_amdgcn_s_barrier()
#define PG8_SCHED __builtin_amdgcn_sched_barrier(0)
    Unit cur, nxt; int ui = 0;
    if (!S.next(0, cur)) return;
    f32x4 acc[2][2][4][2];
#pragma unroll
    for (int a = 0; a < 2; ++a)
#pragma unroll
        for (int b = 0; b < 2; ++b)
#pragma unroll
            for (int m = 0; m < 4; ++m)
#pragma unroll
                for (int n = 0; n < 2; ++n) acc[a][b][m][n] = (f32x4){0.f, 0.f, 0.f, 0.f};
    bf16x8 At[4][2], B0[2][2], B1[2][2];
    const char* cA = (const char*)g.A + (size_t)cur.pm * tstep; const char* cB = (const char*)g.Bt + (size_t)cur.pn * tstep;
    S.a_ready(cur);
    if constexpr (SP2) {
        PG8_STAGE(PG8_SB(0, 0), cB, voffB); PG8_STAGE(PG8_SB(0, 1), cB + hstep, voffB); PG8_STAGE(PG8_SA(0, 0), cA, voffA); PG8_STAGE(PG8_SA(0, 1), cA + hstep, voffA);
        if (wr == 1) PG8_BAR;
        PG8_WAIT_V(2); PG8_BAR;
        PG8_STAGE(PG8_SB(1, 0), cB + kstep, voffB); PG8_STAGE(PG8_SA(1, 0), cA + kstep, voffA); PG8_STAGE(PG8_SB(1, 1), cB + hstep + kstep, voffB);
        PG8_WAIT_V(6); PG8_BAR;
    } else {
        PG8_STAGE(PG8_SB(0, 0), cB, voffB); PG8_STAGE(PG8_SA(0, 0), cA, voffA); PG8_STAGE(PG8_SB(0, 1), cB + hstep, voffB); PG8_STAGE(PG8_SA(0, 1), cA + hstep, voffA);
        if (wr == 1) PG8_BAR;
        PG8_WAIT_V(4); PG8_BAR;
        PG8_STAGE(PG8_SB(1, 0), cB + kstep, voffB); PG8_STAGE(PG8_SA(1, 0), cA + kstep, voffA); PG8_STAGE(PG8_SB(1, 1), cB + hstep + kstep, voffB);
        PG8_WAIT_V(6); PG8_BAR;
    }
    for (;;) {
        const bool has_next = S.next(ui + 1, nxt);
        const char* nA = has_next ? (const char*)g.A + (size_t)nxt.pm * tstep : cA; const char* nB = has_next ? (const char*)g.Bt + (size_t)nxt.pn * tstep : cB;
        for (int t = 0; t < nt; t += 2) {
            const bool last = (t == nt - 2);
            const char* a1 = cA + (size_t)(t + 1) * kstep;
            const char* a2 = last ? nA : cA + (size_t)(t + 2) * kstep; const char* b2 = last ? nB : cB + (size_t)(t + 2) * kstep;
            const char* a3 = a2 + kstep; const char* b3 = b2 + kstep;
            if (last && has_next) S.a_ready(nxt);
            if constexpr (SP2) {
            PG8_LDB(B0, 0, 0); PG8_LDB(B1, 0, 1); PG8_SCHED; PG8_LDA(At, 0, 0); PG8_STAGE(PG8_SA(1, 1), a1 + hstep, voffA);
            PG8_WAIT_V(8); PG8_WAIT_L(0); PG8_BAR; PG8_MMA(0, 0, At, B0); PG8_MMA(0, 1, At, B1); PG8_BAR; PG8_SCHED;
            PG8_LDA(At, 0, 1); PG8_STAGE(PG8_SB(0, 0), b2, voffB); PG8_STAGE(PG8_SB(0, 1), b2 + hstep, voffB); PG8_STAGE(PG8_SA(0, 0), a2, voffA);
            PG8_WAIT_V(8); PG8_WAIT_L(0); PG8_BAR; PG8_MMA(1, 0, At, B0); PG8_MMA(1, 1, At, B1); PG8_BAR; PG8_SCHED;
            PG8_LDB(B0, 1, 0); PG8_LDB(B1, 1, 1); PG8_SCHED; PG8_LDA(At, 1, 0); PG8_STAGE(PG8_SA(0, 1), a2 + hstep, voffA);
            PG8_WAIT_V(8); PG8_WAIT_L(0); PG8_BAR; PG8_MMA(0, 0, At, B0); PG8_MMA(0, 1, At, B1); PG8_BAR; PG8_SCHED;
            PG8_LDA(At, 1, 1); PG8_STAGE(PG8_SB(1, 0), b3, voffB); PG8_STAGE(PG8_SB(1, 1), b3 + hstep, voffB); PG8_STAGE(PG8_SA(1, 0), a3, voffA);
            PG8_WAIT_V(8); PG8_WAIT_L(0); PG8_BAR; PG8_MMA(1, 0, At, B0); PG8_MMA(1, 1, At, B1); PG8_BAR; PG8_SCHED;
            } else {
            PG8_LDB(B0, 0, 0); PG8_SCHED; PG8_LDA(At, 0, 0); PG8_STAGE(PG8_SA(1, 1), a1 + hstep, voffA);
            PG8_WAIT_L(8); PG8_BAR; PG8_WAIT_L(0); PG8_MMA(0, 0, At, B0); PG8_BAR; PG8_SCHED;
            PG8_LDB(B1, 0, 1); PG8_STAGE(PG8_SB(0, 0), b2, voffB);
            PG8_BAR; PG8_WAIT_L(0); PG8_MMA(0, 1, At, B1); PG8_BAR;
            PG8_LDA(At, 0, 1); PG8_STAGE(PG8_SA(0, 0), a2, voffA);
            PG8_BAR; PG8_WAIT_L(0); PG8_MMA(1, 0, At, B0); PG8_BAR; PG8_SCHED;
            PG8_STAGE(PG8_SB(0, 1), b2 + hstep, voffB);
            PG8_WAIT_V(6); PG8_BAR; PG8_MMA(1, 1, At, B1); PG8_BAR;
            PG8_LDB(B0, 1, 0); PG8_SCHED; PG8_LDA(At, 1, 0); PG8_STAGE(PG8_SA(0, 1), a2 + hstep, voffA);
            PG8_WAIT_L(8); PG8_BAR; PG8_WAIT_L(0); PG8_MMA(0, 0, At, B0); PG8_BAR; PG8_SCHED;
            PG8_LDB(B1, 1, 1); PG8_STAGE(PG8_SB(1, 0), b3, voffB);
            PG8_BAR; PG8_WAIT_L(0); PG8_MMA(0, 1, At, B1); PG8_BAR;
            PG8_LDA(At, 1, 1); PG8_STAGE(PG8_SA(1, 0), a3, voffA);
            PG8_BAR; PG8_WAIT_L(0); PG8_MMA(1, 0, At, B0); PG8_BAR; PG8_SCHED;
            PG8_STAGE(PG8_SB(1, 1), b3 + hstep, voffB);
            PG8_WAIT_V(6); PG8_BAR; PG8_MMA(1, 1, At, B1); PG8_BAR;
            }
        }
        if constexpr (ALIGN_EPI) { if (wr == 0) PG8_BAR; }
        if constexpr (!Epi::AFTER_DRAIN) { E(acc, cur, wr, wc, fr, fq); S.done(cur); }
        if (!has_next) break;
#pragma unroll
        for (int a = 0; a < 2; ++a)
#pragma unroll
            for (int b = 0; b < 2; ++b)
#pragma unroll
                for (int m = 0; m < 4; ++m)
#pragma unroll
                    for (int n = 0; n < 2; ++n) acc[a][b][m][n] = (f32x4){0.f, 0.f, 0.f, 0.f};
        cur = nxt; cA = nA; cB = nB; ++ui;
        if constexpr (ALIGN_EPI) { if (wr == 1) PG8_BAR; }
    }
    PG8_WAIT_V(0);
    if constexpr (!ALIGN_EPI) { if (wr == 0) PG8_BAR; }
    PG8_BAR;
    if constexpr (Epi::AFTER_DRAIN) { E.fused(acc, cur, wr, wc, fr, fq, lds, wid, lane); S.done(cur); }
#undef PG8_SA
#undef PG8_SB
#undef PG8_STAGE
#undef PG8_LDA
#undef PG8_LDB
#undef PG8_MMA
#undef PG8_WAIT_V
#undef PG8_WAIT_L
#undef PG8_BAR
#undef PG8_SCHED
}
}

#define DI __device__ __forceinline__
#define LAS __attribute__((address_space(3)))
typedef unsigned short bf16;
typedef short bf16x8 __attribute__((ext_vector_type(8)));
typedef float f32x4 __attribute__((ext_vector_type(4)));
typedef float f32x2 __attribute__((ext_vector_type(2)));
typedef float f32x16 __attribute__((ext_vector_type(16)));
typedef unsigned u32x4 __attribute__((ext_vector_type(4)));
typedef unsigned u32x2 __attribute__((ext_vector_type(2)));
typedef __bf16 bf16x2_t __attribute__((ext_vector_type(2)));

DI unsigned pk2(float lo, float hi) { f32x2 v = {lo, hi}; bf16x2_t b = __builtin_convertvector(v, bf16x2_t); return __builtin_bit_cast(unsigned, b); }
DI bf16 f2bf(float f) { return (bf16)(pk2(f, 0.f) & 0xffffu); }
DI float bf2f(bf16 v) { return __builtin_bit_cast(float, (unsigned)v << 16); }
DI float bflo(unsigned u) { return __builtin_bit_cast(float, u << 16); }
DI float bfhi(unsigned u) { return __builtin_bit_cast(float, u & 0xffff0000u); }
typedef _Float16 f16x2_t __attribute__((ext_vector_type(2)));
typedef __fp16 fp16x2_t __attribute__((ext_vector_type(2)));
DI unsigned pkh2(float lo, float hi) { return __builtin_bit_cast(unsigned, __builtin_amdgcn_cvt_pkrtz(lo, hi)); }
DI float hlo(unsigned u) { return (float)__builtin_bit_cast(f16x2_t, u).x; }
DI float hhi(unsigned u) { return (float)__builtin_bit_cast(f16x2_t, u).y; }
DI float silu_f(float x) { return x * __builtin_amdgcn_rcpf(1.f + __expf(-x)); }
DI float ex2(float x) { return __builtin_amdgcn_exp2f(x); }
#define MFMA32(a, b, c) __builtin_amdgcn_mfma_f32_32x32x16_bf16((a), (b), (c), 0, 0, 0)

constexpr int DM = 1024, NB = 8, SEQ = 4096, CTXL = 256, DEPTH = 4;
constexpr int M_LAT = NB * SEQ, M_CTX = NB * CTXL, M_ALL = M_LAT + M_CTX;
constexpr int DFF = 2816, NGU = 2 * DFF, NIN = 3584, INC = 3588, NKEY = SEQ + CTXL, NVC = 34;
constexpr int XBC0 = 1792;
constexpr float ALPHA = 1.6817928305074290f;
constexpr float QSCALE = 0.125f * 1.4426950408889634f;
constexpr size_t MiB = 1u << 20;
constexpr size_t WS_MOD = 0, WS_TATT = 2 * MiB, WS_LAM = 2 * MiB + 65536, WS_BAR = 2 * MiB + 131072, WS_STAT = 2 * MiB + 262144, WS_ONES = 2 * MiB + 655360, WS_ZEROS = 2 * MiB + 655360 + 4096, WS_HALVES = 2 * MiB + 655360 + 8192, WS_TRET = 3 * MiB, WS_DT = 4 * MiB, WS_DEC = 5 * MiB, WS_XC = 6 * MiB,
                 WS_WGU = 14 * MiB, WS_WDN = 36 * MiB, WS_WIN = 47 * MiB, WS_WOUT = 54 * MiB, WS_A = 56 * MiB, WS_HP = 124 * MiB,
                 WS_VT = 362 * MiB, WS_STS = 396 * MiB, WS_STR = 430 * MiB, WS_U = 447 * MiB, WS_T = 498 * MiB, WS_X16 = 530 * MiB, WS_END = 598 * MiB;
constexpr int LDS_BYTES = 147456;
constexpr int NTHREADS = 512;

struct Args { const float* in[22]; float* out; unsigned char* ws; float afreq[16]; float rfreq[32]; int ph_lo, ph_hi; };
enum { I_X = 0, I_C, I_CTX, I_CCTX, I_ADAW, I_ADAB, I_NG, I_NB, I_WG, I_WU, I_WD, I_WIN, I_CONVW, I_CONVB, I_LAMBDA, I_SUBG, I_ALOG, I_DTB, I_SSMD, I_SSMG, I_RLG, I_WOUT };

DI float* xrow_ptr(float* xlat, float* xctx, int row) { return row < M_LAT ? xlat + (size_t)row * DM : xctx + (size_t)(row - M_LAT) * DM; }
DI int swap23(int o) { return (o & 3) | (((o >> 3) & 1) << 2) | (((o >> 2) & 1) << 3); }

struct EpiSwiglu {
    static constexpr bool PERM = true, AFTER_DRAIN = false;
    bf16* H;
    DI void operator()(const pg8::f32x4 (&acc)[2][2][4][2], const pg8::Unit& u, int wr, int wc, int fr, int fq) const {
        const int row0 = u.pm * 256 + wr * 64 + fr, col = u.pn * 128 + wc * 32 + 8 * fq;
#pragma unroll
        for (int ai = 0; ai < 2; ++ai)
#pragma unroll
            for (int m = 0; m < 4; ++m) {
                bf16* p = H + (size_t)(row0 + ai * 128 + m * 16) * DFF + col;
                float h[8];
#pragma unroll
                for (int n = 0; n < 2; ++n)
#pragma unroll
                    for (int j = 0; j < 4; ++j) h[n * 4 + j] = silu_f(acc[ai][0][m][n][j]) * acc[ai][1][m][n][j];
                u32x4 w; w.x = pk2(h[0], h[1]); w.y = pk2(h[2], h[3]); w.z = pk2(h[4], h[5]); w.w = pk2(h[6], h[7]);
                *(u32x4*)p = w;
                __builtin_amdgcn_sched_barrier(0);
            }
    }
};

struct EpiResid {
    static constexpr bool PERM = true, AFTER_DRAIN = false;
    bf16* X; const float* modg; const float* scale_p; const f32x2* stat; const float* gprev; const float* bprev;
    DI void operator()(const pg8::f32x4 (&acc)[2][2][4][2], const pg8::Unit& u, int wr, int wc, int fr, int fq) const {
        const int mi = (u.pm < 128) ? (u.pm >> 4) : 8;
        const float* gp = modg + (size_t)mi * 9216;
        const int row0 = u.pm * 256 + wr * 64 + fr, col0 = u.pn * 256 + wc * 32 + 8 * fq;
        const float scale = *scale_p;
#pragma unroll
        for (int bj = 0; bj < 2; ++bj) {
            f32x4 gs[2], gq[2], bq[2];
#pragma unroll
            for (int n = 0; n < 2; ++n) { const f32x4 g = *(const f32x4*)(gp + col0 + bj * 128 + 4 * n); gs[n] = (g + 1.0f) * scale;
                gq[n] = *(const f32x4*)(gprev + col0 + bj * 128 + 4 * n) * ALPHA; bq[n] = *(const f32x4*)(bprev + col0 + bj * 128 + 4 * n) * ALPHA; }
#pragma unroll
            for (int ai = 0; ai < 2; ++ai) {
                u32x4 xv[4]; f32x2 st[4];
#pragma unroll
                for (int m = 0; m < 4; ++m) { const int row = row0 + ai * 128 + m * 16; xv[m] = *(const u32x4*)(X + (size_t)row * DM + col0 + bj * 128); st[m] = stat[row]; }
                __builtin_amdgcn_sched_barrier(0);
#pragma unroll
                for (int m = 0; m < 4; ++m) {
                    const f32x4 x0 = {hlo(xv[m].x), hhi(xv[m].x), hlo(xv[m].y), hhi(xv[m].y)}, x1 = {hlo(xv[m].z), hhi(xv[m].z), hlo(xv[m].w), hhi(xv[m].w)};
                    const f32x4 y0 = (x0 - st[m].x) * st[m].y * gq[0] + bq[0] + gs[0] * acc[ai][bj][m][0];
                    const f32x4 y1 = (x1 - st[m].x) * st[m].y * gq[1] + bq[1] + gs[1] * acc[ai][bj][m][1];
                    u32x4 w; w.x = pkh2(y0.x, y0.y); w.y = pkh2(y0.z, y0.w); w.z = pkh2(y1.x, y1.y); w.w = pkh2(y1.z, y1.w);
                    *(u32x4*)(X + (size_t)(row0 + ai * 128 + m * 16) * DM + col0 + bj * 128) = w;
                }
                __builtin_amdgcn_sched_barrier(0);
            }
        }
    }
};
struct EpiPartial {
    static constexpr bool PERM = true, AFTER_DRAIN = false;
    float* T; const float* modg; const float* scale_p;
    DI void operator()(const pg8::f32x4 (&acc)[2][2][4][2], const pg8::Unit& u, int wr, int wc, int fr, int fq) const {
        const float* gp = modg + (size_t)8 * 9216; const float scale = *scale_p;
        const int row0 = u.pm * 256 + wr * 64 + fr - M_LAT, col0 = u.pn * 256 + wc * 32 + 8 * fq;
        f32x4 gs[2][2];
#pragma unroll
        for (int bj = 0; bj < 2; ++bj)
#pragma unroll
            for (int n = 0; n < 2; ++n) { f32x4 g = *(const f32x4*)(gp + col0 + bj * 128 + 4 * n); gs[bj][n] = (g + 1.0f) * scale; }
#pragma unroll
        for (int ai = 0; ai < 2; ++ai)
#pragma unroll
            for (int m = 0; m < 4; ++m) {
                float* tp = T + (size_t)(row0 + ai * 128 + m * 16) * DM + col0;
#pragma unroll
                for (int bj = 0; bj < 2; ++bj)
#pragma unroll
                    for (int n = 0; n < 2; ++n) *(f32x4*)(tp + bj * 128 + 4 * n) = gs[bj][n] * acc[ai][bj][m][n];
                __builtin_amdgcn_sched_barrier(0);
            }
    }
};
struct OneUnit {
    int have; pg8::Unit u;
    DI bool next(int i, pg8::Unit& o) const { if (i == 0 && have) { o = u; return true; } return false; }
    DI void a_ready(const pg8::Unit&) const {}
    DI void done(const pg8::Unit&) const {}
};

struct EpiIn {
    static constexpr bool PERM = true, AFTER_DRAIN = false;
    bf16* P; bf16* Vt; const f32x2* tatt; const f32x2* tret;
    DI void operator()(const pg8::f32x4 (&acc)[2][2][4][2], const pg8::Unit& u, int wr, int wc, int fr, int fq) const {
        const int pn = u.pn;
        const int row0 = u.pm * 256 + wr * 64 + fr;
        if (pn == 4 || pn == 5) {
#pragma unroll
            for (int ai = 0; ai < 2; ++ai)
#pragma unroll
                for (int m = 0; m < 4; ++m) {
                    const int row = row0 + ai * 128 + m * 16;
                    int b, key;
                    if (row < M_LAT) { b = row >> 12; key = row & 4095; } else { const int r2 = row - M_LAT; b = r2 >> 8; key = 4096 + (r2 & 255); }
                    const int kp = (key & ~15) | swap23(key & 15);
#pragma unroll
                    for (int bj = 0; bj < 2; ++bj) {
                        const int h = 2 * (pn - 4) + bj;
                        bf16* vp = Vt + ((size_t)(b * 4 + h) * 128 + wc * 32 + 8 * fq) * NKEY + kp;
#pragma unroll
                        for (int n = 0; n < 2; ++n)
#pragma unroll
                            for (int j = 0; j < 4; ++j) vp[(size_t)(n * 4 + j) * NKEY] = f2bf(acc[ai][bj][m][n][j]);
                    }
                    __builtin_amdgcn_sched_barrier(0);
                }
            return;
        }
        const bool att = pn < 4, ret = (pn == 10 || pn == 11);
        const float sc = (pn < 2) ? QSCALE : (pn == 11 ? 0.125f : 1.0f);
#pragma unroll
        for (int ai = 0; ai < 2; ++ai)
#pragma unroll
            for (int m = 0; m < 4; ++m) {
                const int row = row0 + ai * 128 + m * 16;
                f32x2 cs[4];
                bool rot = false;
                if ((att || ret) && row < M_LAT) {
                    rot = true;
                    const int s = row & 4095;
                    const f32x2* tp;
                    if (att) { const int pos = (wc & 1) ? (s & 63) : (s >> 6); tp = tatt + pos * 16 + 4 * fq; }
                    else { tp = tret + (size_t)s * 32 + 16 * (wc & 1) + 4 * fq; }
                    const f32x4 t0 = *(const f32x4*)tp, t1 = *(const f32x4*)(tp + 2);
                    cs[0] = (f32x2){t0.x, t0.y}; cs[1] = (f32x2){t0.z, t0.w}; cs[2] = (f32x2){t1.x, t1.y}; cs[3] = (f32x2){t1.z, t1.w};
                }
#pragma unroll
                for (int bj = 0; bj < 2; ++bj) {
                    float v[8];
#pragma unroll
                    for (int n = 0; n < 2; ++n)
#pragma unroll
                        for (int j = 0; j < 4; ++j) v[n * 4 + j] = acc[ai][bj][m][n][j];
                    if (rot) {
#pragma unroll
                        for (int q = 0; q < 4; ++q) { const float h1 = v[2 * q], h2 = v[2 * q + 1]; v[2 * q] = h1 * cs[q].x - h2 * cs[q].y; v[2 * q + 1] = h2 * cs[q].x + h1 * cs[q].y; }
                    }
                    u32x4 w; w.x = pk2(v[0] * sc, v[1] * sc); w.y = pk2(v[2] * sc, v[3] * sc); w.z = pk2(v[4] * sc, v[5] * sc); w.w = pk2(v[6] * sc, v[7] * sc);
                    *(u32x4*)(P + (size_t)row * NIN + pn * 256 + bj * 128 + wc * 32 + 8 * fq) = w;
                }
                __builtin_amdgcn_sched_barrier(0);
            }
    }
};

DI void sincos_d(float angf, float& c, float& s) {
    const double a = (double)angf;
    const double k = rint(a * 0.15915494309189535);
    double r = fma(-k, 6.283185307179586, a); r = fma(-k, 2.4492935982947064e-16, r);
    const double r2 = r * r;
    double ts = r, ss = r, tc = 1.0, sc = 1.0;
#pragma unroll 1
    for (int n = 1; n <= 15; ++n) {
        tc = -tc * r2 / (double)((2 * n - 1) * (2 * n)); sc += tc;
        ts = -ts * r2 / (double)((2 * n) * (2 * n + 1)); ss += ts;
    }
    c = (float)sc; s = (float)ss;
}

DI int in_srccol(int j) {
    if (j < 1024) { const int blk = j >> 6, dp = j & 63, half = dp >> 5, i = (dp & 31) >> 1, sec = dp & 1; return blk * 64 + half * 32 + i + 16 * sec; }
    if (j < 2560) return j;
    if (j < 3072) { const int jj = j - 2560, blk = jj >> 6, dp = jj & 63, i = dp >> 1, sec = dp & 1; return 2564 + blk * 64 + i + 32 * sec; }
    return j + 4;
}

DI void transpose_item(const float* W, int ldw, int K, int srccol_lane, bf16* WT, int n0, int k0, LAS float* scr, int lane) {
#pragma unroll 8
    for (int i = 0; i < 32; ++i) { const int kk = 2 * i + (lane >> 5); scr[kk * 33 + (lane & 31)] = W[(size_t)(k0 + kk) * ldw + srccol_lane]; }
    asm volatile("s_waitcnt lgkmcnt(0)" ::: "memory");
    const int c = lane & 7;
#pragma unroll
    for (int j = 0; j < 4; ++j) {
        const int n = (lane >> 3) + 8 * j; const LAS float* s = scr + (8 * c) * 33 + n;
        u32x4 o; o.x = pk2(s[0 * 33], s[1 * 33]); o.y = pk2(s[2 * 33], s[3 * 33]); o.z = pk2(s[4 * 33], s[5 * 33]); o.w = pk2(s[6 * 33], s[7 * 33]);
        *(u32x4*)(WT + (size_t)(n0 + n) * K + k0 + 8 * c) = o;
    }
    asm volatile("s_waitcnt lgkmcnt(0)" ::: "memory");
}

DI void transpose_item_wide(const float* W, int ldw, int K, int src0, bf16* WT, int n0, int k0, LAS float* scr, int lane) {
    const int c4 = lane & 7, kr = lane >> 3;
#pragma unroll
    for (int i = 0; i < 8; ++i) { const int kk = kr + 8 * i; const f32x4 v = *(const f32x4*)(W + (size_t)(k0 + kk) * ldw + src0 + 4 * c4);
        LAS float* d = scr + kk * 33 + 4 * c4; d[0] = v.x; d[1] = v.y; d[2] = v.z; d[3] = v.w; }
    asm volatile("s_waitcnt lgkmcnt(0)" ::: "memory");
    const int c = lane & 7;
#pragma unroll
    for (int j = 0; j < 4; ++j) {
        const int n = (lane >> 3) + 8 * j; const LAS float* sp = scr + (8 * c) * 33 + n;
        u32x4 o; o.x = pk2(sp[0 * 33], sp[1 * 33]); o.y = pk2(sp[2 * 33], sp[3 * 33]); o.z = pk2(sp[4 * 33], sp[5 * 33]); o.w = pk2(sp[6 * 33], sp[7 * 33]);
        *(u32x4*)(WT + (size_t)(n0 + n) * K + k0 + 8 * c) = o;
    }
    asm volatile("s_waitcnt lgkmcnt(0)" ::: "memory");
}

DI void convw_phase(const Args& A, int l, LAS unsigned char* lds, int tid, int bid, int G) {
    const int lane = tid & 63, wave = tid >> 6;
    LAS float* scr = (LAS float*)(lds + 65536 + wave * 8448);
    const int gw = bid * 8 + wave, NGW = G * 8;
    constexpr int I_GU = 2 * 16 * (NGU / 32), I_DN = 2 * (DFF / 64) * (DM / 32), I_IN = 16 * (NIN / 32), I_OUT = 16 * 32;
    bf16* wgu = (bf16*)(A.ws + WS_WGU); bf16* wdn = (bf16*)(A.ws + WS_WDN); bf16* win = (bf16*)(A.ws + WS_WIN); bf16* wout = (bf16*)(A.ws + WS_WOUT);
    for (int it = gw; it < I_GU + I_DN + I_IN + I_OUT; it += NGW) {
        int r = it;
        if (r < I_GU) {
            const int f = r / (16 * (NGU / 32)); r -= f * 16 * (NGU / 32);
            const int kb = r / (NGU / 32), nb = r % (NGU / 32), n0 = nb * 32, pn = n0 >> 8, cc = n0 & 255;
            const float* src = (cc < 128 ? A.in[I_WG] : A.in[I_WU]) + (size_t)(l * 2 + f) * DM * DFF;
            transpose_item_wide(src, DFF, DM, 128 * pn + (cc & 127), wgu + (size_t)f * NGU * DM, n0, kb * 64, scr, lane);
            continue;
        }
        r -= I_GU;
        if (r < I_DN) {
            const int f = r / ((DFF / 64) * 32); r -= f * (DFF / 64) * 32;
            const int kb = r / 32, nb = r % 32;
            transpose_item_wide(A.in[I_WD] + (size_t)(l * 2 + f) * DFF * DM, DM, DFF, nb * 32, wdn + (size_t)f * DM * DFF, nb * 32, kb * 64, scr, lane);
            continue;
        }
        r -= I_DN;
        if (r < I_IN) {
            const int kb = r / (NIN / 32), nb = r % (NIN / 32);
            transpose_item(A.in[I_WIN] + (size_t)l * DM * INC, INC, DM, in_srccol(nb * 32 + (lane & 31)), win, nb * 32, kb * 64, scr, lane);
            continue;
        }
        r -= I_IN;
        { const int kb = r / 32, nb = r % 32;
          transpose_item_wide(A.in[I_WOUT] + (size_t)l * DM * DM, DM, DM, nb * 32, wout, nb * 32, kb * 64, scr, lane); }
    }
}

DI void p0a_phase(const Args& A, LAS unsigned char* lds, int tid, int bid, int G) {
    const int lane = tid & 63, wave = tid >> 6;
    { const int gt = bid * NTHREADS + tid;
      f32x2* tatt = (f32x2*)(A.ws + WS_TATT); f32x2* tret = (f32x2*)(A.ws + WS_TRET);
      if (gt < 1024) { ((float*)(A.ws + WS_ONES))[gt] = 1.0f; ((float*)(A.ws + WS_ZEROS))[gt] = 0.0f; ((float*)(A.ws + WS_HALVES))[gt] = 0.5f; }
      if (gt < 1024) { const int pos = gt >> 4, i = gt & 15; float c, s; sincos_d((float)pos * A.afreq[i], c, s); tatt[gt] = (f32x2){c, s}; }
      for (int e = gt; e < SEQ * 32; e += G * NTHREADS) { const int sidx = e >> 5, i = e & 31; float c, s; sincos_d((float)sidx * A.rfreq[i], c, s); tret[e] = (f32x2){c, s}; }
      if (gt < DEPTH) {
          const float* lv = A.in[I_LAMBDA] + gt * 256; float d0 = 0.f, d1 = 0.f;
          for (int i = 0; i < 64; ++i) { d0 += lv[i] * lv[64 + i]; d1 += lv[128 + i] * lv[192 + i]; }
          const float lam_init = 0.8f - 0.6f * expf(-0.3f * (float)gt);
          ((float*)(A.ws + WS_LAM))[gt] = expf(d0) - expf(d1) + lam_init;
      }
    }
    LAS float* scs = (LAS float*)lds;
    LAS float* red = (LAS float*)(lds + 36864);
    for (int e = tid; e < 9 * 1024; e += NTHREADS) { const int mi = e >> 10, k = e & 1023; const float v = (mi < 8) ? A.in[I_C][mi * 1024 + k] : A.in[I_CCTX][k]; scs[e] = silu_f(v); }
    __syncthreads();
    float* MOD = (float*)(A.ws + WS_MOD);
    for (int it = bid; it < DEPTH * 144; it += G) {
        const int l = it / 144, cg0 = (it % 144) * 64;
        const float* w = A.in[I_ADAW] + (size_t)l * DM * 9216 + cg0 + lane;
        float acc[9];
#pragma unroll
        for (int mi = 0; mi < 9; ++mi) acc[mi] = 0.f;
#pragma unroll 4
        for (int k = wave * 128; k < wave * 128 + 128; ++k) {
            const float wv = w[(size_t)k * 9216];
#pragma unroll
            for (int mi = 0; mi < 9; ++mi) acc[mi] += scs[mi * 1024 + k] * wv;
        }
#pragma unroll
        for (int mi = 0; mi < 9; ++mi) red[(wave * 9 + mi) * 64 + lane] = acc[mi];
        __syncthreads();
        for (int e = tid; e < 576; e += NTHREADS) {
            const int mi = e >> 6, cl = e & 63; float s = A.in[I_ADAB][l * 9216 + cg0 + cl];
#pragma unroll
            for (int w8 = 0; w8 < 8; ++w8) s += red[(w8 * 9 + mi) * 64 + cl];
            MOD[((size_t)l * 9 + mi) * 9216 + cg0 + cl] = s;
        }
        __syncthreads();
    }
    convw_phase(A, 0, lds, tid, bid, G);
}

DI void wave_sum2(float& a, float& b) {
#pragma unroll
    for (int o = 1; o < 64; o <<= 1) { const float ta = __shfl_xor(a, o), tb = __shfl_xor(b, o); a += ta; b += tb; }
}
DI void wave_sum4(float& a, float& b, float& c, float& d) {
#pragma unroll
    for (int o = 1; o < 64; o <<= 1) { const float ta = __shfl_xor(a, o), tb = __shfl_xor(b, o), tc = __shfl_xor(c, o), td = __shfl_xor(d, o); a += ta; b += tb; c += tc; d += td; }
}
DI float wave_sum(float v) {
#pragma unroll
    for (int o = 1; o < 64; o <<= 1) v += __shfl_xor(v, o);
    return v;
}
DI void lnmod_phase(const Args& A, LAS unsigned char* lds, int tid, int bid, int G, bool init, int l_norm, int i_norm, int l_mod, int i_mod, bool want_dt, int nrows, bool ctx_partial, const float* gprev, const float* bprev) {
    const int lane = tid & 63, wave = tid >> 6;
    LAS f32x4* wdt = (LAS f32x4*)lds;
    if (want_dt) {
        for (int k = tid; k < 1024; k += NTHREADS) wdt[k] = *(const f32x4*)(A.in[I_WIN] + ((size_t)l_mod * DM + k) * INC + 2560);
        __syncthreads();
    }
    const float* MOD = (const float*)(A.ws + WS_MOD);
    bf16* Abuf = (bf16*)(A.ws + WS_A);
    float* DT = (float*)(A.ws + WS_DT);
    f32x4 g[4], bb[4];
    if (l_norm >= 0) {
#pragma unroll
        for (int j = 0; j < 4; ++j) { g[j] = *(const f32x4*)(A.in[I_NG] + (l_norm * 3 + i_norm) * DM + 256 * j + 4 * lane); bb[j] = *(const f32x4*)(A.in[I_NB] + (l_norm * 3 + i_norm) * DM + 256 * j + 4 * lane); }
    }
    bf16* X16 = (bf16*)(A.ws + WS_X16);
    u32x2 un[4]; f32x4 fn[4];
    int mi_cur = -1; f32x4 shv[4], sclv[4];
    { const int row = bid * 8 + wave;
      if (row < nrows) {
          if (init) { const float* xin = row < M_LAT ? A.in[I_X] + (size_t)row * DM : A.in[I_CTX] + (size_t)(row - M_LAT) * DM;
#pragma unroll
              for (int j = 0; j < 4; ++j) fn[j] = *(const f32x4*)(xin + 256 * j + 4 * lane); }
          else {
#pragma unroll
              for (int j = 0; j < 4; ++j) un[j] = *(const u32x2*)(X16 + (size_t)row * DM + 256 * j + 4 * lane); } } }
    for (int row = bid * 8 + wave; row < nrows; row += G * 8) {
        bf16* xout = X16 + (size_t)row * DM;
        f32x4 v[4];
#pragma unroll
        for (int j = 0; j < 4; ++j) v[j] = init ? fn[j] : (f32x4){hlo(un[j].x), hhi(un[j].x), hlo(un[j].y), hhi(un[j].y)};
        { const int rown = row + G * 8;
          if (rown < nrows) {
              if (init) { const float* xin = rown < M_LAT ? A.in[I_X] + (size_t)rown * DM : A.in[I_CTX] + (size_t)(rown - M_LAT) * DM;
#pragma unroll
                  for (int j = 0; j < 4; ++j) fn[j] = *(const f32x4*)(xin + 256 * j + 4 * lane); }
              else {
#pragma unroll
                  for (int j = 0; j < 4; ++j) un[j] = *(const u32x2*)(X16 + (size_t)rown * DM + 256 * j + 4 * lane); } } }
        f32x2* STAT = (f32x2*)(A.ws + WS_STAT);
        if (ctx_partial && row >= M_LAT) {
            { const f32x2 st = STAT[row];
#pragma unroll
              for (int j = 0; j < 4; ++j) v[j] = (v[j] - st.x) * st.y * *(const f32x4*)(gprev + 256 * j + 4 * lane) + *(const f32x4*)(bprev + 256 * j + 4 * lane); }
            const float* t0 = (const float*)(A.ws + WS_T) + (size_t)(row - M_LAT) * DM; const float* t1 = t0 + (size_t)M_CTX * DM; const float* t2 = t1 + (size_t)M_CTX * DM; const float* t3 = t2 + (size_t)M_CTX * DM;
#pragma unroll
            for (int j = 0; j < 4; ++j) { v[j] = v[j] * ALPHA + (*(const f32x4*)(t0 + 256 * j + 4 * lane) + *(const f32x4*)(t1 + 256 * j + 4 * lane)) + (*(const f32x4*)(t2 + 256 * j + 4 * lane) + *(const f32x4*)(t3 + 256 * j + 4 * lane)); u32x2 w_; w_.x = pkh2(v[j].x, v[j].y); w_.y = pkh2(v[j].z, v[j].w); *(u32x2*)(xout + 256 * j + 4 * lane) = w_; }
        }
        if (l_norm >= 0) {
            float s = 0.f, s2 = 0.f;
#pragma unroll
            for (int j = 0; j < 4; ++j) { s += (v[j].x + v[j].y) + (v[j].z + v[j].w); s2 += (v[j].x * v[j].x + v[j].y * v[j].y) + (v[j].z * v[j].z + v[j].w * v[j].w); }
            wave_sum2(s, s2);
            const float mean = s * (1.f / DM);
            const float rstd = 1.0f / sqrtf(fmaxf(s2 * (1.f / DM) - mean * mean, 0.f) + 1e-5f);
#pragma unroll
            for (int j = 0; j < 4; ++j) v[j] = v[j] - mean;
            if (l_mod >= 0 && lane == 0) STAT[row] = (f32x2){mean, rstd};
#pragma unroll
            for (int j = 0; j < 4; ++j) v[j] = v[j] * rstd * g[j] + bb[j];
        }
        if (init && lane == 0) STAT[row] = (f32x2){0.f, 1.f};
        if (init) {
#pragma unroll
            for (int j = 0; j < 4; ++j) { u32x2 w_; w_.x = pkh2(v[j].x, v[j].y); w_.y = pkh2(v[j].z, v[j].w); *(u32x2*)(xout + 256 * j + 4 * lane) = w_; }
        }
        if (l_norm >= 0 && l_mod < 0) {
#pragma unroll
            for (int j = 0; j < 4; ++j) *(f32x4*)(A.out + (size_t)row * DM + 256 * j + 4 * lane) = v[j];
        }
        if (l_mod >= 0) {
            const int mi = row < M_LAT ? (row >> 12) : 8;
            const float* mp = MOD + ((size_t)l_mod * 9 + mi) * 9216 + i_mod * 3072;
            if (mi != mi_cur) { mi_cur = mi;
#pragma unroll
                for (int j = 0; j < 4; ++j) { shv[j] = *(const f32x4*)(mp + 256 * j + 4 * lane); sclv[j] = *(const f32x4*)(mp + 1024 + 256 * j + 4 * lane) + 1.0f; } }
            float d0 = 0.f, d1 = 0.f, d2 = 0.f, d3 = 0.f;
#pragma unroll
            for (int j = 0; j < 4; ++j) {
                const f32x4 a = v[j] * sclv[j] + shv[j];
                u32x2 w; w.x = pk2(a.x, a.y); w.y = pk2(a.z, a.w);
                *(u32x2*)(Abuf + (size_t)row * DM + 256 * j + 4 * lane) = w;
                if (want_dt) {
                    const int k0 = 256 * j + 4 * lane;
                    const f32x4 w0 = wdt[k0], w1 = wdt[k0 + 1], w2 = wdt[k0 + 2], w3 = wdt[k0 + 3];
                    d0 += a.x * w0.x + a.y * w1.x + a.z * w2.x + a.w * w3.x;
                    d1 += a.x * w0.y + a.y * w1.y + a.z * w2.y + a.w * w3.y;
                    d2 += a.x * w0.z + a.y * w1.z + a.z * w2.z + a.w * w3.z;
                    d3 += a.x * w0.w + a.y * w1.w + a.z * w2.w + a.w * w3.w;
                }
            }
            if (want_dt) {
                wave_sum4(d0, d1, d2, d3);
                if (lane == 0) *(f32x4*)(DT + (size_t)row * 4) = (f32x4){d0, d1, d2, d3};
            }
        }
    }
}

DI float max3f(float a, float b, float c) { float r; asm("v_max3_f32 %0, %1, %2, %3" : "=v"(r) : "v"(a), "v"(b), "v"(c)); return r; }
DI float max3f_mfma(float a, float b, float c) { float r; asm("s_nop 15\n\ts_nop 7\n\tv_max3_f32 %0, %1, %2, %3" : "=v"(r) : "v"(a), "v"(b), "v"(c)); return r; }
DI void attn_unit(LAS unsigned char* lds, int tid, const bf16* __restrict__ P, const bf16* __restrict__ Vt, bf16* MG, int b, int h, int qrow0, int jt0, int jt1,
                  float lam, float oscale, const float* subg) {
    asm volatile("" : "+v"(tid));
    constexpr int KP = 136, VP = 72, KBYTES = 64 * KP * 2, VBYTES = 128 * VP * 2;
    const int lane = tid & 63, wave = tid >> 6, r32 = lane & 31, hi = lane >> 5;
    const int qb = wave >> 1, m = wave & 1;
    const int qrow = qrow0 + qb * 32 + r32;
    bf16x8 qf[4];
#pragma unroll
    for (int ks = 0; ks < 4; ++ks) qf[ks] = *(const bf16x8*)(P + (size_t)qrow * NIN + h * 128 + m * 64 + ks * 16 + hi * 8);
    f32x16 O[4];
#pragma unroll
    for (int es = 0; es < 4; ++es)
#pragma unroll
        for (int i = 0; i < 16; ++i) O[es][i] = 0.f;
    float mrun = 0.f, lrun = 0.f;
    u32x4 kreg[2], vreg[2];
    const bf16* vbase = Vt + (size_t)(b * 4 + h) * 128 * NKEY;
#define ATT_LOADG(j) do { _Pragma("unroll") for (int i_ = 0; i_ < 2; ++i_) { const int c_ = tid + 512 * i_; const int key_ = c_ >> 4, part_ = c_ & 15; \
        const int row_ = ((j) < 64) ? b * SEQ + (j) * 64 + key_ : M_LAT + b * CTXL + ((j) - 64) * 64 + key_; \
        kreg[i_] = *(const u32x4*)(P + (size_t)row_ * NIN + 512 + h * 128 + part_ * 8); \
        const int e_ = c_ >> 3, vp_ = c_ & 7; vreg[i_] = *(const u32x4*)(vbase + (size_t)e_ * NKEY + (j) * 64 + vp_ * 8); } } while (0)
#define ATT_STORE(buf) do { _Pragma("unroll") for (int i_ = 0; i_ < 2; ++i_) { const int c_ = tid + 512 * i_; const int key_ = c_ >> 4, part_ = c_ & 15, e_ = c_ >> 3, vp_ = c_ & 7; \
        *(LAS u32x4*)(lds + (buf) * KBYTES + (key_ * KP + part_ * 8) * 2) = kreg[i_]; \
        *(LAS u32x4*)(lds + 3 * KBYTES + (buf) * VBYTES + (e_ * VP + vp_ * 8) * 2) = vreg[i_]; } } while (0)
    const bool halfB = wave >= 4;
    bf16x8 pf[4];
#define ATT_QKS(bufk, first_) do { \
        const LAS bf16* Kb = (const LAS bf16*)(lds + (bufk) * KBYTES) + m * 64 + hi * 8; \
        f32x16 s0, s1; \
        { const float ninit = -mrun; _Pragma("unroll") for (int i = 0; i < 16; ++i) { s0[i] = ninit; s1[i] = ninit; } } \
        _Pragma("unroll") for (int ks = 0; ks < 4; ++ks) { \
            const bf16x8 a0 = *(const LAS bf16x8*)(Kb + r32 * KP + ks * 16); \
            const bf16x8 a1 = *(const LAS bf16x8*)(Kb + (32 + r32) * KP + ks * 16); \
            s0 = MFMA32(a0, qf[ks], s0); s1 = MFMA32(a1, qf[ks], s1); } \
        float mx = max3f_mfma(s0[0], s1[0], s0[1]); \
        mx = max3f(mx, s1[1], s0[2]); mx = max3f(mx, s1[2], s0[3]); mx = max3f(mx, s1[3], s0[4]); mx = max3f(mx, s1[4], s0[5]); \
        mx = max3f(mx, s1[5], s0[6]); mx = max3f(mx, s1[6], s0[7]); mx = max3f(mx, s1[7], s0[8]); mx = max3f(mx, s1[8], s0[9]); \
        mx = max3f(mx, s1[9], s0[10]); mx = max3f(mx, s1[10], s0[11]); mx = max3f(mx, s1[11], s0[12]); mx = max3f(mx, s1[12], s0[13]); \
        mx = max3f(mx, s1[13], s0[14]); mx = max3f(mx, s1[14], s0[15]); mx = max3f(mx, s1[15], mx); \
        mx = max3f(mx, __shfl_xor(mx, 32), mx); \
        if ((first_) || __builtin_amdgcn_ballot_w64(mx > 8.0f) != 0ull) { \
            const float d = (first_) ? mx : (mx > 8.0f ? mx : 0.f); \
            mrun += d; \
            if (!(first_)) { const float alpha = ex2(-d); lrun *= alpha; _Pragma("unroll") for (int es = 0; es < 4; ++es) O[es] = O[es] * alpha; } \
            _Pragma("unroll") for (int i = 0; i < 16; ++i) { s0[i] -= d; s1[i] -= d; } } \
        float sum = 0.f; \
        _Pragma("unroll") for (int i = 0; i < 16; ++i) { s0[i] = ex2(s0[i]); s1[i] = ex2(s1[i]); sum += s0[i] + s1[i]; } \
        lrun += sum; \
        _Pragma("unroll") for (int s2 = 0; s2 < 2; ++s2) { u32x4 w0, w1; \
            w0.x = pk2(s0[8 * s2 + 0], s0[8 * s2 + 1]); w0.y = pk2(s0[8 * s2 + 2], s0[8 * s2 + 3]); w0.z = pk2(s0[8 * s2 + 4], s0[8 * s2 + 5]); w0.w = pk2(s0[8 * s2 + 6], s0[8 * s2 + 7]); \
            w1.x = pk2(s1[8 * s2 + 0], s1[8 * s2 + 1]); w1.y = pk2(s1[8 * s2 + 2], s1[8 * s2 + 3]); w1.z = pk2(s1[8 * s2 + 4], s1[8 * s2 + 5]); w1.w = pk2(s1[8 * s2 + 6], s1[8 * s2 + 7]); \
            pf[s2] = __builtin_bit_cast(bf16x8, w0); pf[2 + s2] = __builtin_bit_cast(bf16x8, w1); } } while (0)
#define ATT_PV(bufv) do { \
        const LAS bf16* Vb = (const LAS bf16*)(lds + 3 * KBYTES + (bufv) * VBYTES) + hi * 8; \
        _Pragma("unroll") for (int es = 0; es < 4; ++es) _Pragma("unroll") for (int kk = 0; kk < 4; ++kk) { \
            const bf16x8 a = *(const LAS bf16x8*)(Vb + (es * 32 + r32) * VP + kk * 16); O[es] = MFMA32(a, pf[kk], O[es]); } } while (0)
    __syncthreads();
    ATT_LOADG(jt0);
    int buf = 0, pbuf = 2;
    for (int j = jt0; j < jt1; ++j) {
        ATT_STORE(buf);
        __syncthreads();
        if (j + 1 < jt1) ATT_LOADG(j + 1);
        if (!halfB) { ATT_QKS(buf, j == jt0); ATT_PV(buf); }
        else { if (j > jt0) { ATT_PV(pbuf); } ATT_QKS(buf, j == jt0); }
        pbuf = buf; buf = (buf == 2) ? 0 : buf + 1;
    }
    if (halfB) { ATT_PV(pbuf); }
#undef ATT_QKS
#undef ATT_PV
#undef ATT_LOADG
#undef ATT_STORE
    __syncthreads();
    const float l = lrun + __shfl_xor(lrun, 32);
    const float inv = (m ? lam : 1.0f) / l;
    LAS float* X = (LAS float*)lds + qb * 4096 + lane;
    if (m) {
#pragma unroll
        for (int es = 0; es < 4; ++es)
#pragma unroll
            for (int i = 0; i < 16; ++i) X[(es * 16 + i) * 64] = O[es][i] * inv;
    }
    __syncthreads();
    if (!m) {
        float ss = 0.f;
#pragma unroll
        for (int es = 0; es < 4; ++es)
#pragma unroll
            for (int i = 0; i < 16; ++i) { const float o = O[es][i] * inv - X[(es * 16 + i) * 64]; O[es][i] = o; ss += o * o; }
        ss += __shfl_xor(ss, 32);
        const float rn = (1.0f / sqrtf(ss * (1.0f / 128.0f) + 1e-6f)) * oscale;
#pragma unroll
        for (int es = 0; es < 4; ++es)
#pragma unroll
            for (int g4 = 0; g4 < 4; ++g4) {
                const int e = es * 32 + 8 * g4 + 4 * hi;
                const f32x4 gv = *(const f32x4*)(subg + e);
                u32x2 w; w.x = pk2(O[es][4 * g4 + 0] * rn * gv.x, O[es][4 * g4 + 1] * rn * gv.y); w.y = pk2(O[es][4 * g4 + 2] * rn * gv.z, O[es][4 * g4 + 3] * rn * gv.w);
                *(u32x2*)(MG + (size_t)qrow * DM + h * 128 + e) = w;
            }
    }
}

constexpr int SC_ACF = 0, SC_ACB = 1, SC_DT0 = 2, SC_DT1 = 3;
constexpr int L_STAT = 8192, L_BUF = 16384;
constexpr int TP = 136;
constexpr int QP = 72;
constexpr int UW = 768;

DI int vc_row0(int b, int vc) { return vc < 2 ? M_LAT + b * CTXL + vc * 128 : b * SEQ + (vc - 2) * 128; }
DI float softplus_f(float x) { return fmaxf(x, 0.f) + log1pf(__expf(-fabsf(x))); }

struct ScanCtx { const bf16* P; const bf16* U; const float* DT; bf16* sts; bf16* str; float* dec; bf16* MG; const float* cw; const float* cb; const float* alog; const float* dtb; const float* ssmd; const float* ssmg; const float* rlg; };

DI void conv_phase(const bf16* __restrict__ P, bf16* __restrict__ U, const float* cw, const float* cb, int tid, int bid, int G) {
    const int lane = tid & 63, wave = tid >> 6;
    for (int it = bid * 8 + wave; it < (M_ALL / 16) * 3; it += G * 8) {
        const int run = it / 3, cgp = it % 3, row0 = run * 16, ch = cgp * 256 + 4 * lane;
        int s0, L; if (row0 < M_LAT) { s0 = row0 & (SEQ - 1); L = SEQ; } else { s0 = (row0 - M_LAT) & (CTXL - 1); L = CTXL; }
        f32x4 w[5];
#pragma unroll
        for (int k = 0; k < 5; ++k) w[k] = *(const f32x4*)(cw + k * UW + ch);
        const f32x4 bias = *(const f32x4*)(cb + ch);
        f32x4 x[20];
#pragma unroll
        for (int i = 0; i < 20; ++i) { const int s = s0 - 2 + i; u32x2 v = {0u, 0u}; if (s >= 0 && s < L) v = *(const u32x2*)(P + (size_t)(row0 - 2 + i) * NIN + XBC0 + ch);
            x[i] = (f32x4){bflo(v.x), bfhi(v.x), bflo(v.y), bfhi(v.y)}; }
#pragma unroll
        for (int t = 0; t < 16; ++t) {
            const f32x4 a = bias + w[0] * x[t] + w[1] * x[t + 1] + w[2] * x[t + 2] + w[3] * x[t + 3] + w[4] * x[t + 4];
            u32x2 o; o.x = pk2(silu_f(a.x), silu_f(a.y)); o.y = pk2(silu_f(a.z), silu_f(a.w));
            *(u32x2*)(U + (size_t)(row0 + t) * UW + ch) = o;
        }
    }
}

DI void ssd_scalars(LAS float* sc, int tid, const float* DT, int row0, const float* alog, const float* dtb, float* dec_f, float* dec_b) {
    const int lane = tid & 63, wave = tid >> 6;
    if (wave < 4) {
        const int h = wave;
        const float r0 = DT[(size_t)(row0 + 2 * lane) * 4 + h], r1 = DT[(size_t)(row0 + 2 * lane + 1) * 4 + h];
        const float ea0 = __expf(alog[h]), ea1 = __expf(alog[4 + h]);
        const float d00 = softplus_f(r0 + dtb[h]), d01 = softplus_f(r1 + dtb[h]);
        const float d10 = softplus_f(r0 + dtb[4 + h]), d11 = softplus_f(r1 + dtb[4 + h]);
        const float la00 = -d00 * ea0, la01 = -d01 * ea0, la10 = -d10 * ea1, la11 = -d11 * ea1;
        float pf = la00 + la01, pb = la10 + la11;
#pragma unroll
        for (int o = 1; o < 64; o <<= 1) { const float tf = __shfl_up(pf, o), tb = __shfl_up(pb, o); if (lane >= o) { pf += tf; pb += tb; } }
        const float totb = __shfl(pb, 63), totf = __shfl(pf, 63);
        sc[(SC_ACF * 4 + h) * 128 + 2 * lane + 1] = pf; sc[(SC_ACF * 4 + h) * 128 + 2 * lane] = pf - la01;
        sc[(SC_ACB * 4 + h) * 128 + 2 * lane + 1] = totb - pb + la11; sc[(SC_ACB * 4 + h) * 128 + 2 * lane] = totb - (pb - la11) + la10;
        sc[(SC_DT0 * 4 + h) * 128 + 2 * lane] = d00; sc[(SC_DT0 * 4 + h) * 128 + 2 * lane + 1] = d01;
        sc[(SC_DT1 * 4 + h) * 128 + 2 * lane] = d10; sc[(SC_DT1 * 4 + h) * 128 + 2 * lane + 1] = d11;
        if (dec_f && lane == 0) { dec_f[h] = __expf(totf); dec_b[h] = __expf(totb); }
    }
}

DI f32x16 zero16() { f32x16 z;
#pragma unroll
    for (int i = 0; i < 16; ++i) z[i] = 0.f;
    return z; }
template <int KSTEPS> DI f32x16 mma_lds(f32x16 acc, const LAS bf16* Ap, int pa, const LAS bf16* Bp, int pb, int lane) {
    const int r32 = lane & 31, hi = lane >> 5;
    Ap += r32 * pa + 8 * hi; Bp += r32 * pb + 8 * hi;
#pragma unroll
    for (int ks = 0; ks < KSTEPS; ++ks) { const bf16x8 a = *(const LAS bf16x8*)(Ap + 16 * ks), bq = *(const LAS bf16x8*)(Bp + 16 * ks); acc = MFMA32(a, bq, acc); }
    return acc;
}

template <int C, bool SCALED> DI void stage_T(LAS bf16* d0, LAS bf16* d1, const bf16* __restrict__ src, int spitch, const LAS float* w0, const LAS float* w1, int tid) {
    constexpr int OC = C / 8;
#pragma unroll
    for (int it0 = 0; it0 < 64 * OC; it0 += NTHREADS) {
        const int it = it0 + tid, oct = it % OC, tp = it / OC;
        const u32x4 r0 = *(const u32x4*)(src + (size_t)(2 * tp) * spitch + oct * 8), r1 = *(const u32x4*)(src + (size_t)(2 * tp + 1) * spitch + oct * 8);
        const unsigned a[4] = {r0.x, r0.y, r0.z, r0.w}, bq[4] = {r1.x, r1.y, r1.z, r1.w};
        if (!SCALED) {
#pragma unroll
            for (int k = 0; k < 4; ++k) {
                *(LAS unsigned*)(d0 + (oct * 8 + 2 * k) * TP + 2 * tp) = (a[k] & 0xffffu) | (bq[k] << 16);
                *(LAS unsigned*)(d0 + (oct * 8 + 2 * k + 1) * TP + 2 * tp) = (a[k] >> 16) | (bq[k] & 0xffff0000u);
            }
        } else {
            const float u0 = w0[2 * tp], u1 = w0[2 * tp + 1], v0 = w1[2 * tp], v1 = w1[2 * tp + 1];
#pragma unroll
            for (int k = 0; k < 4; ++k) {
                const float e0 = bflo(a[k]), e1 = bfhi(a[k]), f0 = bflo(bq[k]), f1 = bfhi(bq[k]);
                *(LAS unsigned*)(d0 + (oct * 8 + 2 * k) * TP + 2 * tp) = pk2(e0 * u0, f0 * u1);
                *(LAS unsigned*)(d0 + (oct * 8 + 2 * k + 1) * TP + 2 * tp) = pk2(e1 * u0, f1 * u1);
                *(LAS unsigned*)(d1 + (oct * 8 + 2 * k) * TP + 2 * tp) = pk2(e0 * v0, f0 * v1);
                *(LAS unsigned*)(d1 + (oct * 8 + 2 * k + 1) * TP + 2 * tp) = pk2(e1 * v0, f1 * v1);
            }
        }
    }
}
template <int R, int C> DI void stage_N(LAS bf16* d, int dp, const bf16* __restrict__ src, int spitch, int tid) {
    constexpr int OC = C / 8;
#pragma unroll
    for (int it0 = 0; it0 < R * OC; it0 += NTHREADS) { const int it = it0 + tid, oct = it % OC, r = it / OC; *(LAS u32x4*)(d + r * dp + oct * 8) = *(const u32x4*)(src + (size_t)r * spitch + oct * 8); }
}

DI void s1_ssd_unit(LAS unsigned char* lds, int tid, const ScanCtx& C, int b, int vc) {
    asm volatile("" : "+v"(tid));
    const int lane = tid & 63, wave = tid >> 6, r32 = lane & 31, hi = lane >> 5;
    LAS float* sc = (LAS float*)lds; LAS float* wts = (LAS float*)(lds + L_STAT);
    LAS bf16* BkT = (LAS bf16*)(lds + L_BUF); LAS bf16* XF = (LAS bf16*)(lds + L_BUF + 34816); LAS bf16* XB = (LAS bf16*)(lds + L_BUF + 34816 + 17408);
    const int row0 = vc_row0(b, vc);
    float* decp = C.dec + (size_t)((b * NVC + vc) * 2) * 8;
    __syncthreads();
    ssd_scalars(sc, tid, C.DT, row0, C.alog, C.dtb, decp, decp + 8);
    __syncthreads();
    { const int h = tid >> 7, s = tid & 127;
      wts[h * 128 + s] = __expf(sc[(SC_ACF * 4 + h) * 128 + 127] - sc[(SC_ACF * 4 + h) * 128 + s]) * sc[(SC_DT0 * 4 + h) * 128 + s];
      wts[(4 + h) * 128 + s] = __expf(sc[(SC_ACB * 4 + h) * 128 + 0] - sc[(SC_ACB * 4 + h) * 128 + s]) * sc[(SC_DT1 * 4 + h) * 128 + s]; }
    const bf16* Urow = C.U + (size_t)row0 * UW;
    for (int g = 0; g < 2; ++g) {
        __syncthreads();
        stage_T<128, false>(BkT, BkT, Urow + 256 + g * 128, UW, nullptr, nullptr, tid);
        for (int hh = 0; hh < 2; ++hh) {
            const int h = 2 * g + hh;
            if (hh) __syncthreads();
            stage_T<64, true>(XF, XB, Urow + h * 64, UW, wts + h * 128, wts + (4 + h) * 128, tid);
            __syncthreads();
            const int pt = wave >> 2, nt = wave & 3;
            f32x16 af = zero16(), ab = zero16();
            { const LAS bf16* Bp = BkT + (nt * 32 + r32) * TP + 8 * hi; const LAS bf16* Af = XF + (pt * 32 + r32) * TP + 8 * hi; const LAS bf16* Ab = XB + (pt * 32 + r32) * TP + 8 * hi;
#pragma unroll
              for (int ks = 0; ks < 8; ++ks) { const bf16x8 bq = *(const LAS bf16x8*)(Bp + 16 * ks); af = MFMA32(*(const LAS bf16x8*)(Af + 16 * ks), bq, af); ab = MFMA32(*(const LAS bf16x8*)(Ab + 16 * ks), bq, ab); } }
            bf16* of = C.sts + ((size_t)(((b * NVC + vc) * 2 + 0) * 4 + h)) * 8192; bf16* ob = C.sts + ((size_t)(((b * NVC + vc) * 2 + 1) * 4 + h)) * 8192;
#pragma unroll
            for (int i = 0; i < 16; ++i) { const int p = pt * 32 + 8 * (i >> 2) + 4 * hi + (i & 3), n = nt * 32 + r32; of[p * 128 + n] = f2bf(af[i]); ob[p * 128 + n] = f2bf(ab[i]); }
        }
    }
}
DI void s1_ret_unit(LAS unsigned char* lds, int tid, const ScanCtx& C, int b, int vc, int h0, int nh) {
    asm volatile("" : "+v"(tid));
    const int lane = tid & 63, wave = tid >> 6, r32 = lane & 31, hi = lane >> 5;
    LAS float* wts = (LAS float*)(lds + L_STAT);
    LAS bf16* KT = (LAS bf16*)(lds + L_BUF); LAS bf16* VF = (LAS bf16*)(lds + L_BUF + 17408); LAS bf16* VB = (LAS bf16*)(lds + L_BUF + 2 * 17408);
    const int row0 = vc_row0(b, vc);
    float* decp = C.dec + (size_t)((b * NVC + vc) * 2) * 8;
    __syncthreads();
    { const int h = tid >> 7, s = tid & 127; const float lg0 = C.rlg[h], lg1 = C.rlg[4 + h];
      wts[h * 128 + s] = __expf((float)(127 - s) * lg0); wts[(4 + h) * 128 + s] = __expf((float)s * lg1);
      if (s == 0) { decp[4 + h] = __expf(128.f * lg0); decp[8 + 4 + h] = __expf(128.f * lg1); } }
    const bf16* Prow = C.P + (size_t)row0 * NIN;
#pragma unroll 1
    for (int h = h0; h < h0 + nh; ++h) {
        __syncthreads();
        stage_T<64, false>(KT, KT, Prow + 2816 + h * 64, NIN, nullptr, nullptr, tid);
        stage_T<64, true>(VF, VB, Prow + 3072 + h * 64, NIN, wts + h * 128, wts + (4 + h) * 128, tid);
        __syncthreads();
        const int dir = wave >> 2, pt = (wave >> 1) & 1, nt = wave & 1;
        const f32x16 a = mma_lds<8>(zero16(), (dir ? VB : VF) + pt * 32 * TP, TP, KT + nt * 32 * TP, TP, lane);
        bf16* o = C.str + ((size_t)(((b * NVC + vc) * 2 + dir) * 4 + h)) * 4096;
#pragma unroll
        for (int i = 0; i < 16; ++i) { const int p = pt * 32 + 8 * (i >> 2) + 4 * hi + (i & 3), n = nt * 32 + r32; o[p * 64 + n] = f2bf(a[i]); }
    }
}

DI int s2_order(int dir, int step) { return dir == 0 ? step : (step == 0 ? 1 : (step == 1 ? 0 : 35 - step)); }
DI void s2_item(const ScanCtx& C, int gt) {
    bf16* base; int hh, dir, b; size_t vcstride;
    if (gt < 65536) { const int v = gt & 1023, h = (gt >> 10) & 3; dir = (gt >> 12) & 1; b = gt >> 13; hh = h; base = C.sts + (size_t)((b * NVC * 2 + dir) * 4 + h) * 8192 + v * 8; vcstride = (size_t)2 * 4 * 8192; }
    else if (gt < 65536 + 32768) { const int g2 = gt - 65536; const int v = g2 & 511, h = (g2 >> 9) & 3; dir = (g2 >> 11) & 1; b = g2 >> 12; hh = 4 + h; base = C.str + (size_t)((b * NVC * 2 + dir) * 4 + h) * 4096 + v * 8; vcstride = (size_t)2 * 4 * 4096; }
    else return;
    float s[8]; float zf = 0.f; asm volatile("" : "+v"(zf));
#pragma unroll
    for (int i = 0; i < 8; ++i) s[i] = zf;
#define S2_LD(k, st_) { const int vc_ = s2_order(dir, (st_)); v##k = *(const u32x4*)(base + (size_t)vc_ * vcstride); d##k = C.dec[(size_t)((b * NVC + vc_) * 2 + dir) * 8 + hh]; }
#define S2_ST(k, st_) { const int vc_ = s2_order(dir, (st_)); u32x4 w_; w_.x = pk2(s[0], s[1]); w_.y = pk2(s[2], s[3]); w_.z = pk2(s[4], s[5]); w_.w = pk2(s[6], s[7]); \
        *(u32x4*)(base + (size_t)vc_ * vcstride) = w_; \
        s[0] = s[0] * d##k + bflo(v##k.x); s[1] = s[1] * d##k + bfhi(v##k.x); s[2] = s[2] * d##k + bflo(v##k.y); s[3] = s[3] * d##k + bfhi(v##k.y); \
        s[4] = s[4] * d##k + bflo(v##k.z); s[5] = s[5] * d##k + bfhi(v##k.z); s[6] = s[6] * d##k + bflo(v##k.w); s[7] = s[7] * d##k + bfhi(v##k.w); }
    u32x4 v0, v1, v2, v3, v4, v5, v6, v7; float d0, d1, d2, d3, d4, d5, d6, d7;
    S2_LD(0, 0) S2_LD(1, 1) S2_LD(2, 2) S2_LD(3, 3) S2_LD(4, 4) S2_LD(5, 5) S2_LD(6, 6) S2_LD(7, 7)
#pragma unroll 1
    for (int step = 0; step < 32; step += 8) {
        S2_ST(0, step) if (step + 8 < NVC) S2_LD(0, step + 8)
        S2_ST(1, step + 1) if (step + 9 < NVC) S2_LD(1, step + 9)
        S2_ST(2, step + 2) if (step + 10 < NVC) S2_LD(2, step + 10)
        S2_ST(3, step + 3) if (step + 11 < NVC) S2_LD(3, step + 11)
        S2_ST(4, step + 4) if (step + 12 < NVC) S2_LD(4, step + 12)
        S2_ST(5, step + 5) if (step + 13 < NVC) S2_LD(5, step + 13)
        S2_ST(6, step + 6) if (step + 14 < NVC) S2_LD(6, step + 14)
        S2_ST(7, step + 7) if (step + 15 < NVC) S2_LD(7, step + 15)
    }
    S2_ST(0, 32) S2_ST(1, 33)
#undef S2_LD
#undef S2_ST
}

DI void s2_phase(const ScanCtx& C, int tid, int bid, int G) {
#pragma unroll 1
    for (int gt = bid * NTHREADS + tid; gt < 65536 + 32768; gt += G * NTHREADS) s2_item(C, gt);
}

DI void s3_ssd_unit(LAS unsigned char* lds, int tid, const ScanCtx& C, int b, int vc) {
    asm volatile("" : "+v"(tid));
    const int lane = tid & 63, wave = tid >> 6, r32 = lane & 31, hi = lane >> 5;
    LAS float* sc = (LAS float*)lds; LAS float* stat = (LAS float*)(lds + L_STAT);
    LAS bf16* Cq = (LAS bf16*)(lds + L_BUF); LAS bf16* BkM = (LAS bf16*)(lds + L_BUF + 34816); LAS bf16* XsT = (LAS bf16*)(lds + L_BUF + 2 * 34816);
    LAS bf16* Hf = (LAS bf16*)(lds + L_BUF + 2 * 34816 + 17408); LAS bf16* Hb = (LAS bf16*)(lds + L_BUF + 2 * 34816 + 2 * 17408);
    const int row0 = vc_row0(b, vc);
    const int pt = wave & 1, tt = wave >> 1;
    const bf16* Urow = C.U + (size_t)row0 * UW;
    __syncthreads();
    ssd_scalars(sc, tid, C.DT, row0, C.alog, C.dtb, nullptr, nullptr);
    float ssq = 0.f;
    const int tq_ = tt * 32 + r32; const int rowq = row0 + tq_;
#pragma unroll 1
    for (int g = 0; g < 2; ++g) {
        __syncthreads();
        stage_N<128, 128>(Cq, TP, Urow + 512 + g * 128, UW, tid);
        stage_N<128, 128>(BkM, TP, Urow + 256 + g * 128, UW, tid);
        __syncthreads();
        f32x16 gacc0, gacc1;
        { const int id = 2 * wave, st = id & 3, tq = id >> 2; gacc0 = mma_lds<8>(zero16(), BkM + st * 32 * TP, TP, Cq + tq * 32 * TP, TP, lane); }
        { const int id = 2 * wave + 1, st = id & 3, tq = id >> 2; gacc1 = mma_lds<8>(zero16(), BkM + st * 32 * TP, TP, Cq + tq * 32 * TP, TP, lane); }
#pragma unroll 1
        for (int hh = 0; hh < 2; ++hh) {
            const int h = 2 * g + hh;
            __syncthreads();
            const int oct_ = tid & 7, tp_ = tid >> 3;
            const u32x4 xr0 = *(const u32x4*)(Urow + h * 64 + (size_t)(2 * tp_) * UW + oct_ * 8), xr1 = *(const u32x4*)(Urow + h * 64 + (size_t)(2 * tp_ + 1) * UW + oct_ * 8);
            const bf16* sfp = C.sts + ((size_t)(((b * NVC + vc) * 2 + 0) * 4 + h)) * 8192; const bf16* sbp = C.sts + ((size_t)(((b * NVC + vc) * 2 + 1) * 4 + h)) * 8192;
            u32x4 hfv[2], hbv[2];
#pragma unroll
            for (int i = 0; i < 2; ++i) { const int itn = tid + NTHREADS * i, octn = itn & 15, rn = itn >> 4; hfv[i] = *(const u32x4*)(sfp + rn * 128 + octn * 8); hbv[i] = *(const u32x4*)(sbp + rn * 128 + octn * 8); }
            u32x2 zz[4];
#pragma unroll
            for (int g4 = 0; g4 < 4; ++g4) zz[g4] = *(const u32x2*)(C.P + (size_t)rowq * NIN + 1536 + h * 64 + pt * 32 + 8 * g4 + 4 * hi);
            { const LAS float* acf = sc + (SC_ACF * 4 + h) * 128; const LAS float* acb = sc + (SC_ACB * 4 + h) * 128; const LAS float* d0 = sc + (SC_DT0 * 4 + h) * 128; const LAS float* d1 = sc + (SC_DT1 * 4 + h) * 128;
#pragma unroll
              for (int q = 0; q < 2; ++q) { const int id = 2 * wave + q, st = id & 3, tq = id >> 2; const int t = tq * 32 + r32; const float aft = acf[t], abt = acb[t];
#pragma unroll
                  for (int g4 = 0; g4 < 4; ++g4) { float mv[4];
#pragma unroll
                      for (int j = 0; j < 4; ++j) { const int s = st * 32 + 8 * g4 + 4 * hi + j;
                          float f; if (s < t) f = __expf(aft - acf[s]) * d0[s]; else if (s > t) f = __expf(abt - acb[s]) * d1[s]; else f = d0[s] + d1[s];
                          mv[j] = (q ? gacc1[4 * g4 + j] : gacc0[4 * g4 + j]) * f; }
                      u32x2 w; w.x = pk2(mv[0], mv[1]); w.y = pk2(mv[2], mv[3]);
                      *(LAS u32x2*)(BkM + t * TP + st * 32 + 8 * g4 + 4 * hi) = w; } } }
            { const unsigned a_[4] = {xr0.x, xr0.y, xr0.z, xr0.w}, b_[4] = {xr1.x, xr1.y, xr1.z, xr1.w};
#pragma unroll
              for (int k = 0; k < 4; ++k) {
                  *(LAS unsigned*)(XsT + (oct_ * 8 + 2 * k) * TP + 2 * tp_) = (a_[k] & 0xffffu) | (b_[k] << 16);
                  *(LAS unsigned*)(XsT + (oct_ * 8 + 2 * k + 1) * TP + 2 * tp_) = (a_[k] >> 16) | (b_[k] & 0xffff0000u); }
#pragma unroll
              for (int i = 0; i < 2; ++i) { const int itn = tid + NTHREADS * i, octn = itn & 15, rn = itn >> 4; *(LAS u32x4*)(Hf + rn * TP + octn * 8) = hfv[i]; *(LAS u32x4*)(Hb + rn * TP + octn * 8) = hbv[i]; } }
            __syncthreads();
            f32x16 y = mma_lds<8>(zero16(), XsT + pt * 32 * TP, TP, BkM + tt * 32 * TP, TP, lane);
            { const float dsum = C.ssmd[h] + C.ssmd[4 + h];
#pragma unroll
              for (int i = 0; i < 16; ++i) { const int p = pt * 32 + 8 * (i >> 2) + 4 * hi + (i & 3); y[i] += dsum * bf2f(XsT[p * TP + tq_]); } }
            __builtin_amdgcn_sched_barrier(0);
            { const f32x16 af = mma_lds<8>(zero16(), Hf + pt * 32 * TP, TP, Cq + tt * 32 * TP, TP, lane);
              const float ef = __expf(sc[(SC_ACF * 4 + h) * 128 + tq_]);
#pragma unroll
              for (int i = 0; i < 16; ++i) y[i] += ef * af[i]; }
            __builtin_amdgcn_sched_barrier(0);
            { const f32x16 ab = mma_lds<8>(zero16(), Hb + pt * 32 * TP, TP, Cq + tt * 32 * TP, TP, lane);
              const float eb = __expf(sc[(SC_ACB * 4 + h) * 128 + tq_]);
#pragma unroll
              for (int i = 0; i < 16; ++i) y[i] += eb * ab[i]; }
#pragma unroll
            for (int g4 = 0; g4 < 4; ++g4) {
                const int p = pt * 32 + 8 * g4 + 4 * hi;
                const float v0 = y[4 * g4] * silu_f(bflo(zz[g4].x)), v1 = y[4 * g4 + 1] * silu_f(bfhi(zz[g4].x)), v2 = y[4 * g4 + 2] * silu_f(bflo(zz[g4].y)), v3 = y[4 * g4 + 3] * silu_f(bfhi(zz[g4].y));
                ssq += v0 * v0 + v1 * v1 + v2 * v2 + v3 * v3;
                u32x2 w; w.x = pk2(v0, v1); w.y = pk2(v2, v3);
                *(u32x2*)(C.MG + (size_t)rowq * DM + 512 + h * 64 + p) = w;
            }
        }
    }
    ssq += __shfl_xor(ssq, 32);
    __syncthreads();
    if (hi == 0) stat[tq_ * 2 + pt] = ssq;
    __syncthreads();
    const float rn = 1.0f / sqrtf((stat[tq_ * 2] + stat[tq_ * 2 + 1]) * (1.0f / 256.0f) + 1e-6f);
#pragma unroll
    for (int h = 0; h < 4; ++h)
#pragma unroll
        for (int g4 = 0; g4 < 4; ++g4) {
            const int p = pt * 32 + 8 * g4 + 4 * hi;
            const f32x4 gv = *(const f32x4*)(C.ssmg + h * 64 + p);
            u32x2* mp = (u32x2*)(C.MG + (size_t)rowq * DM + 512 + h * 64 + p);
            const u32x2 v = *mp;
            u32x2 w; w.x = pk2(bflo(v.x) * rn * gv.x, bfhi(v.x) * rn * gv.y); w.y = pk2(bflo(v.y) * rn * gv.z, bfhi(v.y) * rn * gv.w);
            *mp = w;
        }
}
DI void s3_ret_unit(LAS unsigned char* lds, int tid, const ScanCtx& C, int b, int vc, int h0, int nh) {
    asm volatile("" : "+v"(tid));
    const int lane = tid & 63, wave = tid >> 6, r32 = lane & 31, hi = lane >> 5;
    LAS float* stat = (LAS float*)(lds + L_STAT);
    LAS bf16* Q = (LAS bf16*)(lds + L_BUF); LAS bf16* K = (LAS bf16*)(lds + L_BUF + 18432); LAS bf16* VT = (LAS bf16*)(lds + L_BUF + 2 * 18432);
    LAS bf16* Hf = (LAS bf16*)(lds + L_BUF + 2 * 18432 + 17408); LAS bf16* Hb = (LAS bf16*)(lds + L_BUF + 2 * 18432 + 17408 + 9216); LAS bf16* MB = (LAS bf16*)(lds + L_BUF + 2 * 18432 + 17408 + 2 * 9216);
    const int row0 = vc_row0(b, vc);
    const int pt = wave & 1, tt = wave >> 1;
    const bf16* Prow = C.P + (size_t)row0 * NIN;
    const int t = tt * 32 + r32; const int row = row0 + t;
#pragma unroll 1
    for (int h = h0; h < h0 + nh; ++h) {
        const float lg0 = C.rlg[h], lg1 = C.rlg[4 + h];
        __syncthreads();
        stage_N<128, 64>(Q, QP, Prow + 2560 + h * 64, NIN, tid);
        stage_N<128, 64>(K, QP, Prow + 2816 + h * 64, NIN, tid);
        stage_T<64, false>(VT, VT, Prow + 3072 + h * 64, NIN, nullptr, nullptr, tid);
        stage_N<64, 64>(Hf, QP, C.str + ((size_t)(((b * NVC + vc) * 2 + 0) * 4 + h)) * 4096, 64, tid);
        stage_N<64, 64>(Hb, QP, C.str + ((size_t)(((b * NVC + vc) * 2 + 1) * 4 + h)) * 4096, 64, tid);
        __syncthreads();
#pragma unroll
        for (int q = 0; q < 2; ++q) { const int id = 2 * wave + q, st = id & 3, tq = id >> 2;
            const f32x16 gacc = mma_lds<4>(zero16(), K + st * 32 * QP, QP, Q + tq * 32 * QP, QP, lane);
            const int t2 = tq * 32 + r32;
#pragma unroll
            for (int g4 = 0; g4 < 4; ++g4) { float mv[4];
#pragma unroll
                for (int j = 0; j < 4; ++j) { const int s = st * 32 + 8 * g4 + 4 * hi + j;
                    const float f = (s < t2) ? __expf((float)(t2 - s) * lg0) : ((s > t2) ? __expf((float)(s - t2) * lg1) : 2.0f);
                    mv[j] = gacc[4 * g4 + j] * f; }
                u32x2 w; w.x = pk2(mv[0], mv[1]); w.y = pk2(mv[2], mv[3]);
                *(LAS u32x2*)(MB + t2 * TP + st * 32 + 8 * g4 + 4 * hi) = w; } }
        __syncthreads();
        u32x2 ggv[4];
#pragma unroll
        for (int g4 = 0; g4 < 4; ++g4) ggv[g4] = *(const u32x2*)(C.P + (size_t)row * NIN + 3328 + h * 64 + pt * 32 + 8 * g4 + 4 * hi);
        f32x16 y = mma_lds<8>(zero16(), VT + pt * 32 * TP, TP, MB + tt * 32 * TP, TP, lane);
        { const f32x16 af = mma_lds<4>(zero16(), Hf + pt * 32 * QP, QP, Q + tt * 32 * QP, QP, lane);
          const float ef = __expf((float)(t + 1) * lg0);
#pragma unroll
          for (int i = 0; i < 16; ++i) y[i] += ef * af[i]; }
        { const f32x16 ab = mma_lds<4>(zero16(), Hb + pt * 32 * QP, QP, Q + tt * 32 * QP, QP, lane);
          const float eb = __expf((float)(128 - t) * lg1);
#pragma unroll
          for (int i = 0; i < 16; ++i) y[i] += eb * ab[i]; }
        float s1 = 0.f, s2 = 0.f;
#pragma unroll
        for (int i = 0; i < 16; ++i) { s1 += y[i]; s2 += y[i] * y[i]; }
        s1 += __shfl_xor(s1, 32); s2 += __shfl_xor(s2, 32);
        if (hi == 0) { stat[(t * 2 + pt) * 2] = s1; stat[(t * 2 + pt) * 2 + 1] = s2; }
        __syncthreads();
        const float t1 = stat[(t * 2) * 2] + stat[(t * 2 + 1) * 2], t2s = stat[(t * 2) * 2 + 1] + stat[(t * 2 + 1) * 2 + 1];
        const float mean = t1 * (1.0f / 64.0f), var = fmaxf(t2s * (1.0f / 64.0f) - mean * mean, 0.f), rs = 1.0f / sqrtf(var + 1e-5f);
#pragma unroll
        for (int g4 = 0; g4 < 4; ++g4) {
            const int p = pt * 32 + 8 * g4 + 4 * hi;
            const float g0 = silu_f(bflo(ggv[g4].x)), g1 = silu_f(bfhi(ggv[g4].x)), g2 = silu_f(bflo(ggv[g4].y)), g3 = silu_f(bfhi(ggv[g4].y));
            u32x2 w; w.x = pk2((y[4 * g4] - mean) * rs * g0, (y[4 * g4 + 1] - mean) * rs * g1); w.y = pk2((y[4 * g4 + 2] - mean) * rs * g2, (y[4 * g4 + 3] - mean) * rs * g3);
            *(u32x2*)(C.MG + (size_t)row * DM + 768 + h * 64 + p) = w;
        }
    }
}

constexpr int NPP = 13, NPH = 2 + NPP * DEPTH;
#ifndef PMASK
#define PMASK 0xffff
#endif
#define PEN(k) ((PMASK >> (k)) & 1)
#ifndef PROBE_LASTONLY
#define PROBE_LASTONLY 0
#endif
#ifndef PROBE_N
#define PROBE_N 1
#endif
#ifndef REP_SPLIT
#define REP_SPLIT 1
#endif
#ifndef REP_P0
#define REP_P0 1
#endif
#ifndef REP_LN
#define REP_LN 1
#endif
#ifndef REP_SYNC
#define REP_SYNC 1
#endif
#ifndef REP_ATTN
#define REP_ATTN 1
#endif
#ifndef REP_UP
#define REP_UP 1
#endif
#ifndef REP_IN
#define REP_IN 1
#endif
#ifndef REP_SCAN
#define REP_SCAN 1
#endif

#define GAS __attribute__((address_space(1)))
#define XB_TMO      128
#define XB_XCNT(j)  (256  + 64 * (j))
#define XB_XSUB(j)  (1280 + 64 * (j))
#define XB_XGEN(j)  (2304 + 64 * (j))
#define XB_TOP      3328
#define XB_TOPGEN   3392
#define XCD_BAR_WORDS 3456
#define XB_SPIN_CAP (1u << 18)

__device__ __forceinline__ unsigned xb_ld(unsigned* p)              { return __hip_atomic_load(p, __ATOMIC_RELAXED, __HIP_MEMORY_SCOPE_AGENT); }
__device__ __forceinline__ unsigned xb_add(unsigned* p, unsigned v) { return __hip_atomic_fetch_add(p, v, __ATOMIC_RELAXED, __HIP_MEMORY_SCOPE_AGENT); }
__device__ __forceinline__ unsigned xb_xcc_id() { return (unsigned)__builtin_amdgcn_s_getreg((3 << 11) | 20) & 0xFu; }
#define XB_SPIN(cond, bar) do { unsigned _sp = 0; while (cond) { __builtin_amdgcn_s_sleep(1); \
    if ((++_sp & 255u) == 0u) { if (xb_ld(&(bar)[XB_TMO])) break; if (_sp > XB_SPIN_CAP) { atomicAdd(&(bar)[XB_TMO], 1u); break; } } } } while (0)

struct XcdBarrier {
    unsigned* bar; unsigned x;
    volatile LAS unsigned* st;
};

__device__ __forceinline__ XcdBarrier xcd_barrier_post(unsigned* bar, volatile LAS unsigned* st) {
    XcdBarrier b; b.bar = bar; b.x = xb_xcc_id(); b.st = st;
    if (threadIdx.x == 0) (void)xb_add(&bar[XB_XCNT(b.x)], 1u);
    return b;
}
__device__ __forceinline__ void xcd_barrier_complete(unsigned* bar, unsigned x, unsigned& nloc, unsigned& nx) {
    const unsigned G = gridDim.x * gridDim.y * gridDim.z;
    unsigned sum, cnt, mine, sp = 0u;
    for (;;) {
        sum = 0u; cnt = 0u; mine = 0u;
#pragma unroll
        for (unsigned j = 0; j < 16; ++j) { const unsigned c = xb_ld(&bar[XB_XCNT(j)]); sum += c; cnt += (c > 0u) ? 1u : 0u; mine = (j == x) ? c : mine; }
        if (sum == G) break;
        __builtin_amdgcn_s_sleep(1);
        if ((++sp & 255u) == 0u) { if (xb_ld(&bar[XB_TMO])) break; if (sp > XB_SPIN_CAP) { atomicAdd(&bar[XB_TMO], 1u); break; } }
    }
    nloc = mine > 0u ? mine : 1u; nx = cnt > 0u ? cnt : 1u;
}

__device__ __forceinline__ void xcd_barrier(const XcdBarrier& b) {
    asm volatile("s_waitcnt vmcnt(0)" ::: "memory");
    __syncthreads();
    if (threadIdx.x == 0) {
        unsigned* bar = b.bar;
        __builtin_amdgcn_s_waitcnt(0);
        unsigned nloc = b.st[0], nx = b.st[1];
        if (nloc == 0u) { xcd_barrier_complete(bar, b.x, nloc, nx); b.st[0] = nloc; b.st[1] = nx; }
        const unsigned old = xb_add(&bar[XB_XSUB(b.x)], 1u);
        const unsigned gen = old / nloc;
        if (old + 1u == (gen + 1u) * nloc) {
            __builtin_amdgcn_fence(__ATOMIC_RELEASE, "agent");
            asm volatile("s_waitcnt vmcnt(0)" ::: "memory");
            const unsigned og = xb_add(&bar[XB_TOP], 1u);
            const unsigned tg = og / nx;
            if (og + 1u == (tg + 1u) * nx) xb_add(&bar[XB_TOPGEN], 1u);
            else XB_SPIN(xb_ld(&bar[XB_TOPGEN]) == tg, bar);
            __builtin_amdgcn_fence(__ATOMIC_ACQUIRE, "agent");
            xb_add(&bar[XB_XGEN(b.x)], 1u);
            asm volatile("s_waitcnt vmcnt(0)" ::: "memory");
        } else {
            XB_SPIN(xb_ld(&bar[XB_XGEN(b.x)]) == gen, bar);
            __builtin_amdgcn_fence(__ATOMIC_ACQUIRE, "agent");
            asm volatile("s_waitcnt vmcnt(0)" ::: "memory");
        }
    }
    __syncthreads();
}
template <class Epi> DI void run_gemm(LAS unsigned char* lds, int tid, const bf16* Ap, const bf16* Bt, int M, int N, int K, int G, int bid, const Epi& E, int ld = 0) {
    pg8::Gemm g{Ap, Bt, M, N, K, ld ? ld : K}; pg8::StaticOrder S; S.init(M, N, G, bid);
    pg8::gemm_phase<Epi, pg8::StaticOrder, true, true>(lds, g, S, E, tid);
}

__global__ void __launch_bounds__(NTHREADS, 2) mega(Args A) {
    extern __shared__ __attribute__((aligned(16))) unsigned char lds_raw[];
    LAS unsigned char* lds = (LAS unsigned char*)lds_raw;
    cg::grid_group grid = cg::this_grid();
    const int tid0 = threadIdx.x, bid0 = blockIdx.x, G0 = gridDim.x;
    { volatile LAS unsigned* bst0 = (volatile LAS unsigned*)(lds + LDS_BYTES - 64); if (tid0 < 16) bst0[tid0] = 0u;
      if (bid0 == 0) { unsigned* bw = (unsigned*)(A.ws + WS_BAR); for (int i = tid0; i < XCD_BAR_WORDS; i += NTHREADS) bw[i] = 0u; } }
    __syncthreads();
    int rep_done = 0; (void)rep_done;
    for (int ph = A.ph_lo; ph < A.ph_hi; ++ph) {
        if (ph > A.ph_lo) {
            if (ph == A.ph_lo + 1) { grid.sync(); (void)xcd_barrier_post((unsigned*)(A.ws + WS_BAR), (volatile LAS unsigned*)(lds + LDS_BYTES - 64)); }
            else { for (int rs_ = 0; rs_ < REP_SYNC; ++rs_) { XcdBarrier xb_; xb_.bar = (unsigned*)(A.ws + WS_BAR); xb_.x = xb_xcc_id(); xb_.st = (volatile LAS unsigned*)(lds + LDS_BYTES - 64); xcd_barrier(xb_); } }
        }
        int tid = tid0, bid = bid0, G = G0; size_t zoff = 0;
        asm volatile("" : "+v"(tid)); asm volatile("" : "+s"(bid)); asm volatile("" : "+s"(G)); asm volatile("" : "+s"(zoff));
        unsigned char* ws = A.ws + zoff;
        float* xc = (float*)(ws + WS_XC);
        bf16* Abuf = (bf16*)(ws + WS_A); bf16* HP = (bf16*)(ws + WS_HP); bf16* Vt = (bf16*)(ws + WS_VT);
        const float* MOD = (const float*)(ws + WS_MOD);
        if (ph == 0) { if (PEN(0)) for (int rp_ = 0; rp_ < REP_P0; ++rp_) { p0a_phase(A, lds, tid, bid, G); __syncthreads(); } continue; }
        if (ph == 1) { if (PEN(1)) for (int rp_ = 0; rp_ < REP_LN; ++rp_) lnmod_phase(A, lds, tid, bid, G, true, -1, 0, 0, 0, false, M_ALL, false, nullptr, nullptr); continue; }
        const int q = ph - 2, l = q / NPP; int s = q % NPP; const bool is_conv = (s == 4); if (s >= 4) s -= 1; if (is_conv) s = 100;
        const bool last = (l == DEPTH - 1);
        const int Mpost = last ? M_LAT : M_ALL;
        if ((s == 0 || s == 9) && PEN(2)) {
            const int f = (s == 9); EpiSwiglu E{HP};
            for (int rp_ = 0; rp_ < REP_UP; ++rp_) run_gemm(lds, tid, Abuf, (const bf16*)(ws + WS_WGU) + (size_t)f * NGU * DM, f ? Mpost : M_ALL, NGU, DM, G, bid, E);
        } else if ((s == 1 || s == 10 || s == 7) && PEN(3)) {
            const int i = (s == 1) ? 0 : (s == 7 ? 1 : 2);
            const int prev_idx = (i == 0) ? (l == 0 ? -1 : (l - 1) * 3 + 2) : l * 3 + (i - 1);
            const float* modg_p = MOD + (size_t)l * 9 * 9216 + i * 3072 + 2048;
            const float* scale_v = (s == 7) ? (const float*)(ws + WS_ONES) : (const float*)(ws + WS_HALVES);
            const float* gprev_p = prev_idx < 0 ? (const float*)(ws + WS_ONES) : A.in[I_NG] + prev_idx * DM; const float* bprev_p = prev_idx < 0 ? (const float*)(ws + WS_ZEROS) : A.in[I_NB] + prev_idx * DM;
            EpiResid E{(bf16*)(ws + WS_X16), modg_p, scale_v, (const f32x2*)(ws + WS_STAT), gprev_p, bprev_p};
            const bool has_ctx = (s == 1) || !last;
            const bf16* Ap = (s == 7) ? Abuf : HP; const bf16* Bp = (s == 7) ? (const bf16*)(ws + WS_WOUT) : (const bf16*)(ws + WS_WDN) + (size_t)(s == 10) * DM * DFF;
            const int Kd = (s == 7) ? DM : DFF;
            const int ldd = (s == 7) ? DM : DFF;
            run_gemm(lds, tid, Ap, Bp, M_LAT, DM, Kd, G, bid, E, ldd);
            if (has_ctx) {
                const int sb = (G == 256 && ((bid >> 3) & 7) < 4 && bid < 256) ? ((bid & 7) | (((bid >> 3) & 3) << 3) | ((bid >> 6) << 5)) : (G == 256 ? 999 : (bid + G - 64) % G);
                const int qd = (sb >> 5) & 3;
                const int kt0 = (s == 7) ? 4 * qd : (qd < 2 ? 12 * qd : 24 + 10 * (qd - 2));
                const int ktn = (s == 7) ? 4 : (qd < 2 ? 12 : 10);
                OneUnit S1u; S1u.have = sb < 128; S1u.u.pm = 128 + (sb & 7); S1u.u.pn = (sb >> 3) & 3;
                EpiPartial Ep{(float*)(ws + WS_T) + (size_t)qd * M_CTX * DM, modg_p, scale_v};
                pg8::Gemm g2{Ap + (size_t)kt0 * 64, Bp + (size_t)kt0 * 64, M_ALL, DM, ktn * 64, ldd};
                pg8::gemm_phase<EpiPartial, OneUnit, true, true>(lds, g2, S1u, Ep, tid);
            }
        } else if (s == 2 && PEN(1)) {
            lnmod_phase(A, lds, tid, bid, G, false, l, 0, l, 1, true, M_ALL, true, l == 0 ? (const float*)(ws + WS_ONES) : A.in[I_NG] + ((l - 1) * 3 + 2) * DM, l == 0 ? (const float*)(ws + WS_ZEROS) : A.in[I_NB] + ((l - 1) * 3 + 2) * DM);
        } else if (s == 3 && PEN(4)) {
            EpiIn E{HP, Vt, (const f32x2*)(ws + WS_TATT), (const f32x2*)(ws + WS_TRET)};
            for (int rp_ = 0; rp_ < REP_IN; ++rp_) run_gemm(lds, tid, Abuf, (const bf16*)(ws + WS_WIN), M_ALL, NIN, DM, G, bid, E);
        } else if (is_conv || s == 4 || s == 5 || s == 6) {
            ScanCtx C{HP, (const bf16*)(ws + WS_U), (const float*)(ws + WS_DT), (bf16*)(ws + WS_STS), (bf16*)(ws + WS_STR), (float*)(ws + WS_DEC), Abuf,
                      A.in[I_CONVW] + (size_t)l * 5 * 768, A.in[I_CONVB] + l * 768, A.in[I_ALOG] + l * 8, A.in[I_DTB] + l * 8, A.in[I_SSMD] + l * 8, A.in[I_SSMG] + l * 256, A.in[I_RLG] + l * 8};
            const float lam = ((const float*)(ws + WS_LAM))[l];
            const float lam_init = 0.8f - 0.6f * expf(-0.3f * (float)l);
            const float* subg = A.in[I_SUBG] + l * 128;
            const int r = is_conv ? 0 : s - 3;
            if (PEN(7)) for (int rp_ = 0; rp_ < REP_ATTN; ++rp_) for (int u = bid; u < 256; u += G) { const int bh = r * 8 + (u & 7), qb = u >> 3;
                attn_unit(lds, tid, HP, Vt, Abuf, bh >> 2, bh & 3, (bh >> 2) * SEQ + qb * 128, 0, 68, lam, 1.0f - lam_init, subg); }
            if (is_conv) {
                if (PEN(10)) conv_phase(HP, (bf16*)(ws + WS_U), C.cw, C.cb, tid, bid, G);
            } else if (s == 4) {
                { const int nS1 = NB * NVC, extra1 = (nS1 > G && nS1 < 2 * G) ? nS1 - G : 0;
                  if (PEN(5)) { for (int u = bid; u < nS1; u += G) s1_ssd_unit(lds, tid, C, u / NVC, u % NVC);
                      if (bid >= extra1) for (int r = bid - extra1; r < 4 * nS1; r += G - extra1) { const int v = r >> 2; s1_ret_unit(lds, tid, C, v / NVC, v % NVC, r & 3, 1); } } }
            } else if (s == 5) {
                if (PEN(6)) s2_phase(C, tid, bid, G);
            } else {
                const int vc0 = last ? 2 : 0, nvc = NVC - vc0;
                const int nS = NB * nvc, extra = (nS > G && nS < 2 * G) ? nS - G : 0;
                if (PEN(8)) for (int u = bid; u < nS; u += G) s3_ssd_unit(lds, tid, C, u / nvc, vc0 + u % nvc);
                if (PEN(9) && bid >= extra) for (int r = bid - extra; r < 4 * nS; r += G - extra) { const int v = r >> 2; s3_ret_unit(lds, tid, C, v / nvc, vc0 + v % nvc, r & 3, 1); }
                if (!last && PEN(7)) for (int u = (bid + G - 64) % G; u < 64; u += G) { const int bh = u >> 1; attn_unit(lds, tid, HP, Vt, Abuf, bh >> 2, bh & 3, M_LAT + (bh >> 2) * CTXL + (u & 1) * 128, 64, 68, lam, 1.0f - lam_init, subg); }
            }
        } else if (s == 8 && PEN(1)) {
            lnmod_phase(A, lds, tid, bid, G, false, l, 1, l, 2, false, Mpost, !last, A.in[I_NG] + (l * 3) * DM, A.in[I_NB] + (l * 3) * DM);
        } else if (s == 11 && PEN(1)) {
            lnmod_phase(A, lds, tid, bid, G, false, l, 2, last ? -1 : l + 1, 0, false, Mpost, !last, A.in[I_NG] + (l * 3 + 1) * DM, A.in[I_NB] + (l * 3 + 1) * DM);
            if (!last) convw_phase(A, l + 1, lds, tid, bid, G);
        }
#ifdef PROBE_S
        if ((s == (PROBE_S) || s == (PROBE_S2)) && (PROBE_LASTONLY == 0 || last) && rep_done < PROBE_N) { ++rep_done; --ph; } else rep_done = 0;
#endif
    }
}

extern "C" void kernel_launch(void* const* d_in, const int* in_sizes, int n_in, void* d_out, int out_size, void* d_ws, size_t ws_size, hipStream_t stream) {
    static int grid = 0;
    if (grid == 0) {
        if (n_in != 22 || in_sizes[0] != M_LAT * DM || out_size != M_LAT * DM || ws_size < WS_END) { fprintf(stderr, "kernel_launch: unexpected shapes (n_in %d, out %d, ws %zu)\n", n_in, out_size, ws_size); grid = -1; return; }
        int dev = 0, cus = 0, per_cu = 0;
        hipGetDevice(&dev); hipDeviceGetAttribute(&cus, hipDeviceAttributeMultiprocessorCount, dev);
        if (hipFuncSetAttribute((const void*)mega, hipFuncAttributeMaxDynamicSharedMemorySize, LDS_BYTES) != hipSuccess) { fprintf(stderr, "kernel_launch: hipFuncSetAttribute failed\n"); grid = -1; return; }
        if (hipOccupancyMaxActiveBlocksPerMultiprocessor(&per_cu, (const void*)mega, NTHREADS, LDS_BYTES) != hipSuccess || per_cu < 1) { fprintf(stderr, "kernel_launch: occupancy query says %d\n", per_cu); per_cu = 1; }
        (void)hipGetLastError();
        grid = cus * 1;
    }
    if (grid < 0) return;
    Args a{};
    for (int i = 0; i < 22; ++i) a.in[i] = (const float*)d_in[i];
    a.out = (float*)d_out; a.ws = (unsigned char*)d_ws;
    for (int i = 0; i < 16; ++i) a.afreq[i] = 1.0f / powf(10000.0f, (float)(2 * i) / 32.0f);
    for (int i = 0; i < 32; ++i) a.rfreq[i] = 1.0f / powf(10000.0f, (float)i / 31.0f);
#ifdef MK_MULTI
    for (int ph = 0; ph < NPH; ++ph) { a.ph_lo = ph; a.ph_hi = ph + 1; hipLaunchKernelGGL(mega, dim3(grid), dim3(NTHREADS), LDS_BYTES, stream, a); }
#else
    a.ph_lo = 0; a.ph_hi = NPH;
    void* args[] = {&a};
    hipError_t e = hipLaunchCooperativeKernel((const void*)mega, dim3(grid), dim3(NTHREADS), args, LDS_BYTES, stream);
    if (e != hipSuccess) fprintf(stderr, "cooperative launch failed: %s (grid %d)\n", hipGetErrorString(e), grid);
#endif
}
```

```cpp
#include <hip/hip_runtime.h>
#include <hip/hip_cooperative_groups.h>
#include <cstdio>
#include <cstdint>
#include <cmath>
namespace cg = cooperative_groups;

namespace pg8 {
#define PG8_LAS __attribute__((address_space(3)))
typedef unsigned short bf16_t;
typedef short bf16x8 __attribute__((ext_vector_type(8)));
typedef float f32x4 __attribute__((ext_vector_type(4)));
typedef unsigned u32x4 __attribute__((ext_vector_type(4)));
constexpr int BM = 256, BK = 64, HALF = 128, HTB = HALF * BK * 2  , STAGE_BYTES = 8 * HTB, NXCD = 8, WGM = 8;

__host__ __device__ __forceinline__ int lds_byte(int r, int c) { const int st = (r >> 4) * 2 + (c >> 5), rr = r & 15, cc = c & 31, ob = rr * 64 + cc * 2; return st * 1024 + (ob ^ (((ob >> 9) & 1) << 5)); }
__host__ __device__ __forceinline__ void stage_rc(int b, int& R, int& C) { const int st = b / 1024, sb = b % 1024, swz = sb ^ (((sb >> 9) & 1) << 5); R = (st >> 1) * 16 + swz / 64; C = (st & 1) * 32 + (swz % 64) / 2; }
__host__ __device__ __forceinline__ int perm32(int rho) { const int n = rho >> 4, i = rho & 15; return 8 * (i >> 2) + 4 * n + (i & 3); }

struct Unit { int pm, pn; };
struct Gemm { const bf16_t* A; const bf16_t* Bt; int M, N, K, ld; };

struct StaticOrder {
    int nM, nN, nwg, G, c;
    __host__ __device__ void init(int M, int N, int G_, int c_) { nM = M / BM; nN = N / BM; nwg = nM * nN; G = G_; c = c_; }
    __host__ __device__ bool next(int i, Unit& u) const {
        const long L = (long)i * G + c; if (L >= nwg) return false;
        int wgid = (int)L; { const int q = nwg / NXCD, r = nwg % NXCD, xcd = wgid % NXCD, off = wgid / NXCD; wgid = (xcd < r ? xcd * (q + 1) : r * (q + 1) + (xcd - r) * q) + off; }
        const int nig = WGM * nN, gid = wgid / nig, fm = gid * WGM, gsz = (nM - fm) < WGM ? (nM - fm) : WGM;
        u.pm = fm + ((wgid % nig) % gsz); u.pn = (wgid % nig) / gsz; return true;
    }
    __device__ __forceinline__ void a_ready(const Unit&) const {}
    __device__ __forceinline__ void done(const Unit&) const {}
};

__device__ __forceinline__ unsigned cvt_pk_bf16(float lo, float hi) { unsigned r; asm volatile("v_cvt_pk_bf16_f32 %0, %1, %2" : "=v"(r) : "v"(lo), "v"(hi)); return r; }
template <class Epi, class Sched, bool ALIGN_EPI = false, bool SP2 = false>
__device__ __forceinline__ void gemm_phase(PG8_LAS unsigned char* lds, const Gemm g, const Sched& S, const Epi& E, const int tid) {
    const int wid = __builtin_amdgcn_readfirstlane(tid >> 6), lane = tid & 63, wr = wid >> 2, wc = wid & 3, fr = lane & 15, fq = lane >> 4;
    const int K = g.K, nt = K / BK;
    unsigned voffA[2], voffB[2];
#pragma unroll
    for (int i = 0; i < 2; ++i) { int R, C; stage_rc(tid * 16 + i * 8192, R, C); const int Rb = Epi::PERM ? ((R & ~31) + perm32(R & 31)) : R;
        voffA[i] = (unsigned)(R * g.ld + C) * 2u; voffB[i] = (unsigned)(Rb * g.ld + C) * 2u; }
    const size_t kstep = (size_t)(BK * 2);
    const size_t hstep = (size_t)HALF * g.ld * 2;
    const size_t tstep = 2 * hstep;
    const unsigned ldsw = (unsigned)wid * 1024u;
    const int aoff = lds_byte(wr * 64 + fr, fq * 8), boff = lds_byte(wc * 32 + fr, fq * 8);
#define PG8_SA(b, h) (((b) * 2 + (h)) * HTB)
#define PG8_SB(b, h) ((4 + (b) * 2 + (h)) * HTB)
#define PG8_STAGE(bufoff, gbase, voff) do { _Pragma("unroll") for (int _i = 0; _i < 2; ++_i) \
        __builtin_amdgcn_global_load_lds((const unsigned*)((const char*)(gbase) + (voff)[_i]), (PG8_LAS unsigned*)(lds + (bufoff) + ldsw + _i * 8192), 16, 0, 0); } while (0)
#define PG8_LDA(dst, b, h) do { _Pragma("unroll") for (int m = 0; m < 4; ++m) _Pragma("unroll") for (int k = 0; k < 2; ++k) dst[m][k] = *(const PG8_LAS bf16x8*)(lds + PG8_SA(b, h) + aoff + m * 2048 + k * 1024); } while (0)
#define PG8_LDB(dst, b, h) do { _Pragma("unroll") for (int n = 0; n < 2; ++n) _Pragma("unroll") for (int k = 0; k < 2; ++k) dst[n][k] = *(const PG8_LAS bf16x8*)(lds + PG8_SB(b, h) + boff + n * 2048 + k * 1024); } while (0)
#define PG8_MMA(ai, bj, At, Bt) do { __builtin_amdgcn_s_setprio(1); _Pragma("unroll") for (int m = 0; m < 4; ++m) _Pragma("unroll") for (int n = 0; n < 2; ++n) _Pragma("unroll") for (int k = 0; k < 2; ++k) \
        acc[ai][bj][m][n] = __builtin_amdgcn_mfma_f32_16x16x32_bf16(Bt[n][k], At[m][k], acc[ai][bj][m][n], 0, 0, 0); __builtin_amdgcn_s_setprio(0); } while (0)
#define PG8_WAIT_V(n) asm volatile("s_waitcnt vmcnt(" #n ")" ::: "memory")
#define PG8_WAIT_L(n) asm volatile("s_waitcnt lgkmcnt(" #n ")" ::: "memory")
#define PG8_BAR __builtin_amdgcn_s_barrier()
#define PG8_SCHED __builtin_amdgcn_sched_barrier(0)
    Unit cur, nxt; int ui = 0;
    if (!S.next(0, cur)) return;
    f32x4 acc[2][2][4][2];
#pragma unroll
    for (int a = 0; a < 2; ++a)
#pragma unroll
        for (int b = 0; b < 2; ++b)
#pragma unroll
            for (int m = 0; m < 4; ++m)
#pragma unroll
                for (int n = 0; n < 2; ++n) acc[a][b][m][n] = (f32x4){0.f, 0.f, 0.f, 0.f};
    bf16x8 At[4][2], B0[2][2], B1[2][2];
    const char* cA = (const char*)g.A + (size_t)cur.pm * tstep; const char* cB = (const char*)g.Bt + (size_t)cur.pn * tstep;
    S.a_ready(cur);
    if constexpr (SP2) {
        PG8_STAGE(PG8_SB(0, 0), cB, voffB); PG8_STAGE(PG8_SB(0, 1), cB + hstep, voffB); PG8_STAGE(PG8_SA(0, 0), cA, voffA); PG8_STAGE(PG8_SA(0, 1), cA + hstep, voffA);
        if (wr == 1) PG8_BAR;
        PG8_WAIT_V(2); PG8_BAR;
        PG8_STAGE(PG8_SB(1, 0), cB + kstep, voffB); PG8_STAGE(PG8_SA(1, 0), cA + kstep, voffA); PG8_STAGE(PG8_SB(1, 1), cB + hstep + kstep, voffB);
        PG8_WAIT_V(6); PG8_BAR;
    } else {
        PG8_STAGE(PG8_SB(0, 0), cB, voffB); PG8_STAGE(PG8_SA(0, 0), cA, voffA); PG8_STAGE(PG8_SB(0, 1), cB + hstep, voffB); PG8_STAGE(PG8_SA(0, 1), cA + hstep, voffA);
        if (wr == 1) PG8_BAR;
        PG8_WAIT_V(4); PG8_BAR;
        PG8_STAGE(PG8_SB(1, 0), cB + kstep, voffB); PG8_STAGE(PG8_SA(1, 0), cA + kstep, voffA); PG8_STAGE(PG8_SB(1, 1), cB + hstep + kstep, voffB);
        PG8_WAIT_V(6); PG8_BAR;
    }
    for (;;) {
        const bool has_next = S.next(ui + 1, nxt);
        const char* nA = has_next ? (const char*)g.A + (size_t)nxt.pm * tstep : cA; const char* nB = has_next ? (const char*)g.Bt + (size_t)nxt.pn * tstep : cB;
        for (int t = 0; t < nt; t += 2) {
            const bool last = (t == nt - 2);
            const char* a1 = cA + (size_t)(t + 1) * kstep;
            const char* a2 = last ? nA : cA + (size_t)(t + 2) * kstep; const char* b2 = last ? nB : cB + (size_t)(t + 2) * kstep;
            const char* a3 = a2 + kstep; const char* b3 = b2 + kstep;
            if (last && has_next) S.a_ready(nxt);
            if constexpr (SP2) {
            PG8_LDB(B0, 0, 0); PG8_LDB(B1, 0, 1); PG8_SCHED; PG8_LDA(At, 0, 0); PG8_STAGE(PG8_SA(1, 1), a1 + hstep, voffA);
            PG8_WAIT_V(8); PG8_WAIT_L(0); PG8_BAR; PG8_MMA(0, 0, At, B0); PG8_MMA(0, 1, At, B1); PG8_BAR; PG8_SCHED;
            PG8_LDA(At, 0, 1); PG8_STAGE(PG8_SB(0, 0), b2, voffB); PG8_STAGE(PG8_SB(0, 1), b2 + hstep, voffB); PG8_STAGE(PG8_SA(0, 0), a2, voffA);
            PG8_WAIT_V(8); PG8_WAIT_L(0); PG8_BAR; PG8_MMA(1, 0, At, B0); PG8_MMA(1, 1, At, B1); PG8_BAR; PG8_SCHED;
            PG8_LDB(B0, 1, 0); PG8_LDB(B1, 1, 1); PG8_SCHED; PG8_LDA(At, 1, 0); PG8_STAGE(PG8_SA(0, 1), a2 + hstep, voffA);
            PG8_WAIT_V(8); PG8_WAIT_L(0); PG8_BAR; PG8_MMA(0, 0, At, B0); PG8_MMA(0, 1, At, B1); PG8_BAR; PG8_SCHED;
            PG8_LDA(At, 1, 1); PG8_STAGE(PG8_SB(1, 0), b3, voffB); PG8_STAGE(PG8_SB(1, 1), b3 + hstep, voffB); PG8_STAGE(PG8_SA(1, 0), a3, voffA);
            PG8_WAIT_V(8); PG8_WAIT_L(0); PG8_BAR; PG8_MMA(1, 0, At, B0); PG8_MMA(1, 1, At, B1); PG8_BAR; PG8_SCHED;
            } else {
            PG8_LDB(B0, 0, 0); PG8_SCHED; PG8_LDA(At, 0, 0); PG8_STAGE(PG8_SA(1, 1), a1 + hstep, voffA);
            PG8_WAIT_L(8); PG8_BAR; PG8_WAIT_L(0); PG8_MMA(0, 0, At, B0); PG8_BAR; PG8_SCHED;
            PG8_LDB(B1, 0, 1); PG8_STAGE(PG8_SB(0, 0), b2, voffB);
            PG8_BAR; PG8_WAIT_L(0); PG8_MMA(0, 1, At, B1); PG8_BAR;
            PG8_LDA(At, 0, 1); PG8_STAGE(PG8_SA(0, 0), a2, voffA);
            PG8_BAR; PG8_WAIT_L(0); PG8_MMA(1, 0, At, B0); PG8_BAR; PG8_SCHED;
            PG8_STAGE(PG8_SB(0, 1), b2 + hstep, voffB);
            PG8_WAIT_V(6); PG8_BAR; PG8_MMA(1, 1, At, B1); PG8_BAR;
            PG8_LDB(B0, 1, 0); PG8_SCHED; PG8_LDA(At, 1, 0); PG8_STAGE(PG8_SA(0, 1), a2 + hstep, voffA);
            PG8_WAIT_L(8); PG8_BAR; PG8_WAIT_L(0); PG8_MMA(0, 0, At, B0); PG8_BAR; PG8_SCHED;
            PG8_LDB(B1, 1, 1); PG8_STAGE(PG8_SB(1, 0), b3, voffB);
            PG8_BAR; PG8_WAIT_L(0); PG8_MMA(0, 1, At, B1); PG8_BAR;
            PG8_LDA(At, 1, 1); PG8_STAGE(PG8_SA(1, 0), a3, voffA);
            PG8_BAR; PG8_WAIT_L(0); PG8_MMA(1, 0, At, B0); PG8_BAR; PG8_SCHED;
            PG8_STAGE(PG8_SB(1, 1), b3 + hstep, voffB);
            PG8_WAIT_V(6); PG8_BAR; PG8_MMA(1, 1, At, B1); PG8_BAR;
            }
        }
        if constexpr (ALIGN_EPI) { if (wr == 0) PG8_BAR; }
        if constexpr (!Epi::AFTER_DRAIN) { E(acc, cur, wr, wc, fr, fq); S.done(cur); }
        if (!has_next) break;
#pragma unroll
        for (int a = 0; a < 2; ++a)
#pragma unroll
            for (int b = 0; b < 2; ++b)
#pragma unroll
                for (int m = 0; m < 4; ++m)
#pragma unroll
                    for (int n = 0; n < 2; ++n) acc[a][b][m][n] = (f32x4){0.f, 0.f, 0.f, 0.f};
        cur = nxt; cA = nA; cB = nB; ++ui;
        if constexpr (ALIGN_EPI) { if (wr == 1) PG8_BAR; }
    }
    PG8_WAIT_V(0);
    if constexpr (!ALIGN_EPI) { if (wr == 0) PG8_BAR; }
    PG8_BAR;
    if constexpr (Epi::AFTER_DRAIN) { E.fused(acc, cur, wr, wc, fr, fq, lds, wid, lane); S.done(cur); }
#undef PG8_SA
#undef PG8_SB
#undef PG8_STAGE
#undef PG8_LDA
#undef PG8_LDB
#undef PG8_MMA
#undef PG8_WAIT_V
#undef PG8_WAIT_L
#undef PG8_BAR
#undef PG8_SCHED
}
}

#define DI __device__ __forceinline__
#define LAS __attribute__((address_space(3)))
typedef unsigned short bf16;
typedef short bf16x8 __attribute__((ext_vector_type(8)));
typedef float f32x4 __attribute__((ext_vector_type(4)));
typedef float f32x2 __attribute__((ext_vector_type(2)));
typedef float f32x16 __attribute__((ext_vector_type(16)));
typedef unsigned u32x4 __attribute__((ext_vector_type(4)));
typedef unsigned u32x2 __attribute__((ext_vector_type(2)));
typedef __bf16 bf16x2_t __attribute__((ext_vector_type(2)));

DI unsigned pk2(float lo, float hi) { f32x2 v = {lo, hi}; bf16x2_t b = __builtin_convertvector(v, bf16x2_t); return __builtin_bit_cast(unsigned, b); }
DI bf16 f2bf(float f) { return (bf16)(pk2(f, 0.f) & 0xffffu); }
DI float bf2f(bf16 v) { return __builtin_bit_cast(float, (unsigned)v << 16); }
DI float bflo(unsigned u) { return __builtin_bit_cast(float, u << 16); }
DI float bfhi(unsigned u) { return __builtin_bit_cast(float, u & 0xffff0000u); }
typedef _Float16 f16x2_t __attribute__((ext_vector_type(2)));
typedef __fp16 fp16x2_t __attribute__((ext_vector_type(2)));
DI unsigned pkh2(float lo, float hi) { return __builtin_bit_cast(unsigned, __builtin_amdgcn_cvt_pkrtz(lo, hi)); }
DI float hlo(unsigned u) { return (float)__builtin_bit_cast(f16x2_t, u).x; }
DI float hhi(unsigned u) { return (float)__builtin_bit_cast(f16x2_t, u).y; }
DI float silu_f(float x) { return x * __builtin_amdgcn_rcpf(1.f + __expf(-x)); }
DI float ex2(float x) { return __builtin_amdgcn_exp2f(x); }
#define MFMA32(a, b, c) __builtin_amdgcn_mfma_f32_32x32x16_bf16((a), (b), (c), 0, 0, 0)

constexpr int DM = 1024, NB = 8, SEQ = 4096, CTXL = 256, DEPTH = 4;
constexpr int M_LAT = NB * SEQ, M_CTX = NB * CTXL, M_ALL = M_LAT + M_CTX;
constexpr int DFF = 2816, NGU = 2 * DFF, NIN = 3584, INC = 3588, NKEY = SEQ + CTXL, NVC = 34;
constexpr int XBC0 = 1792;
constexpr float ALPHA = 1.6817928305074290f;
constexpr float QSCALE = 0.125f * 1.4426950408889634f;
constexpr size_t MiB = 1u << 20;
constexpr size_t WS_MOD = 0, WS_TATT = 2 * MiB, WS_LAM = 2 * MiB + 65536, WS_BAR = 2 * MiB + 131072, WS_STAT = 2 * MiB + 262144, WS_ONES = 2 * MiB + 655360, WS_ZEROS = 2 * MiB + 655360 + 4096, WS_HALVES = 2 * MiB + 655360 + 8192, WS_TRET = 3 * MiB, WS_DT = 4 * MiB, WS_DEC = 5 * MiB, WS_XC = 6 * MiB,
                 WS_WGU = 14 * MiB, WS_WDN = 36 * MiB, WS_WIN = 47 * MiB, WS_WOUT = 54 * MiB, WS_A = 56 * MiB, WS_HP = 124 * MiB,
                 WS_VT = 362 * MiB, WS_STS = 396 * MiB, WS_STR = 430 * MiB, WS_U = 447 * MiB, WS_T = 498 * MiB, WS_X16 = 530 * MiB, WS_END = 598 * MiB;
constexpr int LDS_BYTES = 147456;
constexpr int NTHREADS = 512;

struct Args { const float* in[22]; float* out; unsigned char* ws; float afreq[16]; float rfreq[32]; int ph_lo, ph_hi; };
enum { I_X = 0, I_C, I_CTX, I_CCTX, I_ADAW, I_ADAB, I_NG, I_NB, I_WG, I_WU, I_WD, I_WIN, I_CONVW, I_CONVB, I_LAMBDA, I_SUBG, I_ALOG, I_DTB, I_SSMD, I_SSMG, I_RLG, I_WOUT };

DI float* xrow_ptr(float* xlat, float* xctx, int row) { return row < M_LAT ? xlat + (size_t)row * DM : xctx + (size_t)(row - M_LAT) * DM; }
DI int swap23(int o) { return (o & 3) | (((o >> 3) & 1) << 2) | (((o >> 2) & 1) << 3); }

struct EpiSwiglu {
    static constexpr bool PERM = true, AFTER_DRAIN = false;
    bf16* H;
    DI void operator()(const pg8::f32x4 (&acc)[2][2][4][2], const pg8::Unit& u, int wr, int wc, int fr, int fq) const {
        const int row0 = u.pm * 256 + wr * 64 + fr, col = u.pn * 128 + wc * 32 + 8 * fq;
#pragma unroll
        for (int ai = 0; ai < 2; ++ai)
#pragma unroll
            for (int m = 0; m < 4; ++m) {
                bf16* p = H + (size_t)(row0 + ai * 128 + m * 16) * DFF + col;
                float h[8];
#pragma unroll
                for (int n = 0; n < 2; ++n)
#pragma unroll
                    for (int j = 0; j < 4; ++j) h[n * 4 + j] = silu_f(acc[ai][0][m][n][j]) * acc[ai][1][m][n][j];
                u32x4 w; w.x = pk2(h[0], h[1]); w.y = pk2(h[2], h[3]); w.z = pk2(h[4], h[5]); w.w = pk2(h[6], h[7]);
                *(u32x4*)p = w;
                __builtin_amdgcn_sched_barrier(0);
            }
    }
};

struct EpiResid {
    static constexpr bool PERM = true, AFTER_DRAIN = false;
    bf16* X; const float* modg; const float* scale_p; const f32x2* stat; const float* gprev; const float* bprev;
    DI void operator()(const pg8::f32x4 (&acc)[2][2][4][2], const pg8::Unit& u, int wr, int wc, int fr, int fq) const {
        const int mi = (u.pm < 128) ? (u.pm >> 4) : 8;
        const float* gp = modg + (size_t)mi * 9216;
        const int row0 = u.pm * 256 + wr * 64 + fr, col0 = u.pn * 256 + wc * 32 + 8 * fq;
        const float scale = *scale_p;
#pragma unroll
        for (int bj = 0; bj < 2; ++bj) {
            f32x4 gs[2], gq[2], bq[2];
#pragma unroll
            for (int n = 0; n < 2; ++n) { const f32x4 g = *(const f32x4*)(gp + col0 + bj * 128 + 4 * n); gs[n] = (g + 1.0f) * scale;
                gq[n] = *(const f32x4*)(gprev + col0 + bj * 128 + 4 * n) * ALPHA; bq[n] = *(const f32x4*)(bprev + col0 + bj * 128 + 4 * n) * ALPHA; }
#pragma unroll
            for (int ai = 0; ai < 2; ++ai) {
                u32x4 xv[4]; f32x2 st[4];
#pragma unroll
                for (int m = 0; m < 4; ++m) { const int row = row0 + ai * 128 + m * 16; xv[m] = *(const u32x4*)(X + (size_t)row * DM + col0 + bj * 128); st[m] = stat[row]; }
                __builtin_amdgcn_sched_barrier(0);
#pragma unroll
                for (int m = 0; m < 4; ++m) {
                    const f32x4 x0 = {hlo(xv[m].x), hhi(xv[m].x), hlo(xv[m].y), hhi(xv[m].y)}, x1 = {hlo(xv[m].z), hhi(xv[m].z), hlo(xv[m].w), hhi(xv[m].w)};
                    const f32x4 y0 = (x0 - st[m].x) * st[m].y * gq[0] + bq[0] + gs[0] * acc[ai][bj][m][0];
                    const f32x4 y1 = (x1 - st[m].x) * st[m].y * gq[1] + bq[1] + gs[1] * acc[ai][bj][m][1];
                    u32x4 w; w.x = pkh2(y0.x, y0.y); w.y = pkh2(y0.z, y0.w); w.z = pkh2(y1.x, y1.y); w.w = pkh2(y1.z, y1.w);
                    *(u32x4*)(X + (size_t)(row0 + ai * 128 + m * 16) * DM + col0 + bj * 128) = w;
                }
                __builtin_amdgcn_sched_barrier(0);
            }
        }
    }
};
struct EpiPartial {
    static constexpr bool PERM = true, AFTER_DRAIN = false;
    float* T; const float* modg; const float* scale_p;
    DI void operator()(const pg8::f32x4 (&acc)[2][2][4][2], const pg8::Unit& u, int wr, int wc, int fr, int fq) const {
        const float* gp = modg + (size_t)8 * 9216; const float scale = *scale_p;
        const int row0 = u.pm * 256 + wr * 64 + fr - M_LAT, col0 = u.pn * 256 + wc * 32 + 8 * fq;
        f32x4 gs[2][2];
#pragma unroll
        for (int bj = 0; bj < 2; ++bj)
#pragma unroll
            for (int n = 0; n < 2; ++n) { f32x4 g = *(const f32x4*)(gp + col0 + bj * 128 + 4 * n); gs[bj][n] = (g + 1.0f) * scale; }
#pragma unroll
        for (int ai = 0; ai < 2; ++ai)
#pragma unroll
            for (int m = 0; m < 4; ++m) {
                float* tp = T + (size_t)(row0 + ai * 128 + m * 16) * DM + col0;
#pragma unroll
                for (int bj = 0; bj < 2; ++bj)
#pragma unroll
                    for (int n = 0; n < 2; ++n) *(f32x4*)(tp + bj * 128 + 4 * n) = gs[bj][n] * acc[ai][bj][m][n];
                __builtin_amdgcn_sched_barrier(0);
            }
    }
};
struct OneUnit {
    int have; pg8::Unit u;
    DI bool next(int i, pg8::Unit& o) const { if (i == 0 && have) { o = u; return true; } return false; }
    DI void a_ready(const pg8::Unit&) const {}
    DI void done(const pg8::Unit&) const {}
};

struct EpiIn {
    static constexpr bool PERM = true, AFTER_DRAIN = false;
    bf16* P; bf16* Vt; const f32x2* tatt; const f32x2* tret;
    DI void operator()(const pg8::f32x4 (&acc)[2][2][4][2], const pg8::Unit& u, int wr, int wc, int fr, int fq) const {
        const int pn = u.pn;
        const int row0 = u.pm * 256 + wr * 64 + fr;
        if (pn == 4 || pn == 5) {
#pragma unroll
            for (int ai = 0; ai < 2; ++ai)
#pragma unroll
                for (int m = 0; m < 4; ++m) {
                    const int row = row0 + ai * 128 + m * 16;
                    int b, key;
                    if (row < M_LAT) { b = row >> 12; key = row & 4095; } else { const int r2 = row - M_LAT; b = r2 >> 8; key = 4096 + (r2 & 255); }
                    const int kp = (key & ~15) | swap23(key & 15);
#pragma unroll
                    for (int bj = 0; bj < 2; ++bj) {
                        const int h = 2 * (pn - 4) + bj;
                        bf16* vp = Vt + ((size_t)(b * 4 + h) * 128 + wc * 32 + 8 * fq) * NKEY + kp;
#pragma unroll
                        for (int n = 0; n < 2; ++n)
#pragma unroll
                            for (int j = 0; j < 4; ++j) vp[(size_t)(n * 4 + j) * NKEY] = f2bf(acc[ai][bj][m][n][j]);
                    }
                    __builtin_amdgcn_sched_barrier(0);
                }
            return;
        }
        const bool att = pn < 4, ret = (pn == 10 || pn == 11);
        const float sc = (pn < 2) ? QSCALE : (pn == 11 ? 0.125f : 1.0f);
#pragma unroll
        for (int ai = 0; ai < 2; ++ai)
#pragma unroll
            for (int m = 0; m < 4; ++m) {
                const int row = row0 + ai * 128 + m * 16;
                f32x2 cs[4];
                bool rot = false;
                if ((att || ret) && row < M_LAT) {
                    rot = true;
                    const int s = row & 4095;
                    const f32x2* tp;
                    if (att) { const int pos = (wc & 1) ? (s & 63) : (s >> 6); tp = tatt + pos * 16 + 4 * fq; }
                    else { tp = tret + (size_t)s * 32 + 16 * (wc & 1) + 4 * fq; }
                    const f32x4 t0 = *(const f32x4*)tp, t1 = *(const f32x4*)(tp + 2);
                    cs[0] = (f32x2){t0.x, t0.y}; cs[1] = (f32x2){t0.z, t0.w}; cs[2] = (f32x2){t1.x, t1.y}; cs[3] = (f32x2){t1.z, t1.w};
                }
#pragma unroll
                for (int bj = 0; bj < 2; ++bj) {
                    float v[8];
#pragma unroll
                    for (int n = 0; n < 2; ++n)
#pragma unroll
                        for (int j = 0; j < 4; ++j) v[n * 4 + j] = acc[ai][bj][m][n][j];
                    if (rot) {
#pragma unroll
                        for (int q = 0; q < 4; ++q) { const float h1 = v[2 * q], h2 = v[2 * q + 1]; v[2 * q] = h1 * cs[q].x - h2 * cs[q].y; v[2 * q + 1] = h2 * cs[q].x + h1 * cs[q].y; }
                    }
                    u32x4 w; w.x = pk2(v[0] * sc, v[1] * sc); w.y = pk2(v[2] * sc, v[3] * sc); w.z = pk2(v[4] * sc, v[5] * sc); w.w = pk2(v[6] * sc, v[7] * sc);
                    *(u32x4*)(P + (size_t)row * NIN + pn * 256 + bj * 128 + wc * 32 + 8 * fq) = w;
                }
                __builtin_amdgcn_sched_barrier(0);
            }
    }
};

DI void sincos_d(float angf, float& c, float& s) {
    const double a = (double)angf;
    const double k = rint(a * 0.15915494309189535);
    double r = fma(-k, 6.283185307179586, a); r = fma(-k, 2.4492935982947064e-16, r);
    const double r2 = r * r;
    double ts = r, ss = r, tc = 1.0, sc = 1.0;
#pragma unroll 1
    for (int n = 1; n <= 15; ++n) {
        tc = -tc * r2 / (double)((2 * n - 1) * (2 * n)); sc += tc;
        ts = -ts * r2 / (double)((2 * n) * (2 * n + 1)); ss += ts;
    }
    c = (float)sc; s = (float)ss;
}

DI int in_srccol(int j) {
    if (j < 1024) { const int blk = j >> 6, dp = j & 63, half = dp >> 5, i = (dp & 31) >> 1, sec = dp & 1; return blk * 64 + half * 32 + i + 16 * sec; }
    if (j < 2560) return j;
    if (j < 3072) { const int jj = j - 2560, blk = jj >> 6, dp = jj & 63, i = dp >> 1, sec = dp & 1; return 2564 + blk * 64 + i + 32 * sec; }
    return j + 4;
}

DI void transpose_item(const float* W, int ldw, int K, int srccol_lane, bf16* WT, int n0, int k0, LAS float* scr, int lane) {
#pragma unroll 8
    for (int i = 0; i < 32; ++i) { const int kk = 2 * i + (lane >> 5); scr[kk * 33 + (lane & 31)] = W[(size_t)(k0 + kk) * ldw + srccol_lane]; }
    asm volatile("s_waitcnt lgkmcnt(0)" ::: "memory");
    const int c = lane & 7;
#pragma unroll
    for (int j = 0; j < 4; ++j) {
        const int n = (lane >> 3) + 8 * j; const LAS float* s = scr + (8 * c) * 33 + n;
        u32x4 o; o.x = pk2(s[0 * 33], s[1 * 33]); o.y = pk2(s[2 * 33], s[3 * 33]); o.z = pk2(s[4 * 33], s[5 * 33]); o.w = pk2(s[6 * 33], s[7 * 33]);
        *(u32x4*)(WT + (size_t)(n0 + n) * K + k0 + 8 * c) = o;
    }
    asm volatile("s_waitcnt lgkmcnt(0)" ::: "memory");
}

DI void transpose_item_wide(const float* W, int ldw, int K, int src0, bf16* WT, int n0, int k0, LAS float* scr, int lane) {
    const int c4 = lane & 7, kr = lane >> 3;
#pragma unroll
    for (int i = 0; i < 8; ++i) { const int kk = kr + 8 * i; const f32x4 v = *(const f32x4*)(W + (size_t)(k0 + kk) * ldw + src0 + 4 * c4);
        LAS float* d = scr + kk * 33 + 4 * c4; d[0] = v.x; d[1] = v.y; d[2] = v.z; d[3] = v.w; }
    asm volatile("s_waitcnt lgkmcnt(0)" ::: "memory");
    const int c = lane & 7;
#pragma unroll
    for (int j = 0; j < 4; ++j) {
        const int n = (lane >> 3) + 8 * j; const LAS float* sp = scr + (8 * c) * 33 + n;
        u32x4 o; o.x = pk2(sp[0 * 33], sp[1 * 33]); o.y = pk2(sp[2 * 33], sp[3 * 33]); o.z = pk2(sp[4 * 33], sp[5 * 33]); o.w = pk2(sp[6 * 33], sp[7 * 33]);
        *(u32x4*)(WT + (size_t)(n0 + n) * K + k0 + 8 * c) = o;
    }
    asm volatile("s_waitcnt lgkmcnt(0)" ::: "memory");
}

DI void convw_phase(const Args& A, int l, LAS unsigned char* lds, int tid, int bid, int G) {
    const int lane = tid & 63, wave = tid >> 6;
    LAS float* scr = (LAS float*)(lds + 65536 + wave * 8448);
    const int gw = bid * 8 + wave, NGW = G * 8;
    constexpr int I_GU = 2 * 16 * (NGU / 32), I_DN = 2 * (DFF / 64) * (DM / 32), I_IN = 16 * (NIN / 32), I_OUT = 16 * 32;
    bf16* wgu = (bf16*)(A.ws + WS_WGU); bf16* wdn = (bf16*)(A.ws + WS_WDN); bf16* win = (bf16*)(A.ws + WS_WIN); bf16* wout = (bf16*)(A.ws + WS_WOUT);
    for (int it = gw; it < I_GU + I_DN + I_IN + I_OUT; it += NGW) {
        int r = it;
        if (r < I_GU) {
            const int f = r / (16 * (NGU / 32)); r -= f * 16 * (NGU / 32);
            const int kb = r / (NGU / 32), nb = r % (NGU / 32), n0 = nb * 32, pn = n0 >> 8, cc = n0 & 255;
            const float* src = (cc < 128 ? A.in[I_WG] : A.in[I_WU]) + (size_t)(l * 2 + f) * DM * DFF;
            transpose_item_wide(src, DFF, DM, 128 * pn + (cc & 127), wgu + (size_t)f * NGU * DM, n0, kb * 64, scr, lane);
            continue;
        }
        r -= I_GU;
        if (r < I_DN) {
            const int f = r / ((DFF / 64) * 32); r -= f * (DFF / 64) * 32;
            const int kb = r / 32, nb = r % 32;
            transpose_item_wide(A.in[I_WD] + (size_t)(l * 2 + f) * DFF * DM, DM, DFF, nb * 32, wdn + (size_t)f * DM * DFF, nb * 32, kb * 64, scr, lane);
            continue;
        }
        r -= I_DN;
        if (r < I_IN) {
            const int kb = r / (NIN / 32), nb = r % (NIN / 32);
            transpose_item(A.in[I_WIN] + (size_t)l * DM * INC, INC, DM, in_srccol(nb * 32 + (lane & 31)), win, nb * 32, kb * 64, scr, lane);
            continue;
        }
        r -= I_IN;
        { const int kb = r / 32, nb = r % 32;
          transpose_item_wide(A.in[I_WOUT] + (size_t)l * DM * DM, DM, DM, nb * 32, wout, nb * 32, kb * 64, scr, lane); }
    }
}

DI void p0a_phase(const Args& A, LAS unsigned char* lds, int tid, int bid, int G) {
    const int lane = tid & 63, wave = tid >> 6;
    { const int gt = bid * NTHREADS + tid;
      f32x2* tatt = (f32x2*)(A.ws + WS_TATT); f32x2* tret = (f32x2*)(A.ws + WS_TRET);
      if (gt < 1024) { ((float*)(A.ws + WS_ONES))[gt] = 1.0f; ((float*)(A.ws + WS_ZEROS))[gt] = 0.0f; ((float*)(A.ws + WS_HALVES))[gt] = 0.5f; }
      if (gt < 1024) { const int pos = gt >> 4, i = gt & 15; float c, s; sincos_d((float)pos * A.afreq[i], c, s); tatt[gt] = (f32x2){c, s}; }
      for (int e = gt; e < SEQ * 32; e += G * NTHREADS) { const int sidx = e >> 5, i = e & 31; float c, s; sincos_d((float)sidx * A.rfreq[i], c, s); tret[e] = (f32x2){c, s}; }
      if (gt < DEPTH) {
          const float* lv = A.in[I_LAMBDA] + gt * 256; float d0 = 0.f, d1 = 0.f;
          for (int i = 0; i < 64; ++i) { d0 += lv[i] * lv[64 + i]; d1 += lv[128 + i] * lv[192 + i]; }
          const float lam_init = 0.8f - 0.6f * expf(-0.3f * (float)gt);
          ((float*)(A.ws + WS_LAM))[gt] = expf(d0) - expf(d1) + lam_init;
      }
    }
    LAS float* scs = (LAS float*)lds;
    LAS float* red = (LAS float*)(lds + 36864);
    for (int e = tid; e < 9 * 1024; e += NTHREADS) { const int mi = e >> 10, k = e & 1023; const float v = (mi < 8) ? A.in[I_C][mi * 1024 + k] : A.in[I_CCTX][k]; scs[e] = silu_f(v); }
    __syncthreads();
    float* MOD = (float*)(A.ws + WS_MOD);
    for (int it = bid; it < DEPTH * 144; it += G) {
        const int l = it / 144, cg0 = (it % 144) * 64;
        const float* w = A.in[I_ADAW] + (size_t)l * DM * 9216 + cg0 + lane;
        float acc[9];
#pragma unroll
        for (int mi = 0; mi < 9; ++mi) acc[mi] = 0.f;
#pragma unroll 4
        for (int k = wave * 128; k < wave * 128 + 128; ++k) {
            const float wv = w[(size_t)k * 9216];
#pragma unroll
            for (int mi = 0; mi < 9; ++mi) acc[mi] += scs[mi * 1024 + k] * wv;
        }
#pragma unroll
        for (int mi = 0; mi < 9; ++mi) red[(wave * 9 + mi) * 64 + lane] = acc[mi];
        __syncthreads();
        for (int e = tid; e < 576; e += NTHREADS) {
            const int mi = e >> 6, cl = e & 63; float s = A.in[I_ADAB][l * 9216 + cg0 + cl];
#pragma unroll
            for (int w8 = 0; w8 < 8; ++w8) s += red[(w8 * 9 + mi) * 64 + cl];
            MOD[((size_t)l * 9 + mi) * 9216 + cg0 + cl] = s;
        }
        __syncthreads();
    }
    convw_phase(A, 0, lds, tid, bid, G);
}

DI void wave_sum2(float& a, float& b) {
#pragma unroll
    for (int o = 1; o < 64; o <<= 1) { const float ta = __shfl_xor(a, o), tb = __shfl_xor(b, o); a += ta; b += tb; }
}
DI void wave_sum4(float& a, float& b, float& c, float& d) {
#pragma unroll
    for (int o = 1; o < 64; o <<= 1) { const float ta = __shfl_xor(a, o), tb = __shfl_xor(b, o), tc = __shfl_xor(c, o), td = __shfl_xor(d, o); a += ta; b += tb; c += tc; d += td; }
}
DI float wave_sum(float v) {
#pragma unroll
    for (int o = 1; o < 64; o <<= 1) v += __shfl_xor(v, o);
    return v;
}
DI void lnmod_phase(const Args& A, LAS unsigned char* lds, int tid, int bid, int G, bool init, int l_norm, int i_norm, int l_mod, int i_mod, bool want_dt, int nrows, bool ctx_partial, const float* gprev, const float* bprev) {
    const int lane = tid & 63, wave = tid >> 6;
    LAS f32x4* wdt = (LAS f32x4*)lds;
    if (want_dt) {
        for (int k = tid; k < 1024; k += NTHREADS) wdt[k] = *(const f32x4*)(A.in[I_WIN] + ((size_t)l_mod * DM + k) * INC + 2560);
        __syncthreads();
    }
    const float* MOD = (const float*)(A.ws + WS_MOD);
    bf16* Abuf = (bf16*)(A.ws + WS_A);
    float* DT = (float*)(A.ws + WS_DT);
    f32x4 g[4], bb[4];
    if (l_norm >= 0) {
#pragma unroll
        for (int j = 0; j < 4; ++j) { g[j] = *(const f32x4*)(A.in[I_NG] + (l_norm * 3 + i_norm) * DM + 256 * j + 4 * lane); bb[j] = *(const f32x4*)(A.in[I_NB] + (l_norm * 3 + i_norm) * DM + 256 * j + 4 * lane); }
    }
    bf16* X16 = (bf16*)(A.ws + WS_X16);
    u32x2 un[4]; f32x4 fn[4];
    int mi_cur = -1; f32x4 shv[4], sclv[4];
    { const int row = bid * 8 + wave;
      if (row < nrows) {
          if (init) { const float* xin = row < M_LAT ? A.in[I_X] + (size_t)row * DM : A.in[I_CTX] + (size_t)(row - M_LAT) * DM;
#pragma unroll
              for (int j = 0; j < 4; ++j) fn[j] = *(const f32x4*)(xin + 256 * j + 4 * lane); }
          else {
#pragma unroll
              for (int j = 0; j < 4; ++j) un[j] = *(const u32x2*)(X16 + (size_t)row * DM + 256 * j + 4 * lane); } } }
    for (int row = bid * 8 + wave; row < nrows; row += G * 8) {
        bf16* xout = X16 + (size_t)row * DM;
        f32x4 v[4];
#pragma unroll
        for (int j = 0; j < 4; ++j) v[j] = init ? fn[j] : (f32x4){hlo(un[j].x), hhi(un[j].x), hlo(un[j].y), hhi(un[j].y)};
        { const int rown = row + G * 8;
          if (rown < nrows) {
              if (init) { const float* xin = rown < M_LAT ? A.in[I_X] + (size_t)rown * DM : A.in[I_CTX] + (size_t)(rown - M_LAT) * DM;
#pragma unroll
                  for (int j = 0; j < 4; ++j) fn[j] = *(const f32x4*)(xin + 256 * j + 4 * lane); }
              else {
#pragma unroll
                  for (int j = 0; j < 4; ++j) un[j] = *(const u32x2*)(X16 + (size_t)rown * DM + 256 * j + 4 * lane); } } }
        f32x2* STAT = (f32x2*)(A.ws + WS_STAT);
        if (ctx_partial && row >= M_LAT) {
            { const f32x2 st = STAT[row];
#pragma unroll
              for (int j = 0; j < 4; ++j) v[j] = (v[j] - st.x) * st.y * *(const f32x4*)(gprev + 256 * j + 4 * lane) + *(const f32x4*)(bprev + 256 * j + 4 * lane); }
            const float* t0 = (const float*)(A.ws + WS_T) + (size_t)(row - M_LAT) * DM; const float* t1 = t0 + (size_t)M_CTX * DM; const float* t2 = t1 + (size_t)M_CTX * DM; const float* t3 = t2 + (size_t)M_CTX * DM;
#pragma unroll
            for (int j = 0; j < 4; ++j) { v[j] = v[j] * ALPHA + (*(const f32x4*)(t0 + 256 * j + 4 * lane) + *(const f32x4*)(t1 + 256 * j + 4 * lane)) + (*(const f32x4*)(t2 + 256 * j + 4 * lane) + *(const f32x4*)(t3 + 256 * j + 4 * lane)); u32x2 w_; w_.x = pkh2(v[j].x, v[j].y); w_.y = pkh2(v[j].z, v[j].w); *(u32x2*)(xout + 256 * j + 4 * lane) = w_; }
        }
        if (l_norm >= 0) {
            float s = 0.f, s2 = 0.f;
#pragma unroll
            for (int j = 0; j < 4; ++j) { s += (v[j].x + v[j].y) + (v[j].z + v[j].w); s2 += (v[j].x * v[j].x + v[j].y * v[j].y) + (v[j].z * v[j].z + v[j].w * v[j].w); }
            wave_sum2(s, s2);
            const float mean = s * (1.f / DM);
            const float rstd = 1.0f / sqrtf(fmaxf(s2 * (1.f / DM) - mean * mean, 0.f) + 1e-5f);
#pragma unroll
            for (int j = 0; j < 4; ++j) v[j] = v[j] - mean;
            if (l_mod >= 0 && lane == 0) STAT[row] = (f32x2){mean, rstd};
#pragma unroll
            for (int j = 0; j < 4; ++j) v[j] = v[j] * rstd * g[j] + bb[j];
        }
        if (init && lane == 0) STAT[row] = (f32x2){0.f, 1.f};
        if (init) {
#pragma unroll
            for (int j = 0; j < 4; ++j) { u32x2 w_; w_.x = pkh2(v[j].x, v[j].y); w_.y = pkh2(v[j].z, v[j].w); *(u32x2*)(xout + 256 * j + 4 * lane) = w_; }
        }
        if (l_norm >= 0 && l_mod < 0) {
#pragma unroll
            for (int j = 0; j < 4; ++j) *(f32x4*)(A.out + (size_t)row * DM + 256 * j + 4 * lane) = v[j];
        }
        if (l_mod >= 0) {
            const int mi = row < M_LAT ? (row >> 12) : 8;
            const float* mp = MOD + ((size_t)l_mod * 9 + mi) * 9216 + i_mod * 3072;
            if (mi != mi_cur) { mi_cur = mi;
#pragma unroll
                for (int j = 0; j < 4; ++j) { shv[j] = *(const f32x4*)(mp + 256 * j + 4 * lane); sclv[j] = *(const f32x4*)(mp + 1024 + 256 * j + 4 * lane) + 1.0f; } }
            float d0 = 0.f, d1 = 0.f, d2 = 0.f, d3 = 0.f;
#pragma unroll
            for (int j = 0; j < 4; ++j) {
                const f32x4 a = v[j] * sclv[j] + shv[j];
                u32x2 w; w.x = pk2(a.x, a.y); w.y = pk2(a.z, a.w);
                *(u32x2*)(Abuf + (size_t)row * DM + 256 * j + 4 * lane) = w;
                if (want_dt) {
                    const int k0 = 256 * j + 4 * lane;
                    const f32x4 w0 = wdt[k0], w1 = wdt[k0 + 1], w2 = wdt[k0 + 2], w3 = wdt[k0 + 3];
                    d0 += a.x * w0.x + a.y * w1.x + a.z * w2.x + a.w * w3.x;
                    d1 += a.x * w0.y + a.y * w1.y + a.z * w2.y + a.w * w3.y;
                    d2 += a.x * w0.z + a.y * w1.z + a.z * w2.z + a.w * w3.z;
                    d3 += a.x * w0.w + a.y * w1.w + a.z * w2.w + a.w * w3.w;
                }
            }
            if (want_dt) {
                wave_sum4(d0, d1, d2, d3);
                if (lane == 0) *(f32x4*)(DT + (size_t)row * 4) = (f32x4){d0, d1, d2, d3};
            }
        }
    }
}

DI float max3f(float a, float b, float c) { float r; asm("v_max3_f32 %0, %1, %2, %3" : "=v"(r) : "v"(a), "v"(b), "v"(c)); return r; }
DI float max3f_mfma(float a, float b, float c) { float r; asm("s_nop 15\n\ts_nop 7\n\tv_max3_f32 %0, %1, %2, %3" : "=v"(r) : "v"(a), "v"(b), "v"(c)); return r; }
DI void attn_unit(LAS unsigned char* lds, int tid, const bf16* __restrict__ P, const bf16* __restrict__ Vt, bf16* MG, int b, int h, int qrow0, int jt0, int jt1,
                  float lam, float oscale, const float* subg) {
    asm volatile("" : "+v"(tid));
    constexpr int KP = 136, VP = 72, KBYTES = 64 * KP * 2, VBYTES = 128 * VP * 2;
    const int lane = tid & 63, wave = tid >> 6, r32 = lane & 31, hi = lane >> 5;
    const int qb = wave >> 1, m = wave & 1;
    const int qrow = qrow0 + qb * 32 + r32;
    bf16x8 qf[4];
#pragma unroll
    for (int ks = 0; ks < 4; ++ks) qf[ks] = *(const bf16x8*)(P + (size_t)qrow * NIN + h * 128 + m * 64 + ks * 16 + hi * 8);
    f32x16 O[4];
#pragma unroll
    for (int es = 0; es < 4; ++es)
#pragma unroll
        for (int i = 0; i < 16; ++i) O[es][i] = 0.f;
    float mrun = 0.f, lrun = 0.f;
    u32x4 kreg[2], vreg[2];
    const bf16* vbase = Vt + (size_t)(b * 4 + h) * 128 * NKEY;
#define ATT_LOADG(j) do { _Pragma("unroll") for (int i_ = 0; i_ < 2; ++i_) { const int c_ = tid + 512 * i_; const int key_ = c_ >> 4, part_ = c_ & 15; \
        const int row_ = ((j) < 64) ? b * SEQ + (j) * 64 + key_ : M_LAT + b * CTXL + ((j) - 64) * 64 + key_; \
        kreg[i_] = *(const u32x4*)(P + (size_t)row_ * NIN + 512 + h * 128 + part_ * 8); \
        const int e_ = c_ >> 3, vp_ = c_ & 7; vreg[i_] = *(const u32x4*)(vbase + (size_t)e_ * NKEY + (j) * 64 + vp_ * 8); } } while (0)
#define ATT_STORE(buf) do { _Pragma("unroll") for (int i_ = 0; i_ < 2; ++i_) { const int c_ = tid + 512 * i_; const int key_ = c_ >> 4, part_ = c_ & 15, e_ = c_ >> 3, vp_ = c_ & 7; \
        *(LAS u32x4*)(lds + (buf) * KBYTES + (key_ * KP + part_ * 8) * 2) = kreg[i_]; \
        *(LAS u32x4*)(lds + 3 * KBYTES + (buf) * VBYTES + (e_ * VP + vp_ * 8) * 2) = vreg[i_]; } } while (0)
    const bool halfB = wave >= 4;
    bf16x8 pf[4];
    f32x16 negm16;
#pragma unroll
    for (int i = 0; i < 16; ++i) negm16[i] = 0.f;
#define ATT_QKS(bufk, first_) do { \
        const LAS bf16* Kb = (const LAS bf16*)(lds + (bufk) * KBYTES) + m * 64 + hi * 8; \
        f32x16 s0, s1; \
        { const bf16x8 a0 = *(const LAS bf16x8*)(Kb + r32 * KP); const bf16x8 a1 = *(const LAS bf16x8*)(Kb + (32 + r32) * KP); \
          s0 = MFMA32(a0, qf[0], negm16); s1 = MFMA32(a1, qf[0], negm16); } \
        _Pragma("unroll") for (int ks = 1; ks < 4; ++ks) { \
            const bf16x8 a0 = *(const LAS bf16x8*)(Kb + r32 * KP + ks * 16); \
            const bf16x8 a1 = *(const LAS bf16x8*)(Kb + (32 + r32) * KP + ks * 16); \
            s0 = MFMA32(a0, qf[ks], s0); s1 = MFMA32(a1, qf[ks], s1); } \
        float mx = max3f_mfma(s0[0], s1[0], s0[1]); \
        mx = max3f(mx, s1[1], s0[2]); mx = max3f(mx, s1[2], s0[3]); mx = max3f(mx, s1[3], s0[4]); mx = max3f(mx, s1[4], s0[5]); \
        mx = max3f(mx, s1[5], s0[6]); mx = max3f(mx, s1[6], s0[7]); mx = max3f(mx, s1[7], s0[8]); mx = max3f(mx, s1[8], s0[9]); \
        mx = max3f(mx, s1[9], s0[10]); mx = max3f(mx, s1[10], s0[11]); mx = max3f(mx, s1[11], s0[12]); mx = max3f(mx, s1[12], s0[13]); \
        mx = max3f(mx, s1[13], s0[14]); mx = max3f(mx, s1[14], s0[15]); mx = max3f(mx, s1[15], mx); \
        mx = max3f(mx, __shfl_xor(mx, 32), mx); \
        if ((first_) || __builtin_amdgcn_ballot_w64(mx > 8.0f) != 0ull) { \
            const float d = (first_) ? mx : (mx > 8.0f ? mx : 0.f); \
            mrun += d; { const float nm_ = -mrun; _Pragma("unroll") for (int i = 0; i < 16; ++i) negm16[i] = nm_; } \
            if (!(first_)) { const float alpha = ex2(-d); lrun *= alpha; _Pragma("unroll") for (int es = 0; es < 4; ++es) O[es] = O[es] * alpha; } \
            _Pragma("unroll") for (int i = 0; i < 16; ++i) { s0[i] -= d; s1[i] -= d; } } \
        float sum = 0.f; \
        _Pragma("unroll") for (int i = 0; i < 16; ++i) { s0[i] = ex2(s0[i]); s1[i] = ex2(s1[i]); sum += s0[i] + s1[i]; } \
        lrun += sum; \
        _Pragma("unroll") for (int s2 = 0; s2 < 2; ++s2) { u32x4 w0, w1; \
            w0.x = pk2(s0[8 * s2 + 0], s0[8 * s2 + 1]); w0.y = pk2(s0[8 * s2 + 2], s0[8 * s2 + 3]); w0.z = pk2(s0[8 * s2 + 4], s0[8 * s2 + 5]); w0.w = pk2(s0[8 * s2 + 6], s0[8 * s2 + 7]); \
            w1.x = pk2(s1[8 * s2 + 0], s1[8 * s2 + 1]); w1.y = pk2(s1[8 * s2 + 2], s1[8 * s2 + 3]); w1.z = pk2(s1[8 * s2 + 4], s1[8 * s2 + 5]); w1.w = pk2(s1[8 * s2 + 6], s1[8 * s2 + 7]); \
            pf[s2] = __builtin_bit_cast(bf16x8, w0); pf[2 + s2] = __builtin_bit_cast(bf16x8, w1); } } while (0)
#define ATT_PV(bufv) do { \
        const LAS bf16* Vb = (const LAS bf16*)(lds + 3 * KBYTES + (bufv) * VBYTES) + hi * 8; \
        _Pragma("unroll") for (int es = 0; es < 4; ++es) _Pragma("unroll") for (int kk = 0; kk < 4; ++kk) { \
            const bf16x8 a = *(const LAS bf16x8*)(Vb + (es * 32 + r32) * VP + kk * 16); O[es] = MFMA32(a, pf[kk], O[es]); } } while (0)
    __syncthreads();
    ATT_LOADG(jt0);
    int buf = 0, pbuf = 2;
    for (int j = jt0; j < jt1; ++j) {
        ATT_STORE(buf);
        __syncthreads();
        if (j + 1 < jt1) ATT_LOADG(j + 1);
        if (!halfB) { ATT_QKS(buf, j == jt0); ATT_PV(buf); }
        else { if (j > jt0) { ATT_PV(pbuf); } ATT_QKS(buf, j == jt0); }
        pbuf = buf; buf = (buf == 2) ? 0 : buf + 1;
    }
    if (halfB) { ATT_PV(pbuf); }
#undef ATT_QKS
#undef ATT_PV
#undef ATT_LOADG
#undef ATT_STORE
    __syncthreads();
    const float l = lrun + __shfl_xor(lrun, 32);
    const float inv = (m ? lam : 1.0f) / l;
    LAS float* X = (LAS float*)lds + qb * 4096 + lane;
    if (m) {
#pragma unroll
        for (int es = 0; es < 4; ++es)
#pragma unroll
            for (int i = 0; i < 16; ++i) X[(es * 16 + i) * 64] = O[es][i] * inv;
    }
    __syncthreads();
    if (!m) {
        float ss = 0.f;
#pragma unroll
        for (int es = 0; es < 4; ++es)
#pragma unroll
            for (int i = 0; i < 16; ++i) { const float o = O[es][i] * inv - X[(es * 16 + i) * 64]; O[es][i] = o; ss += o * o; }
        ss += __shfl_xor(ss, 32);
        const float rn = (1.0f / sqrtf(ss * (1.0f / 128.0f) + 1e-6f)) * oscale;
#pragma unroll
        for (int es = 0; es < 4; ++es)
#pragma unroll
            for (int g4 = 0; g4 < 4; ++g4) {
                const int e = es * 32 + 8 * g4 + 4 * hi;
                const f32x4 gv = *(const f32x4*)(subg + e);
                u32x2 w; w.x = pk2(O[es][4 * g4 + 0] * rn * gv.x, O[es][4 * g4 + 1] * rn * gv.y); w.y = pk2(O[es][4 * g4 + 2] * rn * gv.z, O[es][4 * g4 + 3] * rn * gv.w);
                *(u32x2*)(MG + (size_t)qrow * DM + h * 128 + e) = w;
            }
    }
}

constexpr int SC_ACF = 0, SC_ACB = 1, SC_DT0 = 2, SC_DT1 = 3;
constexpr int L_STAT = 8192, L_BUF = 16384;
constexpr int TP = 136;
constexpr int QP = 72;
constexpr int UW = 768;

DI int vc_row0(int b, int vc) { return vc < 2 ? M_LAT + b * CTXL + vc * 128 : b * SEQ + (vc - 2) * 128; }
DI float softplus_f(float x) { return fmaxf(x, 0.f) + log1pf(__expf(-fabsf(x))); }

struct ScanCtx { const bf16* P; const bf16* U; const float* DT; bf16* sts; bf16* str; float* dec; bf16* MG; const float* cw; const float* cb; const float* alog; const float* dtb; const float* ssmd; const float* ssmg; const float* rlg; };

DI void conv_phase(const bf16* __restrict__ P, bf16* __restrict__ U, const float* cw, const float* cb, int tid, int bid, int G) {
    const int lane = tid & 63, wave = tid >> 6;
    for (int it = bid * 8 + wave; it < (M_ALL / 16) * 3; it += G * 8) {
        const int run = it / 3, cgp = it % 3, row0 = run * 16, ch = cgp * 256 + 4 * lane;
        int s0, L; if (row0 < M_LAT) { s0 = row0 & (SEQ - 1); L = SEQ; } else { s0 = (row0 - M_LAT) & (CTXL - 1); L = CTXL; }
        f32x4 w[5];
#pragma unroll
        for (int k = 0; k < 5; ++k) w[k] = *(const f32x4*)(cw + k * UW + ch);
        const f32x4 bias = *(const f32x4*)(cb + ch);
        f32x4 x[20];
#pragma unroll
        for (int i = 0; i < 20; ++i) { const int s = s0 - 2 + i; u32x2 v = {0u, 0u}; if (s >= 0 && s < L) v = *(const u32x2*)(P + (size_t)(row0 - 2 + i) * NIN + XBC0 + ch);
            x[i] = (f32x4){bflo(v.x), bfhi(v.x), bflo(v.y), bfhi(v.y)}; }
#pragma unroll
        for (int t = 0; t < 16; ++t) {
            const f32x4 a = bias + w[0] * x[t] + w[1] * x[t + 1] + w[2] * x[t + 2] + w[3] * x[t + 3] + w[4] * x[t + 4];
            u32x2 o; o.x = pk2(silu_f(a.x), silu_f(a.y)); o.y = pk2(silu_f(a.z), silu_f(a.w));
            *(u32x2*)(U + (size_t)(row0 + t) * UW + ch) = o;
        }
    }
}

DI void ssd_scalars(LAS float* sc, int tid, const float* DT, int row0, const float* alog, const float* dtb, float* dec_f, float* dec_b) {
    const int lane = tid & 63, wave = tid >> 6;
    if (wave < 4) {
        const int h = wave;
        const float r0 = DT[(size_t)(row0 + 2 * lane) * 4 + h], r1 = DT[(size_t)(row0 + 2 * lane + 1) * 4 + h];
        const float ea0 = __expf(alog[h]), ea1 = __expf(alog[4 + h]);
        const float d00 = softplus_f(r0 + dtb[h]), d01 = softplus_f(r1 + dtb[h]);
        const float d10 = softplus_f(r0 + dtb[4 + h]), d11 = softplus_f(r1 + dtb[4 + h]);
        const float la00 = -d00 * ea0, la01 = -d01 * ea0, la10 = -d10 * ea1, la11 = -d11 * ea1;
        float pf = la00 + la01, pb = la10 + la11;
#pragma unroll
        for (int o = 1; o < 64; o <<= 1) { const float tf = __shfl_up(pf, o), tb = __shfl_up(pb, o); if (lane >= o) { pf += tf; pb += tb; } }
        const float totb = __shfl(pb, 63), totf = __shfl(pf, 63);
        sc[(SC_ACF * 4 + h) * 128 + 2 * lane + 1] = pf; sc[(SC_ACF * 4 + h) * 128 + 2 * lane] = pf - la01;
        sc[(SC_ACB * 4 + h) * 128 + 2 * lane + 1] = totb - pb + la11; sc[(SC_ACB * 4 + h) * 128 + 2 * lane] = totb - (pb - la11) + la10;
        sc[(SC_DT0 * 4 + h) * 128 + 2 * lane] = d00; sc[(SC_DT0 * 4 + h) * 128 + 2 * lane + 1] = d01;
        sc[(SC_DT1 * 4 + h) * 128 + 2 * lane] = d10; sc[(SC_DT1 * 4 + h) * 128 + 2 * lane + 1] = d11;
        if (dec_f && lane == 0) { dec_f[h] = __expf(totf); dec_b[h] = __expf(totb); }
    }
}

DI f32x16 zero16() { f32x16 z;
#pragma unroll
    for (int i = 0; i < 16; ++i) z[i] = 0.f;
    return z; }
template <int KSTEPS> DI f32x16 mma_lds(f32x16 acc, const LAS bf16* Ap, int pa, const LAS bf16* Bp, int pb, int lane) {
    const int r32 = lane & 31, hi = lane >> 5;
    Ap += r32 * pa + 8 * hi; Bp += r32 * pb + 8 * hi;
#pragma unroll
    for (int ks = 0; ks < KSTEPS; ++ks) { const bf16x8 a = *(const LAS bf16x8*)(Ap + 16 * ks), bq = *(const LAS bf16x8*)(Bp + 16 * ks); acc = MFMA32(a, bq, acc); }
    return acc;
}

template <int C, bool SCALED> DI void stage_T(LAS bf16* d0, LAS bf16* d1, const bf16* __restrict__ src, int spitch, const LAS float* w0, const LAS float* w1, int tid) {
    constexpr int OC = C / 8;
#pragma unroll
    for (int it0 = 0; it0 < 64 * OC; it0 += NTHREADS) {
        const int it = it0 + tid, oct = it % OC, tp = it / OC;
        const u32x4 r0 = *(const u32x4*)(src + (size_t)(2 * tp) * spitch + oct * 8), r1 = *(const u32x4*)(src + (size_t)(2 * tp + 1) * spitch + oct * 8);
        const unsigned a[4] = {r0.x, r0.y, r0.z, r0.w}, bq[4] = {r1.x, r1.y, r1.z, r1.w};
        if (!SCALED) {
#pragma unroll
            for (int k = 0; k < 4; ++k) {
                *(LAS unsigned*)(d0 + (oct * 8 + 2 * k) * TP + 2 * tp) = (a[k] & 0xffffu) | (bq[k] << 16);
                *(LAS unsigned*)(d0 + (oct * 8 + 2 * k + 1) * TP + 2 * tp) = (a[k] >> 16) | (bq[k] & 0xffff0000u);
            }
        } else {
            const float u0 = w0[2 * tp], u1 = w0[2 * tp + 1], v0 = w1[2 * tp], v1 = w1[2 * tp + 1];
#pragma unroll
            for (int k = 0; k < 4; ++k) {
                const float e0 = bflo(a[k]), e1 = bfhi(a[k]), f0 = bflo(bq[k]), f1 = bfhi(bq[k]);
                *(LAS unsigned*)(d0 + (oct * 8 + 2 * k) * TP + 2 * tp) = pk2(e0 * u0, f0 * u1);
                *(LAS unsigned*)(d0 + (oct * 8 + 2 * k + 1) * TP + 2 * tp) = pk2(e1 * u0, f1 * u1);
                *(LAS unsigned*)(d1 + (oct * 8 + 2 * k) * TP + 2 * tp) = pk2(e0 * v0, f0 * v1);
                *(LAS unsigned*)(d1 + (oct * 8 + 2 * k + 1) * TP + 2 * tp) = pk2(e1 * v0, f1 * v1);
            }
        }
    }
}
template <int R, int C> DI void stage_N(LAS bf16* d, int dp, const bf16* __restrict__ src, int spitch, int tid) {
    constexpr int OC = C / 8;
#pragma unroll
    for (int it0 = 0; it0 < R * OC; it0 += NTHREADS) { const int it = it0 + tid, oct = it % OC, r = it / OC; *(LAS u32x4*)(d + r * dp + oct * 8) = *(const u32x4*)(src + (size_t)r * spitch + oct * 8); }
}

DI void s1_ssd_unit(LAS unsigned char* lds, int tid, const ScanCtx& C, int b, int vc) {
    asm volatile("" : "+v"(tid));
    const int lane = tid & 63, wave = tid >> 6, r32 = lane & 31, hi = lane >> 5;
    LAS float* sc = (LAS float*)lds; LAS float* wts = (LAS float*)(lds + L_STAT);
    LAS bf16* BkT = (LAS bf16*)(lds + L_BUF); LAS bf16* XF = (LAS bf16*)(lds + L_BUF + 34816); LAS bf16* XB = (LAS bf16*)(lds + L_BUF + 34816 + 17408);
    const int row0 = vc_row0(b, vc);
    float* decp = C.dec + (size_t)((b * NVC + vc) * 2) * 8;
    __syncthreads();
    ssd_scalars(sc, tid, C.DT, row0, C.alog, C.dtb, decp, decp + 8);
    __syncthreads();
    { const int h = tid >> 7, s = tid & 127;
      wts[h * 128 + s] = __expf(sc[(SC_ACF * 4 + h) * 128 + 127] - sc[(SC_ACF * 4 + h) * 128 + s]) * sc[(SC_DT0 * 4 + h) * 128 + s];
      wts[(4 + h) * 128 + s] = __expf(sc[(SC_ACB * 4 + h) * 128 + 0] - sc[(SC_ACB * 4 + h) * 128 + s]) * sc[(SC_DT1 * 4 + h) * 128 + s]; }
    const bf16* Urow = C.U + (size_t)row0 * UW;
    for (int g = 0; g < 2; ++g) {
        __syncthreads();
        stage_T<128, false>(BkT, BkT, Urow + 256 + g * 128, UW, nullptr, nullptr, tid);
        for (int hh = 0; hh < 2; ++hh) {
            const int h = 2 * g + hh;
            if (hh) __syncthreads();
            stage_T<64, true>(XF, XB, Urow + h * 64, UW, wts + h * 128, wts + (4 + h) * 128, tid);
            __syncthreads();
            const int pt = wave >> 2, nt = wave & 3;
            f32x16 af = zero16(), ab = zero16();
            { const LAS bf16* Bp = BkT + (nt * 32 + r32) * TP + 8 * hi; const LAS bf16* Af = XF + (pt * 32 + r32) * TP + 8 * hi; const LAS bf16* Ab = XB + (pt * 32 + r32) * TP + 8 * hi;
#pragma unroll
              for (int ks = 0; ks < 8; ++ks) { const bf16x8 bq = *(const LAS bf16x8*)(Bp + 16 * ks); af = MFMA32(*(const LAS bf16x8*)(Af + 16 * ks), bq, af); ab = MFMA32(*(const LAS bf16x8*)(Ab + 16 * ks), bq, ab); } }
            bf16* of = C.sts + ((size_t)(((b * NVC + vc) * 2 + 0) * 4 + h)) * 8192; bf16* ob = C.sts + ((size_t)(((b * NVC + vc) * 2 + 1) * 4 + h)) * 8192;
#pragma unroll
            for (int i = 0; i < 16; ++i) { const int p = pt * 32 + 8 * (i >> 2) + 4 * hi + (i & 3), n = nt * 32 + r32; of[p * 128 + n] = f2bf(af[i]); ob[p * 128 + n] = f2bf(ab[i]); }
        }
    }
}
DI void s1_ret_unit(LAS unsigned char* lds, int tid, const ScanCtx& C, int b, int vc, int h0, int nh) {
    asm volatile("" : "+v"(tid));
    const int lane = tid & 63, wave = tid >> 6, r32 = lane & 31, hi = lane >> 5;
    LAS float* wts = (LAS float*)(lds + L_STAT);
    LAS bf16* KT = (LAS bf16*)(lds + L_BUF); LAS bf16* VF = (LAS bf16*)(lds + L_BUF + 17408); LAS bf16* VB = (LAS bf16*)(lds + L_BUF + 2 * 17408);
    const int row0 = vc_row0(b, vc);
    float* decp = C.dec + (size_t)((b * NVC + vc) * 2) * 8;
    __syncthreads();
    { const int h = tid >> 7, s = tid & 127; const float lg0 = C.rlg[h], lg1 = C.rlg[4 + h];
      wts[h * 128 + s] = __expf((float)(127 - s) * lg0); wts[(4 + h) * 128 + s] = __expf((float)s * lg1);
      if (s == 0) { decp[4 + h] = __expf(128.f * lg0); decp[8 + 4 + h] = __expf(128.f * lg1); } }
    const bf16* Prow = C.P + (size_t)row0 * NIN;
#pragma unroll 1
    for (int h = h0; h < h0 + nh; ++h) {
        __syncthreads();
        stage_T<64, false>(KT, KT, Prow + 2816 + h * 64, NIN, nullptr, nullptr, tid);
        stage_T<64, true>(VF, VB, Prow + 3072 + h * 64, NIN, wts + h * 128, wts + (4 + h) * 128, tid);
        __syncthreads();
        const int dir = wave >> 2, pt = (wave >> 1) & 1, nt = wave & 1;
        const f32x16 a = mma_lds<8>(zero16(), (dir ? VB : VF) + pt * 32 * TP, TP, KT + nt * 32 * TP, TP, lane);
        bf16* o = C.str + ((size_t)(((b * NVC + vc) * 2 + dir) * 4 + h)) * 4096;
#pragma unroll
        for (int i = 0; i < 16; ++i) { const int p = pt * 32 + 8 * (i >> 2) + 4 * hi + (i & 3), n = nt * 32 + r32; o[p * 64 + n] = f2bf(a[i]); }
    }
}

DI int s2_order(int dir, int step) { return dir == 0 ? step : (step == 0 ? 1 : (step == 1 ? 0 : 35 - step)); }
DI void s2_item(const ScanCtx& C, int gt) {
    bf16* base; int hh, dir, b; size_t vcstride;
    if (gt < 65536) { const int v = gt & 1023, h = (gt >> 10) & 3; dir = (gt >> 12) & 1; b = gt >> 13; hh = h; base = C.sts + (size_t)((b * NVC * 2 + dir) * 4 + h) * 8192 + v * 8; vcstride = (size_t)2 * 4 * 8192; }
    else if (gt < 65536 + 32768) { const int g2 = gt - 65536; const int v = g2 & 511, h = (g2 >> 9) & 3; dir = (g2 >> 11) & 1; b = g2 >> 12; hh = 4 + h; base = C.str + (size_t)((b * NVC * 2 + dir) * 4 + h) * 4096 + v * 8; vcstride = (size_t)2 * 4 * 4096; }
    else return;
    float s[8]; float zf = 0.f; asm volatile("" : "+v"(zf));
#pragma unroll
    for (int i = 0; i < 8; ++i) s[i] = zf;
#define S2_LD(k, st_) { const int vc_ = s2_order(dir, (st_)); v##k = *(const u32x4*)(base + (size_t)vc_ * vcstride); d##k = C.dec[(size_t)((b * NVC + vc_) * 2 + dir) * 8 + hh]; }
#define S2_ST(k, st_) { const int vc_ = s2_order(dir, (st_)); u32x4 w_; w_.x = pk2(s[0], s[1]); w_.y = pk2(s[2], s[3]); w_.z = pk2(s[4], s[5]); w_.w = pk2(s[6], s[7]); \
        *(u32x4*)(base + (size_t)vc_ * vcstride) = w_; \
        s[0] = s[0] * d##k + bflo(v##k.x); s[1] = s[1] * d##k + bfhi(v##k.x); s[2] = s[2] * d##k + bflo(v##k.y); s[3] = s[3] * d##k + bfhi(v##k.y); \
        s[4] = s[4] * d##k + bflo(v##k.z); s[5] = s[5] * d##k + bfhi(v##k.z); s[6] = s[6] * d##k + bflo(v##k.w); s[7] = s[7] * d##k + bfhi(v##k.w); }
    u32x4 v0, v1, v2, v3, v4, v5, v6, v7; float d0, d1, d2, d3, d4, d5, d6, d7;
    S2_LD(0, 0) S2_LD(1, 1) S2_LD(2, 2) S2_LD(3, 3) S2_LD(4, 4) S2_LD(5, 5) S2_LD(6, 6) S2_LD(7, 7)
#pragma unroll 1
    for (int step = 0; step < 32; step += 8) {
        S2_ST(0, step) if (step + 8 < NVC) S2_LD(0, step + 8)
        S2_ST(1, step + 1) if (step + 9 < NVC) S2_LD(1, step + 9)
        S2_ST(2, step + 2) if (step + 10 < NVC) S2_LD(2, step + 10)
        S2_ST(3, step + 3) if (step + 11 < NVC) S2_LD(3, step + 11)
        S2_ST(4, step + 4) if (step + 12 < NVC) S2_LD(4, step + 12)
        S2_ST(5, step + 5) if (step + 13 < NVC) S2_LD(5, step + 13)
        S2_ST(6, step + 6) if (step + 14 < NVC) S2_LD(6, step + 14)
        S2_ST(7, step + 7) if (step + 15 < NVC) S2_LD(7, step + 15)
    }
    S2_ST(0, 32) S2_ST(1, 33)
#undef S2_LD
#undef S2_ST
}

DI void s2_phase(const ScanCtx& C, int tid, int bid, int G) {
#pragma unroll 1
    for (int gt = bid * NTHREADS + tid; gt < 65536 + 32768; gt += G * NTHREADS) s2_item(C, gt);
}

DI void s3_ssd_unit(LAS unsigned char* lds, int tid, const ScanCtx& C, int b, int vc) {
    asm volatile("" : "+v"(tid));
    const int lane = tid & 63, wave = tid >> 6, r32 = lane & 31, hi = lane >> 5;
    LAS float* sc = (LAS float*)lds; LAS float* stat = (LAS float*)(lds + L_STAT);
    LAS bf16* Cq = (LAS bf16*)(lds + L_BUF); LAS bf16* BkM = (LAS bf16*)(lds + L_BUF + 34816); LAS bf16* XsT = (LAS bf16*)(lds + L_BUF + 2 * 34816);
    LAS bf16* Hf = (LAS bf16*)(lds + L_BUF + 2 * 34816 + 17408); LAS bf16* Hb = (LAS bf16*)(lds + L_BUF + 2 * 34816 + 2 * 17408);
    const int row0 = vc_row0(b, vc);
    const int pt = wave & 1, tt = wave >> 1;
    const bf16* Urow = C.U + (size_t)row0 * UW;
    __syncthreads();
    ssd_scalars(sc, tid, C.DT, row0, C.alog, C.dtb, nullptr, nullptr);
    float ssq = 0.f;
    const int tq_ = tt * 32 + r32; const int rowq = row0 + tq_;
#pragma unroll 1
    for (int g = 0; g < 2; ++g) {
        __syncthreads();
        stage_N<128, 128>(Cq, TP, Urow + 512 + g * 128, UW, tid);
        stage_N<128, 128>(BkM, TP, Urow + 256 + g * 128, UW, tid);
        __syncthreads();
        f32x16 gacc0, gacc1;
        { const int id = 2 * wave, st = id & 3, tq = id >> 2; gacc0 = mma_lds<8>(zero16(), BkM + st * 32 * TP, TP, Cq + tq * 32 * TP, TP, lane); }
        { const int id = 2 * wave + 1, st = id & 3, tq = id >> 2; gacc1 = mma_lds<8>(zero16(), BkM + st * 32 * TP, TP, Cq + tq * 32 * TP, TP, lane); }
#pragma unroll 1
        for (int hh = 0; hh < 2; ++hh) {
            const int h = 2 * g + hh;
            __syncthreads();
            const int oct_ = tid & 7, tp_ = tid >> 3;
            const u32x4 xr0 = *(const u32x4*)(Urow + h * 64 + (size_t)(2 * tp_) * UW + oct_ * 8), xr1 = *(const u32x4*)(Urow + h * 64 + (size_t)(2 * tp_ + 1) * UW + oct_ * 8);
            const bf16* sfp = C.sts + ((size_t)(((b * NVC + vc) * 2 + 0) * 4 + h)) * 8192; const bf16* sbp = C.sts + ((size_t)(((b * NVC + vc) * 2 + 1) * 4 + h)) * 8192;
            u32x4 hfv[2], hbv[2];
#pragma unroll
            for (int i = 0; i < 2; ++i) { const int itn = tid + NTHREADS * i, octn = itn & 15, rn = itn >> 4; hfv[i] = *(const u32x4*)(sfp + rn * 128 + octn * 8); hbv[i] = *(const u32x4*)(sbp + rn * 128 + octn * 8); }
            u32x2 zz[4];
#pragma unroll
            for (int g4 = 0; g4 < 4; ++g4) zz[g4] = *(const u32x2*)(C.P + (size_t)rowq * NIN + 1536 + h * 64 + pt * 32 + 8 * g4 + 4 * hi);
            { const LAS float* acf = sc + (SC_ACF * 4 + h) * 128; const LAS float* acb = sc + (SC_ACB * 4 + h) * 128; const LAS float* d0 = sc + (SC_DT0 * 4 + h) * 128; const LAS float* d1 = sc + (SC_DT1 * 4 + h) * 128;
#pragma unroll
              for (int q = 0; q < 2; ++q) { const int id = 2 * wave + q, st = id & 3, tq = id >> 2; const int t = tq * 32 + r32; const float aft = acf[t], abt = acb[t];
#pragma unroll
                  for (int g4 = 0; g4 < 4; ++g4) { float mv[4];
#pragma unroll
                      for (int j = 0; j < 4; ++j) { const int s = st * 32 + 8 * g4 + 4 * hi + j;
                          float f; if (s < t) f = __expf(aft - acf[s]) * d0[s]; else if (s > t) f = __expf(abt - acb[s]) * d1[s]; else f = d0[s] + d1[s];
                          mv[j] = (q ? gacc1[4 * g4 + j] : gacc0[4 * g4 + j]) * f; }
                      u32x2 w; w.x = pk2(mv[0], mv[1]); w.y = pk2(mv[2], mv[3]);
                      *(LAS u32x2*)(BkM + t * TP + st * 32 + 8 * g4 + 4 * hi) = w; } } }
            { const unsigned a_[4] = {xr0.x, xr0.y, xr0.z, xr0.w}, b_[4] = {xr1.x, xr1.y, xr1.z, xr1.w};
#pragma unroll
              for (int k = 0; k < 4; ++k) {
                  *(LAS unsigned*)(XsT + (oct_ * 8 + 2 * k) * TP + 2 * tp_) = (a_[k] & 0xffffu) | (b_[k] << 16);
                  *(LAS unsigned*)(XsT + (oct_ * 8 + 2 * k + 1) * TP + 2 * tp_) = (a_[k] >> 16) | (b_[k] & 0xffff0000u); }
#pragma unroll
              for (int i = 0; i < 2; ++i) { const int itn = tid + NTHREADS * i, octn = itn & 15, rn = itn >> 4; *(LAS u32x4*)(Hf + rn * TP + octn * 8) = hfv[i]; *(LAS u32x4*)(Hb + rn * TP + octn * 8) = hbv[i]; } }
            __syncthreads();
            f32x16 y = mma_lds<8>(zero16(), XsT + pt * 32 * TP, TP, BkM + tt * 32 * TP, TP, lane);
            { const float dsum = C.ssmd[h] + C.ssmd[4 + h];
#pragma unroll
              for (int i = 0; i < 16; ++i) { const int p = pt * 32 + 8 * (i >> 2) + 4 * hi + (i & 3); y[i] += dsum * bf2f(XsT[p * TP + tq_]); } }
            __builtin_amdgcn_sched_barrier(0);
            { const f32x16 af = mma_lds<8>(zero16(), Hf + pt * 32 * TP, TP, Cq + tt * 32 * TP, TP, lane);
              const float ef = __expf(sc[(SC_ACF * 4 + h) * 128 + tq_]);
#pragma unroll
              for (int i = 0; i < 16; ++i) y[i] += ef * af[i]; }
            __builtin_amdgcn_sched_barrier(0);
            { const f32x16 ab = mma_lds<8>(zero16(), Hb + pt * 32 * TP, TP, Cq + tt * 32 * TP, TP, lane);
              const float eb = __expf(sc[(SC_ACB * 4 + h) * 128 + tq_]);
#pragma unroll
              for (int i = 0; i < 16; ++i) y[i] += eb * ab[i]; }
#pragma unroll
            for (int g4 = 0; g4 < 4; ++g4) {
                const int p = pt * 32 + 8 * g4 + 4 * hi;
                const float v0 = y[4 * g4] * silu_f(bflo(zz[g4].x)), v1 = y[4 * g4 + 1] * silu_f(bfhi(zz[g4].x)), v2 = y[4 * g4 + 2] * silu_f(bflo(zz[g4].y)), v3 = y[4 * g4 + 3] * silu_f(bfhi(zz[g4].y));
                ssq += v0 * v0 + v1 * v1 + v2 * v2 + v3 * v3;
                u32x2 w; w.x = pk2(v0, v1); w.y = pk2(v2, v3);
                *(u32x2*)(C.MG + (size_t)rowq * DM + 512 + h * 64 + p) = w;
            }
        }
    }
    ssq += __shfl_xor(ssq, 32);
    __syncthreads();
    if (hi == 0) stat[tq_ * 2 + pt] = ssq;
    __syncthreads();
    const float rn = 1.0f / sqrtf((stat[tq_ * 2] + stat[tq_ * 2 + 1]) * (1.0f / 256.0f) + 1e-6f);
#pragma unroll
    for (int h = 0; h < 4; ++h)
#pragma unroll
        for (int g4 = 0; g4 < 4; ++g4) {
            const int p = pt * 32 + 8 * g4 + 4 * hi;
            const f32x4 gv = *(const f32x4*)(C.ssmg + h * 64 + p);
            u32x2* mp = (u32x2*)(C.MG + (size_t)rowq * DM + 512 + h * 64 + p);
            const u32x2 v = *mp;
            u32x2 w; w.x = pk2(bflo(v.x) * rn * gv.x, bfhi(v.x) * rn * gv.y); w.y = pk2(bflo(v.y) * rn * gv.z, bfhi(v.y) * rn * gv.w);
            *mp = w;
        }
}
DI void s3_ret_unit(LAS unsigned char* lds, int tid, const ScanCtx& C, int b, int vc, int h0, int nh) {
    asm volatile("" : "+v"(tid));
    const int lane = tid & 63, wave = tid >> 6, r32 = lane & 31, hi = lane >> 5;
    LAS float* stat = (LAS float*)(lds + L_STAT);
    LAS bf16* Q = (LAS bf16*)(lds + L_BUF); LAS bf16* K = (LAS bf16*)(lds + L_BUF + 18432); LAS bf16* VT = (LAS bf16*)(lds + L_BUF + 2 * 18432);
    LAS bf16* Hf = (LAS bf16*)(lds + L_BUF + 2 * 18432 + 17408); LAS bf16* Hb = (LAS bf16*)(lds + L_BUF + 2 * 18432 + 17408 + 9216); LAS bf16* MB = (LAS bf16*)(lds + L_BUF + 2 * 18432 + 17408 + 2 * 9216);
    const int row0 = vc_row0(b, vc);
    const int pt = wave & 1, tt = wave >> 1;
    const bf16* Prow = C.P + (size_t)row0 * NIN;
    const int t = tt * 32 + r32; const int row = row0 + t;
#pragma unroll 1
    for (int h = h0; h < h0 + nh; ++h) {
        const float lg0 = C.rlg[h], lg1 = C.rlg[4 + h];
        __syncthreads();
        stage_N<128, 64>(Q, QP, Prow + 2560 + h * 64, NIN, tid);
        stage_N<128, 64>(K, QP, Prow + 2816 + h * 64, NIN, tid);
        stage_T<64, false>(VT, VT, Prow + 3072 + h * 64, NIN, nullptr, nullptr, tid);
        stage_N<64, 64>(Hf, QP, C.str + ((size_t)(((b * NVC + vc) * 2 + 0) * 4 + h)) * 4096, 64, tid);
        stage_N<64, 64>(Hb, QP, C.str + ((size_t)(((b * NVC + vc) * 2 + 1) * 4 + h)) * 4096, 64, tid);
        __syncthreads();
#pragma unroll
        for (int q = 0; q < 2; ++q) { const int id = 2 * wave + q, st = id & 3, tq = id >> 2;
            const f32x16 gacc = mma_lds<4>(zero16(), K + st * 32 * QP, QP, Q + tq * 32 * QP, QP, lane);
            const int t2 = tq * 32 + r32;
#pragma unroll
            for (int g4 = 0; g4 < 4; ++g4) { float mv[4];
#pragma unroll
                for (int j = 0; j < 4; ++j) { const int s = st * 32 + 8 * g4 + 4 * hi + j;
                    const float f = (s < t2) ? __expf((float)(t2 - s) * lg0) : ((s > t2) ? __expf((float)(s - t2) * lg1) : 2.0f);
                    mv[j] = gacc[4 * g4 + j] * f; }
                u32x2 w; w.x = pk2(mv[0], mv[1]); w.y = pk2(mv[2], mv[3]);
                *(LAS u32x2*)(MB + t2 * TP + st * 32 + 8 * g4 + 4 * hi) = w; } }
        __syncthreads();
        u32x2 ggv[4];
#pragma unroll
        for (int g4 = 0; g4 < 4; ++g4) ggv[g4] = *(const u32x2*)(C.P + (size_t)row * NIN + 3328 + h * 64 + pt * 32 + 8 * g4 + 4 * hi);
        f32x16 y = mma_lds<8>(zero16(), VT + pt * 32 * TP, TP, MB + tt * 32 * TP, TP, lane);
        { const f32x16 af = mma_lds<4>(zero16(), Hf + pt * 32 * QP, QP, Q + tt * 32 * QP, QP, lane);
          const float ef = __expf((float)(t + 1) * lg0);
#pragma unroll
          for (int i = 0; i < 16; ++i) y[i] += ef * af[i]; }
        { const f32x16 ab = mma_lds<4>(zero16(), Hb + pt * 32 * QP, QP, Q + tt * 32 * QP, QP, lane);
          const float eb = __expf((float)(128 - t) * lg1);
#pragma unroll
          for (int i = 0; i < 16; ++i) y[i] += eb * ab[i]; }
        float s1 = 0.f, s2 = 0.f;
#pragma unroll
        for (int i = 0; i < 16; ++i) { s1 += y[i]; s2 += y[i] * y[i]; }
        s1 += __shfl_xor(s1, 32); s2 += __shfl_xor(s2, 32);
        if (hi == 0) { stat[(t * 2 + pt) * 2] = s1; stat[(t * 2 + pt) * 2 + 1] = s2; }
        __syncthreads();
        const float t1 = stat[(t * 2) * 2] + stat[(t * 2 + 1) * 2], t2s = stat[(t * 2) * 2 + 1] + stat[(t * 2 + 1) * 2 + 1];
        const float mean = t1 * (1.0f / 64.0f), var = fmaxf(t2s * (1.0f / 64.0f) - mean * mean, 0.f), rs = 1.0f / sqrtf(var + 1e-5f);
#pragma unroll
        for (int g4 = 0; g4 < 4; ++g4) {
            const int p = pt * 32 + 8 * g4 + 4 * hi;
            const float g0 = silu_f(bflo(ggv[g4].x)), g1 = silu_f(bfhi(ggv[g4].x)), g2 = silu_f(bflo(ggv[g4].y)), g3 = silu_f(bfhi(ggv[g4].y));
            u32x2 w; w.x = pk2((y[4 * g4] - mean) * rs * g0, (y[4 * g4 + 1] - mean) * rs * g1); w.y = pk2((y[4 * g4 + 2] - mean) * rs * g2, (y[4 * g4 + 3] - mean) * rs * g3);
            *(u32x2*)(C.MG + (size_t)row * DM + 768 + h * 64 + p) = w;
        }
    }
}

constexpr int NPP = 13, NPH = 2 + NPP * DEPTH;
#ifndef PMASK
#define PMASK 0xffff
#endif
#define PEN(k) ((PMASK >> (k)) & 1)
#ifndef PROBE_LASTONLY
#define PROBE_LASTONLY 0
#endif
#ifndef PROBE_N
#define PROBE_N 1
#endif
#ifndef REP_SPLIT
#define REP_SPLIT 1
#endif
#ifndef REP_P0
#define REP_P0 1
#endif
#ifndef REP_LN
#define REP_LN 1
#endif
#ifndef REP_SYNC
#define REP_SYNC 1
#endif
#ifndef REP_ATTN
#define REP_ATTN 1
#endif
#ifndef REP_UP
#define REP_UP 1
#endif
#ifndef REP_IN
#define REP_IN 1
#endif
#ifndef REP_SCAN
#define REP_SCAN 1
#endif

#define GAS __attribute__((address_space(1)))
#define XB_TMO      128
#define XB_XCNT(j)  (256  + 64 * (j))
#define XB_XSUB(j)  (1280 + 64 * (j))
#define XB_XGEN(j)  (2304 + 64 * (j))
#define XB_TOP      3328
#define XB_TOPGEN   3392
#define XCD_BAR_WORDS 3456
#define XB_SPIN_CAP (1u << 18)

__device__ __forceinline__ unsigned xb_ld(unsigned* p)              { return __hip_atomic_load(p, __ATOMIC_RELAXED, __HIP_MEMORY_SCOPE_AGENT); }
__device__ __forceinline__ unsigned xb_add(unsigned* p, unsigned v) { return __hip_atomic_fetch_add(p, v, __ATOMIC_RELAXED, __HIP_MEMORY_SCOPE_AGENT); }
__device__ __forceinline__ unsigned xb_xcc_id() { return (unsigned)__builtin_amdgcn_s_getreg((3 << 11) | 20) & 0xFu; }
#define XB_SPIN(cond, bar) do { unsigned _sp = 0; while (cond) { __builtin_amdgcn_s_sleep(1); \
    if ((++_sp & 255u) == 0u) { if (xb_ld(&(bar)[XB_TMO])) break; if (_sp > XB_SPIN_CAP) { atomicAdd(&(bar)[XB_TMO], 1u); break; } } } } while (0)

struct XcdBarrier {
    unsigned* bar; unsigned x;
    volatile LAS unsigned* st;
};

__device__ __forceinline__ XcdBarrier xcd_barrier_post(unsigned* bar, volatile LAS unsigned* st) {
    XcdBarrier b; b.bar = bar; b.x = xb_xcc_id(); b.st = st;
    if (threadIdx.x == 0) (void)xb_add(&bar[XB_XCNT(b.x)], 1u);
    return b;
}
__device__ __forceinline__ void xcd_barrier_complete(unsigned* bar, unsigned x, unsigned& nloc, unsigned& nx) {
    const unsigned G = gridDim.x * gridDim.y * gridDim.z;
    unsigned sum, cnt, mine, sp = 0u;
    for (;;) {
        sum = 0u; cnt = 0u; mine = 0u;
#pragma unroll
        for (unsigned j = 0; j < 16; ++j) { const unsigned c = xb_ld(&bar[XB_XCNT(j)]); sum += c; cnt += (c > 0u) ? 1u : 0u; mine = (j == x) ? c : mine; }
        if (sum == G) break;
        __builtin_amdgcn_s_sleep(1);
        if ((++sp & 255u) == 0u) { if (xb_ld(&bar[XB_TMO])) break; if (sp > XB_SPIN_CAP) { atomicAdd(&bar[XB_TMO], 1u); break; } }
    }
    nloc = mine > 0u ? mine : 1u; nx = cnt > 0u ? cnt : 1u;
}

__device__ __forceinline__ void xcd_barrier(const XcdBarrier& b) {
    asm volatile("s_waitcnt vmcnt(0)" ::: "memory");
    __syncthreads();
    if (threadIdx.x == 0) {
        unsigned* bar = b.bar;
        __builtin_amdgcn_s_waitcnt(0);
        unsigned nloc = b.st[0], nx = b.st[1];
        if (nloc == 0u) { xcd_barrier_complete(bar, b.x, nloc, nx); b.st[0] = nloc; b.st[1] = nx; }
        const unsigned old = xb_add(&bar[XB_XSUB(b.x)], 1u);
        const unsigned gen = old / nloc;
        if (old + 1u == (gen + 1u) * nloc) {
            __builtin_amdgcn_fence(__ATOMIC_RELEASE, "agent");
            asm volatile("s_waitcnt vmcnt(0)" ::: "memory");
            const unsigned og = xb_add(&bar[XB_TOP], 1u);
            const unsigned tg = og / nx;
            if (og + 1u == (tg + 1u) * nx) xb_add(&bar[XB_TOPGEN], 1u);
            else XB_SPIN(xb_ld(&bar[XB_TOPGEN]) == tg, bar);
            __builtin_amdgcn_fence(__ATOMIC_ACQUIRE, "agent");
            xb_add(&bar[XB_XGEN(b.x)], 1u);
            asm volatile("s_waitcnt vmcnt(0)" ::: "memory");
        } else {
            XB_SPIN(xb_ld(&bar[XB_XGEN(b.x)]) == gen, bar);
            __builtin_amdgcn_fence(__ATOMIC_ACQUIRE, "agent");
            asm volatile("s_waitcnt vmcnt(0)" ::: "memory");
        }
    }
    __syncthreads();
}
template <class Epi> DI void run_gemm(LAS unsigned char* lds, int tid, const bf16* Ap, const bf16* Bt, int M, int N, int K, int G, int bid, const Epi& E, int ld = 0) {
    pg8::Gemm g{Ap, Bt, M, N, K, ld ? ld : K}; pg8::StaticOrder S; S.init(M, N, G, bid);
    pg8::gemm_phase<Epi, pg8::StaticOrder, true, true>(lds, g, S, E, tid);
}

__global__ void __launch_bounds__(NTHREADS, 2) mega(Args A) {
    extern __shared__ __attribute__((aligned(16))) unsigned char lds_raw[];
    LAS unsigned char* lds = (LAS unsigned char*)lds_raw;
    cg::grid_group grid = cg::this_grid();
    const int tid0 = threadIdx.x, bid0 = blockIdx.x, G0 = gridDim.x;
    { volatile LAS unsigned* bst0 = (volatile LAS unsigned*)(lds + LDS_BYTES - 64); if (tid0 < 16) bst0[tid0] = 0u;
      if (bid0 == 0) { unsigned* bw = (unsigned*)(A.ws + WS_BAR); for (int i = tid0; i < XCD_BAR_WORDS; i += NTHREADS) bw[i] = 0u; } }
    __syncthreads();
    int rep_done = 0; (void)rep_done;
    for (int ph = A.ph_lo; ph < A.ph_hi; ++ph) {
        if (ph > A.ph_lo) {
            if (ph == A.ph_lo + 1) { grid.sync(); (void)xcd_barrier_post((unsigned*)(A.ws + WS_BAR), (volatile LAS unsigned*)(lds + LDS_BYTES - 64)); }
            else { for (int rs_ = 0; rs_ < REP_SYNC; ++rs_) { XcdBarrier xb_; xb_.bar = (unsigned*)(A.ws + WS_BAR); xb_.x = xb_xcc_id(); xb_.st = (volatile LAS unsigned*)(lds + LDS_BYTES - 64); xcd_barrier(xb_); } }
        }
        int tid = tid0, bid = bid0, G = G0; size_t zoff = 0;
        asm volatile("" : "+v"(tid)); asm volatile("" : "+s"(bid)); asm volatile("" : "+s"(G)); asm volatile("" : "+s"(zoff));
        unsigned char* ws = A.ws + zoff;
        float* xc = (float*)(ws + WS_XC);
        bf16* Abuf = (bf16*)(ws + WS_A); bf16* HP = (bf16*)(ws + WS_HP); bf16* Vt = (bf16*)(ws + WS_VT);
        const float* MOD = (const float*)(ws + WS_MOD);
        if (ph == 0) { if (PEN(0)) for (int rp_ = 0; rp_ < REP_P0; ++rp_) { p0a_phase(A, lds, tid, bid, G); __syncthreads(); } continue; }
        if (ph == 1) { if (PEN(1)) for (int rp_ = 0; rp_ < REP_LN; ++rp_) lnmod_phase(A, lds, tid, bid, G, true, -1, 0, 0, 0, false, M_ALL, false, nullptr, nullptr); continue; }
        const int q = ph - 2, l = q / NPP; int s = q % NPP; const bool is_conv = (s == 4); if (s >= 4) s -= 1; if (is_conv) s = 100;
        const bool last = (l == DEPTH - 1);
        const int Mpost = last ? M_LAT : M_ALL;
        if ((s == 0 || s == 9) && PEN(2)) {
            const int f = (s == 9); EpiSwiglu E{HP};
            for (int rp_ = 0; rp_ < REP_UP; ++rp_) run_gemm(lds, tid, Abuf, (const bf16*)(ws + WS_WGU) + (size_t)f * NGU * DM, f ? Mpost : M_ALL, NGU, DM, G, bid, E);
        } else if ((s == 1 || s == 10 || s == 7) && PEN(3)) {
            const int i = (s == 1) ? 0 : (s == 7 ? 1 : 2);
            const int prev_idx = (i == 0) ? (l == 0 ? -1 : (l - 1) * 3 + 2) : l * 3 + (i - 1);
            const float* modg_p = MOD + (size_t)l * 9 * 9216 + i * 3072 + 2048;
            const float* scale_v = (s == 7) ? (const float*)(ws + WS_ONES) : (const float*)(ws + WS_HALVES);
            const float* gprev_p = prev_idx < 0 ? (const float*)(ws + WS_ONES) : A.in[I_NG] + prev_idx * DM; const float* bprev_p = prev_idx < 0 ? (const float*)(ws + WS_ZEROS) : A.in[I_NB] + prev_idx * DM;
            EpiResid E{(bf16*)(ws + WS_X16), modg_p, scale_v, (const f32x2*)(ws + WS_STAT), gprev_p, bprev_p};
            const bool has_ctx = (s == 1) || !last;
            const bf16* Ap = (s == 7) ? Abuf : HP; const bf16* Bp = (s == 7) ? (const bf16*)(ws + WS_WOUT) : (const bf16*)(ws + WS_WDN) + (size_t)(s == 10) * DM * DFF;
            const int Kd = (s == 7) ? DM : DFF;
            const int ldd = (s == 7) ? DM : DFF;
            run_gemm(lds, tid, Ap, Bp, M_LAT, DM, Kd, G, bid, E, ldd);
            if (has_ctx) {
                const int sb = (G == 256 && ((bid >> 3) & 7) < 4 && bid < 256) ? ((bid & 7) | (((bid >> 3) & 3) << 3) | ((bid >> 6) << 5)) : (G == 256 ? 999 : (bid + G - 64) % G);
                const int qd = (sb >> 5) & 3;
                const int kt0 = (s == 7) ? 4 * qd : (qd < 2 ? 12 * qd : 24 + 10 * (qd - 2));
                const int ktn = (s == 7) ? 4 : (qd < 2 ? 12 : 10);
                OneUnit S1u; S1u.have = sb < 128; S1u.u.pm = 128 + (sb & 7); S1u.u.pn = (sb >> 3) & 3;
                EpiPartial Ep{(float*)(ws + WS_T) + (size_t)qd * M_CTX * DM, modg_p, scale_v};
                pg8::Gemm g2{Ap + (size_t)kt0 * 64, Bp + (size_t)kt0 * 64, M_ALL, DM, ktn * 64, ldd};
                pg8::gemm_phase<EpiPartial, OneUnit, true, true>(lds, g2, S1u, Ep, tid);
            }
        } else if (s == 2 && PEN(1)) {
            lnmod_phase(A, lds, tid, bid, G, false, l, 0, l, 1, true, M_ALL, true, l == 0 ? (const float*)(ws + WS_ONES) : A.in[I_NG] + ((l - 1) * 3 + 2) * DM, l == 0 ? (const float*)(ws + WS_ZEROS) : A.in[I_NB] + ((l - 1) * 3 + 2) * DM);
        } else if (s == 3 && PEN(4)) {
            EpiIn E{HP, Vt, (const f32x2*)(ws + WS_TATT), (const f32x2*)(ws + WS_TRET)};
            for (int rp_ = 0; rp_ < REP_IN; ++rp_) run_gemm(lds, tid, Abuf, (const bf16*)(ws + WS_WIN), M_ALL, NIN, DM, G, bid, E);
        } else if (is_conv || s == 4 || s == 5 || s == 6) {
            ScanCtx C{HP, (const bf16*)(ws + WS_U), (const float*)(ws + WS_DT), (bf16*)(ws + WS_STS), (bf16*)(ws + WS_STR), (float*)(ws + WS_DEC), Abuf,
                      A.in[I_CONVW] + (size_t)l * 5 * 768, A.in[I_CONVB] + l * 768, A.in[I_ALOG] + l * 8, A.in[I_DTB] + l * 8, A.in[I_SSMD] + l * 8, A.in[I_SSMG] + l * 256, A.in[I_RLG] + l * 8};
            const float lam = ((const float*)(ws + WS_LAM))[l];
            const float lam_init = 0.8f - 0.6f * expf(-0.3f * (float)l);
            const float* subg = A.in[I_SUBG] + l * 128;
            const int r = is_conv ? 0 : s - 3;
            if (PEN(7)) for (int rp_ = 0; rp_ < REP_ATTN; ++rp_) for (int u = bid; u < 256; u += G) { const int bh = r * 8 + (u & 7), qb = u >> 3;
                attn_unit(lds, tid, HP, Vt, Abuf, bh >> 2, bh & 3, (bh >> 2) * SEQ + qb * 128, 0, 68, lam, 1.0f - lam_init, subg); }
            if (is_conv) {
                if (PEN(10)) conv_phase(HP, (bf16*)(ws + WS_U), C.cw, C.cb, tid, bid, G);
            } else if (s == 4) {
                { const int nS1 = NB * NVC, extra1 = (nS1 > G && nS1 < 2 * G) ? nS1 - G : 0;
                  if (PEN(5)) { for (int u = bid; u < nS1; u += G) s1_ssd_unit(lds, tid, C, u / NVC, u % NVC);
                      if (bid >= extra1) for (int r = bid - extra1; r < 4 * nS1; r += G - extra1) { const int v = r >> 2; s1_ret_unit(lds, tid, C, v / NVC, v % NVC, r & 3, 1); } } }
            } else if (s == 5) {
                if (PEN(6)) s2_phase(C, tid, bid, G);
            } else {
                const int vc0 = last ? 2 : 0, nvc = NVC - vc0;
                const int nS = NB * nvc, extra = (nS > G && nS < 2 * G) ? nS - G : 0;
                if (PEN(8)) for (int u = bid; u < nS; u += G) s3_ssd_unit(lds, tid, C, u / nvc, vc0 + u % nvc);
                if (PEN(9) && bid >= extra) for (int r = bid - extra; r < 4 * nS; r += G - extra) { const int v = r >> 2; s3_ret_unit(lds, tid, C, v / nvc, vc0 + v % nvc, r & 3, 1); }
                if (!last && PEN(7)) for (int u = (bid + G - 64) % G; u < 64; u += G) { const int bh = u >> 1; attn_unit(lds, tid, HP, Vt, Abuf, bh >> 2, bh & 3, M_LAT + (bh >> 2) * CTXL + (u & 1) * 128, 64, 68, lam, 1.0f - lam_init, subg); }
            }
        } else if (s == 8 && PEN(1)) {
            lnmod_phase(A, lds, tid, bid, G, false, l, 1, l, 2, false, Mpost, !last, A.in[I_NG] + (l * 3) * DM, A.in[I_NB] + (l * 3) * DM);
        } else if (s == 11 && PEN(1)) {
            lnmod_phase(A, lds, tid, bid, G, false, l, 2, last ? -1 : l + 1, 0, false, Mpost, !last, A.in[I_NG] + (l * 3 + 1) * DM, A.in[I_NB] + (l * 3 + 1) * DM);
            if (!last) convw_phase(A, l + 1, lds, tid, bid, G);
        }
#ifdef PROBE_S
        if ((s == (PROBE_S) || s == (PROBE_S2)) && (PROBE_LASTONLY == 0 || last) && rep_done < PROBE_N) { ++rep_done; --ph; } else rep_done = 0;
#endif
    }
}

extern "C" void kernel_launch(void* const* d_in, const int* in_sizes, int n_in, void* d_out, int out_size, void* d_ws, size_t ws_size, hipStream_t stream) {
    static int grid = 0;
    if (grid == 0) {
        if (n_in != 22 || in_sizes[0] != M_LAT * DM || out_size != M_LAT * DM || ws_size < WS_END) { fprintf(stderr, "kernel_launch: unexpected shapes (n_in %d, out %d, ws %zu)\n", n_in, out_size, ws_size); grid = -1; return; }
        int dev = 0, cus = 0, per_cu = 0;
        hipGetDevice(&dev); hipDeviceGetAttribute(&cus, hipDeviceAttributeMultiprocessorCount, dev);
        if (hipFuncSetAttribute((const void*)mega, hipFuncAttributeMaxDynamicSharedMemorySize, LDS_BYTES) != hipSuccess) { fprintf(stderr, "kernel_launch: hipFuncSetAttribute failed\n"); grid = -1; return; }
        if (hipOccupancyMaxActiveBlocksPerMultiprocessor(&per_cu, (const void*)mega, NTHREADS, LDS_BYTES) != hipSuccess || per_cu < 1) { fprintf(stderr, "kernel_launch: occupancy query says %d\n", per_cu); per_cu = 1; }
        (void)hipGetLastError();
        grid = cus * 1;
    }
    if (grid < 0) return;
    Args a{};
    for (int i = 0; i < 22; ++i) a.in[i] = (const float*)d_in[i];
    a.out = (float*)d_out; a.ws = (unsigned char*)d_ws;
    for (int i = 0; i < 16; ++i) a.afreq[i] = 1.0f / powf(10000.0f, (float)(2 * i) / 32.0f);
    for (int i = 0; i < 32; ++i) a.rfreq[i] = 1.0f / powf(10000.0f, (float)i / 31.0f);
#ifdef MK_MULTI
    for (int ph = 0; ph < NPH; ++ph) { a.ph_lo = ph; a.ph_hi = ph + 1; hipLaunchKernelGGL(mega, dim3(grid), dim3(NTHREADS), LDS_BYTES, stream, a); }
#else
    a.ph_lo = 0; a.ph_hi = NPH;
    void* args[] = {&a};
    hipError_t e = hipLaunchCooperativeKernel((const void*)mega, dim3(grid), dim3(NTHREADS), args, LDS_BYTES, stream);
    if (e != hipSuccess) fprintf(stderr, "cooperative launch failed: %s (grid %d)\n", hipGetErrorString(e), grid);
#endif
}
```
